# Optimizing an MI355X kernel written in HIP

```python
import math
import jax, jax.numpy as jnp
from jax import lax
import numpy as np

D_MODEL = 1024
BATCH = 16
SEQ = 2048
DEPTH = 1

CHUNK = 64
Q_BLOCK = 128
NORM_EPS = 1e-6
NEG_INF = -1e30

DIFF_HEAD_DIM = 64
DIFF_HEADS = D_MODEL // (2 * DIFF_HEAD_DIM)
DIFF_V_DIM = 2 * DIFF_HEAD_DIM
DIFF_ROT_DIM = DIFF_HEAD_DIM // 4
ROPE_THETA = 500000.0

MLA_HEADS = 8
MLA_NOPE_DIM = 64
MLA_ROPE_DIM = 32
MLA_V_DIM = 64
MLA_Q_LORA = 3 * D_MODEL // 8
MLA_KV_LORA = D_MODEL // 4
MLA_ROPE_THETA = 10000.0

FFN_HIDDEN = ((8 * D_MODEL + 3 * 256 - 1) // (3 * 256)) * 256

PLE_DIM = 256

IN_SPLITS = (
    2 * DIFF_HEADS * DIFF_HEAD_DIM,
    2 * DIFF_HEADS * DIFF_HEAD_DIM,
    DIFF_HEADS * DIFF_V_DIM,
    MLA_Q_LORA,
    MLA_KV_LORA,
    MLA_ROPE_DIM,
    D_MODEL,
    D_MODEL,
)
IN_COLS = sum(IN_SPLITS)
IN_SPLIT_POINTS = [int(c) for c in np.cumsum(IN_SPLITS)[:-1]]

kernel_name = "hybrid_diffattn_mla_gated_block"


def rmsnorm(x, g):
    xf = x.astype(jnp.float32)
    y = xf * lax.rsqrt(jnp.mean(xf * xf, axis=-1, keepdims=True) + NORM_EPS)
    return (y * g.astype(jnp.float32)).astype(x.dtype)


def apply_rope(x, rot_dim, theta):
    seq = x.shape[1]
    half = rot_dim // 2
    pos = jnp.arange(seq, dtype=jnp.float32)
    inv_freq = theta ** (-(jnp.arange(0, rot_dim, 2, dtype=jnp.float32) / rot_dim))
    ang = pos[:, None] * inv_freq[None, :]
    cos = jnp.cos(ang)[None, :, None, :]
    sin = jnp.sin(ang)[None, :, None, :]
    xr = x[..., :rot_dim].astype(jnp.float32)
    x1, x2 = xr[..., :half], xr[..., half:]
    rot = jnp.concatenate([x1 * cos - x2 * sin, x2 * cos + x1 * sin], axis=-1).astype(x.dtype)
    return jnp.concatenate([rot, x[..., rot_dim:]], axis=-1)


def chunk_mask(q_start, seq):
    q_chunk = (q_start + jnp.arange(Q_BLOCK)) // CHUNK
    k_chunk = jnp.arange(seq) // CHUNK
    return k_chunk[None, :] <= q_chunk[:, None]


def masked_softmax(scores, mask):
    s = jnp.where(mask, scores.astype(jnp.float32), NEG_INF)
    return jax.nn.softmax(s, axis=-1)


def blocks_to_seq(o):
    nb, b, h, qb, d = o.shape
    return jnp.transpose(o, (1, 0, 3, 2, 4)).reshape(b, nb * qb, h, d)


def diff_attention(q1, q2, k1, k2, v, lam):
    seq = q1.shape[2]
    scale = DIFF_HEAD_DIM ** -0.5

    def block(i):
        s0 = i * Q_BLOCK
        mask = chunk_mask(s0, seq)
        qb1 = lax.dynamic_slice_in_dim(q1, s0, Q_BLOCK, axis=2)
        qb2 = lax.dynamic_slice_in_dim(q2, s0, Q_BLOCK, axis=2)
        a1 = masked_softmax(jnp.einsum('bhqd,bhkd->bhqk', qb1, k1).astype(jnp.float32) * scale, mask)
        a2 = masked_softmax(jnp.einsum('bhqd,bhkd->bhqk', qb2, k2).astype(jnp.float32) * scale, mask)
        w = (a1 - lam * a2).astype(v.dtype)
        return jnp.einsum('bhqk,bhkd->bhqd', w, v)

    return blocks_to_seq(lax.map(block, jnp.arange(seq // Q_BLOCK)))


def mla_attention(q_nope, q_rope, k_nope, k_rope, v):
    seq = q_nope.shape[2]
    scale = (MLA_NOPE_DIM + MLA_ROPE_DIM) ** -0.5

    def block(i):
        s0 = i * Q_BLOCK
        mask = chunk_mask(s0, seq)
        qn = lax.dynamic_slice_in_dim(q_nope, s0, Q_BLOCK, axis=2)
        qr = lax.dynamic_slice_in_dim(q_rope, s0, Q_BLOCK, axis=2)
        s = (jnp.einsum('bhqd,bhkd->bhqk', qn, k_nope).astype(jnp.float32)
             + jnp.einsum('bhqr,bkr->bhqk', qr, k_rope).astype(jnp.float32)) * scale
        a = masked_softmax(s, mask).astype(v.dtype)
        return jnp.einsum('bhqk,bhkd->bhqd', a, v)

    return blocks_to_seq(lax.map(block, jnp.arange(seq // Q_BLOCK)))


def setup_inputs(seed: int = 0) -> dict:
    key = jax.random.key(seed)
    ks = jax.random.split(key, 32)
    f32 = jnp.float32

    def nrm(k, shape, scale):
        return jax.random.normal(k, shape, f32) * scale

    def gain(k, shape):
        return 1.0 + 0.05 * jax.random.normal(k, shape, f32)

    L, D = DEPTH, D_MODEL
    return {
        "x": nrm(ks[0], (BATCH, SEQ, D), 1.0),
        "p": nrm(ks[1], (DEPTH, BATCH, SEQ, PLE_DIM), 1.0),
        "attn_norm": gain(ks[2], (L, D)),
        "w_in": nrm(ks[3], (L, D, IN_COLS), D ** -0.5),
        "b_gate": nrm(ks[4], (L, 2, D), 0.1),
        "lam_q1": nrm(ks[5], (L, DIFF_HEAD_DIM), 0.1),
        "lam_k1": nrm(ks[6], (L, DIFF_HEAD_DIM), 0.1),
        "lam_q2": nrm(ks[7], (L, DIFF_HEAD_DIM), 0.1),
        "lam_k2": nrm(ks[8], (L, DIFF_HEAD_DIM), 0.1),
        "diff_subln": gain(ks[9], (L, DIFF_V_DIM)),
        "w_o_diff": nrm(ks[10], (L, DIFF_HEADS * DIFF_V_DIM, D), (DIFF_HEADS * DIFF_V_DIM) ** -0.5),
        "q_norm": gain(ks[11], (L, MLA_Q_LORA)),
        "w_uq": nrm(ks[12], (L, MLA_Q_LORA, MLA_HEADS * (MLA_NOPE_DIM + MLA_ROPE_DIM)), MLA_Q_LORA ** -0.5),
        "kv_norm": gain(ks[13], (L, MLA_KV_LORA)),
        "w_ukv": nrm(ks[14], (L, MLA_KV_LORA, MLA_HEADS * (MLA_NOPE_DIM + MLA_V_DIM)), MLA_KV_LORA ** -0.5),
        "w_o_mla": nrm(ks[15], (L, MLA_HEADS * MLA_V_DIM, D), (MLA_HEADS * MLA_V_DIM) ** -0.5),
        "w_out": nrm(ks[16], (L, D, D), D ** -0.5),
        "ffn_norm": gain(ks[17], (L, D)),
        "w_ffn_gate": nrm(ks[18], (L, D, FFN_HIDDEN), D ** -0.5),
        "w_ffn_up": nrm(ks[19], (L, D, FFN_HIDDEN), D ** -0.5),
        "w_ffn_down": nrm(ks[20], (L, FFN_HIDDEN, D), FFN_HIDDEN ** -0.5),
        "ple_norm": gain(ks[21], (L, D)),
        "w_ple_gate": nrm(ks[22], (L, D, D), D ** -0.5),
        "b_ple_gate": nrm(ks[23], (L, D), 0.1),
        "w_ple": nrm(ks[24], (L, PLE_DIM, D), PLE_DIM ** -0.5),
        "final_norm": gain(ks[25], (D,)),
    }


def reference(x, p, attn_norm, w_in, b_gate, lam_q1, lam_k1, lam_q2, lam_k2, diff_subln,
              w_o_diff, q_norm, w_uq, kv_norm, w_ukv, w_o_mla, w_out, ffn_norm,
              w_ffn_gate, w_ffn_up, w_ffn_down, ple_norm, w_ple_gate, b_ple_gate, w_ple,
              final_norm):
    B, S, _ = x.shape
    for i in range(DEPTH):
        h = rmsnorm(x, attn_norm[i])
        proj = jnp.einsum('bsd,dc->bsc', h, w_in[i])
        dq, dk, dv, cq, ckv, kr, ga, gb = jnp.split(proj, IN_SPLIT_POINTS, axis=-1)

        dq = apply_rope(dq.reshape(B, S, 2 * DIFF_HEADS, DIFF_HEAD_DIM), DIFF_ROT_DIM, ROPE_THETA)
        dk = apply_rope(dk.reshape(B, S, 2 * DIFF_HEADS, DIFF_HEAD_DIM), DIFF_ROT_DIM, ROPE_THETA)
        dq = jnp.transpose(dq.reshape(B, S, DIFF_HEADS, 2, DIFF_HEAD_DIM), (3, 0, 2, 1, 4))
        dk = jnp.transpose(dk.reshape(B, S, DIFF_HEADS, 2, DIFF_HEAD_DIM), (3, 0, 2, 1, 4))
        dv = jnp.transpose(dv.reshape(B, S, DIFF_HEADS, DIFF_V_DIM), (0, 2, 1, 3))
        lam_init = 0.8 - 0.6 * math.exp(-0.3 * i)
        lam = (jnp.exp(jnp.sum(lam_q1[i].astype(jnp.float32) * lam_k1[i].astype(jnp.float32)))
               - jnp.exp(jnp.sum(lam_q2[i].astype(jnp.float32) * lam_k2[i].astype(jnp.float32)))
               + lam_init)
        od = diff_attention(dq[0], dq[1], dk[0], dk[1], dv, lam)
        od = rmsnorm(od, diff_subln[i]) * (1.0 - lam_init)
        out_a = jnp.einsum('bsc,cd->bsd', od.reshape(B, S, DIFF_HEADS * DIFF_V_DIM), w_o_diff[i])

        q = jnp.einsum('bsr,rc->bsc', rmsnorm(cq, q_norm[i]), w_uq[i])
        q = q.reshape(B, S, MLA_HEADS, MLA_NOPE_DIM + MLA_ROPE_DIM)
        q_nope = jnp.transpose(q[..., :MLA_NOPE_DIM], (0, 2, 1, 3))
        q_rope = jnp.transpose(apply_rope(q[..., MLA_NOPE_DIM:], MLA_ROPE_DIM, MLA_ROPE_THETA), (0, 2, 1, 3))
        kv = jnp.einsum('bsr,rc->bsc', rmsnorm(ckv, kv_norm[i]), w_ukv[i])
        kv = kv.reshape(B, S, MLA_HEADS, MLA_NOPE_DIM + MLA_V_DIM)
        k_nope = jnp.transpose(kv[..., :MLA_NOPE_DIM], (0, 2, 1, 3))
        v_mla = jnp.transpose(kv[..., MLA_NOPE_DIM:], (0, 2, 1, 3))
        k_rope = apply_rope(kr[:, :, None, :], MLA_ROPE_DIM, MLA_ROPE_THETA)[:, :, 0, :]
        om = mla_attention(q_nope, q_rope, k_nope, k_rope, v_mla)
        out_b = jnp.einsum('bsc,cd->bsd', om.reshape(B, S, MLA_HEADS * MLA_V_DIM), w_o_mla[i])

        merged = jax.nn.sigmoid(ga + b_gate[i, 0]) * out_a + jax.nn.sigmoid(gb + b_gate[i, 1]) * out_b
        x = x + jnp.einsum('bsd,de->bse', merged, w_out[i])

        h = rmsnorm(x, ffn_norm[i])
        hid = jax.nn.silu(jnp.einsum('bsd,df->bsf', h, w_ffn_gate[i])) * jnp.einsum('bsd,df->bsf', h, w_ffn_up[i])
        x = x + jnp.einsum('bsf,fd->bsd', hid, w_ffn_down[i])

        h = rmsnorm(x, ple_norm[i])
        gate = jax.nn.sigmoid(jnp.einsum('bsd,de->bse', h, w_ple_gate[i]) + b_ple_gate[i])
        x = x + jnp.einsum('bsp,pd->bsd', p[i], w_ple[i]) * gate

    return rmsnorm(x, final_norm)
```

```cpp
#include <hip/hip_runtime.h>
#include <hip/hip_cooperative_groups.h>
#include <cstdio>
#include <cstdint>
namespace cg = cooperative_groups;

constexpr int M_TOK = 32768, SEQ_LEN = 2048;
constexpr float NEPS = 1e-6f;
constexpr float LOG2E_F = 1.4426950408889634f;
constexpr float QS_D = 0.125f * LOG2E_F;
constexpr float QS_M = 0.10206207261596575f * LOG2E_F;
namespace pg8 {
#define PG8_LAS __attribute__((address_space(3)))
typedef unsigned short bf16_t;
typedef short bf16x8 __attribute__((ext_vector_type(8)));
typedef float f32x4 __attribute__((ext_vector_type(4)));
typedef unsigned u32x4 __attribute__((ext_vector_type(4)));
constexpr int BM = 256, BK = 64, HALF = 128, HTB = HALF * BK * 2  , STAGE_BYTES = 8 * HTB, NXCD = 8, WGM = 8;

__host__ __device__ __forceinline__ int lds_byte(int r, int c) { const int st = (r >> 4) * 2 + (c >> 5), rr = r & 15, cc = c & 31, ob = rr * 64 + cc * 2; return st * 1024 + (ob ^ (((ob >> 9) & 1) << 5)); }
__host__ __device__ __forceinline__ void stage_rc(int b, int& R, int& C) { const int st = b / 1024, sb = b % 1024, swz = sb ^ (((sb >> 9) & 1) << 5); R = (st >> 1) * 16 + swz / 64; C = (st & 1) * 32 + (swz % 64) / 2; }
__host__ __device__ __forceinline__ int perm32(int rho) { const int n = rho >> 4, i = rho & 15; return 8 * (i >> 2) + 4 * n + (i & 3); }

struct Unit { int pm, pn; };
struct Gemm { const bf16_t* A; const bf16_t* Bt; int M, N, K; };

struct StaticOrder {
    int nM, nN, nwg, G, c;
    __host__ __device__ void init(int M, int N, int G_, int c_) { nM = M / BM; nN = N / BM; nwg = nM * nN; G = G_; c = c_; }
    __host__ __device__ bool next(int i, Unit& u) const {
        const long L = (long)i * G + c; if (L >= nwg) return false;
        int wgid = (int)L; { const int q = nwg / NXCD, r = nwg % NXCD, xcd = wgid % NXCD, off = wgid / NXCD; wgid = (xcd < r ? xcd * (q + 1) : r * (q + 1) + (xcd - r) * q) + off; }
        const int nig = WGM * nN, gid = wgid / nig, fm = gid * WGM, gsz = (nM - fm) < WGM ? (nM - fm) : WGM;
        u.pm = fm + ((wgid % nig) % gsz); u.pn = (wgid % nig) / gsz; return true;
    }
    __device__ __forceinline__ void a_ready(const Unit&) const {}
    __device__ __forceinline__ void done(const Unit&) const {}
};

typedef unsigned u32x4 __attribute__((ext_vector_type(4)));
typedef unsigned u32x2 __attribute__((ext_vector_type(2)));
typedef float f32x2 __attribute__((ext_vector_type(2)));
typedef __bf16 bf16x2_t __attribute__((ext_vector_type(2)));
__device__ __forceinline__ unsigned pk2(float lo, float hi) { f32x2 v = {lo, hi}; bf16x2_t b = __builtin_convertvector(v, bf16x2_t); return __builtin_bit_cast(unsigned, b); }
__device__ __forceinline__ void st8(bf16_t* p, f32x4 a, f32x4 b) { u32x4 w; w.x = pk2(a[0], a[1]); w.y = pk2(a[2], a[3]); w.z = pk2(b[0], b[1]); w.w = pk2(b[2], b[3]); *(u32x4*)p = w; }
__device__ __forceinline__ void ld8(const bf16_t* p, f32x4& a, f32x4& b) { const u32x4 w = *(const u32x4*)p;
    a[0] = __uint_as_float(w.x << 16); a[1] = __uint_as_float(w.x & 0xffff0000u); a[2] = __uint_as_float(w.y << 16); a[3] = __uint_as_float(w.y & 0xffff0000u);
    b[0] = __uint_as_float(w.z << 16); b[1] = __uint_as_float(w.z & 0xffff0000u); b[2] = __uint_as_float(w.w << 16); b[3] = __uint_as_float(w.w & 0xffff0000u); }
__device__ __forceinline__ float sigm(float x) { return __builtin_amdgcn_rcpf(1.f + __expf(-x)); }
__device__ __forceinline__ f32x4 sigm4(f32x4 x) { f32x4 o; o[0] = sigm(x[0]); o[1] = sigm(x[1]); o[2] = sigm(x[2]); o[3] = sigm(x[3]); return o; }
__device__ __forceinline__ float quad_sum(float s) { s += __shfl_xor(s, 16); s += __shfl_xor(s, 32); return s; }
__device__ __forceinline__ float sq4(f32x4 v) { return (v[0] * v[0] + v[1] * v[1]) + (v[2] * v[2] + v[3] * v[3]); }
__device__ __forceinline__ f32x4 rope4(f32x4 v, f32x4 t) { f32x4 o; o[0] = v[0] * t[0] - v[1] * t[1]; o[1] = v[1] * t[0] + v[0] * t[1]; o[2] = v[2] * t[2] - v[3] * t[3]; o[3] = v[3] * t[2] + v[2] * t[3]; return o; }
#define EPI_FENCE() asm volatile("" ::: "memory")
#define EPI_LOOP_AM _Pragma("unroll") for (int ai = 0; ai < 2; ++ai) _Pragma("unroll") for (int m = 0; m < 4; ++m)

struct EpiInProj {
    static constexpr bool PERM = true, AFTER_DRAIN = false;
    bf16_t *QD, *KD, *VD, *SA, *SB, *CKV, *CQ, *KR; float *SSQ, *SSKV; const float* bgate; const float* tabD; const float* tabM;
    __device__ __forceinline__ void operator()(const f32x4 (&acc)[2][2][4][2], const Unit& u, int wr, int wc, int fr, int fq) const {
        const int pn = u.pn, rbase = u.pm * BM + wr * 64 + fr, lc = wc * 32 + fq * 8;
        if (pn < 8) {
            bf16_t* dst = (pn < 4 ? QD : KD) + (pn & 3) * 256 + lc; const float sc = pn < 4 ? QS_D : 1.f;
            const bool rp = ((wc & 1) == 0) && (fq < 2);
            EPI_LOOP_AM { const int row = rbase + ai * HALF + m * 16; f32x4 t0 = {1.f, 0.f, 1.f, 0.f}, t1 = t0;
                if (rp) { const f32x4* tp = (const f32x4*)(tabD + ((size_t)(row & (SEQ_LEN - 1)) * 8 + 4 * fq) * 2); t0 = tp[0]; t1 = tp[1]; }
#pragma unroll
                for (int bj = 0; bj < 2; ++bj) st8(dst + (size_t)row * 1024 + bj * HALF, rope4(acc[ai][bj][m][0], t0) * sc, rope4(acc[ai][bj][m][1], t1) * sc);
                EPI_FENCE(); }
        } else if (pn < 12) {
            bf16_t* dst = VD + (pn - 8) * 256 + lc;
            EPI_LOOP_AM { const int row = rbase + ai * HALF + m * 16;
#pragma unroll
                for (int bj = 0; bj < 2; ++bj) st8(dst + (size_t)row * 1024 + bj * HALF, acc[ai][bj][m][0], acc[ai][bj][m][1]); }
        } else if (pn < 20) {
            const int t = (pn - 12) & 3; bf16_t* dst = (pn < 16 ? SA : SB) + t * 256 + lc; const float* bp = bgate + (pn < 16 ? 0 : 1024) + t * 256 + lc;
            f32x4 b[2][2];
#pragma unroll
            for (int bj = 0; bj < 2; ++bj) { b[bj][0] = *(const f32x4*)(bp + bj * HALF); b[bj][1] = *(const f32x4*)(bp + bj * HALF + 4); }
            EPI_LOOP_AM { const int row = rbase + ai * HALF + m * 16;
#pragma unroll
                for (int bj = 0; bj < 2; ++bj) st8(dst + (size_t)row * 1024 + bj * HALF, sigm4(acc[ai][bj][m][0] + b[bj][0]), sigm4(acc[ai][bj][m][1] + b[bj][1])); }
        } else if (pn == 20) {
            EPI_LOOP_AM { const int row = rbase + ai * HALF + m * 16; float s = 0.f;
#pragma unroll
                for (int bj = 0; bj < 2; ++bj) { st8(CKV + (size_t)row * 256 + bj * HALF + lc, acc[ai][bj][m][0], acc[ai][bj][m][1]); s += sq4(acc[ai][bj][m][0]) + sq4(acc[ai][bj][m][1]); }
                s = quad_sum(s); if (fq == 0) SSKV[(size_t)row * 4 + wc] = s; }
        } else if (pn == 21) {
            EPI_LOOP_AM { const int row = rbase + ai * HALF + m * 16; float s = 0.f;
#pragma unroll
                for (int bj = 0; bj < 2; ++bj) { st8(CQ + (size_t)row * 384 + bj * HALF + lc, acc[ai][bj][m][0], acc[ai][bj][m][1]); s += sq4(acc[ai][bj][m][0]) + sq4(acc[ai][bj][m][1]); }
                s = quad_sum(s); if (fq == 0) SSQ[(size_t)row * 8 + wc] = s; }
        } else {
            EPI_LOOP_AM { const int row = rbase + ai * HALF + m * 16;
                st8(CQ + (size_t)row * 384 + 256 + lc, acc[ai][0][m][0], acc[ai][0][m][1]);
                float s = sq4(acc[ai][0][m][0]) + sq4(acc[ai][0][m][1]); s = quad_sum(s); if (fq == 0) SSQ[(size_t)row * 8 + 4 + wc] = s;
                if (wc == 0) { const f32x4* tp = (const f32x4*)(tabM + ((size_t)(row & (SEQ_LEN - 1)) * 16 + 4 * fq) * 2);
                    st8(KR + (size_t)row * 32 + fq * 8, rope4(acc[ai][1][m][0], tp[0]), rope4(acc[ai][1][m][1], tp[1])); }
                EPI_FENCE(); }
        }
    }
};
struct EpiQUp {
    static constexpr bool PERM = true, AFTER_DRAIN = false;
    const float* SSQ; const float* tabM; bf16_t* QM;
    __device__ __forceinline__ void operator()(const f32x4 (&acc)[2][2][4][2], const Unit& u, int wr, int wc, int fr, int fq) const {
        const int rbase = u.pm * BM + wr * 64 + fr, c0 = u.pn * BM + wc * 32 + fq * 8;
        const int hl0 = c0 % 96, hl1 = (c0 + HALF) % 96;
        EPI_LOOP_AM { const int row = rbase + ai * HALF + m * 16;
            const f32x4 s0 = *(const f32x4*)(SSQ + (size_t)row * 8), s1 = *(const f32x4*)(SSQ + (size_t)row * 8 + 4);
            const float rstd = __builtin_amdgcn_rsqf(((s0[0] + s0[1]) + (s0[2] + s0[3]) + (s1[0] + s1[1]) + (s1[2] + s1[3])) * (1.f / 384.f) + NEPS) * QS_M;
            const float* tb = tabM + (size_t)(row & (SEQ_LEN - 1)) * 32;
#pragma unroll
            for (int bj = 0; bj < 2; ++bj) { const int hl = bj ? hl1 : hl0; const bool rp = hl >= 64; const f32x4 id = {1.f, 0.f, 1.f, 0.f};
                const f32x4* tp = (const f32x4*)(tb + (rp ? hl - 64 : 0)); const f32x4 t0 = rp ? tp[0] : id, t1 = rp ? tp[1] : id;
                st8(QM + (size_t)row * 768 + c0 + bj * HALF, rope4(acc[ai][bj][m][0] * rstd, t0), rope4(acc[ai][bj][m][1] * rstd, t1)); EPI_FENCE(); }
            }
    }
};
struct EpiKVUp {
    static constexpr bool PERM = true, AFTER_DRAIN = false;
    const float* SSKV; bf16_t* KVM;
    __device__ __forceinline__ void operator()(const f32x4 (&acc)[2][2][4][2], const Unit& u, int wr, int wc, int fr, int fq) const {
        const int rbase = u.pm * BM + wr * 64 + fr, c0 = u.pn * BM + wc * 32 + fq * 8;
        EPI_LOOP_AM { const int row = rbase + ai * HALF + m * 16;
            const f32x4 s0 = *(const f32x4*)(SSKV + (size_t)row * 4);
            const float rstd = __builtin_amdgcn_rsqf(((s0[0] + s0[1]) + (s0[2] + s0[3])) * (1.f / 256.f) + NEPS);
#pragma unroll
            for (int bj = 0; bj < 2; ++bj) st8(KVM + (size_t)row * 1024 + c0 + bj * HALF, acc[ai][bj][m][0] * rstd, acc[ai][bj][m][1] * rstd);
            EPI_FENCE(); }
    }
};
struct EpiOutA {
    static constexpr bool PERM = true, AFTER_DRAIN = false;
    const bf16_t* SA; float* T;
    __device__ __forceinline__ void operator()(const f32x4 (&acc)[2][2][4][2], const Unit& u, int wr, int wc, int fr, int fq) const {
        const int rbase = u.pm * BM + wr * 64 + fr, c0 = u.pn * BM + wc * 32 + fq * 8;
        EPI_LOOP_AM { const int row = rbase + ai * HALF + m * 16;
#pragma unroll
            for (int bj = 0; bj < 2; ++bj) { const size_t o = (size_t)row * 1024 + c0 + bj * HALF; f32x4 g0, g1; ld8(SA + o, g0, g1);
                *(f32x4*)(T + o) = acc[ai][bj][m][0] * g0; *(f32x4*)(T + o + 4) = acc[ai][bj][m][1] * g1; }
            EPI_FENCE(); }
    }
};
struct EpiOutB {
    static constexpr bool PERM = true, AFTER_DRAIN = false;
    const bf16_t* SB; const float* T; bf16_t* MG;
    __device__ __forceinline__ void operator()(const f32x4 (&acc)[2][2][4][2], const Unit& u, int wr, int wc, int fr, int fq) const {
        const int rbase = u.pm * BM + wr * 64 + fr, c0 = u.pn * BM + wc * 32 + fq * 8;
        EPI_LOOP_AM { const int row = rbase + ai * HALF + m * 16;
#pragma unroll
            for (int bj = 0; bj < 2; ++bj) { const size_t o = (size_t)row * 1024 + c0 + bj * HALF; f32x4 g0, g1; ld8(SB + o, g0, g1);
                const f32x4 t0 = *(const f32x4*)(T + o), t1 = *(const f32x4*)(T + o + 4);
                st8(MG + o, t0 + acc[ai][bj][m][0] * g0, t1 + acc[ai][bj][m][1] * g1); }
            EPI_FENCE(); }
    }
};
struct EpiResid {
    static constexpr bool PERM = true, AFTER_DRAIN = false;
    const float* res; float* xo; bf16_t* xb; float* SS;
    __device__ __forceinline__ void operator()(const f32x4 (&acc)[2][2][4][2], const Unit& u, int wr, int wc, int fr, int fq) const {
        const int rbase = u.pm * BM + wr * 64 + fr, c0 = u.pn * BM + wc * 32 + fq * 8;
        EPI_LOOP_AM { const int row = rbase + ai * HALF + m * 16; float s = 0.f;
#pragma unroll
            for (int bj = 0; bj < 2; ++bj) { const size_t o = (size_t)row * 1024 + c0 + bj * HALF;
                const f32x4 v0 = *(const f32x4*)(res + o) + acc[ai][bj][m][0], v1 = *(const f32x4*)(res + o + 4) + acc[ai][bj][m][1];
                *(f32x4*)(xo + o) = v0; *(f32x4*)(xo + o + 4) = v1; st8(xb + o, v0, v1); s += sq4(v0) + sq4(v1); }
            s = quad_sum(s); if (fq == 0) SS[(size_t)row * 16 + u.pn * 4 + wc] = s;
            EPI_FENCE(); }
    }
};
__device__ __forceinline__ float rstd16(const float* ss) { const f32x4 a = *(const f32x4*)ss, b = *(const f32x4*)(ss + 4), c = *(const f32x4*)(ss + 8), d = *(const f32x4*)(ss + 12);
    const f32x4 t = (a + b) + (c + d); return __builtin_amdgcn_rsqf(((t[0] + t[1]) + (t[2] + t[3])) * (1.f / 1024.f) + NEPS); }
struct EpiSwiGLU {
    static constexpr bool PERM = true, AFTER_DRAIN = false;
    const float* SS; bf16_t* HID;
    __device__ __forceinline__ void operator()(const f32x4 (&acc)[2][2][4][2], const Unit& u, int wr, int wc, int fr, int fq) const {
        const int rbase = u.pm * BM + wr * 64 + fr, c0 = u.pn * HALF + wc * 32 + fq * 8;
        EPI_LOOP_AM { const int row = rbase + ai * HALF + m * 16; const float rstd = rstd16(SS + (size_t)row * 16);
            const f32x4 g0 = acc[ai][0][m][0] * rstd, g1 = acc[ai][0][m][1] * rstd, u0 = acc[ai][1][m][0] * rstd, u1 = acc[ai][1][m][1] * rstd;
            st8(HID + (size_t)row * 2816 + c0, g0 * sigm4(g0) * u0, g1 * sigm4(g1) * u1);
            EPI_FENCE(); }
    }
};
struct EpiPleA {
    static constexpr bool PERM = true, AFTER_DRAIN = false;
    float* T;
    __device__ __forceinline__ void operator()(const f32x4 (&acc)[2][2][4][2], const Unit& u, int wr, int wc, int fr, int fq) const {
        const int rbase = u.pm * BM + wr * 64 + fr, c0 = u.pn * BM + wc * 32 + fq * 8;
        EPI_LOOP_AM { const int row = rbase + ai * HALF + m * 16;
#pragma unroll
            for (int bj = 0; bj < 2; ++bj) { const size_t o = (size_t)row * 1024 + c0 + bj * HALF; *(f32x4*)(T + o) = acc[ai][bj][m][0]; *(f32x4*)(T + o + 4) = acc[ai][bj][m][1]; } }
    }
};
struct EpiPleB {
    static constexpr bool PERM = true, AFTER_DRAIN = false;
    const float* SS2; const float* bias; const float* X2; float* OUT; float* SS3;
    __device__ __forceinline__ void operator()(const f32x4 (&acc)[2][2][4][2], const Unit& u, int wr, int wc, int fr, int fq) const {
        const int rbase = u.pm * BM + wr * 64 + fr, c0 = u.pn * BM + wc * 32 + fq * 8;
        EPI_LOOP_AM { const int row = rbase + ai * HALF + m * 16; const float rstd = rstd16(SS2 + (size_t)row * 16); float s = 0.f; EPI_FENCE();
#pragma unroll
            for (int bj = 0; bj < 2; ++bj) { const size_t o = (size_t)row * 1024 + c0 + bj * HALF;
                const f32x4 b0 = *(const f32x4*)(bias + c0 + bj * HALF), b1 = *(const f32x4*)(bias + c0 + bj * HALF + 4);
                const f32x4 v0 = *(const f32x4*)(X2 + o) + *(const f32x4*)(OUT + o) * sigm4(acc[ai][bj][m][0] * rstd + b0);
                const f32x4 v1 = *(const f32x4*)(X2 + o + 4) + *(const f32x4*)(OUT + o + 4) * sigm4(acc[ai][bj][m][1] * rstd + b1);
                *(f32x4*)(OUT + o) = v0; *(f32x4*)(OUT + o + 4) = v1; s += sq4(v0) + sq4(v1); EPI_FENCE(); }
            s = quad_sum(s); if (fq == 0) SS3[(size_t)row * 16 + u.pn * 4 + wc] = s;
            EPI_FENCE(); }
    }
};
template <class Epi, class Sched, bool ALIGN_EPI = false, bool SP2 = false>
__device__ __forceinline__ void gemm_phase(PG8_LAS unsigned char* lds, const Gemm g, const Sched& S, const Epi& E) {
    int tid_ = threadIdx.x; asm volatile("" : "+v"(tid_)); const int tid = tid_, wid = __builtin_amdgcn_readfirstlane(tid >> 6), lane = tid & 63, wr = wid >> 2, wc = wid & 3, fr = lane & 15, fq = lane >> 4;
    const int K = g.K, nt = K / BK;
    unsigned voffA[2], voffB[2];
#pragma unroll
    for (int i = 0; i < 2; ++i) { int R, C; stage_rc(tid * 16 + i * 8192, R, C); const int Rb = Epi::PERM ? ((R & ~31) + perm32(R & 31)) : R;
        voffA[i] = (unsigned)(R * K + C) * 2u; voffB[i] = (unsigned)(Rb * K + C) * 2u; }
    const size_t kstep = (size_t)(BK * 2);
    const size_t hstep = (size_t)HALF * K * 2;
    const size_t tstep = 2 * hstep;
    const unsigned ldsw = (unsigned)wid * 1024u;
    const int aoff = lds_byte(wr * 64 + fr, fq * 8), boff = lds_byte(wc * 32 + fr, fq * 8);
#define PG8_SA(b, h) (((b) * 2 + (h)) * HTB)
#define PG8_SB(b, h) ((4 + (b) * 2 + (h)) * HTB)
#define PG8_STAGE(bufoff, gbase, voff) do { _Pragma("unroll") for (int _i = 0; _i < 2; ++_i) \
        __builtin_amdgcn_global_load_lds((const unsigned*)((const char*)(gbase) + (voff)[_i]), (PG8_LAS unsigned*)(lds + (bufoff) + ldsw + _i * 8192), 16, 0, 0); } while (0)
#define PG8_LDA(dst, b, h) do { _Pragma("unroll") for (int m = 0; m < 4; ++m) _Pragma("unroll") for (int k = 0; k < 2; ++k) dst[m][k] = *(const PG8_LAS bf16x8*)(lds + PG8_SA(b, h) + aoff + m * 2048 + k * 1024); } while (0)
#define PG8_LDB(dst, b, h) do { _Pragma("unroll") for (int n = 0; n < 2; ++n) _Pragma("unroll") for (int k = 0; k < 2; ++k) dst[n][k] = *(const PG8_LAS bf16x8*)(lds + PG8_SB(b, h) + boff + n * 2048 + k * 1024); } while (0)
#define PG8_MMA(ai, bj, At, Bt) do { __builtin_amdgcn_s_setprio(1); _Pragma("unroll") for (int m = 0; m < 4; ++m) _Pragma("unroll") for (int n = 0; n < 2; ++n) _Pragma("unroll") for (int k = 0; k < 2; ++k) \
        acc[ai][bj][m][n] = __builtin_amdgcn_mfma_f32_16x16x32_bf16(Bt[n][k], At[m][k], acc[ai][bj][m][n], 0, 0, 0); __builtin_amdgcn_s_setprio(0); } while (0)
#define PG8_WAIT_V(n) asm volatile("s_waitcnt vmcnt(" #n ")" ::: "memory")
#define PG8_WAIT_L(n) asm volatile("s_waitcnt lgkmcnt(" #n ")" ::: "memory")
#define PG8_BAR __builtin_amdgcn_s_barrier()
#define PG8_SCHED __builtin_amdgcn_sched_barrier(0)
    Unit cur, nxt; int ui = 0;
    if (!S.next(0, cur)) return;
    f32x4 acc[2][2][4][2];
#pragma unroll
    for (int a = 0; a < 2; ++a)
#pragma unroll
        for (int b = 0; b < 2; ++b)
#pragma unroll
            for (int m = 0; m < 4; ++m)
#pragma unroll
                for (int n = 0; n < 2; ++n) acc[a][b][m][n] = (f32x4){0.f, 0.f, 0.f, 0.f};
    bf16x8 At[4][2], B0[2][2], B1[2][2];
    const char* cA = (const char*)g.A + (size_t)cur.pm * tstep; const char* cB = (const char*)g.Bt + (size_t)cur.pn * tstep;
    S.a_ready(cur);
    if constexpr (SP2) {
        PG8_STAGE(PG8_SB(0, 0), cB, voffB); PG8_STAGE(PG8_SB(0, 1), cB + hstep, voffB); PG8_STAGE(PG8_SA(0, 0), cA, voffA); PG8_STAGE(PG8_SA(0, 1), cA + hstep, voffA);
        if (wr == 1) PG8_BAR;
        PG8_WAIT_V(2); PG8_BAR;
        PG8_STAGE(PG8_SB(1, 0), cB + kstep, voffB); PG8_STAGE(PG8_SA(1, 0), cA + kstep, voffA); PG8_STAGE(PG8_SB(1, 1), cB + hstep + kstep, voffB);
        PG8_WAIT_V(6); PG8_BAR;
    } else {
        PG8_STAGE(PG8_SB(0, 0), cB, voffB); PG8_STAGE(PG8_SA(0, 0), cA, voffA); PG8_STAGE(PG8_SB(0, 1), cB + hstep, voffB); PG8_STAGE(PG8_SA(0, 1), cA + hstep, voffA);
        if (wr == 1) PG8_BAR;
        PG8_WAIT_V(4); PG8_BAR;
        PG8_STAGE(PG8_SB(1, 0), cB + kstep, voffB); PG8_STAGE(PG8_SA(1, 0), cA + kstep, voffA); PG8_STAGE(PG8_SB(1, 1), cB + hstep + kstep, voffB);
        PG8_WAIT_V(6); PG8_BAR;
    }
    for (;;) {
        const bool has_next = S.next(ui + 1, nxt);
        const char* nA = has_next ? (const char*)g.A + (size_t)nxt.pm * tstep : cA; const char* nB = has_next ? (const char*)g.Bt + (size_t)nxt.pn * tstep : cB;
        for (int t = 0; t < nt; t += 2) {
            const bool last = (t == nt - 2);
            const char* a1 = cA + (size_t)(t + 1) * kstep;
            const char* a2 = last ? nA : cA + (size_t)(t + 2) * kstep; const char* b2 = last ? nB : cB + (size_t)(t + 2) * kstep;
            const char* a3 = a2 + kstep; const char* b3 = b2 + kstep;
            if (last && has_next) S.a_ready(nxt);
            if constexpr (SP2) {
            PG8_LDB(B0, 0, 0); PG8_LDB(B1, 0, 1); PG8_SCHED; PG8_LDA(At, 0, 0); PG8_STAGE(PG8_SA(1, 1), a1 + hstep, voffA);
            PG8_WAIT_V(8); PG8_WAIT_L(0); PG8_BAR; PG8_MMA(0, 0, At, B0); PG8_MMA(0, 1, At, B1); PG8_BAR; PG8_SCHED;
            PG8_LDA(At, 0, 1); PG8_STAGE(PG8_SB(0, 0), b2, voffB); PG8_STAGE(PG8_SB(0, 1), b2 + hstep, voffB); PG8_STAGE(PG8_SA(0, 0), a2, voffA);
            PG8_WAIT_V(8); PG8_WAIT_L(0); PG8_BAR; PG8_MMA(1, 0, At, B0); PG8_MMA(1, 1, At, B1); PG8_BAR; PG8_SCHED;
            PG8_LDB(B0, 1, 0); PG8_LDB(B1, 1, 1); PG8_SCHED; PG8_LDA(At, 1, 0); PG8_STAGE(PG8_SA(0, 1), a2 + hstep, voffA);
            PG8_WAIT_V(8); PG8_WAIT_L(0); PG8_BAR; PG8_MMA(0, 0, At, B0); PG8_MMA(0, 1, At, B1); PG8_BAR; PG8_SCHED;
            PG8_LDA(At, 1, 1); PG8_STAGE(PG8_SB(1, 0), b3, voffB); PG8_STAGE(PG8_SB(1, 1), b3 + hstep, voffB); PG8_STAGE(PG8_SA(1, 0), a3, voffA);
            PG8_WAIT_V(8); PG8_WAIT_L(0); PG8_BAR; PG8_MMA(1, 0, At, B0); PG8_MMA(1, 1, At, B1); PG8_BAR; PG8_SCHED;
            } else {
            PG8_LDB(B0, 0, 0); PG8_SCHED; PG8_LDA(At, 0, 0); PG8_STAGE(PG8_SA(1, 1), a1 + hstep, voffA);
            PG8_WAIT_L(8); PG8_BAR; PG8_WAIT_L(0); PG8_MMA(0, 0, At, B0); PG8_BAR; PG8_SCHED;
            PG8_LDB(B1, 0, 1); PG8_STAGE(PG8_SB(0, 0), b2, voffB);
            PG8_BAR; PG8_WAIT_L(0); PG8_MMA(0, 1, At, B1); PG8_BAR;
            PG8_LDA(At, 0, 1); PG8_STAGE(PG8_SA(0, 0), a2, voffA);
            PG8_BAR; PG8_WAIT_L(0); PG8_MMA(1, 0, At, B0); PG8_BAR; PG8_SCHED;
            PG8_STAGE(PG8_SB(0, 1), b2 + hstep, voffB);
            PG8_WAIT_V(6); PG8_BAR; PG8_MMA(1, 1, At, B1); PG8_BAR;
            PG8_LDB(B0, 1, 0); PG8_SCHED; PG8_LDA(At, 1, 0); PG8_STAGE(PG8_SA(0, 1), a2 + hstep, voffA);
            PG8_WAIT_L(8); PG8_BAR; PG8_WAIT_L(0); PG8_MMA(0, 0, At, B0); PG8_BAR; PG8_SCHED;
            PG8_LDB(B1, 1, 1); PG8_STAGE(PG8_SB(1, 0), b3, voffB);
            PG8_BAR; PG8_WAIT_L(0); PG8_MMA(0, 1, At, B1); PG8_BAR;
            PG8_LDA(At, 1, 1); PG8_STAGE(PG8_SA(1, 0), a3, voffA);
            PG8_BAR; PG8_WAIT_L(0); PG8_MMA(1, 0, At, B0); PG8_BAR; PG8_SCHED;
            PG8_STAGE(PG8_SB(1, 1), b3 + hstep, voffB);
            PG8_WAIT_V(6); PG8_BAR; PG8_MMA(1, 1, At, B1); PG8_BAR;
            }
        }
        if constexpr (ALIGN_EPI) { if (wr == 0) PG8_BAR; }
        if constexpr (!Epi::AFTER_DRAIN) { E(acc, cur, wr, wc, fr, fq); S.done(cur); }
        if (!has_next) break;
#pragma unroll
        for (int a = 0; a < 2; ++a)
#pragma unroll
            for (int b = 0; b < 2; ++b)
#pragma unroll
                for (int m = 0; m < 4; ++m)
#pragma unroll
                    for (int n = 0; n < 2; ++n) acc[a][b][m][n] = (f32x4){0.f, 0.f, 0.f, 0.f};
        cur = nxt; cA = nA; cB = nB; ++ui;
        if constexpr (ALIGN_EPI) { if (wr == 1) PG8_BAR; }
    }
    PG8_WAIT_V(0);
    if constexpr (!ALIGN_EPI) { if (wr == 0) PG8_BAR; }
    PG8_BAR;
    if constexpr (Epi::AFTER_DRAIN) { E.fused(acc, cur, wr, wc, fr, fq, lds, wid, lane); S.done(cur); }
#undef PG8_SA
#undef PG8_SB
#undef PG8_STAGE
#undef PG8_LDA
#undef PG8_LDB
#undef PG8_MMA
#undef PG8_WAIT_V
#undef PG8_WAIT_L
#undef PG8_BAR
#undef PG8_SCHED
}
}
namespace att {
#define ATT_LAS __attribute__((address_space(3)))
typedef unsigned short bf16_t;
typedef short bf16x8 __attribute__((ext_vector_type(8)));
typedef short s16x4 __attribute__((ext_vector_type(4)));
typedef float f32x16 __attribute__((ext_vector_type(16)));
typedef float f32x4 __attribute__((ext_vector_type(4)));
typedef unsigned u32x4 __attribute__((ext_vector_type(4)));
typedef unsigned u32x2 __attribute__((ext_vector_type(2)));
constexpr int KB0 = 0, KBSZ = 12288, VB0 = 24576, VBSZ = 16384;
__device__ __forceinline__ float swap_max(float m) { auto rr = __builtin_amdgcn_permlane32_swap(__float_as_uint(m), __float_as_uint(m), false, false); return fmaxf(__uint_as_float(rr[0]), __uint_as_float(rr[1])); }
__device__ __forceinline__ float swap_sum(float m) { auto rr = __builtin_amdgcn_permlane32_swap(__float_as_uint(m), __float_as_uint(m), false, false); return __uint_as_float(rr[0]) + __uint_as_float(rr[1]); }
__device__ __forceinline__ s16x4 vtr(const ATT_LAS char* p) { return __builtin_bit_cast(s16x4, __builtin_amdgcn_ds_read_tr16_b64_v4i16((ATT_LAS s16x4*)p)); }
__device__ __forceinline__ int crow(int r, int hi) { return (r & 3) + 8 * (r >> 2) + 4 * hi; }

template <int DQK, int DV, bool MLA>
__device__ __forceinline__ void attn_pass(ATT_LAS char* lds, const bf16_t* qp, const bf16_t* kg, const bf16_t* krg, const bf16_t* vg, int NT, int myNT, f32x16 (&o)[DV / 32], float& linv) {
    int tid_ = threadIdx.x; asm volatile("" : "+v"(tid_)); const int tid = tid_, lane = tid & 63, wid = __builtin_amdgcn_readfirstlane(tid >> 6), r32 = lane & 31, hi = lane >> 5;
    bf16x8 qr[DQK / 16];
#pragma unroll
    for (int d0 = 0; d0 < DQK / 16; ++d0) qr[d0] = *(const bf16x8*)(qp + d0 * 16);
    const bf16_t* ksrc = kg + (size_t)lane * 1024 + wid * 8;
    const bf16_t* krsrc = krg + (size_t)lane * 32 + (wid & 3) * 8;
    const bf16_t* vsrc = vg + (size_t)(16 * (wid & 3) + (lane >> 2)) * 1024 + (wid >> 2) * 32 + (lane & 3) * 8;
    const int sto = wid * 1024 + lane * 16;
    u32x4 kr0 = {0u, 0u, 0u, 0u}, kr1 = kr0, vr0 = kr0, vr1 = kr0;
#define ATT_LOAD(t) do { kr0 = *(const u32x4*)(ksrc + (size_t)(t) * 65536); if (MLA) { if (wid < 4) kr1 = *(const u32x4*)(krsrc + (size_t)(t) * 2048); } \
        vr0 = *(const u32x4*)(vsrc + (size_t)(t) * 65536); if (DV == 128) vr1 = *(const u32x4*)(vsrc + (size_t)(t) * 65536 + 64); } while (0)
#define ATT_STORE(b) do { *(ATT_LAS u32x4*)(lds + KB0 + (b) * KBSZ + sto) = kr0; if (MLA) { if (wid < 4) *(ATT_LAS u32x4*)(lds + KB0 + (b) * KBSZ + 8192 + sto) = kr1; } \
        *(ATT_LAS u32x4*)(lds + VB0 + (b) * VBSZ + sto) = vr0; if (DV == 128) *(ATT_LAS u32x4*)(lds + VB0 + (b) * VBSZ + 8192 + sto) = vr1; } while (0)
#pragma unroll
    for (int i = 0; i < DV / 32; ++i)
#pragma unroll
        for (int r = 0; r < 16; ++r) o[i][r] = 0.f;
    float mref = -1e30f, lsum = 0.f;
    ATT_LOAD(0); ATT_STORE(0); __syncthreads();
    for (int t = 0; t < NT; ++t) {
        const int b = t & 1;
        if (t + 1 < NT) ATT_LOAD(t + 1);
        if (t < myNT) {
            const ATT_LAS char* kp = lds + KB0 + b * KBSZ + hi * 1024 + r32 * 16;
            f32x16 p0, p1;
#pragma unroll
            for (int r = 0; r < 16; ++r) { p0[r] = 0.f; p1[r] = 0.f; }
#pragma unroll
            for (int d0 = 0; d0 < DQK / 16; ++d0) {
                const bf16x8 k0 = *(const ATT_LAS bf16x8*)(kp + d0 * 2048), k1 = *(const ATT_LAS bf16x8*)(kp + d0 * 2048 + 512);
                p0 = __builtin_amdgcn_mfma_f32_32x32x16_bf16(k0, qr[d0], p0, 0, 0, 0);
                p1 = __builtin_amdgcn_mfma_f32_32x32x16_bf16(k1, qr[d0], p1, 0, 0, 0);
            }
            float mx = fmaxf(p0[0], p1[0]);
#pragma unroll
            for (int r = 1; r < 16; ++r) mx = fmaxf(mx, fmaxf(p0[r], p1[r]));
            mx = swap_max(mx);
            if (__any(mx > mref + 8.f)) {
                const float mn = fmaxf(mref, mx), al = __builtin_amdgcn_exp2f(mref - mn);
                lsum *= al;
#pragma unroll
                for (int i = 0; i < DV / 32; ++i)
#pragma unroll
                    for (int r = 0; r < 16; ++r) o[i][r] *= al;
                mref = mn;
            }
            float ls = 0.f;
#pragma unroll
            for (int r = 0; r < 16; ++r) { p0[r] = __builtin_amdgcn_exp2f(p0[r] - mref); p1[r] = __builtin_amdgcn_exp2f(p1[r] - mref); ls += p0[r] + p1[r]; }
            lsum += ls;
            u32x4 pw[4];
#pragma unroll
            for (int j = 0; j < 4; ++j) { pw[0][j] = pg8::pk2(p0[2 * j], p0[2 * j + 1]); pw[1][j] = pg8::pk2(p0[8 + 2 * j], p0[9 + 2 * j]); pw[2][j] = pg8::pk2(p1[2 * j], p1[2 * j + 1]); pw[3][j] = pg8::pk2(p1[8 + 2 * j], p1[9 + 2 * j]); }
            const ATT_LAS char* vp = lds + VB0 + b * VBSZ + ((lane >> 4) & 1) * 32 + (lane & 3) * 8 + (4 * hi + ((lane & 15) >> 2)) * 64;
#pragma unroll
            for (int i = 0; i < DV / 32; ++i)
#pragma unroll
                for (int ks = 0; ks < 4; ++ks) {
                    const s16x4 lo = vtr(vp + i * 4096 + ks * 1024), hh = vtr(vp + i * 4096 + ks * 1024 + 512);
                    const bf16x8 vf = {lo[0], lo[1], lo[2], lo[3], hh[0], hh[1], hh[2], hh[3]};
                    o[i] = __builtin_amdgcn_mfma_f32_32x32x16_bf16(vf, __builtin_bit_cast(bf16x8, pw[ks]), o[i], 0, 0, 0);
                }
        }
        if (t + 1 < NT) ATT_STORE(b ^ 1);
        __syncthreads();
    }
    linv = __builtin_amdgcn_rcpf(swap_sum(lsum));
#undef ATT_LOAD
#undef ATT_STORE
}

__device__ __forceinline__ void diff_unit(ATT_LAS char* lds, int b, int h, int qb, const bf16_t* QD, const bf16_t* KD, const bf16_t* VD, bf16_t* OD, const float* subln, float lam) {
    int tid_ = threadIdx.x; asm volatile("" : "+v"(tid_)); const int tid = tid_, lane = tid & 63, wid = __builtin_amdgcn_readfirstlane(tid >> 6), r32 = lane & 31, hi = lane >> 5;
    const size_t row0 = (size_t)b * SEQ_LEN, qrow = row0 + qb * 256 + wid * 32 + r32;
    const int NT = 4 * qb + 4, myNT = 4 * qb + (wid >> 1) + 1;
    f32x16 o1[4], o2[4]; float li1, li2;
    attn_pass<64, 128, false>(lds, QD + qrow * 1024 + (2 * h) * 64 + hi * 8, KD + row0 * 1024 + (2 * h) * 64, nullptr, VD + row0 * 1024 + h * 128, NT, myNT, o1, li1);
    attn_pass<64, 128, false>(lds, QD + qrow * 1024 + (2 * h + 1) * 64 + hi * 8, KD + row0 * 1024 + (2 * h + 1) * 64, nullptr, VD + row0 * 1024 + h * 128, NT, myNT, o2, li2);
    const float c2 = lam * li2; float ss = 0.f;
#pragma unroll
    for (int i = 0; i < 4; ++i)
#pragma unroll
        for (int r = 0; r < 16; ++r) { const float v = o1[i][r] * li1 - o2[i][r] * c2; o1[i][r] = v; ss += v * v; }
    ss = swap_sum(ss);
    const float rstd = __builtin_amdgcn_rsqf(ss * (1.f / 128.f) + NEPS) * 0.8f;
    bf16_t* op = OD + qrow * 1024 + h * 128 + 4 * hi;
#pragma unroll
    for (int i = 0; i < 4; ++i)
#pragma unroll
        for (int rq = 0; rq < 4; ++rq) { const int dv = 32 * i + 8 * rq; const f32x4 g = *(const f32x4*)(subln + dv + 4 * hi);
            u32x2 w; w.x = pg8::pk2(o1[i][4 * rq] * rstd * g[0], o1[i][4 * rq + 1] * rstd * g[1]); w.y = pg8::pk2(o1[i][4 * rq + 2] * rstd * g[2], o1[i][4 * rq + 3] * rstd * g[3]);
            *(u32x2*)(op + dv) = w; }
}
__device__ __forceinline__ void mla_unit(ATT_LAS char* lds, int b, int h, int qb, const bf16_t* QM, const bf16_t* KVM, const bf16_t* KR, bf16_t* OM) {
    int tid_ = threadIdx.x; asm volatile("" : "+v"(tid_)); const int tid = tid_, lane = tid & 63, wid = __builtin_amdgcn_readfirstlane(tid >> 6), r32 = lane & 31, hi = lane >> 5;
    const size_t row0 = (size_t)b * SEQ_LEN, qrow = row0 + qb * 256 + wid * 32 + r32;
    const int NT = 4 * qb + 4, myNT = 4 * qb + (wid >> 1) + 1;
    f32x16 o[2]; float li;
    attn_pass<96, 64, true>(lds, QM + qrow * 768 + h * 96 + hi * 8, KVM + row0 * 1024 + h * 128, KR + row0 * 32, KVM + row0 * 1024 + h * 128 + 64, NT, myNT, o, li);
    bf16_t* op = OM + qrow * 512 + h * 64 + 4 * hi;
#pragma unroll
    for (int i = 0; i < 2; ++i)
#pragma unroll
        for (int rq = 0; rq < 4; ++rq) { const int dv = 32 * i + 8 * rq;
            u32x2 w; w.x = pg8::pk2(o[i][4 * rq] * li, o[i][4 * rq + 1] * li); w.y = pg8::pk2(o[i][4 * rq + 2] * li, o[i][4 * rq + 3] * li);
            *(u32x2*)(op + dv) = w; }
}
}
#define LAS __attribute__((address_space(3)))
typedef unsigned short bf16;
typedef float f32x4 __attribute__((ext_vector_type(4)));
typedef unsigned v4u __attribute__((ext_vector_type(4)));
typedef unsigned v2u __attribute__((ext_vector_type(2)));
constexpr int NWAVES = 8, LDS_BYTES = 147456;
constexpr size_t MiB = 1ull << 20;
constexpr size_t WS_TABD = 0, WS_TABM = 128 * 1024, WS_LAM = 384 * 1024;
constexpr size_t WS_SSQ = 1 * MiB, WS_SSKV = 2 * MiB, WS_SS1 = 3 * MiB, WS_SS2 = 5 * MiB, WS_SS3 = 7 * MiB;
constexpr size_t WS_WIN = 10 * MiB, WS_WGU = WS_WIN + 5888ull * 1024 * 2, WS_WDN = WS_WGU + 5632ull * 1024 * 2, WS_WOD = WS_WDN + 1024ull * 2816 * 2, WS_WOUT = WS_WOD + 2 * MiB,
                 WS_WPG = WS_WOUT + 2 * MiB, WS_WOM = WS_WPG + 2 * MiB, WS_WUQ = WS_WOM + 1 * MiB, WS_WUKV = WS_WUQ + 768ull * 384 * 2, WS_WPLE = WS_WUKV + 1024ull * 256 * 2, WS_WEND = WS_WPLE + 1024ull * 256 * 2;
static_assert(WS_WEND <= 47 * MiB, "weights");
constexpr size_t WS_PB = 47 * MiB;
constexpr size_t WS_XN = 64 * MiB, WS_QM = 64 * MiB, WS_X1B = 64 * MiB;
constexpr size_t WS_QD = 128 * MiB, WS_KD = 192 * MiB, WS_VD = 256 * MiB, WS_KVM = 320 * MiB;
constexpr size_t WS_T = 192 * MiB, WS_MG = 320 * MiB;
constexpr size_t WS_HID = 128 * MiB, WS_X2B = 304 * MiB;
constexpr size_t WS_XR = 384 * MiB;
constexpr size_t WS_CKV = 384 * MiB, WS_CQ = 400 * MiB, WS_KR = 424 * MiB, WS_OM = 426 * MiB;
constexpr size_t WS_END = 512 * MiB;

struct Args {
    const float *x, *p, *attn_norm, *w_in, *b_gate, *lam_q1, *lam_k1, *lam_q2, *lam_k2, *diff_subln, *w_o_diff, *q_norm, *w_uq, *kv_norm, *w_ukv, *w_o_mla, *w_out, *ffn_norm,
        *w_ffn_gate, *w_ffn_up, *w_ffn_down, *ple_norm, *w_ple_gate, *b_ple_gate, *w_ple, *final_norm;
    float* out; unsigned char* ws;
};

__device__ __forceinline__ float wave_sum(float v) {
#pragma unroll
    for (int o = 1; o < 64; o <<= 1) v += __shfl_xor(v, o);
    return v;
}
__device__ __forceinline__ void wprep_item(int kind, const float* W, const float* W2, int ld, int K, int Nout, const float* gain, bf16* WT, int item, LAS float* scr, int lane) {
    const int nnb = Nout / 64, kb = item / nnb, nb = item % nnb, k0 = kb * 64, n0 = nb * 64, n = n0 + lane;
    const float* base = W; int col = n;
    if (kind == 1) {
        if (n < 2048) { const int hl = n & 63; col = (n & ~63) + (hl < 16 ? ((hl & 1) ? (hl >> 1) + 8 : (hl >> 1)) : hl); }
        else if (n < 3072) col = n;
        else if (n < 5120) col = 3744 + (n - 3072);
        else if (n < 5376) col = 3456 + (n - 5120);
        else if (n < 5760) col = 3072 + (n - 5376);
        else if (n < 5792) { const int hl = n - 5760; col = 3712 + ((hl & 1) ? (hl >> 1) + 16 : (hl >> 1)); }
        else col = -1;
    } else if (kind == 2) { const int h = n / 96, hl = n % 96; int s = hl; if (hl >= 64) { const int r = hl - 64; s = 64 + ((r & 1) ? (r >> 1) + 16 : (r >> 1)); } col = h * 96 + s;
    } else if (kind == 3) { const int pn = n >> 8, r = n & 255; if (r < 128) col = pn * 128 + r; else { base = W2; col = pn * 128 + (r - 128); } }
#pragma unroll 8
    for (int kk = 0; kk < 64; ++kk) { float v = (col >= 0) ? base[(size_t)(k0 + kk) * ld + col] : 0.f; if (gain) v *= gain[k0 + kk]; scr[kk * 65 + lane] = v; }
    asm volatile("s_waitcnt lgkmcnt(0)" ::: "memory");
    const int c = lane & 7;
#pragma unroll
    for (int j = 0; j < 8; ++j) { const int nn = (lane >> 3) + 8 * j; const LAS float* s = scr + (8 * c) * 65 + nn;
        v4u o; o.x = pg8::pk2(s[0], s[65]); o.y = pg8::pk2(s[2 * 65], s[3 * 65]); o.z = pg8::pk2(s[4 * 65], s[5 * 65]); o.w = pg8::pk2(s[6 * 65], s[7 * 65]);
        *(v4u*)(WT + (size_t)(n0 + nn) * K + k0 + 8 * c) = o; }
    asm volatile("s_waitcnt lgkmcnt(0)" ::: "memory");
}


#define WSP(T, off) ((T*)(a.ws + (off)))
#define tabD WSP(float, WS_TABD)
#define tabM WSP(float, WS_TABM)
#define lamp WSP(float, WS_LAM)
#define SSQ WSP(float, WS_SSQ)
#define SSKV WSP(float, WS_SSKV)
#define SS1 WSP(float, WS_SS1)
#define SS2 WSP(float, WS_SS2)
#define SS3 WSP(float, WS_SS3)
#define Win WSP(bf16, WS_WIN)
#define Wgu WSP(bf16, WS_WGU)
#define Wdn WSP(bf16, WS_WDN)
#define Wod WSP(bf16, WS_WOD)
#define Wout WSP(bf16, WS_WOUT)
#define Wpg WSP(bf16, WS_WPG)
#define Wom WSP(bf16, WS_WOM)
#define Wuq WSP(bf16, WS_WUQ)
#define Wukv WSP(bf16, WS_WUKV)
#define Wple WSP(bf16, WS_WPLE)
#define PB WSP(bf16, WS_PB)
#define XN WSP(bf16, WS_XN)
#define QM WSP(bf16, WS_QM)
#define X1B WSP(bf16, WS_X1B)
#define QD WSP(bf16, WS_QD)
#define KD WSP(bf16, WS_KD)
#define VD WSP(bf16, WS_VD)
#define KVM WSP(bf16, WS_KVM)
#define MG WSP(bf16, WS_MG)
#define HID WSP(bf16, WS_HID)
#define X2B WSP(bf16, WS_X2B)
#define CKV WSP(bf16, WS_CKV)
#define CQ WSP(bf16, WS_CQ)
#define KR WSP(bf16, WS_KR)
#define OM WSP(bf16, WS_OM)
#define TBUF WSP(float, WS_T)
#define XR WSP(float, WS_XR)
#define SA ((bf16*)a.out)
#define SB ((bf16*)a.out + (size_t)M_TOK * 1024)
template <class E> __device__ __forceinline__ void run_gemm(LAS unsigned char* lds, const bf16* A, const bf16* Bt, int N, int K, const E& e) {
    asm volatile("" : "+s"(K));
    pg8::Gemm g{A, Bt, M_TOK, N, K}; pg8::StaticOrder S; S.init(M_TOK, N, (int)gridDim.x, (int)blockIdx.x);
    pg8::gemm_phase<E, pg8::StaticOrder, true, true>(lds, g, S, e);
}

__global__ void __launch_bounds__(NWAVES * 64, 2) fwd_megakernel(Args a) {
    extern __shared__ __attribute__((aligned(16))) unsigned char lds_raw[];
    cg::grid_group grid = cg::this_grid();
    LAS unsigned char* lds = (LAS unsigned char*)lds_raw;
    int tid0_ = threadIdx.x; asm volatile("" : "+v"(tid0_)); const int tid = tid0_, lane = tid & 63, wave = __builtin_amdgcn_readfirstlane(tid >> 6);
    const int G = gridDim.x, gw = blockIdx.x * NWAVES + wave, NGW = G * NWAVES;
#if !defined(SKIP_P0)
    {
        LAS float* scr = (LAS float*)(lds + wave * 16640);
        constexpr int I0 = 16 * 92, I1 = I0 + 16 * 88, I2 = I1 + 44 * 16, I3 = I2 + 256, I4 = I3 + 256, I5 = I4 + 256, I6 = I5 + 128, I7 = I6 + 72, I8 = I7 + 64, I9 = I8 + 64;
        for (int it = gw; it < I9; it += NGW) {
            if (it < I0)      wprep_item(1, a.w_in, nullptr, 5792, 1024, 5888, nullptr, Win, it, scr, lane);
            else if (it < I1) wprep_item(3, a.w_ffn_gate, a.w_ffn_up, 2816, 1024, 5632, a.ffn_norm, Wgu, it - I0, scr, lane);
            else if (it < I2) wprep_item(0, a.w_ffn_down, nullptr, 1024, 2816, 1024, nullptr, Wdn, it - I1, scr, lane);
            else if (it < I3) wprep_item(0, a.w_o_diff, nullptr, 1024, 1024, 1024, nullptr, Wod, it - I2, scr, lane);
            else if (it < I4) wprep_item(0, a.w_out, nullptr, 1024, 1024, 1024, nullptr, Wout, it - I3, scr, lane);
            else if (it < I5) wprep_item(0, a.w_ple_gate, nullptr, 1024, 1024, 1024, a.ple_norm, Wpg, it - I4, scr, lane);
            else if (it < I6) wprep_item(0, a.w_o_mla, nullptr, 1024, 512, 1024, nullptr, Wom, it - I5, scr, lane);
            else if (it < I7) wprep_item(2, a.w_uq, nullptr, 768, 384, 768, a.q_norm, Wuq, it - I6, scr, lane);
            else if (it < I8) wprep_item(0, a.w_ukv, nullptr, 1024, 256, 1024, a.kv_norm, Wukv, it - I7, scr, lane);
            else              wprep_item(0, a.w_ple, nullptr, 1024, 256, 1024, nullptr, Wple, it - I8, scr, lane);
        }
        for (int r = gw; r < M_TOK; r += NGW) {
            const f32x4* xr = (const f32x4*)(a.x + (size_t)r * 1024) + lane; f32x4 v[4]; float s = 0.f;
#pragma unroll
            for (int j = 0; j < 4; ++j) { v[j] = xr[64 * j]; s += pg8::sq4(v[j]); }
            const float rstd = __builtin_amdgcn_rsqf(wave_sum(s) * (1.f / 1024.f) + NEPS);
            v2u* o8 = (v2u*)(XN + (size_t)r * 1024) + lane;
#pragma unroll
            for (int j = 0; j < 4; ++j) { const f32x4 g = ((const f32x4*)a.attn_norm)[lane + 64 * j]; const f32x4 y = v[j] * rstd * g; v2u w; w.x = pg8::pk2(y[0], y[1]); w.y = pg8::pk2(y[2], y[3]); o8[64 * j] = w; }
        }
        { const int gt = blockIdx.x * 512 + tid, GT = G * 512;
          for (int i = gt; i < M_TOK * 256 / 8; i += GT) { const f32x4 p0 = ((const f32x4*)a.p)[2 * i], p1 = ((const f32x4*)a.p)[2 * i + 1]; pg8::st8(PB + (size_t)i * 8, p0, p1); }
          for (int i = gt; i < 2048 * 24; i += GT) {
              const int pos = i / 24, f = i % 24; const bool dm = f < 8; const int fi = dm ? f : f - 8;
              const float invf = dm ? __builtin_amdgcn_exp2f(-18.931568569324174f * (float)fi * 0.125f) : __builtin_amdgcn_exp2f(-13.287712379549449f * (float)fi * 0.0625f);
              const float ang = (float)pos * invf; const double rev = (double)ang * 0.15915494309189535; const float fr = (float)(rev - floor(rev));
              const float cs = __builtin_amdgcn_cosf(fr), sn = __builtin_amdgcn_sinf(fr);
              float* dst = dm ? tabD + ((size_t)pos * 8 + fi) * 2 : tabM + ((size_t)pos * 16 + fi) * 2; dst[0] = cs; dst[1] = sn;
          }
          if (blockIdx.x == 0 && wave == 0) { const float s1 = wave_sum(a.lam_q1[lane] * a.lam_k1[lane]), s2 = wave_sum(a.lam_q2[lane] * a.lam_k2[lane]); if (lane == 0) lamp[0] = __expf(s1) - __expf(s2) + 0.2f; }
        }
    }
    grid.sync();
    #endif

#if !defined(SKIP_P1)
    { pg8::EpiInProj e{QD, KD, VD, SA, SB, CKV, CQ, KR, SSQ, SSKV, a.b_gate, tabD, tabM}; run_gemm(lds, XN, Win, 5888, 1024, e); }
    grid.sync();
    #endif

#if !defined(SKIP_P2)
    { pg8::EpiQUp e{SSQ, tabM, QM}; run_gemm(lds, CQ, Wuq, 768, 384, e); }
    { pg8::EpiKVUp e{SSKV, KVM}; run_gemm(lds, CKV, Wukv, 1024, 256, e); }
    grid.sync();
    #endif

#if !defined(SKIP_P3)
    {
        const float lam = lamp[0];
        for (int i = blockIdx.x; i < 2048; i += G) {
            const int type = i >> 10, rem = i & 1023, j = rem >> 8, half = (rem >> 7) & 1, bh = rem & 127;
            const int qb = half ? (j == 0 ? 6 : j == 1 ? 4 : j == 2 ? 3 : 1) : (j == 0 ? 7 : j == 1 ? 5 : j == 2 ? 2 : 0);
            if (type == 0) att::diff_unit((ATT_LAS char*)lds, bh >> 3, bh & 7, qb, QD, KD, VD, QD, a.diff_subln, lam);
            else           att::mla_unit((ATT_LAS char*)lds, bh >> 3, bh & 7, qb, QM, KVM, KR, OM);
        }
    }
    grid.sync();
    #endif

#if !defined(SKIP_P4)
    { pg8::EpiOutA e{SA, TBUF}; run_gemm(lds, QD, Wod, 1024, 1024, e); }
    { pg8::EpiOutB e{SB, TBUF, MG}; run_gemm(lds, OM, Wom, 1024, 512, e); }
    grid.sync();
    #endif

#if !defined(SKIP_P5)
    { pg8::EpiResid e{a.x, XR, X1B, SS1}; run_gemm(lds, MG, Wout, 1024, 1024, e); }
    grid.sync();
    #endif

#if !defined(SKIP_P6)
    { pg8::EpiSwiGLU e{SS1, HID}; run_gemm(lds, X1B, Wgu, 5632, 1024, e); }
    grid.sync();
    #endif

#if !defined(SKIP_P7)
    { pg8::EpiResid e{XR, XR, X2B, SS2}; run_gemm(lds, HID, Wdn, 1024, 2816, e); }
    grid.sync();
    #endif

#if !defined(SKIP_P8)
    { pg8::EpiPleA e{a.out}; run_gemm(lds, PB, Wple, 1024, 256, e); }
    { pg8::EpiPleB e{SS2, a.b_ple_gate, XR, a.out, SS3}; run_gemm(lds, X2B, Wpg, 1024, 1024, e); }
    grid.sync();
    #endif

#if !defined(SKIP_P9)
    { int t9_ = threadIdx.x; asm volatile("" : "+v"(t9_)); const int lane = t9_ & 63, gw = blockIdx.x * NWAVES + __builtin_amdgcn_readfirstlane(t9_ >> 6), NGW = gridDim.x * NWAVES;
    for (int r = gw; r < M_TOK; r += NGW) {
        float s = (lane < 16) ? SS3[(size_t)r * 16 + lane] : 0.f; const float rstd = __builtin_amdgcn_rsqf(wave_sum(s) * (1.f / 1024.f) + NEPS);
        f32x4* xr = (f32x4*)(a.out + (size_t)r * 1024) + lane;
#pragma unroll
        for (int j = 0; j < 4; ++j) { const f32x4 g = ((const f32x4*)a.final_norm)[lane + 64 * j]; xr[64 * j] = xr[64 * j] * rstd * g; }
    } }
#endif
}

extern "C" void kernel_launch(void* const* d_in, const int* in_sizes, int n_in, void* d_out, int out_size, void* d_ws, size_t ws_size, hipStream_t stream) {
    static int grid = 0;
    if (grid == 0) {
        if (n_in != 26 || out_size != M_TOK * 1024 || ws_size < WS_END) { fprintf(stderr, "kernel_launch: unexpected shapes (n_in %d out %d ws %zu)\n", n_in, out_size, ws_size); grid = -1; return; }
        int dev = 0, cus = 0, per_cu = 0;
        (void)hipGetDevice(&dev); (void)hipDeviceGetAttribute(&cus, hipDeviceAttributeMultiprocessorCount, dev);
        (void)hipFuncSetAttribute((const void*)fwd_megakernel, hipFuncAttributeMaxDynamicSharedMemorySize, LDS_BYTES);
        if (hipOccupancyMaxActiveBlocksPerMultiprocessor(&per_cu, (const void*)fwd_megakernel, NWAVES * 64, LDS_BYTES) != hipSuccess || per_cu < 1) per_cu = 1;
        (void)hipGetLastError();
        grid = cus * per_cu;
    }
    if (grid < 0) return;
    Args a{};
    const float** f = (const float**)&a;
    for (int i = 0; i < 26; ++i) f[i] = (const float*)d_in[i];
    a.out = (float*)d_out; a.ws = (unsigned char*)d_ws;
    void* args[] = {&a};
    hipError_t e = hipLaunchCooperativeKernel((const void*)fwd_megakernel, dim3(grid), dim3(NWAVES * 64), args, LDS_BYTES, stream);
    if (e != hipSuccess) fprintf(stderr, "cooperative launch failed: %s (grid %d)\n", hipGetErrorString(e), grid);
}
```

```cpp
#include <hip/hip_runtime.h>
#include <hip/hip_cooperative_groups.h>
#include <cstdio>
#include <cstdint>
namespace cg = cooperative_groups;

constexpr int M_TOK = 32768, SEQ_LEN = 2048;
constexpr float NEPS = 1e-6f;
constexpr float LOG2E_F = 1.4426950408889634f;
constexpr float QS_D = 0.125f * LOG2E_F;
constexpr float QS_M = 0.10206207261596575f * LOG2E_F;
namespace pg8 {
#define PG8_LAS __attribute__((address_space(3)))
typedef unsigned short bf16_t;
typedef short bf16x8 __attribute__((ext_vector_type(8)));
typedef float f32x4 __attribute__((ext_vector_type(4)));
typedef unsigned u32x4 __attribute__((ext_vector_type(4)));
constexpr int BM = 256, BK = 64, HALF = 128, HTB = HALF * BK * 2  , STAGE_BYTES = 8 * HTB, NXCD = 8, WGM = 8;

__host__ __device__ __forceinline__ int lds_byte(int r, int c) { const int st = (r >> 4) * 2 + (c >> 5), rr = r & 15, cc = c & 31, ob = rr * 64 + cc * 2; return st * 1024 + (ob ^ (((ob >> 9) & 1) << 5)); }
__host__ __device__ __forceinline__ void stage_rc(int b, int& R, int& C) { const int st = b / 1024, sb = b % 1024, swz = sb ^ (((sb >> 9) & 1) << 5); R = (st >> 1) * 16 + swz / 64; C = (st & 1) * 32 + (swz % 64) / 2; }
__host__ __device__ __forceinline__ int perm32(int rho) { const int n = rho >> 4, i = rho & 15; return 8 * (i >> 2) + 4 * n + (i & 3); }

struct Unit { int pm, pn; };
struct Gemm { const bf16_t* A; const bf16_t* Bt; int M, N, K; };

struct StaticOrder {
    int nM, nN, nwg, G, c;
    __host__ __device__ void init(int M, int N, int G_, int c_) { nM = M / BM; nN = N / BM; nwg = nM * nN; G = G_; c = c_; }
    __host__ __device__ bool next(int i, Unit& u) const {
        const long L = (long)i * G + c; if (L >= nwg) return false;
        int wgid = (int)L; { const int q = nwg / NXCD, r = nwg % NXCD, xcd = wgid % NXCD, off = wgid / NXCD; wgid = (xcd < r ? xcd * (q + 1) : r * (q + 1) + (xcd - r) * q) + off; }
        const int nig = WGM * nN, gid = wgid / nig, fm = gid * WGM, gsz = (nM - fm) < WGM ? (nM - fm) : WGM;
        u.pm = fm + ((wgid % nig) % gsz); u.pn = (wgid % nig) / gsz; return true;
    }
    __device__ __forceinline__ void a_ready(const Unit&) const {}
    __device__ __forceinline__ void done(const Unit&) const {}
};

typedef unsigned u32x4 __attribute__((ext_vector_type(4)));
typedef unsigned u32x2 __attribute__((ext_vector_type(2)));
typedef float f32x2 __attribute__((ext_vector_type(2)));
typedef __bf16 bf16x2_t __attribute__((ext_vector_type(2)));
__device__ __forceinline__ unsigned pk2(float lo, float hi) { f32x2 v = {lo, hi}; bf16x2_t b = __builtin_convertvector(v, bf16x2_t); return __builtin_bit_cast(unsigned, b); }
__device__ __forceinline__ void st8(bf16_t* p, f32x4 a, f32x4 b) { u32x4 w; w.x = pk2(a[0], a[1]); w.y = pk2(a[2], a[3]); w.z = pk2(b[0], b[1]); w.w = pk2(b[2], b[3]); *(u32x4*)p = w; }
__device__ __forceinline__ void ld8(const bf16_t* p, f32x4& a, f32x4& b) { const u32x4 w = *(const u32x4*)p;
    a[0] = __uint_as_float(w.x << 16); a[1] = __uint_as_float(w.x & 0xffff0000u); a[2] = __uint_as_float(w.y << 16); a[3] = __uint_as_float(w.y & 0xffff0000u);
    b[0] = __uint_as_float(w.z << 16); b[1] = __uint_as_float(w.z & 0xffff0000u); b[2] = __uint_as_float(w.w << 16); b[3] = __uint_as_float(w.w & 0xffff0000u); }
__device__ __forceinline__ float sigm(float x) { return __builtin_amdgcn_rcpf(1.f + __expf(-x)); }
__device__ __forceinline__ f32x4 sigm4(f32x4 x) { f32x4 o; o[0] = sigm(x[0]); o[1] = sigm(x[1]); o[2] = sigm(x[2]); o[3] = sigm(x[3]); return o; }
__device__ __forceinline__ float quad_sum(float s) { s += __shfl_xor(s, 16); s += __shfl_xor(s, 32); return s; }
__device__ __forceinline__ float sq4(f32x4 v) { return (v[0] * v[0] + v[1] * v[1]) + (v[2] * v[2] + v[3] * v[3]); }
__device__ __forceinline__ f32x4 rope4(f32x4 v, f32x4 t) { f32x4 o; o[0] = v[0] * t[0] - v[1] * t[1]; o[1] = v[1] * t[0] + v[0] * t[1]; o[2] = v[2] * t[2] - v[3] * t[3]; o[3] = v[3] * t[2] + v[2] * t[3]; return o; }
#define EPI_FENCE() asm volatile("" ::: "memory")
#define EPI_LOOP_AM _Pragma("unroll") for (int ai = 0; ai < 2; ++ai) _Pragma("unroll") for (int m = 0; m < 4; ++m)

struct EpiInProj {
    static constexpr bool PERM = true, AFTER_DRAIN = false;
    bf16_t *QD, *KD, *VD, *SA, *SB, *CKV, *CQ, *KR; float *SSQ, *SSKV; const float* bgate; const float* tabD; const float* tabM;
    __device__ __forceinline__ void operator()(const f32x4 (&acc)[2][2][4][2], const Unit& u, int wr, int wc, int fr, int fq) const {
        const int pn = u.pn, rbase = u.pm * BM + wr * 64 + fr, lc = wc * 32 + fq * 8;
        if (pn < 8) {
            bf16_t* dst = (pn < 4 ? QD : KD) + (pn & 3) * 256 + lc; const float sc = pn < 4 ? QS_D : 1.f;
            const bool rp = ((wc & 1) == 0) && (fq < 2);
            EPI_LOOP_AM { const int row = rbase + ai * HALF + m * 16; f32x4 t0 = {1.f, 0.f, 1.f, 0.f}, t1 = t0;
                if (rp) { const f32x4* tp = (const f32x4*)(tabD + ((size_t)(row & (SEQ_LEN - 1)) * 8 + 4 * fq) * 2); t0 = tp[0]; t1 = tp[1]; }
#pragma unroll
                for (int bj = 0; bj < 2; ++bj) st8(dst + (size_t)row * 1024 + bj * HALF, rope4(acc[ai][bj][m][0], t0) * sc, rope4(acc[ai][bj][m][1], t1) * sc);
                EPI_FENCE(); }
        } else if (pn < 12) {
            bf16_t* dst = VD + (pn - 8) * 256 + lc;
            EPI_LOOP_AM { const int row = rbase + ai * HALF + m * 16;
#pragma unroll
                for (int bj = 0; bj < 2; ++bj) st8(dst + (size_t)row * 1024 + bj * HALF, acc[ai][bj][m][0], acc[ai][bj][m][1]); }
        } else if (pn < 20) {
            const int t = (pn - 12) & 3; bf16_t* dst = (pn < 16 ? SA : SB) + t * 256 + lc; const float* bp = bgate + (pn < 16 ? 0 : 1024) + t * 256 + lc;
            f32x4 b[2][2];
#pragma unroll
            for (int bj = 0; bj < 2; ++bj) { b[bj][0] = *(const f32x4*)(bp + bj * HALF); b[bj][1] = *(const f32x4*)(bp + bj * HALF + 4); }
            EPI_LOOP_AM { const int row = rbase + ai * HALF + m * 16;
#pragma unroll
                for (int bj = 0; bj < 2; ++bj) st8(dst + (size_t)row * 1024 + bj * HALF, sigm4(acc[ai][bj][m][0] + b[bj][0]), sigm4(acc[ai][bj][m][1] + b[bj][1])); }
        } else if (pn == 20) {
            EPI_LOOP_AM { const int row = rbase + ai * HALF + m * 16; float s = 0.f;
#pragma unroll
                for (int bj = 0; bj < 2; ++bj) { st8(CKV + (size_t)row * 256 + bj * HALF + lc, acc[ai][bj][m][0], acc[ai][bj][m][1]); s += sq4(acc[ai][bj][m][0]) + sq4(acc[ai][bj][m][1]); }
                s = quad_sum(s); if (fq == 0) SSKV[(size_t)row * 4 + wc] = s; }
        } else if (pn == 21) {
            EPI_LOOP_AM { const int row = rbase + ai * HALF + m * 16; float s = 0.f;
#pragma unroll
                for (int bj = 0; bj < 2; ++bj) { st8(CQ + (size_t)row * 384 + bj * HALF + lc, acc[ai][bj][m][0], acc[ai][bj][m][1]); s += sq4(acc[ai][bj][m][0]) + sq4(acc[ai][bj][m][1]); }
                s = quad_sum(s); if (fq == 0) SSQ[(size_t)row * 8 + wc] = s; }
        } else {
            EPI_LOOP_AM { const int row = rbase + ai * HALF + m * 16;
                st8(CQ + (size_t)row * 384 + 256 + lc, acc[ai][0][m][0], acc[ai][0][m][1]);
                float s = sq4(acc[ai][0][m][0]) + sq4(acc[ai][0][m][1]); s = quad_sum(s); if (fq == 0) SSQ[(size_t)row * 8 + 4 + wc] = s;
                if (wc == 0) { const f32x4* tp = (const f32x4*)(tabM + ((size_t)(row & (SEQ_LEN - 1)) * 16 + 4 * fq) * 2);
                    st8(KR + (size_t)row * 32 + fq * 8, rope4(acc[ai][1][m][0], tp[0]), rope4(acc[ai][1][m][1], tp[1])); }
                EPI_FENCE(); }
        }
    }
};
struct EpiQUp {
    static constexpr bool PERM = true, AFTER_DRAIN = false;
    const float* SSQ; const float* tabM; bf16_t* QM;
    __device__ __forceinline__ void operator()(const f32x4 (&acc)[2][2][4][2], const Unit& u, int wr, int wc, int fr, int fq) const {
        const int rbase = u.pm * BM + wr * 64 + fr, c0 = u.pn * BM + wc * 32 + fq * 8;
        const int hl0 = c0 % 96, hl1 = (c0 + HALF) % 96;
        EPI_LOOP_AM { const int row = rbase + ai * HALF + m * 16;
            const f32x4 s0 = *(const f32x4*)(SSQ + (size_t)row * 8), s1 = *(const f32x4*)(SSQ + (size_t)row * 8 + 4);
            const float rstd = __builtin_amdgcn_rsqf(((s0[0] + s0[1]) + (s0[2] + s0[3]) + (s1[0] + s1[1]) + (s1[2] + s1[3])) * (1.f / 384.f) + NEPS) * QS_M;
            const float* tb = tabM + (size_t)(row & (SEQ_LEN - 1)) * 32;
#pragma unroll
            for (int bj = 0; bj < 2; ++bj) { const int hl = bj ? hl1 : hl0; const bool rp = hl >= 64; const f32x4 id = {1.f, 0.f, 1.f, 0.f};
                const f32x4* tp = (const f32x4*)(tb + (rp ? hl - 64 : 0)); const f32x4 t0 = rp ? tp[0] : id, t1 = rp ? tp[1] : id;
                st8(QM + (size_t)row * 768 + c0 + bj * HALF, rope4(acc[ai][bj][m][0] * rstd, t0), rope4(acc[ai][bj][m][1] * rstd, t1)); EPI_FENCE(); }
            }
    }
};
struct EpiKVUp {
    static constexpr bool PERM = true, AFTER_DRAIN = false;
    const float* SSKV; bf16_t* KVM;
    __device__ __forceinline__ void operator()(const f32x4 (&acc)[2][2][4][2], const Unit& u, int wr, int wc, int fr, int fq) const {
        const int rbase = u.pm * BM + wr * 64 + fr, c0 = u.pn * BM + wc * 32 + fq * 8;
        EPI_LOOP_AM { const int row = rbase + ai * HALF + m * 16;
            const f32x4 s0 = *(const f32x4*)(SSKV + (size_t)row * 4);
            const float rstd = __builtin_amdgcn_rsqf(((s0[0] + s0[1]) + (s0[2] + s0[3])) * (1.f / 256.f) + NEPS);
#pragma unroll
            for (int bj = 0; bj < 2; ++bj) st8(KVM + (size_t)row * 1024 + c0 + bj * HALF, acc[ai][bj][m][0] * rstd, acc[ai][bj][m][1] * rstd);
            EPI_FENCE(); }
    }
};
struct EpiOutA {
    static constexpr bool PERM = true, AFTER_DRAIN = false;
    const bf16_t* SA; bf16_t* T;
    __device__ __forceinline__ void operator()(const f32x4 (&acc)[2][2][4][2], const Unit& u, int wr, int wc, int fr, int fq) const {
        const int rbase = u.pm * BM + wr * 64 + fr, c0 = u.pn * BM + wc * 32 + fq * 8;
        EPI_LOOP_AM { const int row = rbase + ai * HALF + m * 16;
#pragma unroll
            for (int bj = 0; bj < 2; ++bj) { const size_t o = (size_t)row * 1024 + c0 + bj * HALF; f32x4 g0, g1; ld8(SA + o, g0, g1);
                st8(T + o, acc[ai][bj][m][0] * g0, acc[ai][bj][m][1] * g1); }
            EPI_FENCE(); }
    }
};
struct EpiOutB {
    static constexpr bool PERM = true, AFTER_DRAIN = false;
    const bf16_t* SB; const bf16_t* T; bf16_t* MG;
    __device__ __forceinline__ void operator()(const f32x4 (&acc)[2][2][4][2], const Unit& u, int wr, int wc, int fr, int fq) const {
        const int rbase = u.pm * BM + wr * 64 + fr, c0 = u.pn * BM + wc * 32 + fq * 8;
        EPI_LOOP_AM { const int row = rbase + ai * HALF + m * 16;
#pragma unroll
            for (int bj = 0; bj < 2; ++bj) { const size_t o = (size_t)row * 1024 + c0 + bj * HALF; f32x4 g0, g1; ld8(SB + o, g0, g1);
                f32x4 t0, t1; ld8(T + o, t0, t1);
                st8(MG + o, t0 + acc[ai][bj][m][0] * g0, t1 + acc[ai][bj][m][1] * g1); }
            EPI_FENCE(); }
    }
};
template <bool RES_BF16> struct EpiResid {
    static constexpr bool PERM = true, AFTER_DRAIN = false;
    const void* res; bf16_t* xb; float* SS;
    __device__ __forceinline__ void operator()(const f32x4 (&acc)[2][2][4][2], const Unit& u, int wr, int wc, int fr, int fq) const {
        const int rbase = u.pm * BM + wr * 64 + fr, c0 = u.pn * BM + wc * 32 + fq * 8;
        EPI_LOOP_AM { const int row = rbase + ai * HALF + m * 16; float s = 0.f;
#pragma unroll
            for (int bj = 0; bj < 2; ++bj) { const size_t o = (size_t)row * 1024 + c0 + bj * HALF; f32x4 r0, r1;
                if (RES_BF16) ld8((const bf16_t*)res + o, r0, r1); else { r0 = *(const f32x4*)((const float*)res + o); r1 = *(const f32x4*)((const float*)res + o + 4); }
                const f32x4 v0 = r0 + acc[ai][bj][m][0], v1 = r1 + acc[ai][bj][m][1];
                st8(xb + o, v0, v1); s += sq4(v0) + sq4(v1); }
            s = quad_sum(s); if (fq == 0) SS[(size_t)row * 16 + u.pn * 4 + wc] = s;
            EPI_FENCE(); }
    }
};
__device__ __forceinline__ float rstd16(const float* ss) { const f32x4 a = *(const f32x4*)ss, b = *(const f32x4*)(ss + 4), c = *(const f32x4*)(ss + 8), d = *(const f32x4*)(ss + 12);
    const f32x4 t = (a + b) + (c + d); return __builtin_amdgcn_rsqf(((t[0] + t[1]) + (t[2] + t[3])) * (1.f / 1024.f) + NEPS); }
struct EpiSwiGLU {
    static constexpr bool PERM = true, AFTER_DRAIN = false;
    const float* SS; bf16_t* HID;
    __device__ __forceinline__ void operator()(const f32x4 (&acc)[2][2][4][2], const Unit& u, int wr, int wc, int fr, int fq) const {
        const int rbase = u.pm * BM + wr * 64 + fr, c0 = u.pn * HALF + wc * 32 + fq * 8;
        EPI_LOOP_AM { const int row = rbase + ai * HALF + m * 16; const float rstd = rstd16(SS + (size_t)row * 16);
            const f32x4 g0 = acc[ai][0][m][0] * rstd, g1 = acc[ai][0][m][1] * rstd, u0 = acc[ai][1][m][0] * rstd, u1 = acc[ai][1][m][1] * rstd;
            st8(HID + (size_t)row * 2816 + c0, g0 * sigm4(g0) * u0, g1 * sigm4(g1) * u1);
            EPI_FENCE(); }
    }
};
struct EpiPleA {
    static constexpr bool PERM = true, AFTER_DRAIN = false;
    bf16_t* T;
    __device__ __forceinline__ void operator()(const f32x4 (&acc)[2][2][4][2], const Unit& u, int wr, int wc, int fr, int fq) const {
        const int rbase = u.pm * BM + wr * 64 + fr, c0 = u.pn * BM + wc * 32 + fq * 8;
        EPI_LOOP_AM { const int row = rbase + ai * HALF + m * 16;
#pragma unroll
            for (int bj = 0; bj < 2; ++bj) st8(T + (size_t)row * 1024 + c0 + bj * HALF, acc[ai][bj][m][0], acc[ai][bj][m][1]); }
    }
};
struct EpiPleB {
    static constexpr bool PERM = true, AFTER_DRAIN = false;
    const float* SS2; const float* bias; const bf16_t* X2; const bf16_t* T2; bf16_t* X3; float* SS3;
    __device__ __forceinline__ void operator()(const f32x4 (&acc)[2][2][4][2], const Unit& u, int wr, int wc, int fr, int fq) const {
        const int rbase = u.pm * BM + wr * 64 + fr, c0 = u.pn * BM + wc * 32 + fq * 8;
        EPI_LOOP_AM { const int row = rbase + ai * HALF + m * 16; const float rstd = rstd16(SS2 + (size_t)row * 16); float s = 0.f; EPI_FENCE();
#pragma unroll
            for (int bj = 0; bj < 2; ++bj) { const size_t o = (size_t)row * 1024 + c0 + bj * HALF;
                const f32x4 b0 = *(const f32x4*)(bias + c0 + bj * HALF), b1 = *(const f32x4*)(bias + c0 + bj * HALF + 4);
                f32x4 x0, x1, t0, t1; ld8(X2 + o, x0, x1); ld8(T2 + o, t0, t1);
                const f32x4 v0 = x0 + t0 * sigm4(acc[ai][bj][m][0] * rstd + b0), v1 = x1 + t1 * sigm4(acc[ai][bj][m][1] * rstd + b1);
                st8(X3 + o, v0, v1); s += sq4(v0) + sq4(v1); EPI_FENCE(); }
            s = quad_sum(s); if (fq == 0) SS3[(size_t)row * 16 + u.pn * 4 + wc] = s;
            EPI_FENCE(); }
    }
};
template <class Epi, class Sched, bool ALIGN_EPI = false, bool SP2 = false>
__device__ __forceinline__ void gemm_phase(PG8_LAS unsigned char* lds, const Gemm g, const Sched& S, const Epi& E) {
    int tid_ = threadIdx.x; asm volatile("" : "+v"(tid_)); const int tid = tid_, wid = __builtin_amdgcn_readfirstlane(tid >> 6), lane = tid & 63, wr = wid >> 2, wc = wid & 3, fr = lane & 15, fq = lane >> 4;
    const int K = g.K, nt = K / BK;
    unsigned voffA[2], voffB[2];
#pragma unroll
    for (int i = 0; i < 2; ++i) { int R, C; stage_rc(tid * 16 + i * 8192, R, C); const int Rb = Epi::PERM ? ((R & ~31) + perm32(R & 31)) : R;
        voffA[i] = (unsigned)(R * K + C) * 2u; voffB[i] = (unsigned)(Rb * K + C) * 2u; }
    const size_t kstep = (size_t)(BK * 2);
    const size_t hstep = (size_t)HALF * K * 2;
    const size_t tstep = 2 * hstep;
    const unsigned ldsw = (unsigned)wid * 1024u;
    const int aoff = lds_byte(wr * 64 + fr, fq * 8), boff = lds_byte(wc * 32 + fr, fq * 8);
#define PG8_SA(b, h) (((b) * 2 + (h)) * HTB)
#define PG8_SB(b, h) ((4 + (b) * 2 + (h)) * HTB)
#define PG8_STAGE(bufoff, gbase, voff) do { _Pragma("unroll") for (int _i = 0; _i < 2; ++_i) \
        __builtin_amdgcn_global_load_lds((const unsigned*)((const char*)(gbase) + (voff)[_i]), (PG8_LAS unsigned*)(lds + (bufoff) + ldsw + _i * 8192), 16, 0, 0); } while (0)
#define PG8_LDA(dst, b, h) do { _Pragma("unroll") for (int m = 0; m < 4; ++m) _Pragma("unroll") for (int k = 0; k < 2; ++k) dst[m][k] = *(const PG8_LAS bf16x8*)(lds + PG8_SA(b, h) + aoff + m * 2048 + k * 1024); } while (0)
#define PG8_LDB(dst, b, h) do { _Pragma("unroll") for (int n = 0; n < 2; ++n) _Pragma("unroll") for (int k = 0; k < 2; ++k) dst[n][k] = *(const PG8_LAS bf16x8*)(lds + PG8_SB(b, h) + boff + n * 2048 + k * 1024); } while (0)
#define PG8_MMA(ai, bj, At, Bt) do { __builtin_amdgcn_s_setprio(1); _Pragma("unroll") for (int m = 0; m < 4; ++m) _Pragma("unroll") for (int n = 0; n < 2; ++n) _Pragma("unroll") for (int k = 0; k < 2; ++k) \
        acc[ai][bj][m][n] = __builtin_amdgcn_mfma_f32_16x16x32_bf16(Bt[n][k], At[m][k], acc[ai][bj][m][n], 0, 0, 0); __builtin_amdgcn_s_setprio(0); } while (0)
#define PG8_WAIT_V(n) asm volatile("s_waitcnt vmcnt(" #n ")" ::: "memory")
#define PG8_WAIT_L(n) asm volatile("s_waitcnt lgkmcnt(" #n ")" ::: "memory")
#define PG8_BAR __builtin_amdgcn_s_barrier()
#define PG8_SCHED __builtin_amdgcn_sched_barrier(0)
    Unit cur, nxt; int ui = 0;
    if (!S.next(0, cur)) return;
    f32x4 acc[2][2][4][2];
#pragma unroll
    for (int a = 0; a < 2; ++a)
#pragma unroll
        for (int b = 0; b < 2; ++b)
#pragma unroll
            for (int m = 0; m < 4; ++m)
#pragma unroll
                for (int n = 0; n < 2; ++n) acc[a][b][m][n] = (f32x4){0.f, 0.f, 0.f, 0.f};
    bf16x8 At[4][2], B0[2][2], B1[2][2];
    const char* cA = (const char*)g.A + (size_t)cur.pm * tstep; const char* cB = (const char*)g.Bt + (size_t)cur.pn * tstep;
    S.a_ready(cur);
    if constexpr (SP2) {
        PG8_STAGE(PG8_SB(0, 0), cB, voffB); PG8_STAGE(PG8_SB(0, 1), cB + hstep, voffB); PG8_STAGE(PG8_SA(0, 0), cA, voffA); PG8_STAGE(PG8_SA(0, 1), cA + hstep, voffA);
        if (wr == 1) PG8_BAR;
        PG8_WAIT_V(2); PG8_BAR;
        PG8_STAGE(PG8_SB(1, 0), cB + kstep, voffB); PG8_STAGE(PG8_SA(1, 0), cA + kstep, voffA); PG8_STAGE(PG8_SB(1, 1), cB + hstep + kstep, voffB);
        PG8_WAIT_V(6); PG8_BAR;
    } else {
        PG8_STAGE(PG8_SB(0, 0), cB, voffB); PG8_STAGE(PG8_SA(0, 0), cA, voffA); PG8_STAGE(PG8_SB(0, 1), cB + hstep, voffB); PG8_STAGE(PG8_SA(0, 1), cA + hstep, voffA);
        if (wr == 1) PG8_BAR;
        PG8_WAIT_V(4); PG8_BAR;
        PG8_STAGE(PG8_SB(1, 0), cB + kstep, voffB); PG8_STAGE(PG8_SA(1, 0), cA + kstep, voffA); PG8_STAGE(PG8_SB(1, 1), cB + hstep + kstep, voffB);
        PG8_WAIT_V(6); PG8_BAR;
    }
    for (;;) {
        const bool has_next = S.next(ui + 1, nxt);
        const char* nA = has_next ? (const char*)g.A + (size_t)nxt.pm * tstep : cA; const char* nB = has_next ? (const char*)g.Bt + (size_t)nxt.pn * tstep : cB;
        for (int t = 0; t < nt; t += 2) {
            const bool last = (t == nt - 2);
            const char* a1 = cA + (size_t)(t + 1) * kstep;
            const char* a2 = last ? nA : cA + (size_t)(t + 2) * kstep; const char* b2 = last ? nB : cB + (size_t)(t + 2) * kstep;
            const char* a3 = a2 + kstep; const char* b3 = b2 + kstep;
            if (last && has_next) S.a_ready(nxt);
            if constexpr (SP2) {
            PG8_LDB(B0, 0, 0); PG8_LDB(B1, 0, 1); PG8_SCHED; PG8_LDA(At, 0, 0); PG8_STAGE(PG8_SA(1, 1), a1 + hstep, voffA);
            PG8_WAIT_V(8); PG8_WAIT_L(0); PG8_BAR; PG8_MMA(0, 0, At, B0); PG8_MMA(0, 1, At, B1); PG8_BAR; PG8_SCHED;
            PG8_LDA(At, 0, 1); PG8_STAGE(PG8_SB(0, 0), b2, voffB); PG8_STAGE(PG8_SB(0, 1), b2 + hstep, voffB); PG8_STAGE(PG8_SA(0, 0), a2, voffA);
            PG8_WAIT_V(8); PG8_WAIT_L(0); PG8_BAR; PG8_MMA(1, 0, At, B0); PG8_MMA(1, 1, At, B1); PG8_BAR; PG8_SCHED;
            PG8_LDB(B0, 1, 0); PG8_LDB(B1, 1, 1); PG8_SCHED; PG8_LDA(At, 1, 0); PG8_STAGE(PG8_SA(0, 1), a2 + hstep, voffA);
            PG8_WAIT_V(8); PG8_WAIT_L(0); PG8_BAR; PG8_MMA(0, 0, At, B0); PG8_MMA(0, 1, At, B1); PG8_BAR; PG8_SCHED;
            PG8_LDA(At, 1, 1); PG8_STAGE(PG8_SB(1, 0), b3, voffB); PG8_STAGE(PG8_SB(1, 1), b3 + hstep, voffB); PG8_STAGE(PG8_SA(1, 0), a3, voffA);
            PG8_WAIT_V(8); PG8_WAIT_L(0); PG8_BAR; PG8_MMA(1, 0, At, B0); PG8_MMA(1, 1, At, B1); PG8_BAR; PG8_SCHED;
            } else {
            PG8_LDB(B0, 0, 0); PG8_SCHED; PG8_LDA(At, 0, 0); PG8_STAGE(PG8_SA(1, 1), a1 + hstep, voffA);
            PG8_WAIT_L(8); PG8_BAR; PG8_WAIT_L(0); PG8_MMA(0, 0, At, B0); PG8_BAR; PG8_SCHED;
            PG8_LDB(B1, 0, 1); PG8_STAGE(PG8_SB(0, 0), b2, voffB);
            PG8_BAR; PG8_WAIT_L(0); PG8_MMA(0, 1, At, B1); PG8_BAR;
            PG8_LDA(At, 0, 1); PG8_STAGE(PG8_SA(0, 0), a2, voffA);
            PG8_BAR; PG8_WAIT_L(0); PG8_MMA(1, 0, At, B0); PG8_BAR; PG8_SCHED;
            PG8_STAGE(PG8_SB(0, 1), b2 + hstep, voffB);
            PG8_WAIT_V(6); PG8_BAR; PG8_MMA(1, 1, At, B1); PG8_BAR;
            PG8_LDB(B0, 1, 0); PG8_SCHED; PG8_LDA(At, 1, 0); PG8_STAGE(PG8_SA(0, 1), a2 + hstep, voffA);
            PG8_WAIT_L(8); PG8_BAR; PG8_WAIT_L(0); PG8_MMA(0, 0, At, B0); PG8_BAR; PG8_SCHED;
            PG8_LDB(B1, 1, 1); PG8_STAGE(PG8_SB(1, 0), b3, voffB);
            PG8_BAR; PG8_WAIT_L(0); PG8_MMA(0, 1, At, B1); PG8_BAR;
            PG8_LDA(At, 1, 1); PG8_STAGE(PG8_SA(1, 0), a3, voffA);
            PG8_BAR; PG8_WAIT_L(0); PG8_MMA(1, 0, At, B0); PG8_BAR; PG8_SCHED;
            PG8_STAGE(PG8_SB(1, 1), b3 + hstep, voffB);
            PG8_WAIT_V(6); PG8_BAR; PG8_MMA(1, 1, At, B1); PG8_BAR;
            }
        }
        if constexpr (ALIGN_EPI) { if (wr == 0) PG8_BAR; }
        if constexpr (!Epi::AFTER_DRAIN) { E(acc, cur, wr, wc, fr, fq); S.done(cur); }
        if (!has_next) break;
#pragma unroll
        for (int a = 0; a < 2; ++a)
#pragma unroll
            for (int b = 0; b < 2; ++b)
#pragma unroll
                for (int m = 0; m < 4; ++m)
#pragma unroll
                    for (int n = 0; n < 2; ++n) acc[a][b][m][n] = (f32x4){0.f, 0.f, 0.f, 0.f};
        cur = nxt; cA = nA; cB = nB; ++ui;
        if constexpr (ALIGN_EPI) { if (wr == 1) PG8_BAR; }
    }
    PG8_WAIT_V(0);
    if constexpr (!ALIGN_EPI) { if (wr == 0) PG8_BAR; }
    PG8_BAR;
    if constexpr (Epi::AFTER_DRAIN) { E.fused(acc, cur, wr, wc, fr, fq, lds, wid, lane); S.done(cur); }
#undef PG8_SA
#undef PG8_SB
#undef PG8_STAGE
#undef PG8_LDA
#undef PG8_LDB
#undef PG8_MMA
#undef PG8_WAIT_V
#undef PG8_WAIT_L
#undef PG8_BAR
#undef PG8_SCHED
}
}
namespace att {
#define ATT_LAS __attribute__((address_space(3)))
typedef unsigned short bf16_t;
typedef short bf16x8 __attribute__((ext_vector_type(8)));
typedef short s16x4 __attribute__((ext_vector_type(4)));
typedef float f32x16 __attribute__((ext_vector_type(16)));
typedef float f32x4 __attribute__((ext_vector_type(4)));
typedef unsigned u32x4 __attribute__((ext_vector_type(4)));
typedef unsigned u32x2 __attribute__((ext_vector_type(2)));
constexpr int KB0 = 0, KBSZ = 12288, VB0 = 24576, VBSZ = 16384;
__device__ __forceinline__ float swap_max(float m) { auto rr = __builtin_amdgcn_permlane32_swap(__float_as_uint(m), __float_as_uint(m), false, false); return fmaxf(__uint_as_float(rr[0]), __uint_as_float(rr[1])); }
__device__ __forceinline__ float swap_sum(float m) { auto rr = __builtin_amdgcn_permlane32_swap(__float_as_uint(m), __float_as_uint(m), false, false); return __uint_as_float(rr[0]) + __uint_as_float(rr[1]); }
__device__ __forceinline__ s16x4 vtr(const ATT_LAS char* p) { return __builtin_bit_cast(s16x4, __builtin_amdgcn_ds_read_tr16_b64_v4i16((ATT_LAS s16x4*)p)); }
__device__ __forceinline__ int crow(int r, int hi) { return (r & 3) + 8 * (r >> 2) + 4 * hi; }

template <int DQK, int DV, bool MLA>
__device__ __forceinline__ void attn_pass(ATT_LAS char* lds, const bf16_t* qp, const bf16_t* kg, const bf16_t* krg, const bf16_t* vg, int NT, int myNT, f32x16 (&o)[DV / 32], float& linv) {
    int tid_ = threadIdx.x; asm volatile("" : "+v"(tid_)); const int tid = tid_, lane = tid & 63, wid = __builtin_amdgcn_readfirstlane(tid >> 6), r32 = lane & 31, hi = lane >> 5;
    bf16x8 qr[DQK / 16];
#pragma unroll
    for (int d0 = 0; d0 < DQK / 16; ++d0) qr[d0] = *(const bf16x8*)(qp + d0 * 16);
    const bf16_t* ksrc = kg + (size_t)lane * 1024 + wid * 8;
    const bf16_t* krsrc = krg + (size_t)lane * 32 + (wid & 3) * 8;
    const bf16_t* vsrc = vg + (size_t)(16 * (wid & 3) + (lane >> 2)) * 1024 + (wid >> 2) * 32 + (lane & 3) * 8;
    const int sto = wid * 1024 + lane * 16;
    u32x4 kr0 = {0u, 0u, 0u, 0u}, kr1 = kr0, vr0 = kr0, vr1 = kr0;
#define ATT_LOAD(t) do { kr0 = *(const u32x4*)(ksrc + (size_t)(t) * 65536); if (MLA) { if (wid < 4) kr1 = *(const u32x4*)(krsrc + (size_t)(t) * 2048); } \
        vr0 = *(const u32x4*)(vsrc + (size_t)(t) * 65536); if (DV == 128) vr1 = *(const u32x4*)(vsrc + (size_t)(t) * 65536 + 64); } while (0)
#define ATT_STORE(b) do { *(ATT_LAS u32x4*)(lds + KB0 + (b) * KBSZ + sto) = kr0; if (MLA) { if (wid < 4) *(ATT_LAS u32x4*)(lds + KB0 + (b) * KBSZ + 8192 + sto) = kr1; } \
        *(ATT_LAS u32x4*)(lds + VB0 + (b) * VBSZ + sto) = vr0; if (DV == 128) *(ATT_LAS u32x4*)(lds + VB0 + (b) * VBSZ + 8192 + sto) = vr1; } while (0)
#pragma unroll
    for (int i = 0; i < DV / 32; ++i)
#pragma unroll
        for (int r = 0; r < 16; ++r) o[i][r] = 0.f;
    float mref = -1e30f, lsum = 0.f;
    ATT_LOAD(0); ATT_STORE(0); __syncthreads();
    for (int t = 0; t < NT; ++t) {
        const int b = t & 1;
        if (t + 1 < NT) ATT_LOAD(t + 1);
        if (t < myNT) {
            const ATT_LAS char* kp = lds + KB0 + b * KBSZ + hi * 1024 + r32 * 16;
            f32x16 p0, p1;
#pragma unroll
            for (int r = 0; r < 16; ++r) { p0[r] = 0.f; p1[r] = 0.f; }
#pragma unroll
            for (int d0 = 0; d0 < DQK / 16; ++d0) {
                const bf16x8 k0 = *(const ATT_LAS bf16x8*)(kp + d0 * 2048), k1 = *(const ATT_LAS bf16x8*)(kp + d0 * 2048 + 512);
                p0 = __builtin_amdgcn_mfma_f32_32x32x16_bf16(k0, qr[d0], p0, 0, 0, 0);
                p1 = __builtin_amdgcn_mfma_f32_32x32x16_bf16(k1, qr[d0], p1, 0, 0, 0);
            }
            float mx = fmaxf(p0[0], p1[0]);
#pragma unroll
            for (int r = 1; r < 16; ++r) mx = fmaxf(mx, fmaxf(p0[r], p1[r]));
            mx = swap_max(mx);
            if (__any(mx > mref + 8.f)) {
                const float mn = fmaxf(mref, mx), al = __builtin_amdgcn_exp2f(mref - mn);
                lsum *= al;
#pragma unroll
                for (int i = 0; i < DV / 32; ++i)
#pragma unroll
                    for (int r = 0; r < 16; ++r) o[i][r] *= al;
                mref = mn;
            }
            float ls = 0.f;
#pragma unroll
            for (int r = 0; r < 16; ++r) { p0[r] = __builtin_amdgcn_exp2f(p0[r] - mref); p1[r] = __builtin_amdgcn_exp2f(p1[r] - mref); ls += p0[r] + p1[r]; }
            lsum += ls;
            u32x4 pw[4];
#pragma unroll
            for (int j = 0; j < 4; ++j) { pw[0][j] = pg8::pk2(p0[2 * j], p0[2 * j + 1]); pw[1][j] = pg8::pk2(p0[8 + 2 * j], p0[9 + 2 * j]); pw[2][j] = pg8::pk2(p1[2 * j], p1[2 * j + 1]); pw[3][j] = pg8::pk2(p1[8 + 2 * j], p1[9 + 2 * j]); }
            const ATT_LAS char* vp = lds + VB0 + b * VBSZ + ((lane >> 4) & 1) * 32 + (lane & 3) * 8 + (4 * hi + ((lane & 15) >> 2)) * 64;
#pragma unroll
            for (int i = 0; i < DV / 32; ++i)
#pragma unroll
                for (int ks = 0; ks < 4; ++ks) {
                    const s16x4 lo = vtr(vp + i * 4096 + ks * 1024), hh = vtr(vp + i * 4096 + ks * 1024 + 512);
                    const bf16x8 vf = {lo[0], lo[1], lo[2], lo[3], hh[0], hh[1], hh[2], hh[3]};
                    o[i] = __builtin_amdgcn_mfma_f32_32x32x16_bf16(vf, __builtin_bit_cast(bf16x8, pw[ks]), o[i], 0, 0, 0);
                }
        }
        if (t + 1 < NT) ATT_STORE(b ^ 1);
        __syncthreads();
    }
    linv = __builtin_amdgcn_rcpf(swap_sum(lsum));
#undef ATT_LOAD
#undef ATT_STORE
}

__device__ __forceinline__ void diff_unit(ATT_LAS char* lds, int b, int h, int qb, const bf16_t* QD, const bf16_t* KD, const bf16_t* VD, bf16_t* OD, const float* subln, float lam) {
    int tid_ = threadIdx.x; asm volatile("" : "+v"(tid_)); const int tid = tid_, lane = tid & 63, wid = __builtin_amdgcn_readfirstlane(tid >> 6), r32 = lane & 31, hi = lane >> 5;
    const size_t row0 = (size_t)b * SEQ_LEN, qrow = row0 + qb * 256 + wid * 32 + r32;
    const int NT = 4 * qb + 4, myNT = 4 * qb + (wid >> 1) + 1;
    f32x16 o1[4], o2[4]; float li1, li2;
    attn_pass<64, 128, false>(lds, QD + qrow * 1024 + (2 * h) * 64 + hi * 8, KD + row0 * 1024 + (2 * h) * 64, nullptr, VD + row0 * 1024 + h * 128, NT, myNT, o1, li1);
    attn_pass<64, 128, false>(lds, QD + qrow * 1024 + (2 * h + 1) * 64 + hi * 8, KD + row0 * 1024 + (2 * h + 1) * 64, nullptr, VD + row0 * 1024 + h * 128, NT, myNT, o2, li2);
    const float c2 = lam * li2; float ss = 0.f;
#pragma unroll
    for (int i = 0; i < 4; ++i)
#pragma unroll
        for (int r = 0; r < 16; ++r) { const float v = o1[i][r] * li1 - o2[i][r] * c2; o1[i][r] = v; ss += v * v; }
    ss = swap_sum(ss);
    const float rstd = __builtin_amdgcn_rsqf(ss * (1.f / 128.f) + NEPS) * 0.8f;
    bf16_t* op = OD + qrow * 1024 + h * 128 + 4 * hi;
#pragma unroll
    for (int i = 0; i < 4; ++i)
#pragma unroll
        for (int rq = 0; rq < 4; ++rq) { const int dv = 32 * i + 8 * rq; const f32x4 g = *(const f32x4*)(subln + dv + 4 * hi);
            u32x2 w; w.x = pg8::pk2(o1[i][4 * rq] * rstd * g[0], o1[i][4 * rq + 1] * rstd * g[1]); w.y = pg8::pk2(o1[i][4 * rq + 2] * rstd * g[2], o1[i][4 * rq + 3] * rstd * g[3]);
            *(u32x2*)(op + dv) = w; }
}
__device__ __forceinline__ void mla_unit(ATT_LAS char* lds, int b, int h, int qb, const bf16_t* QM, const bf16_t* KVM, const bf16_t* KR, bf16_t* OM) {
    int tid_ = threadIdx.x; asm volatile("" : "+v"(tid_)); const int tid = tid_, lane = tid & 63, wid = __builtin_amdgcn_readfirstlane(tid >> 6), r32 = lane & 31, hi = lane >> 5;
    const size_t row0 = (size_t)b * SEQ_LEN, qrow = row0 + qb * 256 + wid * 32 + r32;
    const int NT = 4 * qb + 4, myNT = 4 * qb + (wid >> 1) + 1;
    f32x16 o[2]; float li;
    attn_pass<96, 64, true>(lds, QM + qrow * 768 + h * 96 + hi * 8, KVM + row0 * 1024 + h * 128, KR + row0 * 32, KVM + row0 * 1024 + h * 128 + 64, NT, myNT, o, li);
    bf16_t* op = OM + qrow * 512 + h * 64 + 4 * hi;
#pragma unroll
    for (int i = 0; i < 2; ++i)
#pragma unroll
        for (int rq = 0; rq < 4; ++rq) { const int dv = 32 * i + 8 * rq;
            u32x2 w; w.x = pg8::pk2(o[i][4 * rq] * li, o[i][4 * rq + 1] * li); w.y = pg8::pk2(o[i][4 * rq + 2] * li, o[i][4 * rq + 3] * li);
            *(u32x2*)(op + dv) = w; }
}
}
#define LAS __attribute__((address_space(3)))
typedef unsigned short bf16;
typedef float f32x4 __attribute__((ext_vector_type(4)));
typedef unsigned v4u __attribute__((ext_vector_type(4)));
typedef unsigned v2u __attribute__((ext_vector_type(2)));
constexpr int NWAVES = 8, LDS_BYTES = 147456;
constexpr size_t MiB = 1ull << 20;
constexpr size_t WS_TABD = 0, WS_TABM = 128 * 1024, WS_LAM = 384 * 1024;
constexpr size_t WS_SSQ = 1 * MiB, WS_SSKV = 2 * MiB, WS_SS1 = 3 * MiB, WS_SS2 = 5 * MiB, WS_SS3 = 7 * MiB;
constexpr size_t WS_WIN = 10 * MiB, WS_WGU = WS_WIN + 5888ull * 1024 * 2, WS_WDN = WS_WGU + 5632ull * 1024 * 2, WS_WOD = WS_WDN + 1024ull * 2816 * 2, WS_WOUT = WS_WOD + 2 * MiB,
                 WS_WPG = WS_WOUT + 2 * MiB, WS_WOM = WS_WPG + 2 * MiB, WS_WUQ = WS_WOM + 1 * MiB, WS_WUKV = WS_WUQ + 768ull * 384 * 2, WS_WPLE = WS_WUKV + 1024ull * 256 * 2, WS_WEND = WS_WPLE + 1024ull * 256 * 2;
static_assert(WS_WEND <= 47 * MiB, "weights");
constexpr size_t WS_PB = 47 * MiB;
constexpr size_t WS_XN = 64 * MiB, WS_QM = 64 * MiB, WS_X1B = 64 * MiB;
constexpr size_t WS_QD = 128 * MiB, WS_KD = 192 * MiB, WS_VD = 256 * MiB, WS_KVM = 320 * MiB;
constexpr size_t WS_T = 192 * MiB, WS_MG = 320 * MiB;
constexpr size_t WS_HID = 128 * MiB, WS_X2B = 304 * MiB;
constexpr size_t WS_X3B = 384 * MiB, WS_T2B = 448 * MiB;
constexpr size_t WS_CKV = 384 * MiB, WS_CQ = 400 * MiB, WS_KR = 424 * MiB, WS_OM = 426 * MiB;
constexpr size_t WS_END = 512 * MiB;

struct Args {
    const float *x, *p, *attn_norm, *w_in, *b_gate, *lam_q1, *lam_k1, *lam_q2, *lam_k2, *diff_subln, *w_o_diff, *q_norm, *w_uq, *kv_norm, *w_ukv, *w_o_mla, *w_out, *ffn_norm,
        *w_ffn_gate, *w_ffn_up, *w_ffn_down, *ple_norm, *w_ple_gate, *b_ple_gate, *w_ple, *final_norm;
    float* out; unsigned char* ws;
};

__device__ __forceinline__ float wave_sum(float v) {
#pragma unroll
    for (int o = 1; o < 64; o <<= 1) v += __shfl_xor(v, o);
    return v;
}
__device__ __forceinline__ void wprep_item(int kind, const float* W, const float* W2, int ld, int K, int Nout, const float* gain, bf16* WT, int item, LAS float* scr, int lane) {
    const int nnb = Nout / 64, kb = item / nnb, nb = item % nnb, k0 = kb * 64, n0 = nb * 64, n = n0 + lane;
    const float* base = W; int col = n;
    if (kind == 1) {
        if (n < 2048) { const int hl = n & 63; col = (n & ~63) + (hl < 16 ? ((hl & 1) ? (hl >> 1) + 8 : (hl >> 1)) : hl); }
        else if (n < 3072) col = n;
        else if (n < 5120) col = 3744 + (n - 3072);
        else if (n < 5376) col = 3456 + (n - 5120);
        else if (n < 5760) col = 3072 + (n - 5376);
        else if (n < 5792) { const int hl = n - 5760; col = 3712 + ((hl & 1) ? (hl >> 1) + 16 : (hl >> 1)); }
        else col = -1;
    } else if (kind == 2) { const int h = n / 96, hl = n % 96; int s = hl; if (hl >= 64) { const int r = hl - 64; s = 64 + ((r & 1) ? (r >> 1) + 16 : (r >> 1)); } col = h * 96 + s;
    } else if (kind == 3) { const int pn = n >> 8, r = n & 255; if (r < 128) col = pn * 128 + r; else { base = W2; col = pn * 128 + (r - 128); } }
#pragma unroll 32
    for (int kk = 0; kk < 64; ++kk) { float v = (col >= 0) ? base[(size_t)(k0 + kk) * ld + col] : 0.f; if (gain) v *= gain[k0 + kk]; scr[kk * 65 + lane] = v; }
    asm volatile("s_waitcnt lgkmcnt(0)" ::: "memory");
    const int c = lane & 7;
#pragma unroll
    for (int j = 0; j < 8; ++j) { const int nn = (lane >> 3) + 8 * j; const LAS float* s = scr + (8 * c) * 65 + nn;
        v4u o; o.x = pg8::pk2(s[0], s[65]); o.y = pg8::pk2(s[2 * 65], s[3 * 65]); o.z = pg8::pk2(s[4 * 65], s[5 * 65]); o.w = pg8::pk2(s[6 * 65], s[7 * 65]);
        *(v4u*)(WT + (size_t)(n0 + nn) * K + k0 + 8 * c) = o; }
    asm volatile("s_waitcnt lgkmcnt(0)" ::: "memory");
}


#define WSP(T, off) ((T*)(a.ws + (off)))
#define tabD WSP(float, WS_TABD)
#define tabM WSP(float, WS_TABM)
#define lamp WSP(float, WS_LAM)
#define SSQ WSP(float, WS_SSQ)
#define SSKV WSP(float, WS_SSKV)
#define SS1 WSP(float, WS_SS1)
#define SS2 WSP(float, WS_SS2)
#define SS3 WSP(float, WS_SS3)
#define Win WSP(bf16, WS_WIN)
#define Wgu WSP(bf16, WS_WGU)
#define Wdn WSP(bf16, WS_WDN)
#define Wod WSP(bf16, WS_WOD)
#define Wout WSP(bf16, WS_WOUT)
#define Wpg WSP(bf16, WS_WPG)
#define Wom WSP(bf16, WS_WOM)
#define Wuq WSP(bf16, WS_WUQ)
#define Wukv WSP(bf16, WS_WUKV)
#define Wple WSP(bf16, WS_WPLE)
#define PB WSP(bf16, WS_PB)
#define XN WSP(bf16, WS_XN)
#define QM WSP(bf16, WS_QM)
#define X1B WSP(bf16, WS_X1B)
#define QD WSP(bf16, WS_QD)
#define KD WSP(bf16, WS_KD)
#define VD WSP(bf16, WS_VD)
#define KVM WSP(bf16, WS_KVM)
#define MG WSP(bf16, WS_MG)
#define HID WSP(bf16, WS_HID)
#define X2B WSP(bf16, WS_X2B)
#define CKV WSP(bf16, WS_CKV)
#define CQ WSP(bf16, WS_CQ)
#define KR WSP(bf16, WS_KR)
#define OM WSP(bf16, WS_OM)
#define TBUF WSP(bf16, WS_T)
#define X3B WSP(bf16, WS_X3B)
#define T2B WSP(bf16, WS_T2B)
#define SA ((bf16*)a.out)
#define SB ((bf16*)a.out + (size_t)M_TOK * 1024)
template <class E> __device__ __forceinline__ void run_gemm(LAS unsigned char* lds, const bf16* A, const bf16* Bt, int N, int K, const E& e) {
    asm volatile("" : "+s"(K));
    pg8::Gemm g{A, Bt, M_TOK, N, K}; pg8::StaticOrder S; S.init(M_TOK, N, (int)gridDim.x, (int)blockIdx.x);
    pg8::gemm_phase<E, pg8::StaticOrder, true, true>(lds, g, S, e);
}

__global__ void __launch_bounds__(NWAVES * 64, 2) fwd_megakernel(Args a) {
    extern __shared__ __attribute__((aligned(16))) unsigned char lds_raw[];
    cg::grid_group grid = cg::this_grid();
    LAS unsigned char* lds = (LAS unsigned char*)lds_raw;
    int tid0_ = threadIdx.x; asm volatile("" : "+v"(tid0_)); const int tid = tid0_, lane = tid & 63, wave = __builtin_amdgcn_readfirstlane(tid >> 6);
    const int G = gridDim.x, gw = blockIdx.x * NWAVES + wave, NGW = G * NWAVES;
#if !defined(SKIP_P0)
    {
        LAS float* scr = (LAS float*)(lds + wave * 16640);
        constexpr int I0 = 16 * 92, I1 = I0 + 16 * 88, I2 = I1 + 44 * 16, I3 = I2 + 256, I4 = I3 + 256, I5 = I4 + 256, I6 = I5 + 128, I7 = I6 + 72, I8 = I7 + 64, I9 = I8 + 64;
        for (int it = gw; it < I9; it += NGW) {
            if (it < I0)      wprep_item(1, a.w_in, nullptr, 5792, 1024, 5888, nullptr, Win, it, scr, lane);
            else if (it < I1) wprep_item(3, a.w_ffn_gate, a.w_ffn_up, 2816, 1024, 5632, a.ffn_norm, Wgu, it - I0, scr, lane);
            else if (it < I2) wprep_item(0, a.w_ffn_down, nullptr, 1024, 2816, 1024, nullptr, Wdn, it - I1, scr, lane);
            else if (it < I3) wprep_item(0, a.w_o_diff, nullptr, 1024, 1024, 1024, nullptr, Wod, it - I2, scr, lane);
            else if (it < I4) wprep_item(0, a.w_out, nullptr, 1024, 1024, 1024, nullptr, Wout, it - I3, scr, lane);
            else if (it < I5) wprep_item(0, a.w_ple_gate, nullptr, 1024, 1024, 1024, a.ple_norm, Wpg, it - I4, scr, lane);
            else if (it < I6) wprep_item(0, a.w_o_mla, nullptr, 1024, 512, 1024, nullptr, Wom, it - I5, scr, lane);
            else if (it < I7) wprep_item(2, a.w_uq, nullptr, 768, 384, 768, a.q_norm, Wuq, it - I6, scr, lane);
            else if (it < I8) wprep_item(0, a.w_ukv, nullptr, 1024, 256, 1024, a.kv_norm, Wukv, it - I7, scr, lane);
            else              wprep_item(0, a.w_ple, nullptr, 1024, 256, 1024, nullptr, Wple, it - I8, scr, lane);
        }
        for (int r0 = gw * 4; r0 < M_TOK; r0 += NGW * 4) {
            f32x4 v[4][4]; float s[4];
#pragma unroll
            for (int q = 0; q < 4; ++q) { const f32x4* xr = (const f32x4*)(a.x + (size_t)(r0 + q) * 1024) + lane; s[q] = 0.f;
#pragma unroll
                for (int j = 0; j < 4; ++j) v[q][j] = xr[64 * j]; }
#pragma unroll
            for (int q = 0; q < 4; ++q) {
#pragma unroll
                for (int j = 0; j < 4; ++j) s[q] += pg8::sq4(v[q][j]);
                const float rstd = __builtin_amdgcn_rsqf(wave_sum(s[q]) * (1.f / 1024.f) + NEPS);
                v2u* o8 = (v2u*)(XN + (size_t)(r0 + q) * 1024) + lane;
#pragma unroll
                for (int j = 0; j < 4; ++j) { const f32x4 g = ((const f32x4*)a.attn_norm)[lane + 64 * j]; const f32x4 y = v[q][j] * rstd * g; v2u w; w.x = pg8::pk2(y[0], y[1]); w.y = pg8::pk2(y[2], y[3]); o8[64 * j] = w; } }
        }
        { const int gt = blockIdx.x * 512 + tid, GT = G * 512;
          for (int i = gt; i < M_TOK * 256 / 8; i += GT) { const f32x4 p0 = ((const f32x4*)a.p)[2 * i], p1 = ((const f32x4*)a.p)[2 * i + 1]; pg8::st8(PB + (size_t)i * 8, p0, p1); }
          for (int i = gt; i < 2048 * 24; i += GT) {
              const int pos = i / 24, f = i % 24; const bool dm = f < 8; const int fi = dm ? f : f - 8;
              const float invf = dm ? __builtin_amdgcn_exp2f(-18.931568569324174f * (float)fi * 0.125f) : __builtin_amdgcn_exp2f(-13.287712379549449f * (float)fi * 0.0625f);
              const float ang = (float)pos * invf; const double rev = (double)ang * 0.15915494309189535; const float fr = (float)(rev - floor(rev));
              const float cs = __builtin_amdgcn_cosf(fr), sn = __builtin_amdgcn_sinf(fr);
              float* dst = dm ? tabD + ((size_t)pos * 8 + fi) * 2 : tabM + ((size_t)pos * 16 + fi) * 2; dst[0] = cs; dst[1] = sn;
          }
          if (blockIdx.x == 0 && wave == 0) { const float s1 = wave_sum(a.lam_q1[lane] * a.lam_k1[lane]), s2 = wave_sum(a.lam_q2[lane] * a.lam_k2[lane]); if (lane == 0) lamp[0] = __expf(s1) - __expf(s2) + 0.2f; }
        }
    }
    grid.sync();
    #endif

#if !defined(SKIP_P1)
    { pg8::EpiInProj e{QD, KD, VD, SA, SB, CKV, CQ, KR, SSQ, SSKV, a.b_gate, tabD, tabM}; run_gemm(lds, XN, Win, 5888, 1024, e); }
    grid.sync();
    #endif

#if !defined(SKIP_P2)
    { pg8::EpiQUp e{SSQ, tabM, QM}; run_gemm(lds, CQ, Wuq, 768, 384, e); }
    { pg8::EpiKVUp e{SSKV, KVM}; run_gemm(lds, CKV, Wukv, 1024, 256, e); }
    grid.sync();
    #endif

#if !defined(SKIP_P3)
    {
        const float lam = lamp[0];
        for (int i = blockIdx.x; i < 2048; i += G) {
            const int type = i >> 10, rem = i & 1023, j = rem >> 8, half = (rem >> 7) & 1, bh = rem & 127;
            const int qb = half ? (j == 0 ? 6 : j == 1 ? 4 : j == 2 ? 3 : 1) : (j == 0 ? 7 : j == 1 ? 5 : j == 2 ? 2 : 0);
            if (type == 0) att::diff_unit((ATT_LAS char*)lds, bh >> 3, bh & 7, qb, QD, KD, VD, QD, a.diff_subln, lam);
            else           att::mla_unit((ATT_LAS char*)lds, bh >> 3, bh & 7, qb, QM, KVM, KR, OM);
        }
    }
    grid.sync();
    #endif

#if !defined(SKIP_P4)
    { pg8::EpiOutA e{SA, TBUF}; run_gemm(lds, QD, Wod, 1024, 1024, e); }
    { pg8::EpiOutB e{SB, TBUF, MG}; run_gemm(lds, OM, Wom, 1024, 512, e); }
    grid.sync();
    #endif

#if !defined(SKIP_P5)
    { pg8::EpiResid<false> e{a.x, X1B, SS1}; run_gemm(lds, MG, Wout, 1024, 1024, e); }
    grid.sync();
    #endif

#if !defined(SKIP_P6)
    { pg8::EpiSwiGLU e{SS1, HID}; run_gemm(lds, X1B, Wgu, 5632, 1024, e); }
    grid.sync();
    #endif

#if !defined(SKIP_P7)
    { pg8::EpiResid<true> e{X1B, X2B, SS2}; run_gemm(lds, HID, Wdn, 1024, 2816, e); }
    grid.sync();
    #endif

#if !defined(SKIP_P8)
    { pg8::EpiPleA e{T2B}; run_gemm(lds, PB, Wple, 1024, 256, e); }
    { pg8::EpiPleB e{SS2, a.b_ple_gate, X2B, T2B, X3B, SS3}; run_gemm(lds, X2B, Wpg, 1024, 1024, e); }
    grid.sync();
    #endif

#if !defined(SKIP_P9)
    { int t9_ = threadIdx.x; asm volatile("" : "+v"(t9_)); const int lane = t9_ & 63, gw = blockIdx.x * NWAVES + __builtin_amdgcn_readfirstlane(t9_ >> 6), NGW = gridDim.x * NWAVES;
    for (int r0 = gw * 4; r0 < M_TOK; r0 += NGW * 4) {
        v4u w[4][2]; float s[4];
#pragma unroll
        for (int q = 0; q < 4; ++q) { const v4u* xr = (const v4u*)(X3B + (size_t)(r0 + q) * 1024) + lane; w[q][0] = xr[0]; w[q][1] = xr[64]; s[q] = (lane < 16) ? SS3[(size_t)(r0 + q) * 16 + lane] : 0.f; }
#pragma unroll
        for (int q = 0; q < 4; ++q) { const float rstd = __builtin_amdgcn_rsqf(wave_sum(s[q]) * (1.f / 1024.f) + NEPS);
#pragma unroll
            for (int j = 0; j < 2; ++j) { const int c = (lane + 64 * j) * 8; const f32x4 g0 = *(const f32x4*)(a.final_norm + c), g1 = *(const f32x4*)(a.final_norm + c + 4); const v4u ww = w[q][j];
                f32x4 x0, x1; x0[0] = __uint_as_float(ww.x << 16); x0[1] = __uint_as_float(ww.x & 0xffff0000u); x0[2] = __uint_as_float(ww.y << 16); x0[3] = __uint_as_float(ww.y & 0xffff0000u);
                x1[0] = __uint_as_float(ww.z << 16); x1[1] = __uint_as_float(ww.z & 0xffff0000u); x1[2] = __uint_as_float(ww.w << 16); x1[3] = __uint_as_float(ww.w & 0xffff0000u);
                float* o = a.out + (size_t)(r0 + q) * 1024 + c; *(f32x4*)o = x0 * rstd * g0; *(f32x4*)(o + 4) = x1 * rstd * g1; } }
    } }
#endif
}

extern "C" void kernel_launch(void* const* d_in, const int* in_sizes, int n_in, void* d_out, int out_size, void* d_ws, size_t ws_size, hipStream_t stream) {
    static int grid = 0;
    if (grid == 0) {
        if (n_in != 26 || out_size != M_TOK * 1024 || ws_size < WS_END) { fprintf(stderr, "kernel_launch: unexpected shapes (n_in %d out %d ws %zu)\n", n_in, out_size, ws_size); grid = -1; return; }
        int dev = 0, cus = 0, per_cu = 0;
        (void)hipGetDevice(&dev); (void)hipDeviceGetAttribute(&cus, hipDeviceAttributeMultiprocessorCount, dev);
        (void)hipFuncSetAttribute((const void*)fwd_megakernel, hipFuncAttributeMaxDynamicSharedMemorySize, LDS_BYTES);
        if (hipOccupancyMaxActiveBlocksPerMultiprocessor(&per_cu, (const void*)fwd_megakernel, NWAVES * 64, LDS_BYTES) != hipSuccess || per_cu < 1) per_cu = 1;
        (void)hipGetLastError();
        grid = cus * per_cu;
    }
    if (grid < 0) return;
    Args a{};
    const float** f = (const float**)&a;
    for (int i = 0; i < 26; ++i) f[i] = (const float*)d_in[i];
    a.out = (float*)d_out; a.ws = (unsigned char*)d_ws;
    void* args[] = {&a};
    hipError_t e = hipLaunchCooperativeKernel((const void*)fwd_megakernel, dim3(grid), dim3(NWAVES * 64), args, LDS_BYTES, stream);
    if (e != hipSuccess) fprintf(stderr, "cooperative launch failed: %s (grid %d)\n", hipGetErrorString(e), grid);
}
```

```cpp
#include <hip/hip_runtime.h>
#include <hip/hip_cooperative_groups.h>
#include <cstdio>
#include <cstdint>
namespace cg = cooperative_groups;

constexpr int M_TOK = 32768, SEQ_LEN = 2048;
constexpr float NEPS = 1e-6f;
constexpr float LOG2E_F = 1.4426950408889634f;
constexpr float QS_D = 0.125f * LOG2E_F;
constexpr float QS_M = 0.10206207261596575f * LOG2E_F;
namespace pg8 {
#define PG8_LAS __attribute__((address_space(3)))
typedef unsigned short bf16_t;
typedef short bf16x8 __attribute__((ext_vector_type(8)));
typedef float f32x4 __attribute__((ext_vector_type(4)));
typedef unsigned u32x4 __attribute__((ext_vector_type(4)));
constexpr int BM = 256, BK = 64, HALF = 128, HTB = HALF * BK * 2  , STAGE_BYTES = 8 * HTB, NXCD = 8, WGM = 8;

__host__ __device__ __forceinline__ int lds_byte(int r, int c) { const int st = (r >> 4) * 2 + (c >> 5), rr = r & 15, cc = c & 31, ob = rr * 64 + cc * 2; return st * 1024 + (ob ^ (((ob >> 9) & 1) << 5)); }
__host__ __device__ __forceinline__ void stage_rc(int b, int& R, int& C) { const int st = b / 1024, sb = b % 1024, swz = sb ^ (((sb >> 9) & 1) << 5); R = (st >> 1) * 16 + swz / 64; C = (st & 1) * 32 + (swz % 64) / 2; }
__host__ __device__ __forceinline__ int perm32(int rho) { const int n = rho >> 4, i = rho & 15; return 8 * (i >> 2) + 4 * n + (i & 3); }

struct Unit { int pm, pn; };
struct Gemm { const bf16_t* A; const bf16_t* Bt; int M, N, K; };

struct StaticOrder {
    int nM, nN, nwg, G, c;
    __host__ __device__ void init(int M, int N, int G_, int c_) { nM = M / BM; nN = N / BM; nwg = nM * nN; G = G_; c = c_; }
    __host__ __device__ bool next(int i, Unit& u) const {
        const long L = (long)i * G + c; if (L >= nwg) return false;
        int wgid = (int)L; { const int q = nwg / NXCD, r = nwg % NXCD, xcd = wgid % NXCD, off = wgid / NXCD; wgid = (xcd < r ? xcd * (q + 1) : r * (q + 1) + (xcd - r) * q) + off; }
        const int nig = WGM * nN, gid = wgid / nig, fm = gid * WGM, gsz = (nM - fm) < WGM ? (nM - fm) : WGM;
        u.pm = fm + ((wgid % nig) % gsz); u.pn = (wgid % nig) / gsz; return true;
    }
    __device__ __forceinline__ void a_ready(const Unit&) const {}
    __device__ __forceinline__ void done(const Unit&) const {}
};

typedef unsigned u32x4 __attribute__((ext_vector_type(4)));
typedef unsigned u32x2 __attribute__((ext_vector_type(2)));
typedef float f32x2 __attribute__((ext_vector_type(2)));
typedef __bf16 bf16x2_t __attribute__((ext_vector_type(2)));
__device__ __forceinline__ unsigned pk2(float lo, float hi) { f32x2 v = {lo, hi}; bf16x2_t b = __builtin_convertvector(v, bf16x2_t); return __builtin_bit_cast(unsigned, b); }
__device__ __forceinline__ void st8(bf16_t* p, f32x4 a, f32x4 b) { u32x4 w; w.x = pk2(a[0], a[1]); w.y = pk2(a[2], a[3]); w.z = pk2(b[0], b[1]); w.w = pk2(b[2], b[3]); *(u32x4*)p = w; }
__device__ __forceinline__ void ld8(const bf16_t* p, f32x4& a, f32x4& b) { const u32x4 w = *(const u32x4*)p;
    a[0] = __uint_as_float(w.x << 16); a[1] = __uint_as_float(w.x & 0xffff0000u); a[2] = __uint_as_float(w.y << 16); a[3] = __uint_as_float(w.y & 0xffff0000u);
    b[0] = __uint_as_float(w.z << 16); b[1] = __uint_as_float(w.z & 0xffff0000u); b[2] = __uint_as_float(w.w << 16); b[3] = __uint_as_float(w.w & 0xffff0000u); }
__device__ __forceinline__ void up8(const u32x4 w, f32x4& a, f32x4& b) {
    a[0] = __uint_as_float(w.x << 16); a[1] = __uint_as_float(w.x & 0xffff0000u); a[2] = __uint_as_float(w.y << 16); a[3] = __uint_as_float(w.y & 0xffff0000u);
    b[0] = __uint_as_float(w.z << 16); b[1] = __uint_as_float(w.z & 0xffff0000u); b[2] = __uint_as_float(w.w << 16); b[3] = __uint_as_float(w.w & 0xffff0000u); }
__device__ __forceinline__ float sigm(float x) { return __builtin_amdgcn_rcpf(1.f + __expf(-x)); }
__device__ __forceinline__ f32x4 sigm4(f32x4 x) { f32x4 o; o[0] = sigm(x[0]); o[1] = sigm(x[1]); o[2] = sigm(x[2]); o[3] = sigm(x[3]); return o; }
__device__ __forceinline__ float quad_sum(float s) { s += __shfl_xor(s, 16); s += __shfl_xor(s, 32); return s; }
__device__ __forceinline__ float sq4(f32x4 v) { return (v[0] * v[0] + v[1] * v[1]) + (v[2] * v[2] + v[3] * v[3]); }
__device__ __forceinline__ f32x4 rope4(f32x4 v, f32x4 t) { f32x4 o; o[0] = v[0] * t[0] - v[1] * t[1]; o[1] = v[1] * t[0] + v[0] * t[1]; o[2] = v[2] * t[2] - v[3] * t[3]; o[3] = v[3] * t[2] + v[2] * t[3]; return o; }
#define EPI_FENCE() asm volatile("" ::: "memory")
#define EPI_LOOP_AM _Pragma("unroll") for (int ai = 0; ai < 2; ++ai) _Pragma("unroll") for (int m = 0; m < 4; ++m)

struct EpiInProj {
    static constexpr bool PERM = true, AFTER_DRAIN = false;
    bf16_t *QD, *KD, *VD, *SA, *SB, *CKV, *CQ, *KR; float *SSQ, *SSKV; const float* bgate; const float* tabD; const float* tabM;
    __device__ __forceinline__ void operator()(const f32x4 (&acc)[2][2][4][2], const Unit& u, int wr, int wc, int fr, int fq) const {
        const int pn = u.pn, rbase = u.pm * BM + wr * 64 + fr, lc = wc * 32 + fq * 8;
        if (pn < 8) {
            bf16_t* dst = (pn < 4 ? QD : KD) + (pn & 3) * 256 + lc; const float sc = pn < 4 ? QS_D : 1.f;
            const bool rp = ((wc & 1) == 0) && (fq < 2);
            EPI_LOOP_AM { const int row = rbase + ai * HALF + m * 16; f32x4 t0 = {1.f, 0.f, 1.f, 0.f}, t1 = t0;
                if (rp) { const f32x4* tp = (const f32x4*)(tabD + ((size_t)(row & (SEQ_LEN - 1)) * 8 + 4 * fq) * 2); t0 = tp[0]; t1 = tp[1]; }
#pragma unroll
                for (int bj = 0; bj < 2; ++bj) st8(dst + (size_t)row * 1024 + bj * HALF, rope4(acc[ai][bj][m][0], t0) * sc, rope4(acc[ai][bj][m][1], t1) * sc);
                EPI_FENCE(); }
        } else if (pn < 12) {
            bf16_t* dst = VD + (pn - 8) * 256 + lc;
            EPI_LOOP_AM { const int row = rbase + ai * HALF + m * 16;
#pragma unroll
                for (int bj = 0; bj < 2; ++bj) st8(dst + (size_t)row * 1024 + bj * HALF, acc[ai][bj][m][0], acc[ai][bj][m][1]); }
        } else if (pn < 20) {
            const int t = (pn - 12) & 3; bf16_t* dst = (pn < 16 ? SA : SB) + t * 256 + lc; const float* bp = bgate + (pn < 16 ? 0 : 1024) + t * 256 + lc;
            f32x4 b[2][2];
#pragma unroll
            for (int bj = 0; bj < 2; ++bj) { b[bj][0] = *(const f32x4*)(bp + bj * HALF); b[bj][1] = *(const f32x4*)(bp + bj * HALF + 4); }
            EPI_LOOP_AM { const int row = rbase + ai * HALF + m * 16;
#pragma unroll
                for (int bj = 0; bj < 2; ++bj) st8(dst + (size_t)row * 1024 + bj * HALF, sigm4(acc[ai][bj][m][0] + b[bj][0]), sigm4(acc[ai][bj][m][1] + b[bj][1])); }
        } else if (pn == 20) {
            EPI_LOOP_AM { const int row = rbase + ai * HALF + m * 16; float s = 0.f;
#pragma unroll
                for (int bj = 0; bj < 2; ++bj) { st8(CKV + (size_t)row * 256 + bj * HALF + lc, acc[ai][bj][m][0], acc[ai][bj][m][1]); s += sq4(acc[ai][bj][m][0]) + sq4(acc[ai][bj][m][1]); }
                s = quad_sum(s); if (fq == 0) SSKV[(size_t)row * 4 + wc] = s; }
        } else if (pn == 21) {
            EPI_LOOP_AM { const int row = rbase + ai * HALF + m * 16; float s = 0.f;
#pragma unroll
                for (int bj = 0; bj < 2; ++bj) { st8(CQ + (size_t)row * 384 + bj * HALF + lc, acc[ai][bj][m][0], acc[ai][bj][m][1]); s += sq4(acc[ai][bj][m][0]) + sq4(acc[ai][bj][m][1]); }
                s = quad_sum(s); if (fq == 0) SSQ[(size_t)row * 8 + wc] = s; }
        } else {
            EPI_LOOP_AM { const int row = rbase + ai * HALF + m * 16;
                st8(CQ + (size_t)row * 384 + 256 + lc, acc[ai][0][m][0], acc[ai][0][m][1]);
                float s = sq4(acc[ai][0][m][0]) + sq4(acc[ai][0][m][1]); s = quad_sum(s); if (fq == 0) SSQ[(size_t)row * 8 + 4 + wc] = s;
                if (wc == 0) { const f32x4* tp = (const f32x4*)(tabM + ((size_t)(row & (SEQ_LEN - 1)) * 16 + 4 * fq) * 2);
                    st8(KR + (size_t)row * 32 + fq * 8, rope4(acc[ai][1][m][0], tp[0]), rope4(acc[ai][1][m][1], tp[1])); }
                EPI_FENCE(); }
        }
    }
};
struct EpiQUp {
    static constexpr bool PERM = true, AFTER_DRAIN = false;
    const float* SSQ; const float* tabM; bf16_t* QM;
    __device__ __forceinline__ void operator()(const f32x4 (&acc)[2][2][4][2], const Unit& u, int wr, int wc, int fr, int fq) const {
        const int rbase = u.pm * BM + wr * 64 + fr, c0 = u.pn * BM + wc * 32 + fq * 8;
        const int hl0 = c0 % 96, hl1 = (c0 + HALF) % 96;
        EPI_LOOP_AM { const int row = rbase + ai * HALF + m * 16;
            const f32x4 s0 = *(const f32x4*)(SSQ + (size_t)row * 8), s1 = *(const f32x4*)(SSQ + (size_t)row * 8 + 4);
            const float rstd = __builtin_amdgcn_rsqf(((s0[0] + s0[1]) + (s0[2] + s0[3]) + (s1[0] + s1[1]) + (s1[2] + s1[3])) * (1.f / 384.f) + NEPS) * QS_M;
            const float* tb = tabM + (size_t)(row & (SEQ_LEN - 1)) * 32;
#pragma unroll
            for (int bj = 0; bj < 2; ++bj) { const int hl = bj ? hl1 : hl0; const bool rp = hl >= 64; const f32x4 id = {1.f, 0.f, 1.f, 0.f};
                const f32x4* tp = (const f32x4*)(tb + (rp ? hl - 64 : 0)); const f32x4 t0 = rp ? tp[0] : id, t1 = rp ? tp[1] : id;
                st8(QM + (size_t)row * 768 + c0 + bj * HALF, rope4(acc[ai][bj][m][0] * rstd, t0), rope4(acc[ai][bj][m][1] * rstd, t1)); EPI_FENCE(); }
            }
    }
};
struct EpiKVUp {
    static constexpr bool PERM = true, AFTER_DRAIN = false;
    const float* SSKV; bf16_t* KVM;
    __device__ __forceinline__ void operator()(const f32x4 (&acc)[2][2][4][2], const Unit& u, int wr, int wc, int fr, int fq) const {
        const int rbase = u.pm * BM + wr * 64 + fr, c0 = u.pn * BM + wc * 32 + fq * 8;
        EPI_LOOP_AM { const int row = rbase + ai * HALF + m * 16;
            const f32x4 s0 = *(const f32x4*)(SSKV + (size_t)row * 4);
            const float rstd = __builtin_amdgcn_rsqf(((s0[0] + s0[1]) + (s0[2] + s0[3])) * (1.f / 256.f) + NEPS);
#pragma unroll
            for (int bj = 0; bj < 2; ++bj) st8(KVM + (size_t)row * 1024 + c0 + bj * HALF, acc[ai][bj][m][0] * rstd, acc[ai][bj][m][1] * rstd);
            EPI_FENCE(); }
    }
};
struct EpiOutA {
    static constexpr bool PERM = true, AFTER_DRAIN = false;
    const bf16_t* SA; bf16_t* T;
    __device__ __forceinline__ void operator()(const f32x4 (&acc)[2][2][4][2], const Unit& u, int wr, int wc, int fr, int fq) const {
        const int rbase = u.pm * BM + wr * 64 + fr, c0 = u.pn * BM + wc * 32 + fq * 8;
#pragma unroll
        for (int ai = 0; ai < 2; ++ai) { u32x4 g[4][2];
#pragma unroll
            for (int m = 0; m < 4; ++m)
#pragma unroll
                for (int bj = 0; bj < 2; ++bj) g[m][bj] = *(const u32x4*)(SA + (size_t)(rbase + ai * HALF + m * 16) * 1024 + c0 + bj * HALF);
            EPI_FENCE();
#pragma unroll
            for (int m = 0; m < 4; ++m)
#pragma unroll
                for (int bj = 0; bj < 2; ++bj) { f32x4 g0, g1; up8(g[m][bj], g0, g1); st8(T + (size_t)(rbase + ai * HALF + m * 16) * 1024 + c0 + bj * HALF, acc[ai][bj][m][0] * g0, acc[ai][bj][m][1] * g1); }
            EPI_FENCE(); }
    }
};
struct EpiOutB {
    static constexpr bool PERM = true, AFTER_DRAIN = false;
    const bf16_t* SB; const bf16_t* T; bf16_t* MG;
    __device__ __forceinline__ void operator()(const f32x4 (&acc)[2][2][4][2], const Unit& u, int wr, int wc, int fr, int fq) const {
        const int rbase = u.pm * BM + wr * 64 + fr, c0 = u.pn * BM + wc * 32 + fq * 8;
#pragma unroll
        for (int ai = 0; ai < 2; ++ai) { u32x4 g[4][2], t[4][2];
#pragma unroll
            for (int m = 0; m < 4; ++m)
#pragma unroll
                for (int bj = 0; bj < 2; ++bj) { const size_t o = (size_t)(rbase + ai * HALF + m * 16) * 1024 + c0 + bj * HALF; g[m][bj] = *(const u32x4*)(SB + o); t[m][bj] = *(const u32x4*)(T + o); }
            EPI_FENCE();
#pragma unroll
            for (int m = 0; m < 4; ++m)
#pragma unroll
                for (int bj = 0; bj < 2; ++bj) { f32x4 g0, g1, t0, t1; up8(g[m][bj], g0, g1); up8(t[m][bj], t0, t1);
                    st8(MG + (size_t)(rbase + ai * HALF + m * 16) * 1024 + c0 + bj * HALF, t0 + acc[ai][bj][m][0] * g0, t1 + acc[ai][bj][m][1] * g1); }
            EPI_FENCE(); }
    }
};
template <bool RES_BF16> struct EpiResid {
    static constexpr bool PERM = true, AFTER_DRAIN = false;
    const void* res; bf16_t* xb; float* SS;
    __device__ __forceinline__ void operator()(const f32x4 (&acc)[2][2][4][2], const Unit& u, int wr, int wc, int fr, int fq) const {
        const int rbase = u.pm * BM + wr * 64 + fr, c0 = u.pn * BM + wc * 32 + fq * 8;
        if constexpr (RES_BF16) {
#pragma unroll
            for (int ai = 0; ai < 2; ++ai) { u32x4 r[4][2];
#pragma unroll
                for (int m = 0; m < 4; ++m)
#pragma unroll
                    for (int bj = 0; bj < 2; ++bj) r[m][bj] = *(const u32x4*)((const bf16_t*)res + (size_t)(rbase + ai * HALF + m * 16) * 1024 + c0 + bj * HALF);
                EPI_FENCE();
#pragma unroll
                for (int m = 0; m < 4; ++m) { const int row = rbase + ai * HALF + m * 16; float s = 0.f;
#pragma unroll
                    for (int bj = 0; bj < 2; ++bj) { f32x4 r0, r1; up8(r[m][bj], r0, r1); const f32x4 v0 = r0 + acc[ai][bj][m][0], v1 = r1 + acc[ai][bj][m][1];
                        st8(xb + (size_t)row * 1024 + c0 + bj * HALF, v0, v1); s += sq4(v0) + sq4(v1); }
                    s = quad_sum(s); if (fq == 0) SS[(size_t)row * 16 + u.pn * 4 + wc] = s; }
                EPI_FENCE(); }
        } else {
#pragma unroll
            for (int ai = 0; ai < 2; ++ai)
#pragma unroll
                for (int mp = 0; mp < 2; ++mp) { f32x4 r[2][2][2];
#pragma unroll
                    for (int mm = 0; mm < 2; ++mm)
#pragma unroll
                        for (int bj = 0; bj < 2; ++bj) { const float* p = (const float*)res + (size_t)(rbase + ai * HALF + (2 * mp + mm) * 16) * 1024 + c0 + bj * HALF; r[mm][bj][0] = *(const f32x4*)p; r[mm][bj][1] = *(const f32x4*)(p + 4); }
                    EPI_FENCE();
#pragma unroll
                    for (int mm = 0; mm < 2; ++mm) { const int m = 2 * mp + mm, row = rbase + ai * HALF + m * 16; float s = 0.f;
#pragma unroll
                        for (int bj = 0; bj < 2; ++bj) { const f32x4 v0 = r[mm][bj][0] + acc[ai][bj][m][0], v1 = r[mm][bj][1] + acc[ai][bj][m][1];
                            st8(xb + (size_t)row * 1024 + c0 + bj * HALF, v0, v1); s += sq4(v0) + sq4(v1); }
                        s = quad_sum(s); if (fq == 0) SS[(size_t)row * 16 + u.pn * 4 + wc] = s; }
                    EPI_FENCE(); }
        }
    }
};
__device__ __forceinline__ float rstd16(const float* ss) { const f32x4 a = *(const f32x4*)ss, b = *(const f32x4*)(ss + 4), c = *(const f32x4*)(ss + 8), d = *(const f32x4*)(ss + 12);
    const f32x4 t = (a + b) + (c + d); return __builtin_amdgcn_rsqf(((t[0] + t[1]) + (t[2] + t[3])) * (1.f / 1024.f) + NEPS); }
struct EpiSwiGLU {
    static constexpr bool PERM = true, AFTER_DRAIN = false;
    const float* SS; bf16_t* HID;
    __device__ __forceinline__ void operator()(const f32x4 (&acc)[2][2][4][2], const Unit& u, int wr, int wc, int fr, int fq) const {
        const int rbase = u.pm * BM + wr * 64 + fr, c0 = u.pn * HALF + wc * 32 + fq * 8;
        EPI_LOOP_AM { const int row = rbase + ai * HALF + m * 16; const float rstd = rstd16(SS + (size_t)row * 16);
            const f32x4 g0 = acc[ai][0][m][0] * rstd, g1 = acc[ai][0][m][1] * rstd, u0 = acc[ai][1][m][0] * rstd, u1 = acc[ai][1][m][1] * rstd;
            st8(HID + (size_t)row * 2816 + c0, g0 * sigm4(g0) * u0, g1 * sigm4(g1) * u1);
            EPI_FENCE(); }
    }
};
struct EpiPleA {
    static constexpr bool PERM = true, AFTER_DRAIN = false;
    bf16_t* T;
    __device__ __forceinline__ void operator()(const f32x4 (&acc)[2][2][4][2], const Unit& u, int wr, int wc, int fr, int fq) const {
        const int rbase = u.pm * BM + wr * 64 + fr, c0 = u.pn * BM + wc * 32 + fq * 8;
        EPI_LOOP_AM { const int row = rbase + ai * HALF + m * 16;
#pragma unroll
            for (int bj = 0; bj < 2; ++bj) st8(T + (size_t)row * 1024 + c0 + bj * HALF, acc[ai][bj][m][0], acc[ai][bj][m][1]); }
    }
};
struct EpiPleB {
    static constexpr bool PERM = true, AFTER_DRAIN = false;
    const float* SS2; const float* bias; const bf16_t* X2; const bf16_t* T2; bf16_t* X3; float* SS3;
    __device__ __forceinline__ void operator()(const f32x4 (&acc)[2][2][4][2], const Unit& u, int wr, int wc, int fr, int fq) const {
        const int rbase = u.pm * BM + wr * 64 + fr, c0 = u.pn * BM + wc * 32 + fq * 8;
#pragma unroll
        for (int ai = 0; ai < 2; ++ai)
#pragma unroll
          for (int mp = 0; mp < 2; ++mp) { u32x4 x[2][2], t[2][2]; float rs[2];
#pragma unroll
            for (int mm = 0; mm < 2; ++mm) { const int row = rbase + ai * HALF + (2 * mp + mm) * 16;
#pragma unroll
                for (int bj = 0; bj < 2; ++bj) { const size_t o = (size_t)row * 1024 + c0 + bj * HALF; x[mm][bj] = *(const u32x4*)(X2 + o); t[mm][bj] = *(const u32x4*)(T2 + o); }
                rs[mm] = rstd16(SS2 + (size_t)row * 16); }
            EPI_FENCE();
#pragma unroll
            for (int mm = 0; mm < 2; ++mm) { const int m = 2 * mp + mm, row = rbase + ai * HALF + m * 16; float s = 0.f;
#pragma unroll
                for (int bj = 0; bj < 2; ++bj) { const f32x4 b0 = *(const f32x4*)(bias + c0 + bj * HALF), b1 = *(const f32x4*)(bias + c0 + bj * HALF + 4);
                    f32x4 x0, x1, t0, t1; up8(x[mm][bj], x0, x1); up8(t[mm][bj], t0, t1);
                    const f32x4 v0 = x0 + t0 * sigm4(acc[ai][bj][m][0] * rs[mm] + b0), v1 = x1 + t1 * sigm4(acc[ai][bj][m][1] * rs[mm] + b1);
                    st8(X3 + (size_t)row * 1024 + c0 + bj * HALF, v0, v1); s += sq4(v0) + sq4(v1); }
                s = quad_sum(s); if (fq == 0) SS3[(size_t)row * 16 + u.pn * 4 + wc] = s; }
            EPI_FENCE(); }
    }
};
template <class Epi, class Sched, bool ALIGN_EPI = false, bool SP2 = false>
__device__ __forceinline__ void gemm_phase(PG8_LAS unsigned char* lds, const Gemm g, const Sched& S, const Epi& E) {
    int tid_ = threadIdx.x; asm volatile("" : "+v"(tid_)); const int tid = tid_, wid = __builtin_amdgcn_readfirstlane(tid >> 6), lane = tid & 63, wr = wid >> 2, wc = wid & 3, fr = lane & 15, fq = lane >> 4;
    const int K = g.K, nt = K / BK;
    unsigned voffA[2], voffB[2];
#pragma unroll
    for (int i = 0; i < 2; ++i) { int R, C; stage_rc(tid * 16 + i * 8192, R, C); const int Rb = Epi::PERM ? ((R & ~31) + perm32(R & 31)) : R;
        voffA[i] = (unsigned)(R * K + C) * 2u; voffB[i] = (unsigned)(Rb * K + C) * 2u; }
    const size_t kstep = (size_t)(BK * 2);
    const size_t hstep = (size_t)HALF * K * 2;
    const size_t tstep = 2 * hstep;
    const unsigned ldsw = (unsigned)wid * 1024u;
    const int aoff = lds_byte(wr * 64 + fr, fq * 8), boff = lds_byte(wc * 32 + fr, fq * 8);
#define PG8_SA(b, h) (((b) * 2 + (h)) * HTB)
#define PG8_SB(b, h) ((4 + (b) * 2 + (h)) * HTB)
#define PG8_STAGE(bufoff, gbase, voff) do { _Pragma("unroll") for (int _i = 0; _i < 2; ++_i) \
        __builtin_amdgcn_global_load_lds((const unsigned*)((const char*)(gbase) + (voff)[_i]), (PG8_LAS unsigned*)(lds + (bufoff) + ldsw + _i * 8192), 16, 0, 0); } while (0)
#define PG8_LDA(dst, b, h) do { _Pragma("unroll") for (int m = 0; m < 4; ++m) _Pragma("unroll") for (int k = 0; k < 2; ++k) dst[m][k] = *(const PG8_LAS bf16x8*)(lds + PG8_SA(b, h) + aoff + m * 2048 + k * 1024); } while (0)
#define PG8_LDB(dst, b, h) do { _Pragma("unroll") for (int n = 0; n < 2; ++n) _Pragma("unroll") for (int k = 0; k < 2; ++k) dst[n][k] = *(const PG8_LAS bf16x8*)(lds + PG8_SB(b, h) + boff + n * 2048 + k * 1024); } while (0)
#define PG8_MMA(ai, bj, At, Bt) do { __builtin_amdgcn_s_setprio(1); _Pragma("unroll") for (int m = 0; m < 4; ++m) _Pragma("unroll") for (int n = 0; n < 2; ++n) _Pragma("unroll") for (int k = 0; k < 2; ++k) \
        acc[ai][bj][m][n] = __builtin_amdgcn_mfma_f32_16x16x32_bf16(Bt[n][k], At[m][k], acc[ai][bj][m][n], 0, 0, 0); __builtin_amdgcn_s_setprio(0); } while (0)
#define PG8_WAIT_V(n) asm volatile("s_waitcnt vmcnt(" #n ")" ::: "memory")
#define PG8_WAIT_L(n) asm volatile("s_waitcnt lgkmcnt(" #n ")" ::: "memory")
#define PG8_BAR __builtin_amdgcn_s_barrier()
#define PG8_SCHED __builtin_amdgcn_sched_barrier(0)
    Unit cur, nxt; int ui = 0;
    if (!S.next(0, cur)) return;
    f32x4 acc[2][2][4][2];
#pragma unroll
    for (int a = 0; a < 2; ++a)
#pragma unroll
        for (int b = 0; b < 2; ++b)
#pragma unroll
            for (int m = 0; m < 4; ++m)
#pragma unroll
                for (int n = 0; n < 2; ++n) acc[a][b][m][n] = (f32x4){0.f, 0.f, 0.f, 0.f};
    bf16x8 At[4][2], B0[2][2], B1[2][2];
    const char* cA = (const char*)g.A + (size_t)cur.pm * tstep; const char* cB = (const char*)g.Bt + (size_t)cur.pn * tstep;
    S.a_ready(cur);
    if constexpr (SP2) {
        PG8_STAGE(PG8_SB(0, 0), cB, voffB); PG8_STAGE(PG8_SB(0, 1), cB + hstep, voffB); PG8_STAGE(PG8_SA(0, 0), cA, voffA); PG8_STAGE(PG8_SA(0, 1), cA + hstep, voffA);
        if (wr == 1) PG8_BAR;
        PG8_WAIT_V(2); PG8_BAR;
        PG8_STAGE(PG8_SB(1, 0), cB + kstep, voffB); PG8_STAGE(PG8_SA(1, 0), cA + kstep, voffA); PG8_STAGE(PG8_SB(1, 1), cB + hstep + kstep, voffB);
        PG8_WAIT_V(6); PG8_BAR;
    } else {
        PG8_STAGE(PG8_SB(0, 0), cB, voffB); PG8_STAGE(PG8_SA(0, 0), cA, voffA); PG8_STAGE(PG8_SB(0, 1), cB + hstep, voffB); PG8_STAGE(PG8_SA(0, 1), cA + hstep, voffA);
        if (wr == 1) PG8_BAR;
        PG8_WAIT_V(4); PG8_BAR;
        PG8_STAGE(PG8_SB(1, 0), cB + kstep, voffB); PG8_STAGE(PG8_SA(1, 0), cA + kstep, voffA); PG8_STAGE(PG8_SB(1, 1), cB + hstep + kstep, voffB);
        PG8_WAIT_V(6); PG8_BAR;
    }
    for (;;) {
        const bool has_next = S.next(ui + 1, nxt);
        const char* nA = has_next ? (const char*)g.A + (size_t)nxt.pm * tstep : cA; const char* nB = has_next ? (const char*)g.Bt + (size_t)nxt.pn * tstep : cB;
        for (int t = 0; t < nt; t += 2) {
            const bool last = (t == nt - 2);
            const char* a1 = cA + (size_t)(t + 1) * kstep;
            const char* a2 = last ? nA : cA + (size_t)(t + 2) * kstep; const char* b2 = last ? nB : cB + (size_t)(t + 2) * kstep;
            const char* a3 = a2 + kstep; const char* b3 = b2 + kstep;
            if (last && has_next) S.a_ready(nxt);
            if constexpr (SP2) {
            PG8_LDB(B0, 0, 0); PG8_LDB(B1, 0, 1); PG8_SCHED; PG8_LDA(At, 0, 0); PG8_STAGE(PG8_SA(1, 1), a1 + hstep, voffA);
            PG8_WAIT_V(8); PG8_WAIT_L(0); PG8_BAR; PG8_MMA(0, 0, At, B0); PG8_MMA(0, 1, At, B1); PG8_BAR; PG8_SCHED;
            PG8_LDA(At, 0, 1); PG8_STAGE(PG8_SB(0, 0), b2, voffB); PG8_STAGE(PG8_SB(0, 1), b2 + hstep, voffB); PG8_STAGE(PG8_SA(0, 0), a2, voffA);
            PG8_WAIT_V(8); PG8_WAIT_L(0); PG8_BAR; PG8_MMA(1, 0, At, B0); PG8_MMA(1, 1, At, B1); PG8_BAR; PG8_SCHED;
            PG8_LDB(B0, 1, 0); PG8_LDB(B1, 1, 1); PG8_SCHED; PG8_LDA(At, 1, 0); PG8_STAGE(PG8_SA(0, 1), a2 + hstep, voffA);
            PG8_WAIT_V(8); PG8_WAIT_L(0); PG8_BAR; PG8_MMA(0, 0, At, B0); PG8_MMA(0, 1, At, B1); PG8_BAR; PG8_SCHED;
            PG8_LDA(At, 1, 1); PG8_STAGE(PG8_SB(1, 0), b3, voffB); PG8_STAGE(PG8_SB(1, 1), b3 + hstep, voffB); PG8_STAGE(PG8_SA(1, 0), a3, voffA);
            PG8_WAIT_V(8); PG8_WAIT_L(0); PG8_BAR; PG8_MMA(1, 0, At, B0); PG8_MMA(1, 1, At, B1); PG8_BAR; PG8_SCHED;
            } else {
            PG8_LDB(B0, 0, 0); PG8_SCHED; PG8_LDA(At, 0, 0); PG8_STAGE(PG8_SA(1, 1), a1 + hstep, voffA);
            PG8_WAIT_L(8); PG8_BAR; PG8_WAIT_L(0); PG8_MMA(0, 0, At, B0); PG8_BAR; PG8_SCHED;
            PG8_LDB(B1, 0, 1); PG8_STAGE(PG8_SB(0, 0), b2, voffB);
            PG8_BAR; PG8_WAIT_L(0); PG8_MMA(0, 1, At, B1); PG8_BAR;
            PG8_LDA(At, 0, 1); PG8_STAGE(PG8_SA(0, 0), a2, voffA);
            PG8_BAR; PG8_WAIT_L(0); PG8_MMA(1, 0, At, B0); PG8_BAR; PG8_SCHED;
            PG8_STAGE(PG8_SB(0, 1), b2 + hstep, voffB);
            PG8_WAIT_V(6); PG8_BAR; PG8_MMA(1, 1, At, B1); PG8_BAR;
            PG8_LDB(B0, 1, 0); PG8_SCHED; PG8_LDA(At, 1, 0); PG8_STAGE(PG8_SA(0, 1), a2 + hstep, voffA);
            PG8_WAIT_L(8); PG8_BAR; PG8_WAIT_L(0); PG8_MMA(0, 0, At, B0); PG8_BAR; PG8_SCHED;
            PG8_LDB(B1, 1, 1); PG8_STAGE(PG8_SB(1, 0), b3, voffB);
            PG8_BAR; PG8_WAIT_L(0); PG8_MMA(0, 1, At, B1); PG8_BAR;
            PG8_LDA(At, 1, 1); PG8_STAGE(PG8_SA(1, 0), a3, voffA);
            PG8_BAR; PG8_WAIT_L(0); PG8_MMA(1, 0, At, B0); PG8_BAR; PG8_SCHED;
            PG8_STAGE(PG8_SB(1, 1), b3 + hstep, voffB);
            PG8_WAIT_V(6); PG8_BAR; PG8_MMA(1, 1, At, B1); PG8_BAR;
            }
        }
        if constexpr (ALIGN_EPI) { if (wr == 0) PG8_BAR; }
        if constexpr (!Epi::AFTER_DRAIN) { E(acc, cur, wr, wc, fr, fq); S.done(cur); }
        if (!has_next) break;
#pragma unroll
        for (int a = 0; a < 2; ++a)
#pragma unroll
            for (int b = 0; b < 2; ++b)
#pragma unroll
                for (int m = 0; m < 4; ++m)
#pragma unroll
                    for (int n = 0; n < 2; ++n) acc[a][b][m][n] = (f32x4){0.f, 0.f, 0.f, 0.f};
        cur = nxt; cA = nA; cB = nB; ++ui;
        if constexpr (ALIGN_EPI) { if (wr == 1) PG8_BAR; }
    }
    PG8_WAIT_V(0);
    if constexpr (!ALIGN_EPI) { if (wr == 0) PG8_BAR; }
    PG8_BAR;
    if constexpr (Epi::AFTER_DRAIN) { E.fused(acc, cur, wr, wc, fr, fq, lds, wid, lane); S.done(cur); }
#undef PG8_SA
#undef PG8_SB
#undef PG8_STAGE
#undef PG8_LDA
#undef PG8_LDB
#undef PG8_MMA
#undef PG8_WAIT_V
#undef PG8_WAIT_L
#undef PG8_BAR
#undef PG8_SCHED
}
}
namespace att {
#define ATT_LAS __attribute__((address_space(3)))
typedef unsigned short bf16_t;
typedef short bf16x8 __attribute__((ext_vector_type(8)));
typedef short s16x4 __attribute__((ext_vector_type(4)));
typedef float f32x16 __attribute__((ext_vector_type(16)));
typedef float f32x4 __attribute__((ext_vector_type(4)));
typedef unsigned u32x4 __attribute__((ext_vector_type(4)));
typedef unsigned u32x2 __attribute__((ext_vector_type(2)));
constexpr int KB0 = 0, KBSZ = 12288, VB0 = 24576, VBSZ = 16384;
__device__ __forceinline__ float swap_max(float m) { auto rr = __builtin_amdgcn_permlane32_swap(__float_as_uint(m), __float_as_uint(m), false, false); return fmaxf(__uint_as_float(rr[0]), __uint_as_float(rr[1])); }
__device__ __forceinline__ float swap_sum(float m) { auto rr = __builtin_amdgcn_permlane32_swap(__float_as_uint(m), __float_as_uint(m), false, false); return __uint_as_float(rr[0]) + __uint_as_float(rr[1]); }
__device__ __forceinline__ s16x4 vtr(const ATT_LAS char* p) { return __builtin_bit_cast(s16x4, __builtin_amdgcn_ds_read_tr16_b64_v4i16((ATT_LAS s16x4*)p)); }
__device__ __forceinline__ int crow(int r, int hi) { return (r & 3) + 8 * (r >> 2) + 4 * hi; }

template <int DQK, int DV, bool MLA>
__device__ __forceinline__ void attn_pass(ATT_LAS char* lds, const bf16_t* qp, const bf16_t* kg, const bf16_t* krg, const bf16_t* vg, int NT, int myNT, f32x16 (&o)[DV / 32], float& linv) {
    int tid_ = threadIdx.x; asm volatile("" : "+v"(tid_)); const int tid = tid_, lane = tid & 63, wid = __builtin_amdgcn_readfirstlane(tid >> 6), r32 = lane & 31, hi = lane >> 5;
    bf16x8 qr[DQK / 16];
#pragma unroll
    for (int d0 = 0; d0 < DQK / 16; ++d0) qr[d0] = *(const bf16x8*)(qp + d0 * 16);
    const bf16_t* ksrc = kg + (size_t)lane * 1024 + wid * 8;
    const bf16_t* krsrc = krg + (size_t)lane * 32 + (wid & 3) * 8;
    const bf16_t* vsrc = vg + (size_t)(16 * (wid & 3) + (lane >> 2)) * 1024 + (wid >> 2) * 32 + (lane & 3) * 8;
    const int sto = wid * 1024 + lane * 16;
    u32x4 kr0 = {0u, 0u, 0u, 0u}, kr1 = kr0, vr0 = kr0, vr1 = kr0;
#define ATT_LOAD(t) do { kr0 = *(const u32x4*)(ksrc + (size_t)(t) * 65536); if (MLA) { if (wid < 4) kr1 = *(const u32x4*)(krsrc + (size_t)(t) * 2048); } \
        vr0 = *(const u32x4*)(vsrc + (size_t)(t) * 65536); if (DV == 128) vr1 = *(const u32x4*)(vsrc + (size_t)(t) * 65536 + 64); } while (0)
#define ATT_STORE(b) do { *(ATT_LAS u32x4*)(lds + KB0 + (b) * KBSZ + sto) = kr0; if (MLA) { if (wid < 4) *(ATT_LAS u32x4*)(lds + KB0 + (b) * KBSZ + 8192 + sto) = kr1; } \
        *(ATT_LAS u32x4*)(lds + VB0 + (b) * VBSZ + sto) = vr0; if (DV == 128) *(ATT_LAS u32x4*)(lds + VB0 + (b) * VBSZ + 8192 + sto) = vr1; } while (0)
#pragma unroll
    for (int i = 0; i < DV / 32; ++i)
#pragma unroll
        for (int r = 0; r < 16; ++r) o[i][r] = 0.f;
    float mref = -1e30f, lsum = 0.f;
    ATT_LOAD(0); ATT_STORE(0); __syncthreads();
    for (int t = 0; t < NT; ++t) {
        const int b = t & 1;
        if (t + 1 < NT) ATT_LOAD(t + 1);
        if (t < myNT) {
            const ATT_LAS char* kp = lds + KB0 + b * KBSZ + hi * 1024 + r32 * 16;
            f32x16 p0, p1;
#pragma unroll
            for (int r = 0; r < 16; ++r) { p0[r] = 0.f; p1[r] = 0.f; }
#pragma unroll
            for (int d0 = 0; d0 < DQK / 16; ++d0) {
                const bf16x8 k0 = *(const ATT_LAS bf16x8*)(kp + d0 * 2048), k1 = *(const ATT_LAS bf16x8*)(kp + d0 * 2048 + 512);
                p0 = __builtin_amdgcn_mfma_f32_32x32x16_bf16(k0, qr[d0], p0, 0, 0, 0);
                p1 = __builtin_amdgcn_mfma_f32_32x32x16_bf16(k1, qr[d0], p1, 0, 0, 0);
            }
            float mx = fmaxf(p0[0], p1[0]);
#pragma unroll
            for (int r = 1; r < 16; ++r) mx = fmaxf(mx, fmaxf(p0[r], p1[r]));
            mx = swap_max(mx);
            if (__any(mx > mref + 8.f)) {
                const float mn = fmaxf(mref, mx), al = __builtin_amdgcn_exp2f(mref - mn);
                lsum *= al;
#pragma unroll
                for (int i = 0; i < DV / 32; ++i)
#pragma unroll
                    for (int r = 0; r < 16; ++r) o[i][r] *= al;
                mref = mn;
            }
            float ls = 0.f;
#pragma unroll
            for (int r = 0; r < 16; ++r) { p0[r] = __builtin_amdgcn_exp2f(p0[r] - mref); p1[r] = __builtin_amdgcn_exp2f(p1[r] - mref); ls += p0[r] + p1[r]; }
            lsum += ls;
            u32x4 pw[4];
#pragma unroll
            for (int j = 0; j < 4; ++j) { pw[0][j] = pg8::pk2(p0[2 * j], p0[2 * j + 1]); pw[1][j] = pg8::pk2(p0[8 + 2 * j], p0[9 + 2 * j]); pw[2][j] = pg8::pk2(p1[2 * j], p1[2 * j + 1]); pw[3][j] = pg8::pk2(p1[8 + 2 * j], p1[9 + 2 * j]); }
            const ATT_LAS char* vp = lds + VB0 + b * VBSZ + ((lane >> 4) & 1) * 32 + (lane & 3) * 8 + (4 * hi + ((lane & 15) >> 2)) * 64;
#pragma unroll
            for (int i = 0; i < DV / 32; ++i)
#pragma unroll
                for (int ks = 0; ks < 4; ++ks) {
                    const s16x4 lo = vtr(vp + i * 4096 + ks * 1024), hh = vtr(vp + i * 4096 + ks * 1024 + 512);
                    const bf16x8 vf = {lo[0], lo[1], lo[2], lo[3], hh[0], hh[1], hh[2], hh[3]};
                    o[i] = __builtin_amdgcn_mfma_f32_32x32x16_bf16(vf, __builtin_bit_cast(bf16x8, pw[ks]), o[i], 0, 0, 0);
                }
        }
        if (t + 1 < NT) ATT_STORE(b ^ 1);
        __syncthreads();
    }
    linv = __builtin_amdgcn_rcpf(swap_sum(lsum));
#undef ATT_LOAD
#undef ATT_STORE
}

__device__ __forceinline__ void diff_unit(ATT_LAS char* lds, int b, int h, int qb, const bf16_t* QD, const bf16_t* KD, const bf16_t* VD, bf16_t* OD, const float* subln, float lam) {
    int tid_ = threadIdx.x; asm volatile("" : "+v"(tid_)); const int tid = tid_, lane = tid & 63, wid = __builtin_amdgcn_readfirstlane(tid >> 6), r32 = lane & 31, hi = lane >> 5;
    const size_t row0 = (size_t)b * SEQ_LEN, qrow = row0 + qb * 256 + wid * 32 + r32;
    const int NT = 4 * qb + 4, myNT = 4 * qb + (wid >> 1) + 1;
    f32x16 o1[4], o2[4]; float li1, li2;
    attn_pass<64, 128, false>(lds, QD + qrow * 1024 + (2 * h) * 64 + hi * 8, KD + row0 * 1024 + (2 * h) * 64, nullptr, VD + row0 * 1024 + h * 128, NT, myNT, o1, li1);
    attn_pass<64, 128, false>(lds, QD + qrow * 1024 + (2 * h + 1) * 64 + hi * 8, KD + row0 * 1024 + (2 * h + 1) * 64, nullptr, VD + row0 * 1024 + h * 128, NT, myNT, o2, li2);
    const float c2 = lam * li2; float ss = 0.f;
#pragma unroll
    for (int i = 0; i < 4; ++i)
#pragma unroll
        for (int r = 0; r < 16; ++r) { const float v = o1[i][r] * li1 - o2[i][r] * c2; o1[i][r] = v; ss += v * v; }
    ss = swap_sum(ss);
    const float rstd = __builtin_amdgcn_rsqf(ss * (1.f / 128.f) + NEPS) * 0.8f;
    bf16_t* op = OD + qrow * 1024 + h * 128 + 4 * hi;
#pragma unroll
    for (int i = 0; i < 4; ++i)
#pragma unroll
        for (int rq = 0; rq < 4; ++rq) { const int dv = 32 * i + 8 * rq; const f32x4 g = *(const f32x4*)(subln + dv + 4 * hi);
            u32x2 w; w.x = pg8::pk2(o1[i][4 * rq] * rstd * g[0], o1[i][4 * rq + 1] * rstd * g[1]); w.y = pg8::pk2(o1[i][4 * rq + 2] * rstd * g[2], o1[i][4 * rq + 3] * rstd * g[3]);
            *(u32x2*)(op + dv) = w; }
}
__device__ __forceinline__ void mla_unit(ATT_LAS char* lds, int b, int h, int qb, const bf16_t* QM, const bf16_t* KVM, const bf16_t* KR, bf16_t* OM) {
    int tid_ = threadIdx.x; asm volatile("" : "+v"(tid_)); const int tid = tid_, lane = tid & 63, wid = __builtin_amdgcn_readfirstlane(tid >> 6), r32 = lane & 31, hi = lane >> 5;
    const size_t row0 = (size_t)b * SEQ_LEN, qrow = row0 + qb * 256 + wid * 32 + r32;
    const int NT = 4 * qb + 4, myNT = 4 * qb + (wid >> 1) + 1;
    f32x16 o[2]; float li;
    attn_pass<96, 64, true>(lds, QM + qrow * 768 + h * 96 + hi * 8, KVM + row0 * 1024 + h * 128, KR + row0 * 32, KVM + row0 * 1024 + h * 128 + 64, NT, myNT, o, li);
    bf16_t* op = OM + qrow * 512 + h * 64 + 4 * hi;
#pragma unroll
    for (int i = 0; i < 2; ++i)
#pragma unroll
        for (int rq = 0; rq < 4; ++rq) { const int dv = 32 * i + 8 * rq;
            u32x2 w; w.x = pg8::pk2(o[i][4 * rq] * li, o[i][4 * rq + 1] * li); w.y = pg8::pk2(o[i][4 * rq + 2] * li, o[i][4 * rq + 3] * li);
            *(u32x2*)(op + dv) = w; }
}
}
#define LAS __attribute__((address_space(3)))
typedef unsigned short bf16;
typedef float f32x4 __attribute__((ext_vector_type(4)));
typedef unsigned v4u __attribute__((ext_vector_type(4)));
typedef unsigned v2u __attribute__((ext_vector_type(2)));
constexpr int NWAVES = 8, LDS_BYTES = 147456;
constexpr size_t MiB = 1ull << 20;
constexpr size_t WS_TABD = 0, WS_TABM = 128 * 1024, WS_LAM = 384 * 1024, WS_BAR = 512 * 1024;
constexpr size_t WS_SSQ = 1 * MiB, WS_SSKV = 2 * MiB, WS_SS1 = 3 * MiB, WS_SS2 = 5 * MiB, WS_SS3 = 7 * MiB;
constexpr size_t WS_WIN = 10 * MiB, WS_WGU = WS_WIN + 5888ull * 1024 * 2, WS_WDN = WS_WGU + 5632ull * 1024 * 2, WS_WOD = WS_WDN + 1024ull * 2816 * 2, WS_WOUT = WS_WOD + 2 * MiB,
                 WS_WPG = WS_WOUT + 2 * MiB, WS_WOM = WS_WPG + 2 * MiB, WS_WUQ = WS_WOM + 1 * MiB, WS_WUKV = WS_WUQ + 768ull * 384 * 2, WS_WPLE = WS_WUKV + 1024ull * 256 * 2, WS_WEND = WS_WPLE + 1024ull * 256 * 2;
static_assert(WS_WEND <= 47 * MiB, "weights");
constexpr size_t WS_PB = 47 * MiB;
constexpr size_t WS_XN = 64 * MiB, WS_QM = 64 * MiB, WS_X1B = 64 * MiB;
constexpr size_t WS_QD = 128 * MiB, WS_KD = 192 * MiB, WS_VD = 256 * MiB, WS_KVM = 320 * MiB;
constexpr size_t WS_T = 192 * MiB, WS_MG = 320 * MiB;
constexpr size_t WS_HID = 128 * MiB, WS_X2B = 304 * MiB;
constexpr size_t WS_X3B = 384 * MiB, WS_T2B = 448 * MiB;
constexpr size_t WS_CKV = 384 * MiB, WS_CQ = 400 * MiB, WS_KR = 424 * MiB, WS_OM = 426 * MiB;
constexpr size_t WS_END = 512 * MiB;

#define XB_TMO      128
#define XB_XCNT(j)  (256  + 64 * (j))
#define XB_XSUB(j)  (1280 + 64 * (j))
#define XB_XGEN(j)  (2304 + 64 * (j))
#define XB_TOP      3328
#define XB_TOPGEN   3392
#define XCD_BAR_WORDS 3456
#define XB_SPIN_CAP (1u << 18)

__device__ __forceinline__ unsigned xb_ld(unsigned* p)              { return __hip_atomic_load(p, __ATOMIC_RELAXED, __HIP_MEMORY_SCOPE_AGENT); }
__device__ __forceinline__ unsigned xb_add(unsigned* p, unsigned v) { return __hip_atomic_fetch_add(p, v, __ATOMIC_RELAXED, __HIP_MEMORY_SCOPE_AGENT); }
__device__ __forceinline__ unsigned xb_xcc_id() { return (unsigned)__builtin_amdgcn_s_getreg((3 << 11) | 20) & 0xFu; }
#define XB_SPIN(cond, bar) do { unsigned _sp = 0; while (cond) { __builtin_amdgcn_s_sleep(1); \
    if ((++_sp & 255u) == 0u) { if (xb_ld(&(bar)[XB_TMO])) break; if (_sp > XB_SPIN_CAP) { atomicAdd(&(bar)[XB_TMO], 1u); break; } } } } while (0)

struct XcdBarrier {
    unsigned* bar; unsigned x;
    volatile LAS unsigned* st;
};

__device__ __forceinline__ XcdBarrier xcd_barrier_post(unsigned* bar, volatile LAS unsigned* st) {
    XcdBarrier b; b.bar = bar; b.x = xb_xcc_id(); b.st = st;
    if (threadIdx.x == 0) (void)xb_add(&bar[XB_XCNT(b.x)], 1u);
    return b;
}
__device__ __forceinline__ void xcd_barrier_complete(unsigned* bar, unsigned x, unsigned& nloc, unsigned& nx) {
    const unsigned G = gridDim.x * gridDim.y * gridDim.z;
    unsigned sum, cnt, mine, sp = 0u;
    for (;;) {
        sum = 0u; cnt = 0u; mine = 0u;
#pragma unroll
        for (unsigned j = 0; j < 16; ++j) { const unsigned c = xb_ld(&bar[XB_XCNT(j)]); sum += c; cnt += (c > 0u) ? 1u : 0u; mine = (j == x) ? c : mine; }
        if (sum == G) break;
        __builtin_amdgcn_s_sleep(1);
        if ((++sp & 255u) == 0u) { if (xb_ld(&bar[XB_TMO])) break; if (sp > XB_SPIN_CAP) { atomicAdd(&bar[XB_TMO], 1u); break; } }
    }
    nloc = mine > 0u ? mine : 1u; nx = cnt > 0u ? cnt : 1u;
}

__device__ __forceinline__ void xcd_barrier(const XcdBarrier& b) {
    asm volatile("s_waitcnt vmcnt(0)" ::: "memory");
    __syncthreads();
    if (threadIdx.x == 0) {
        unsigned* bar = b.bar;
        __builtin_amdgcn_s_waitcnt(0);
        unsigned nloc = b.st[0], nx = b.st[1];
        if (nloc == 0u) { xcd_barrier_complete(bar, b.x, nloc, nx); b.st[0] = nloc; b.st[1] = nx; }
        const unsigned old = xb_add(&bar[XB_XSUB(b.x)], 1u);
        const unsigned gen = old / nloc;
        if (old + 1u == (gen + 1u) * nloc) {
            __builtin_amdgcn_fence(__ATOMIC_RELEASE, "agent");
            asm volatile("s_waitcnt vmcnt(0)" ::: "memory");
            const unsigned og = xb_add(&bar[XB_TOP], 1u);
            const unsigned tg = og / nx;
            if (og + 1u == (tg + 1u) * nx) xb_add(&bar[XB_TOPGEN], 1u);
            else XB_SPIN(xb_ld(&bar[XB_TOPGEN]) == tg, bar);
            __builtin_amdgcn_fence(__ATOMIC_ACQUIRE, "agent");
            xb_add(&bar[XB_XGEN(b.x)], 1u);
            asm volatile("s_waitcnt vmcnt(0)" ::: "memory");
        } else {
            XB_SPIN(xb_ld(&bar[XB_XGEN(b.x)]) == gen, bar);
            __builtin_amdgcn_fence(__ATOMIC_ACQUIRE, "agent");
            asm volatile("s_waitcnt vmcnt(0)" ::: "memory");
        }
    }
    __syncthreads();
}

struct Args {
    const float *x, *p, *attn_norm, *w_in, *b_gate, *lam_q1, *lam_k1, *lam_q2, *lam_k2, *diff_subln, *w_o_diff, *q_norm, *w_uq, *kv_norm, *w_ukv, *w_o_mla, *w_out, *ffn_norm,
        *w_ffn_gate, *w_ffn_up, *w_ffn_down, *ple_norm, *w_ple_gate, *b_ple_gate, *w_ple, *final_norm;
    float* out; unsigned char* ws;
};

__device__ __forceinline__ float wave_sum(float v) {
#pragma unroll
    for (int o = 1; o < 64; o <<= 1) v += __shfl_xor(v, o);
    return v;
}
__device__ __forceinline__ void wprep_item(int kind, const float* W, const float* W2, int ld, int K, int Nout, const float* gain, bf16* WT, int item, LAS float* scr, int lane) {
    const int nnb = Nout / 64, kb = item / nnb, nb = item % nnb, k0 = kb * 64, n0 = nb * 64, n = n0 + lane;
    const float* base = W; int col = n;
    if (kind == 1) {
        if (n < 2048) { const int hl = n & 63; col = (n & ~63) + (hl < 16 ? ((hl & 1) ? (hl >> 1) + 8 : (hl >> 1)) : hl); }
        else if (n < 3072) col = n;
        else if (n < 5120) col = 3744 + (n - 3072);
        else if (n < 5376) col = 3456 + (n - 5120);
        else if (n < 5760) col = 3072 + (n - 5376);
        else if (n < 5792) { const int hl = n - 5760; col = 3712 + ((hl & 1) ? (hl >> 1) + 16 : (hl >> 1)); }
        else col = -1;
    } else if (kind == 2) { const int h = n / 96, hl = n % 96; int s = hl; if (hl >= 64) { const int r = hl - 64; s = 64 + ((r & 1) ? (r >> 1) + 16 : (r >> 1)); } col = h * 96 + s;
    } else if (kind == 3) { const int pn = n >> 8, r = n & 255; if (r < 128) col = pn * 128 + r; else { base = W2; col = pn * 128 + (r - 128); } }
#pragma unroll 32
    for (int kk = 0; kk < 64; ++kk) { float v = (col >= 0) ? base[(size_t)(k0 + kk) * ld + col] : 0.f; if (gain) v *= gain[k0 + kk]; scr[kk * 65 + lane] = v; }
    asm volatile("s_waitcnt lgkmcnt(0)" ::: "memory");
    const int c = lane & 7;
#pragma unroll
    for (int j = 0; j < 8; ++j) { const int nn = (lane >> 3) + 8 * j; const LAS float* s = scr + (8 * c) * 65 + nn;
        v4u o; o.x = pg8::pk2(s[0], s[65]); o.y = pg8::pk2(s[2 * 65], s[3 * 65]); o.z = pg8::pk2(s[4 * 65], s[5 * 65]); o.w = pg8::pk2(s[6 * 65], s[7 * 65]);
        *(v4u*)(WT + (size_t)(n0 + nn) * K + k0 + 8 * c) = o; }
    asm volatile("s_waitcnt lgkmcnt(0)" ::: "memory");
}


#define WSP(T, off) ((T*)(a.ws + (off)))
#define tabD WSP(float, WS_TABD)
#define tabM WSP(float, WS_TABM)
#define lamp WSP(float, WS_LAM)
#define SSQ WSP(float, WS_SSQ)
#define SSKV WSP(float, WS_SSKV)
#define SS1 WSP(float, WS_SS1)
#define SS2 WSP(float, WS_SS2)
#define SS3 WSP(float, WS_SS3)
#define Win WSP(bf16, WS_WIN)
#define Wgu WSP(bf16, WS_WGU)
#define Wdn WSP(bf16, WS_WDN)
#define Wod WSP(bf16, WS_WOD)
#define Wout WSP(bf16, WS_WOUT)
#define Wpg WSP(bf16, WS_WPG)
#define Wom WSP(bf16, WS_WOM)
#define Wuq WSP(bf16, WS_WUQ)
#define Wukv WSP(bf16, WS_WUKV)
#define Wple WSP(bf16, WS_WPLE)
#define PB WSP(bf16, WS_PB)
#define XN WSP(bf16, WS_XN)
#define QM WSP(bf16, WS_QM)
#define X1B WSP(bf16, WS_X1B)
#define QD WSP(bf16, WS_QD)
#define KD WSP(bf16, WS_KD)
#define VD WSP(bf16, WS_VD)
#define KVM WSP(bf16, WS_KVM)
#define MG WSP(bf16, WS_MG)
#define HID WSP(bf16, WS_HID)
#define X2B WSP(bf16, WS_X2B)
#define CKV WSP(bf16, WS_CKV)
#define CQ WSP(bf16, WS_CQ)
#define KR WSP(bf16, WS_KR)
#define OM WSP(bf16, WS_OM)
#define TBUF WSP(bf16, WS_T)
#define X3B WSP(bf16, WS_X3B)
#define T2B WSP(bf16, WS_T2B)
#define SA ((bf16*)a.out)
#define SB ((bf16*)a.out + (size_t)M_TOK * 1024)
template <class E> __device__ __forceinline__ void run_gemm(LAS unsigned char* lds, const bf16* A, const bf16* Bt, int N, int K, const E& e) {
    asm volatile("" : "+s"(K));
    pg8::Gemm g{A, Bt, M_TOK, N, K}; pg8::StaticOrder S; S.init(M_TOK, N, (int)gridDim.x, (int)blockIdx.x);
    pg8::gemm_phase<E, pg8::StaticOrder, true, true>(lds, g, S, e);
}

__global__ void __launch_bounds__(NWAVES * 64, 2) fwd_megakernel(Args a) {
    extern __shared__ __attribute__((aligned(16))) unsigned char lds_raw[];
    cg::grid_group grid = cg::this_grid();
    LAS unsigned char* lds = (LAS unsigned char*)lds_raw;
    int tid0_ = threadIdx.x; asm volatile("" : "+v"(tid0_)); const int tid = tid0_, lane = tid & 63, wave = __builtin_amdgcn_readfirstlane(tid >> 6);
    const int G = gridDim.x, gw = blockIdx.x * NWAVES + wave, NGW = G * NWAVES;
    volatile LAS unsigned* bst = (volatile LAS unsigned*)(lds + (LDS_BYTES - 64));
    if (tid < 2) bst[tid] = 0u;
    __syncthreads();
    const XcdBarrier xbar = xcd_barrier_post((unsigned*)(a.ws + WS_BAR), bst);
#if !defined(SKIP_P0)
    {
        LAS float* scr = (LAS float*)(lds + wave * 16640);
        constexpr int I0 = 16 * 92, I1 = I0 + 16 * 88, I2 = I1 + 44 * 16, I3 = I2 + 256, I4 = I3 + 256, I5 = I4 + 256, I6 = I5 + 128, I7 = I6 + 72, I8 = I7 + 64, I9 = I8 + 64;
        for (int it = gw; it < I9; it += NGW) {
            if (it < I0)      wprep_item(1, a.w_in, nullptr, 5792, 1024, 5888, nullptr, Win, it, scr, lane);
            else if (it < I1) wprep_item(3, a.w_ffn_gate, a.w_ffn_up, 2816, 1024, 5632, a.ffn_norm, Wgu, it - I0, scr, lane);
            else if (it < I2) wprep_item(0, a.w_ffn_down, nullptr, 1024, 2816, 1024, nullptr, Wdn, it - I1, scr, lane);
            else if (it < I3) wprep_item(0, a.w_o_diff, nullptr, 1024, 1024, 1024, nullptr, Wod, it - I2, scr, lane);
            else if (it < I4) wprep_item(0, a.w_out, nullptr, 1024, 1024, 1024, nullptr, Wout, it - I3, scr, lane);
            else if (it < I5) wprep_item(0, a.w_ple_gate, nullptr, 1024, 1024, 1024, a.ple_norm, Wpg, it - I4, scr, lane);
            else if (it < I6) wprep_item(0, a.w_o_mla, nullptr, 1024, 512, 1024, nullptr, Wom, it - I5, scr, lane);
            else if (it < I7) wprep_item(2, a.w_uq, nullptr, 768, 384, 768, a.q_norm, Wuq, it - I6, scr, lane);
            else if (it < I8) wprep_item(0, a.w_ukv, nullptr, 1024, 256, 1024, a.kv_norm, Wukv, it - I7, scr, lane);
            else              wprep_item(0, a.w_ple, nullptr, 1024, 256, 1024, nullptr, Wple, it - I8, scr, lane);
        }
        for (int r0 = gw * 4; r0 < M_TOK; r0 += NGW * 4) {
            f32x4 v[4][4]; float s[4];
#pragma unroll
            for (int q = 0; q < 4; ++q) { const f32x4* xr = (const f32x4*)(a.x + (size_t)(r0 + q) * 1024) + lane; s[q] = 0.f;
#pragma unroll
                for (int j = 0; j < 4; ++j) v[q][j] = xr[64 * j]; }
#pragma unroll
            for (int q = 0; q < 4; ++q) {
#pragma unroll
                for (int j = 0; j < 4; ++j) s[q] += pg8::sq4(v[q][j]);
                const float rstd = __builtin_amdgcn_rsqf(wave_sum(s[q]) * (1.f / 1024.f) + NEPS);
                v2u* o8 = (v2u*)(XN + (size_t)(r0 + q) * 1024) + lane;
#pragma unroll
                for (int j = 0; j < 4; ++j) { const f32x4 g = ((const f32x4*)a.attn_norm)[lane + 64 * j]; const f32x4 y = v[q][j] * rstd * g; v2u w; w.x = pg8::pk2(y[0], y[1]); w.y = pg8::pk2(y[2], y[3]); o8[64 * j] = w; } }
        }
        { const int gt = blockIdx.x * 512 + tid, GT = G * 512;
          for (int i = gt; i < M_TOK * 256 / 8; i += GT) { const f32x4 p0 = ((const f32x4*)a.p)[2 * i], p1 = ((const f32x4*)a.p)[2 * i + 1]; pg8::st8(PB + (size_t)i * 8, p0, p1); }
          for (int i = gt; i < 2048 * 24; i += GT) {
              const int pos = i / 24, f = i % 24; const bool dm = f < 8; const int fi = dm ? f : f - 8;
              const float invf = dm ? __builtin_amdgcn_exp2f(-18.931568569324174f * (float)fi * 0.125f) : __builtin_amdgcn_exp2f(-13.287712379549449f * (float)fi * 0.0625f);
              const float ang = (float)pos * invf; const double rev = (double)ang * 0.15915494309189535; const float fr = (float)(rev - floor(rev));
              const float cs = __builtin_amdgcn_cosf(fr), sn = __builtin_amdgcn_sinf(fr);
              float* dst = dm ? tabD + ((size_t)pos * 8 + fi) * 2 : tabM + ((size_t)pos * 16 + fi) * 2; dst[0] = cs; dst[1] = sn;
          }
          if (blockIdx.x == 0 && wave == 0) { const float s1 = wave_sum(a.lam_q1[lane] * a.lam_k1[lane]), s2 = wave_sum(a.lam_q2[lane] * a.lam_k2[lane]); if (lane == 0) lamp[0] = __expf(s1) - __expf(s2) + 0.2f; }
        }
    }
    grid.sync();
    #endif

#if !defined(SKIP_P1)
    { pg8::EpiInProj e{QD, KD, VD, SA, SB, CKV, CQ, KR, SSQ, SSKV, a.b_gate, tabD, tabM}; run_gemm(lds, XN, Win, 5888, 1024, e); }
    xcd_barrier(xbar);
    #endif

#if !defined(SKIP_P2)
    { pg8::EpiQUp e{SSQ, tabM, QM}; run_gemm(lds, CQ, Wuq, 768, 384, e); }
    { pg8::EpiKVUp e{SSKV, KVM}; run_gemm(lds, CKV, Wukv, 1024, 256, e); }
    xcd_barrier(xbar);
    #endif

#if !defined(SKIP_P3)
    {
        const float lam = lamp[0];
        for (int i = blockIdx.x; i < 2048; i += G) {
            const int type = i >> 10, rem = i & 1023, j = rem >> 8, half = (rem >> 7) & 1, bh = rem & 127;
            const int qb = half ? (j == 0 ? 6 : j == 1 ? 4 : j == 2 ? 3 : 1) : (j == 0 ? 7 : j == 1 ? 5 : j == 2 ? 2 : 0);
            if (type == 0) att::diff_unit((ATT_LAS char*)lds, bh >> 3, bh & 7, qb, QD, KD, VD, QD, a.diff_subln, lam);
            else           att::mla_unit((ATT_LAS char*)lds, bh >> 3, bh & 7, qb, QM, KVM, KR, OM);
        }
    }
    xcd_barrier(xbar);
    #endif

#if !defined(SKIP_P4)
    { pg8::EpiOutA e{SA, TBUF}; run_gemm(lds, QD, Wod, 1024, 1024, e); }
    { pg8::EpiOutB e{SB, TBUF, MG}; run_gemm(lds, OM, Wom, 1024, 512, e); }
    xcd_barrier(xbar);
    #endif

#if !defined(SKIP_P5)
    { pg8::EpiResid<false> e{a.x, X1B, SS1}; run_gemm(lds, MG, Wout, 1024, 1024, e); }
    xcd_barrier(xbar);
    #endif

#if !defined(SKIP_P6)
    { pg8::EpiSwiGLU e{SS1, HID}; run_gemm(lds, X1B, Wgu, 5632, 1024, e); }
    xcd_barrier(xbar);
    #endif

#if !defined(SKIP_P7)
    { pg8::EpiResid<true> e{X1B, X2B, SS2}; run_gemm(lds, HID, Wdn, 1024, 2816, e); }
    xcd_barrier(xbar);
    #endif

#if !defined(SKIP_P8)
    { pg8::EpiPleA e{T2B}; run_gemm(lds, PB, Wple, 1024, 256, e); }
    { pg8::EpiPleB e{SS2, a.b_ple_gate, X2B, T2B, X3B, SS3}; run_gemm(lds, X2B, Wpg, 1024, 1024, e); }
    xcd_barrier(xbar);
    #endif

#if !defined(SKIP_P9)
    { int t9_ = threadIdx.x; asm volatile("" : "+v"(t9_)); const int lane = t9_ & 63, gw = blockIdx.x * NWAVES + __builtin_amdgcn_readfirstlane(t9_ >> 6), NGW = gridDim.x * NWAVES;
    for (int r0 = gw * 4; r0 < M_TOK; r0 += NGW * 4) {
        v4u w[4][2]; float s[4];
#pragma unroll
        for (int q = 0; q < 4; ++q) { const v4u* xr = (const v4u*)(X3B + (size_t)(r0 + q) * 1024) + lane; w[q][0] = xr[0]; w[q][1] = xr[64]; s[q] = (lane < 16) ? SS3[(size_t)(r0 + q) * 16 + lane] : 0.f; }
#pragma unroll
        for (int q = 0; q < 4; ++q) { const float rstd = __builtin_amdgcn_rsqf(wave_sum(s[q]) * (1.f / 1024.f) + NEPS);
#pragma unroll
            for (int j = 0; j < 2; ++j) { const int c = (lane + 64 * j) * 8; const f32x4 g0 = *(const f32x4*)(a.final_norm + c), g1 = *(const f32x4*)(a.final_norm + c + 4); const v4u ww = w[q][j];
                f32x4 x0, x1; x0[0] = __uint_as_float(ww.x << 16); x0[1] = __uint_as_float(ww.x & 0xffff0000u); x0[2] = __uint_as_float(ww.y << 16); x0[3] = __uint_as_float(ww.y & 0xffff0000u);
                x1[0] = __uint_as_float(ww.z << 16); x1[1] = __uint_as_float(ww.z & 0xffff0000u); x1[2] = __uint_as_float(ww.w << 16); x1[3] = __uint_as_float(ww.w & 0xffff0000u);
                float* o = a.out + (size_t)(r0 + q) * 1024 + c; *(f32x4*)o = x0 * rstd * g0; *(f32x4*)(o + 4) = x1 * rstd * g1; } }
    } }
#endif
}

extern "C" void kernel_launch(void* const* d_in, const int* in_sizes, int n_in, void* d_out, int out_size, void* d_ws, size_t ws_size, hipStream_t stream) {
    static int grid = 0;
    if (grid == 0) {
        if (n_in != 26 || out_size != M_TOK * 1024 || ws_size < WS_END) { fprintf(stderr, "kernel_launch: unexpected shapes (n_in %d out %d ws %zu)\n", n_in, out_size, ws_size); grid = -1; return; }
        int dev = 0, cus = 0, per_cu = 0;
        (void)hipGetDevice(&dev); (void)hipDeviceGetAttribute(&cus, hipDeviceAttributeMultiprocessorCount, dev);
        (void)hipFuncSetAttribute((const void*)fwd_megakernel, hipFuncAttributeMaxDynamicSharedMemorySize, LDS_BYTES);
        if (hipOccupancyMaxActiveBlocksPerMultiprocessor(&per_cu, (const void*)fwd_megakernel, NWAVES * 64, LDS_BYTES) != hipSuccess || per_cu < 1) per_cu = 1;
        (void)hipGetLastError();
        grid = cus * per_cu;
    }
    if (grid < 0) return;
    Args a{};
    const float** f = (const float**)&a;
    for (int i = 0; i < 26; ++i) f[i] = (const float*)d_in[i];
    a.out = (float*)d_out; a.ws = (unsigned char*)d_ws;
    (void)hipMemsetAsync((char*)d_ws + WS_BAR, 0, 16384, stream);
    void* args[] = {&a};
    hipError_t e = hipLaunchCooperativeKernel((const void*)fwd_megakernel, dim3(grid), dim3(NWAVES * 64), args, LDS_BYTES, stream);
    if (e != hipSuccess) fprintf(stderr, "cooperative launch failed: %s (grid %d)\n", hipGetErrorString(e), grid);
}
```

```cpp
#include <hip/hip_runtime.h>
#include <hip/hip_cooperative_groups.h>
#include <cstdio>
#include <cstdint>
namespace cg = cooperative_groups;

constexpr int M_TOK = 32768, SEQ_LEN = 2048;
constexpr float NEPS = 1e-6f;
constexpr float LOG2E_F = 1.4426950408889634f;
constexpr float QS_D = 0.125f * LOG2E_F;
constexpr float QS_M = 0.10206207261596575f * LOG2E_F;
namespace pg8 {
#define PG8_LAS __attribute__((address_space(3)))
typedef unsigned short bf16_t;
typedef short bf16x8 __attribute__((ext_vector_type(8)));
typedef float f32x4 __attribute__((ext_vector_type(4)));
typedef unsigned u32x4 __attribute__((ext_vector_type(4)));
constexpr int BM = 256, BK = 64, HALF = 128, HTB = HALF * BK * 2  , STAGE_BYTES = 8 * HTB, NXCD = 8, WGM = 8;

__host__ __device__ __forceinline__ int lds_byte(int r, int c) { const int st = (r >> 4) * 2 + (c >> 5), rr = r & 15, cc = c & 31, ob = rr * 64 + cc * 2; return st * 1024 + (ob ^ (((ob >> 9) & 1) << 5)); }
__host__ __device__ __forceinline__ void stage_rc(int b, int& R, int& C) { const int st = b / 1024, sb = b % 1024, swz = sb ^ (((sb >> 9) & 1) << 5); R = (st >> 1) * 16 + swz / 64; C = (st & 1) * 32 + (swz % 64) / 2; }
__host__ __device__ __forceinline__ int perm32(int rho) { const int n = rho >> 4, i = rho & 15; return 8 * (i >> 2) + 4 * n + (i & 3); }

struct Unit { int pm, pn; };
struct Gemm { const bf16_t* A; const bf16_t* Bt; int M, N, K; };

struct StaticOrder {
    int nM, nN, nwg, G, c;
    __host__ __device__ void init(int M, int N, int G_, int c_) { nM = M / BM; nN = N / BM; nwg = nM * nN; G = G_; c = c_; }
    __host__ __device__ bool next(int i, Unit& u) const {
        const long L = (long)i * G + c; if (L >= nwg) return false;
        int wgid = (int)L; { const int q = nwg / NXCD, r = nwg % NXCD, xcd = wgid % NXCD, off = wgid / NXCD; wgid = (xcd < r ? xcd * (q + 1) : r * (q + 1) + (xcd - r) * q) + off; }
        const int nig = WGM * nN, gid = wgid / nig, fm = gid * WGM, gsz = (nM - fm) < WGM ? (nM - fm) : WGM;
        u.pm = fm + ((wgid % nig) % gsz); u.pn = (wgid % nig) / gsz; return true;
    }
    __device__ __forceinline__ void a_ready(const Unit&) const {}
    __device__ __forceinline__ void done(const Unit&) const {}
};

typedef unsigned u32x4 __attribute__((ext_vector_type(4)));
typedef unsigned u32x2 __attribute__((ext_vector_type(2)));
typedef float f32x2 __attribute__((ext_vector_type(2)));
typedef __bf16 bf16x2_t __attribute__((ext_vector_type(2)));
__device__ __forceinline__ unsigned pk2(float lo, float hi) { f32x2 v = {lo, hi}; bf16x2_t b = __builtin_convertvector(v, bf16x2_t); return __builtin_bit_cast(unsigned, b); }
__device__ __forceinline__ void st8(bf16_t* p, f32x4 a, f32x4 b) { u32x4 w; w.x = pk2(a[0], a[1]); w.y = pk2(a[2], a[3]); w.z = pk2(b[0], b[1]); w.w = pk2(b[2], b[3]); *(u32x4*)p = w; }
__device__ __forceinline__ void ld8(const bf16_t* p, f32x4& a, f32x4& b) { const u32x4 w = *(const u32x4*)p;
    a[0] = __uint_as_float(w.x << 16); a[1] = __uint_as_float(w.x & 0xffff0000u); a[2] = __uint_as_float(w.y << 16); a[3] = __uint_as_float(w.y & 0xffff0000u);
    b[0] = __uint_as_float(w.z << 16); b[1] = __uint_as_float(w.z & 0xffff0000u); b[2] = __uint_as_float(w.w << 16); b[3] = __uint_as_float(w.w & 0xffff0000u); }
__device__ __forceinline__ void up8(const u32x4 w, f32x4& a, f32x4& b) {
    a[0] = __uint_as_float(w.x << 16); a[1] = __uint_as_float(w.x & 0xffff0000u); a[2] = __uint_as_float(w.y << 16); a[3] = __uint_as_float(w.y & 0xffff0000u);
    b[0] = __uint_as_float(w.z << 16); b[1] = __uint_as_float(w.z & 0xffff0000u); b[2] = __uint_as_float(w.w << 16); b[3] = __uint_as_float(w.w & 0xffff0000u); }
__device__ __forceinline__ float sigm(float x) { return __builtin_amdgcn_rcpf(1.f + __expf(-x)); }
__device__ __forceinline__ f32x4 sigm4(f32x4 x) { f32x4 o; o[0] = sigm(x[0]); o[1] = sigm(x[1]); o[2] = sigm(x[2]); o[3] = sigm(x[3]); return o; }
__device__ __forceinline__ float quad_sum(float s) { s += __shfl_xor(s, 16); s += __shfl_xor(s, 32); return s; }
__device__ __forceinline__ float sq4(f32x4 v) { return (v[0] * v[0] + v[1] * v[1]) + (v[2] * v[2] + v[3] * v[3]); }
__device__ __forceinline__ f32x4 rope4(f32x4 v, f32x4 t) { f32x4 o; o[0] = v[0] * t[0] - v[1] * t[1]; o[1] = v[1] * t[0] + v[0] * t[1]; o[2] = v[2] * t[2] - v[3] * t[3]; o[3] = v[3] * t[2] + v[2] * t[3]; return o; }
#define EPI_FENCE() asm volatile("" ::: "memory")
#define EPI_LOOP_AM _Pragma("unroll") for (int ai = 0; ai < 2; ++ai) _Pragma("unroll") for (int m = 0; m < 4; ++m)

struct EpiInProj {
    static constexpr bool PERM = true, AFTER_DRAIN = false;
    bf16_t *QD, *KD, *VD, *SA, *SB, *CKV, *CQ, *KR; float *SSQ, *SSKV; const float* bgate; const float* tabD; const float* tabM;
    __device__ __forceinline__ void operator()(const f32x4 (&acc)[2][2][4][2], const Unit& u, int wr, int wc, int fr, int fq) const {
        const int pn = u.pn, rbase = u.pm * BM + wr * 64 + fr, lc = wc * 32 + fq * 8;
        if (pn < 8) {
            bf16_t* dst = (pn < 4 ? QD : KD) + (pn & 3) * 256 + lc; const float sc = pn < 4 ? QS_D : 1.f;
            const bool rp = ((wc & 1) == 0) && (fq < 2);
            EPI_LOOP_AM { const int row = rbase + ai * HALF + m * 16; f32x4 t0 = {1.f, 0.f, 1.f, 0.f}, t1 = t0;
                if (rp) { const f32x4* tp = (const f32x4*)(tabD + ((size_t)(row & (SEQ_LEN - 1)) * 8 + 4 * fq) * 2); t0 = tp[0]; t1 = tp[1]; }
#pragma unroll
                for (int bj = 0; bj < 2; ++bj) st8(dst + (size_t)row * 1024 + bj * HALF, rope4(acc[ai][bj][m][0], t0) * sc, rope4(acc[ai][bj][m][1], t1) * sc);
                EPI_FENCE(); }
        } else if (pn < 12) {
            bf16_t* dst = VD + (pn - 8) * 256 + lc;
            EPI_LOOP_AM { const int row = rbase + ai * HALF + m * 16;
#pragma unroll
                for (int bj = 0; bj < 2; ++bj) st8(dst + (size_t)row * 1024 + bj * HALF, acc[ai][bj][m][0], acc[ai][bj][m][1]); }
        } else if (pn < 20) {
            const int t = (pn - 12) & 3; bf16_t* dst = (pn < 16 ? SA : SB) + t * 256 + lc; const float* bp = bgate + (pn < 16 ? 0 : 1024) + t * 256 + lc;
            f32x4 b[2][2];
#pragma unroll
            for (int bj = 0; bj < 2; ++bj) { b[bj][0] = *(const f32x4*)(bp + bj * HALF); b[bj][1] = *(const f32x4*)(bp + bj * HALF + 4); }
            EPI_LOOP_AM { const int row = rbase + ai * HALF + m * 16;
#pragma unroll
                for (int bj = 0; bj < 2; ++bj) st8(dst + (size_t)row * 1024 + bj * HALF, sigm4(acc[ai][bj][m][0] + b[bj][0]), sigm4(acc[ai][bj][m][1] + b[bj][1])); }
        } else if (pn == 20) {
            EPI_LOOP_AM { const int row = rbase + ai * HALF + m * 16; float s = 0.f;
#pragma unroll
                for (int bj = 0; bj < 2; ++bj) { st8(CKV + (size_t)row * 256 + bj * HALF + lc, acc[ai][bj][m][0], acc[ai][bj][m][1]); s += sq4(acc[ai][bj][m][0]) + sq4(acc[ai][bj][m][1]); }
                s = quad_sum(s); if (fq == 0) SSKV[(size_t)row * 4 + wc] = s; }
        } else if (pn == 21) {
            EPI_LOOP_AM { const int row = rbase + ai * HALF + m * 16; float s = 0.f;
#pragma unroll
                for (int bj = 0; bj < 2; ++bj) { st8(CQ + (size_t)row * 384 + bj * HALF + lc, acc[ai][bj][m][0], acc[ai][bj][m][1]); s += sq4(acc[ai][bj][m][0]) + sq4(acc[ai][bj][m][1]); }
                s = quad_sum(s); if (fq == 0) SSQ[(size_t)row * 8 + wc] = s; }
        } else {
            EPI_LOOP_AM { const int row = rbase + ai * HALF + m * 16;
                st8(CQ + (size_t)row * 384 + 256 + lc, acc[ai][0][m][0], acc[ai][0][m][1]);
                float s = sq4(acc[ai][0][m][0]) + sq4(acc[ai][0][m][1]); s = quad_sum(s); if (fq == 0) SSQ[(size_t)row * 8 + 4 + wc] = s;
                if (wc == 0) { const f32x4* tp = (const f32x4*)(tabM + ((size_t)(row & (SEQ_LEN - 1)) * 16 + 4 * fq) * 2);
                    st8(KR + (size_t)row * 32 + fq * 8, rope4(acc[ai][1][m][0], tp[0]), rope4(acc[ai][1][m][1], tp[1])); }
                EPI_FENCE(); }
        }
    }
};
struct EpiQUp {
    static constexpr bool PERM = true, AFTER_DRAIN = false;
    const float* SSQ; const float* tabM; bf16_t* QM;
    __device__ __forceinline__ void operator()(const f32x4 (&acc)[2][2][4][2], const Unit& u, int wr, int wc, int fr, int fq) const {
        const int rbase = u.pm * BM + wr * 64 + fr, c0 = u.pn * BM + wc * 32 + fq * 8;
        const int hl0 = c0 % 96, hl1 = (c0 + HALF) % 96;
        EPI_LOOP_AM { const int row = rbase + ai * HALF + m * 16;
            const f32x4 s0 = *(const f32x4*)(SSQ + (size_t)row * 8), s1 = *(const f32x4*)(SSQ + (size_t)row * 8 + 4);
            const float rstd = __builtin_amdgcn_rsqf(((s0[0] + s0[1]) + (s0[2] + s0[3]) + (s1[0] + s1[1]) + (s1[2] + s1[3])) * (1.f / 384.f) + NEPS) * QS_M;
            const float* tb = tabM + (size_t)(row & (SEQ_LEN - 1)) * 32;
#pragma unroll
            for (int bj = 0; bj < 2; ++bj) { const int hl = bj ? hl1 : hl0; const bool rp = hl >= 64; const f32x4 id = {1.f, 0.f, 1.f, 0.f};
                const f32x4* tp = (const f32x4*)(tb + (rp ? hl - 64 : 0)); const f32x4 t0 = rp ? tp[0] : id, t1 = rp ? tp[1] : id;
                st8(QM + (size_t)row * 768 + c0 + bj * HALF, rope4(acc[ai][bj][m][0] * rstd, t0), rope4(acc[ai][bj][m][1] * rstd, t1)); EPI_FENCE(); }
            }
    }
};
struct EpiKVUp {
    static constexpr bool PERM = true, AFTER_DRAIN = false;
    const float* SSKV; bf16_t* KVM;
    __device__ __forceinline__ void operator()(const f32x4 (&acc)[2][2][4][2], const Unit& u, int wr, int wc, int fr, int fq) const {
        const int rbase = u.pm * BM + wr * 64 + fr, c0 = u.pn * BM + wc * 32 + fq * 8;
        EPI_LOOP_AM { const int row = rbase + ai * HALF + m * 16;
            const f32x4 s0 = *(const f32x4*)(SSKV + (size_t)row * 4);
            const float rstd = __builtin_amdgcn_rsqf(((s0[0] + s0[1]) + (s0[2] + s0[3])) * (1.f / 256.f) + NEPS);
#pragma unroll
            for (int bj = 0; bj < 2; ++bj) st8(KVM + (size_t)row * 1024 + c0 + bj * HALF, acc[ai][bj][m][0] * rstd, acc[ai][bj][m][1] * rstd);
            EPI_FENCE(); }
    }
};
struct EpiOutA {
    static constexpr bool PERM = true, AFTER_DRAIN = false;
    const bf16_t* SA; bf16_t* T;
    __device__ __forceinline__ void operator()(const f32x4 (&acc)[2][2][4][2], const Unit& u, int wr, int wc, int fr, int fq) const {
        const int rbase = u.pm * BM + wr * 64 + fr, c0 = u.pn * BM + wc * 32 + fq * 8;
#pragma unroll
        for (int ai = 0; ai < 2; ++ai) { u32x4 g[4][2];
#pragma unroll
            for (int m = 0; m < 4; ++m)
#pragma unroll
                for (int bj = 0; bj < 2; ++bj) g[m][bj] = *(const u32x4*)(SA + (size_t)(rbase + ai * HALF + m * 16) * 1024 + c0 + bj * HALF);
            EPI_FENCE();
#pragma unroll
            for (int m = 0; m < 4; ++m)
#pragma unroll
                for (int bj = 0; bj < 2; ++bj) { f32x4 g0, g1; up8(g[m][bj], g0, g1); st8(T + (size_t)(rbase + ai * HALF + m * 16) * 1024 + c0 + bj * HALF, acc[ai][bj][m][0] * g0, acc[ai][bj][m][1] * g1); }
            EPI_FENCE(); }
    }
};
struct EpiOutB {
    static constexpr bool PERM = true, AFTER_DRAIN = false;
    const bf16_t* SB; const bf16_t* T; bf16_t* MG;
    __device__ __forceinline__ void operator()(const f32x4 (&acc)[2][2][4][2], const Unit& u, int wr, int wc, int fr, int fq) const {
        const int rbase = u.pm * BM + wr * 64 + fr, c0 = u.pn * BM + wc * 32 + fq * 8;
#pragma unroll
        for (int ai = 0; ai < 2; ++ai) { u32x4 g[4][2], t[4][2];
#pragma unroll
            for (int m = 0; m < 4; ++m)
#pragma unroll
                for (int bj = 0; bj < 2; ++bj) { const size_t o = (size_t)(rbase + ai * HALF + m * 16) * 1024 + c0 + bj * HALF; g[m][bj] = *(const u32x4*)(SB + o); t[m][bj] = *(const u32x4*)(T + o); }
            EPI_FENCE();
#pragma unroll
            for (int m = 0; m < 4; ++m)
#pragma unroll
                for (int bj = 0; bj < 2; ++bj) { f32x4 g0, g1, t0, t1; up8(g[m][bj], g0, g1); up8(t[m][bj], t0, t1);
                    st8(MG + (size_t)(rbase + ai * HALF + m * 16) * 1024 + c0 + bj * HALF, t0 + acc[ai][bj][m][0] * g0, t1 + acc[ai][bj][m][1] * g1); }
            EPI_FENCE(); }
    }
};
template <bool RES_BF16> struct EpiResid {
    static constexpr bool PERM = true, AFTER_DRAIN = false;
    const void* res; bf16_t* xb; float* SS;
    __device__ __forceinline__ void operator()(const f32x4 (&acc)[2][2][4][2], const Unit& u, int wr, int wc, int fr, int fq) const {
        const int rbase = u.pm * BM + wr * 64 + fr, c0 = u.pn * BM + wc * 32 + fq * 8;
        if constexpr (RES_BF16) {
#pragma unroll
            for (int ai = 0; ai < 2; ++ai) { u32x4 r[4][2];
#pragma unroll
                for (int m = 0; m < 4; ++m)
#pragma unroll
                    for (int bj = 0; bj < 2; ++bj) r[m][bj] = *(const u32x4*)((const bf16_t*)res + (size_t)(rbase + ai * HALF + m * 16) * 1024 + c0 + bj * HALF);
                EPI_FENCE();
#pragma unroll
                for (int m = 0; m < 4; ++m) { const int row = rbase + ai * HALF + m * 16; float s = 0.f;
#pragma unroll
                    for (int bj = 0; bj < 2; ++bj) { f32x4 r0, r1; up8(r[m][bj], r0, r1); const f32x4 v0 = r0 + acc[ai][bj][m][0], v1 = r1 + acc[ai][bj][m][1];
                        st8(xb + (size_t)row * 1024 + c0 + bj * HALF, v0, v1); s += sq4(v0) + sq4(v1); }
                    s = quad_sum(s); if (fq == 0) SS[(size_t)row * 16 + u.pn * 4 + wc] = s; }
                EPI_FENCE(); }
        } else {
#pragma unroll
            for (int ai = 0; ai < 2; ++ai)
#pragma unroll
                for (int mp = 0; mp < 2; ++mp) { f32x4 r[2][2][2];
#pragma unroll
                    for (int mm = 0; mm < 2; ++mm)
#pragma unroll
                        for (int bj = 0; bj < 2; ++bj) { const float* p = (const float*)res + (size_t)(rbase + ai * HALF + (2 * mp + mm) * 16) * 1024 + c0 + bj * HALF; r[mm][bj][0] = *(const f32x4*)p; r[mm][bj][1] = *(const f32x4*)(p + 4); }
                    EPI_FENCE();
#pragma unroll
                    for (int mm = 0; mm < 2; ++mm) { const int m = 2 * mp + mm, row = rbase + ai * HALF + m * 16; float s = 0.f;
#pragma unroll
                        for (int bj = 0; bj < 2; ++bj) { const f32x4 v0 = r[mm][bj][0] + acc[ai][bj][m][0], v1 = r[mm][bj][1] + acc[ai][bj][m][1];
                            st8(xb + (size_t)row * 1024 + c0 + bj * HALF, v0, v1); s += sq4(v0) + sq4(v1); }
                        s = quad_sum(s); if (fq == 0) SS[(size_t)row * 16 + u.pn * 4 + wc] = s; }
                    EPI_FENCE(); }
        }
    }
};
__device__ __forceinline__ float rstd16(const float* ss) { const f32x4 a = *(const f32x4*)ss, b = *(const f32x4*)(ss + 4), c = *(const f32x4*)(ss + 8), d = *(const f32x4*)(ss + 12);
    const f32x4 t = (a + b) + (c + d); return __builtin_amdgcn_rsqf(((t[0] + t[1]) + (t[2] + t[3])) * (1.f / 1024.f) + NEPS); }
struct EpiSwiGLU {
    static constexpr bool PERM = true, AFTER_DRAIN = false;
    const float* SS; bf16_t* HID;
    __device__ __forceinline__ void operator()(const f32x4 (&acc)[2][2][4][2], const Unit& u, int wr, int wc, int fr, int fq) const {
        const int rbase = u.pm * BM + wr * 64 + fr, c0 = u.pn * HALF + wc * 32 + fq * 8;
        EPI_LOOP_AM { const int row = rbase + ai * HALF + m * 16; const float rstd = rstd16(SS + (size_t)row * 16);
            const f32x4 g0 = acc[ai][0][m][0] * rstd, g1 = acc[ai][0][m][1] * rstd, u0 = acc[ai][1][m][0] * rstd, u1 = acc[ai][1][m][1] * rstd;
            st8(HID + (size_t)row * 2816 + c0, g0 * sigm4(g0) * u0, g1 * sigm4(g1) * u1);
            EPI_FENCE(); }
    }
};
struct EpiPleA {
    static constexpr bool PERM = true, AFTER_DRAIN = false;
    bf16_t* T;
    __device__ __forceinline__ void operator()(const f32x4 (&acc)[2][2][4][2], const Unit& u, int wr, int wc, int fr, int fq) const {
        const int rbase = u.pm * BM + wr * 64 + fr, c0 = u.pn * BM + wc * 32 + fq * 8;
        EPI_LOOP_AM { const int row = rbase + ai * HALF + m * 16;
#pragma unroll
            for (int bj = 0; bj < 2; ++bj) st8(T + (size_t)row * 1024 + c0 + bj * HALF, acc[ai][bj][m][0], acc[ai][bj][m][1]); }
    }
};
struct EpiPleB {
    static constexpr bool PERM = true, AFTER_DRAIN = false;
    const float* SS2; const float* bias; const bf16_t* X2; const bf16_t* T2; bf16_t* X3; float* SS3;
    __device__ __forceinline__ void operator()(const f32x4 (&acc)[2][2][4][2], const Unit& u, int wr, int wc, int fr, int fq) const {
        const int rbase = u.pm * BM + wr * 64 + fr, c0 = u.pn * BM + wc * 32 + fq * 8;
#pragma unroll
        for (int ai = 0; ai < 2; ++ai)
#pragma unroll
          for (int mp = 0; mp < 2; ++mp) { u32x4 x[2][2], t[2][2]; float rs[2];
#pragma unroll
            for (int mm = 0; mm < 2; ++mm) { const int row = rbase + ai * HALF + (2 * mp + mm) * 16;
#pragma unroll
                for (int bj = 0; bj < 2; ++bj) { const size_t o = (size_t)row * 1024 + c0 + bj * HALF; x[mm][bj] = *(const u32x4*)(X2 + o); t[mm][bj] = *(const u32x4*)(T2 + o); }
                rs[mm] = rstd16(SS2 + (size_t)row * 16); }
            EPI_FENCE();
#pragma unroll
            for (int mm = 0; mm < 2; ++mm) { const int m = 2 * mp + mm, row = rbase + ai * HALF + m * 16; float s = 0.f;
#pragma unroll
                for (int bj = 0; bj < 2; ++bj) { const f32x4 b0 = *(const f32x4*)(bias + c0 + bj * HALF), b1 = *(const f32x4*)(bias + c0 + bj * HALF + 4);
                    f32x4 x0, x1, t0, t1; up8(x[mm][bj], x0, x1); up8(t[mm][bj], t0, t1);
                    const f32x4 v0 = x0 + t0 * sigm4(acc[ai][bj][m][0] * rs[mm] + b0), v1 = x1 + t1 * sigm4(acc[ai][bj][m][1] * rs[mm] + b1);
                    st8(X3 + (size_t)row * 1024 + c0 + bj * HALF, v0, v1); s += sq4(v0) + sq4(v1); }
                s = quad_sum(s); if (fq == 0) SS3[(size_t)row * 16 + u.pn * 4 + wc] = s; }
            EPI_FENCE(); }
    }
};
template <class Epi, class Sched, bool ALIGN_EPI = false, bool SP2 = false>
__device__ __forceinline__ void gemm_phase(PG8_LAS unsigned char* lds, const Gemm g, const Sched& S, const Epi& E) {
    int tid_ = threadIdx.x; asm volatile("" : "+v"(tid_)); const int tid = tid_, wid = __builtin_amdgcn_readfirstlane(tid >> 6), lane = tid & 63, wr = wid >> 2, wc = wid & 3, fr = lane & 15, fq = lane >> 4;
    const int K = g.K, nt = K / BK;
    unsigned voffA[2], voffB[2];
#pragma unroll
    for (int i = 0; i < 2; ++i) { int R, C; stage_rc(tid * 16 + i * 8192, R, C); const int Rb = Epi::PERM ? ((R & ~31) + perm32(R & 31)) : R;
        voffA[i] = (unsigned)(R * K + C) * 2u; voffB[i] = (unsigned)(Rb * K + C) * 2u; }
    const size_t kstep = (size_t)(BK * 2);
    const size_t hstep = (size_t)HALF * K * 2;
    const size_t tstep = 2 * hstep;
    const unsigned ldsw = (unsigned)wid * 1024u;
    const int aoff = lds_byte(wr * 64 + fr, fq * 8), boff = lds_byte(wc * 32 + fr, fq * 8);
#define PG8_SA(b, h) (((b) * 2 + (h)) * HTB)
#define PG8_SB(b, h) ((4 + (b) * 2 + (h)) * HTB)
#define PG8_STAGE(bufoff, gbase, voff) do { _Pragma("unroll") for (int _i = 0; _i < 2; ++_i) \
        __builtin_amdgcn_global_load_lds((const unsigned*)((const char*)(gbase) + (voff)[_i]), (PG8_LAS unsigned*)(lds + (bufoff) + ldsw + _i * 8192), 16, 0, 0); } while (0)
#define PG8_LDA(dst, b, h) do { _Pragma("unroll") for (int m = 0; m < 4; ++m) _Pragma("unroll") for (int k = 0; k < 2; ++k) dst[m][k] = *(const PG8_LAS bf16x8*)(lds + PG8_SA(b, h) + aoff + m * 2048 + k * 1024); } while (0)
#define PG8_LDB(dst, b, h) do { _Pragma("unroll") for (int n = 0; n < 2; ++n) _Pragma("unroll") for (int k = 0; k < 2; ++k) dst[n][k] = *(const PG8_LAS bf16x8*)(lds + PG8_SB(b, h) + boff + n * 2048 + k * 1024); } while (0)
#define PG8_MMA(ai, bj, At, Bt) do { __builtin_amdgcn_s_setprio(1); _Pragma("unroll") for (int m = 0; m < 4; ++m) _Pragma("unroll") for (int n = 0; n < 2; ++n) _Pragma("unroll") for (int k = 0; k < 2; ++k) \
        acc[ai][bj][m][n] = __builtin_amdgcn_mfma_f32_16x16x32_bf16(Bt[n][k], At[m][k], acc[ai][bj][m][n], 0, 0, 0); __builtin_amdgcn_s_setprio(0); } while (0)
#define PG8_WAIT_V(n) asm volatile("s_waitcnt vmcnt(" #n ")" ::: "memory")
#define PG8_WAIT_L(n) asm volatile("s_waitcnt lgkmcnt(" #n ")" ::: "memory")
#define PG8_BAR __builtin_amdgcn_s_barrier()
#define PG8_SCHED __builtin_amdgcn_sched_barrier(0)
    Unit cur, nxt; int ui = 0;
    if (!S.next(0, cur)) return;
    f32x4 acc[2][2][4][2];
#pragma unroll
    for (int a = 0; a < 2; ++a)
#pragma unroll
        for (int b = 0; b < 2; ++b)
#pragma unroll
            for (int m = 0; m < 4; ++m)
#pragma unroll
                for (int n = 0; n < 2; ++n) acc[a][b][m][n] = (f32x4){0.f, 0.f, 0.f, 0.f};
    bf16x8 At[4][2], B0[2][2], B1[2][2];
    const char* cA = (const char*)g.A + (size_t)cur.pm * tstep; const char* cB = (const char*)g.Bt + (size_t)cur.pn * tstep;
    S.a_ready(cur);
    if constexpr (SP2) {
        PG8_STAGE(PG8_SB(0, 0), cB, voffB); PG8_STAGE(PG8_SB(0, 1), cB + hstep, voffB); PG8_STAGE(PG8_SA(0, 0), cA, voffA); PG8_STAGE(PG8_SA(0, 1), cA + hstep, voffA);
        if (wr == 1) PG8_BAR;
        PG8_WAIT_V(2); PG8_BAR;
        PG8_STAGE(PG8_SB(1, 0), cB + kstep, voffB); PG8_STAGE(PG8_SA(1, 0), cA + kstep, voffA); PG8_STAGE(PG8_SB(1, 1), cB + hstep + kstep, voffB);
        PG8_WAIT_V(6); PG8_BAR;
    } else {
        PG8_STAGE(PG8_SB(0, 0), cB, voffB); PG8_STAGE(PG8_SA(0, 0), cA, voffA); PG8_STAGE(PG8_SB(0, 1), cB + hstep, voffB); PG8_STAGE(PG8_SA(0, 1), cA + hstep, voffA);
        if (wr == 1) PG8_BAR;
        PG8_WAIT_V(4); PG8_BAR;
        PG8_STAGE(PG8_SB(1, 0), cB + kstep, voffB); PG8_STAGE(PG8_SA(1, 0), cA + kstep, voffA); PG8_STAGE(PG8_SB(1, 1), cB + hstep + kstep, voffB);
        PG8_WAIT_V(6); PG8_BAR;
    }
    for (;;) {
        const bool has_next = S.next(ui + 1, nxt);
        const char* nA = has_next ? (const char*)g.A + (size_t)nxt.pm * tstep : cA; const char* nB = has_next ? (const char*)g.Bt + (size_t)nxt.pn * tstep : cB;
        for (int t = 0; t < nt; t += 2) {
            const bool last = (t == nt - 2);
            const char* a1 = cA + (size_t)(t + 1) * kstep;
            const char* a2 = last ? nA : cA + (size_t)(t + 2) * kstep; const char* b2 = last ? nB : cB + (size_t)(t + 2) * kstep;
            const char* a3 = a2 + kstep; const char* b3 = b2 + kstep;
            if (last && has_next) S.a_ready(nxt);
            if constexpr (SP2) {
            PG8_LDB(B0, 0, 0); PG8_LDB(B1, 0, 1); PG8_SCHED; PG8_LDA(At, 0, 0); PG8_STAGE(PG8_SA(1, 1), a1 + hstep, voffA);
            PG8_WAIT_V(8); PG8_WAIT_L(0); PG8_BAR; PG8_MMA(0, 0, At, B0); PG8_MMA(0, 1, At, B1); PG8_BAR; PG8_SCHED;
            PG8_LDA(At, 0, 1); PG8_STAGE(PG8_SB(0, 0), b2, voffB); PG8_STAGE(PG8_SB(0, 1), b2 + hstep, voffB); PG8_STAGE(PG8_SA(0, 0), a2, voffA);
            PG8_WAIT_V(8); PG8_WAIT_L(0); PG8_BAR; PG8_MMA(1, 0, At, B0); PG8_MMA(1, 1, At, B1); PG8_BAR; PG8_SCHED;
            PG8_LDB(B0, 1, 0); PG8_LDB(B1, 1, 1); PG8_SCHED; PG8_LDA(At, 1, 0); PG8_STAGE(PG8_SA(0, 1), a2 + hstep, voffA);
            PG8_WAIT_V(8); PG8_WAIT_L(0); PG8_BAR; PG8_MMA(0, 0, At, B0); PG8_MMA(0, 1, At, B1); PG8_BAR; PG8_SCHED;
            PG8_LDA(At, 1, 1); PG8_STAGE(PG8_SB(1, 0), b3, voffB); PG8_STAGE(PG8_SB(1, 1), b3 + hstep, voffB); PG8_STAGE(PG8_SA(1, 0), a3, voffA);
            PG8_WAIT_V(8); PG8_WAIT_L(0); PG8_BAR; PG8_MMA(1, 0, At, B0); PG8_MMA(1, 1, At, B1); PG8_BAR; PG8_SCHED;
            } else {
            PG8_LDB(B0, 0, 0); PG8_SCHED; PG8_LDA(At, 0, 0); PG8_STAGE(PG8_SA(1, 1), a1 + hstep, voffA);
            PG8_WAIT_L(8); PG8_BAR; PG8_WAIT_L(0); PG8_MMA(0, 0, At, B0); PG8_BAR; PG8_SCHED;
            PG8_LDB(B1, 0, 1); PG8_STAGE(PG8_SB(0, 0), b2, voffB);
            PG8_BAR; PG8_WAIT_L(0); PG8_MMA(0, 1, At, B1); PG8_BAR;
            PG8_LDA(At, 0, 1); PG8_STAGE(PG8_SA(0, 0), a2, voffA);
            PG8_BAR; PG8_WAIT_L(0); PG8_MMA(1, 0, At, B0); PG8_BAR; PG8_SCHED;
            PG8_STAGE(PG8_SB(0, 1), b2 + hstep, voffB);
            PG8_WAIT_V(6); PG8_BAR; PG8_MMA(1, 1, At, B1); PG8_BAR;
            PG8_LDB(B0, 1, 0); PG8_SCHED; PG8_LDA(At, 1, 0); PG8_STAGE(PG8_SA(0, 1), a2 + hstep, voffA);
            PG8_WAIT_L(8); PG8_BAR; PG8_WAIT_L(0); PG8_MMA(0, 0, At, B0); PG8_BAR; PG8_SCHED;
            PG8_LDB(B1, 1, 1); PG8_STAGE(PG8_SB(1, 0), b3, voffB);
            PG8_BAR; PG8_WAIT_L(0); PG8_MMA(0, 1, At, B1); PG8_BAR;
            PG8_LDA(At, 1, 1); PG8_STAGE(PG8_SA(1, 0), a3, voffA);
            PG8_BAR; PG8_WAIT_L(0); PG8_MMA(1, 0, At, B0); PG8_BAR; PG8_SCHED;
            PG8_STAGE(PG8_SB(1, 1), b3 + hstep, voffB);
            PG8_WAIT_V(6); PG8_BAR; PG8_MMA(1, 1, At, B1); PG8_BAR;
            }
        }
        if constexpr (ALIGN_EPI) { if (wr == 0) PG8_BAR; }
        if constexpr (!Epi::AFTER_DRAIN) { E(acc, cur, wr, wc, fr, fq); S.done(cur); }
        if (!has_next) break;
#pragma unroll
        for (int a = 0; a < 2; ++a)
#pragma unroll
            for (int b = 0; b < 2; ++b)
#pragma unroll
                for (int m = 0; m < 4; ++m)
#pragma unroll
                    for (int n = 0; n < 2; ++n) acc[a][b][m][n] = (f32x4){0.f, 0.f, 0.f, 0.f};
        cur = nxt; cA = nA; cB = nB; ++ui;
        if constexpr (ALIGN_EPI) { if (wr == 1) PG8_BAR; }
    }
    PG8_WAIT_V(0);
    if constexpr (!ALIGN_EPI) { if (wr == 0) PG8_BAR; }
    PG8_BAR;
    if constexpr (Epi::AFTER_DRAIN) { E.fused(acc, cur, wr, wc, fr, fq, lds, wid, lane); S.done(cur); }
#undef PG8_SA
#undef PG8_SB
#undef PG8_STAGE
#undef PG8_LDA
#undef PG8_LDB
#undef PG8_MMA
#undef PG8_WAIT_V
#undef PG8_WAIT_L
#undef PG8_BAR
#undef PG8_SCHED
}
}
namespace att {
#define ATT_LAS __attribute__((address_space(3)))
typedef unsigned short bf16_t;
typedef short bf16x8 __attribute__((ext_vector_type(8)));
typedef short s16x4 __attribute__((ext_vector_type(4)));
typedef float f32x16 __attribute__((ext_vector_type(16)));
typedef float f32x4 __attribute__((ext_vector_type(4)));
typedef unsigned u32x4 __attribute__((ext_vector_type(4)));
typedef unsigned u32x2 __attribute__((ext_vector_type(2)));
constexpr int KB0 = 0, KBSZ = 12288, VB0 = 24576, VBSZ = 16384;
__device__ __forceinline__ float swap_max(float m) { auto rr = __builtin_amdgcn_permlane32_swap(__float_as_uint(m), __float_as_uint(m), false, false); return fmaxf(__uint_as_float(rr[0]), __uint_as_float(rr[1])); }
__device__ __forceinline__ float swap_sum(float m) { auto rr = __builtin_amdgcn_permlane32_swap(__float_as_uint(m), __float_as_uint(m), false, false); return __uint_as_float(rr[0]) + __uint_as_float(rr[1]); }
__device__ __forceinline__ s16x4 vtr(const ATT_LAS char* p) { return __builtin_bit_cast(s16x4, __builtin_amdgcn_ds_read_tr16_b64_v4i16((ATT_LAS s16x4*)p)); }
__device__ __forceinline__ int crow(int r, int hi) { return (r & 3) + 8 * (r >> 2) + 4 * hi; }

template <int DQK, int DV, bool MLA>
__device__ __forceinline__ void attn_pass(ATT_LAS char* lds, const bf16_t* qp, const bf16_t* kg, const bf16_t* krg, const bf16_t* vg, int NT, int myNT, f32x16 (&o)[DV / 32], float& linv) {
    int tid_ = threadIdx.x; asm volatile("" : "+v"(tid_)); const int tid = tid_, lane = tid & 63, wid = __builtin_amdgcn_readfirstlane(tid >> 6), r32 = lane & 31, hi = lane >> 5;
    bf16x8 qr[DQK / 16];
#pragma unroll
    for (int d0 = 0; d0 < DQK / 16; ++d0) qr[d0] = *(const bf16x8*)(qp + d0 * 16);
    const bf16_t* ksrc = kg + (size_t)lane * 1024 + wid * 8;
    const bf16_t* krsrc = krg + (size_t)lane * 32 + (wid & 3) * 8;
    const bf16_t* vsrc = vg + (size_t)(16 * (wid & 3) + (lane >> 2)) * 1024 + (wid >> 2) * 32 + (lane & 3) * 8;
    const int sto = wid * 1024 + lane * 16;
    u32x4 kr0 = {0u, 0u, 0u, 0u}, kr1 = kr0, vr0 = kr0, vr1 = kr0;
#define ATT_LOAD(t) do { kr0 = *(const u32x4*)(ksrc + (size_t)(t) * 65536); if (MLA) { if (wid < 4) kr1 = *(const u32x4*)(krsrc + (size_t)(t) * 2048); } \
        vr0 = *(const u32x4*)(vsrc + (size_t)(t) * 65536); if (DV == 128) vr1 = *(const u32x4*)(vsrc + (size_t)(t) * 65536 + 64); } while (0)
#define ATT_STORE(b) do { *(ATT_LAS u32x4*)(lds + KB0 + (b) * KBSZ + sto) = kr0; if (MLA) { if (wid < 4) *(ATT_LAS u32x4*)(lds + KB0 + (b) * KBSZ + 8192 + sto) = kr1; } \
        *(ATT_LAS u32x4*)(lds + VB0 + (b) * VBSZ + sto) = vr0; if (DV == 128) *(ATT_LAS u32x4*)(lds + VB0 + (b) * VBSZ + 8192 + sto) = vr1; } while (0)
#pragma unroll
    for (int i = 0; i < DV / 32; ++i)
#pragma unroll
        for (int r = 0; r < 16; ++r) o[i][r] = 0.f;
    float mref = 0.f, lsum = 0.f;
    ATT_LOAD(0); ATT_STORE(0); __syncthreads();
    for (int t = 0; t < NT; ++t) {
        const int b = t & 1;
        if (t + 1 < NT) ATT_LOAD(t + 1);
        if (t < myNT) {
            const ATT_LAS char* kp = lds + KB0 + b * KBSZ + hi * 1024 + r32 * 16;
            f32x16 p0, p1;
#pragma unroll
            for (int r = 0; r < 16; ++r) { p0[r] = -mref; p1[r] = -mref; }
#pragma unroll
            for (int d0 = 0; d0 < DQK / 16; ++d0) {
                const bf16x8 k0 = *(const ATT_LAS bf16x8*)(kp + d0 * 2048), k1 = *(const ATT_LAS bf16x8*)(kp + d0 * 2048 + 512);
                p0 = __builtin_amdgcn_mfma_f32_32x32x16_bf16(k0, qr[d0], p0, 0, 0, 0);
                p1 = __builtin_amdgcn_mfma_f32_32x32x16_bf16(k1, qr[d0], p1, 0, 0, 0);
            }
            float mx = fmaxf(p0[0], p1[0]);
#pragma unroll
            for (int r = 1; r < 16; ++r) mx = fmaxf(mx, fmaxf(p0[r], p1[r]));
            mx = swap_max(mx);
            if (__any(mx > 8.f)) {
                const float dl = fmaxf(mx, 0.f), al = __builtin_amdgcn_exp2f(-dl);
                lsum *= al;
#pragma unroll
                for (int i = 0; i < DV / 32; ++i)
#pragma unroll
                    for (int r = 0; r < 16; ++r) o[i][r] *= al;
#pragma unroll
                for (int r = 0; r < 16; ++r) { p0[r] -= dl; p1[r] -= dl; }
                mref += dl;
            }
            float ls = 0.f;
#pragma unroll
            for (int r = 0; r < 16; ++r) { p0[r] = __builtin_amdgcn_exp2f(p0[r]); p1[r] = __builtin_amdgcn_exp2f(p1[r]); ls += p0[r] + p1[r]; }
            lsum += ls;
            u32x4 pw[4];
#pragma unroll
            for (int j = 0; j < 4; ++j) { pw[0][j] = pg8::pk2(p0[2 * j], p0[2 * j + 1]); pw[1][j] = pg8::pk2(p0[8 + 2 * j], p0[9 + 2 * j]); pw[2][j] = pg8::pk2(p1[2 * j], p1[2 * j + 1]); pw[3][j] = pg8::pk2(p1[8 + 2 * j], p1[9 + 2 * j]); }
            const ATT_LAS char* vp = lds + VB0 + b * VBSZ + ((lane >> 4) & 1) * 32 + (lane & 3) * 8 + (4 * hi + ((lane & 15) >> 2)) * 64;
#pragma unroll
            for (int i = 0; i < DV / 32; ++i)
#pragma unroll
                for (int ks = 0; ks < 4; ++ks) {
                    const s16x4 lo = vtr(vp + i * 4096 + ks * 1024), hh = vtr(vp + i * 4096 + ks * 1024 + 512);
                    const bf16x8 vf = {lo[0], lo[1], lo[2], lo[3], hh[0], hh[1], hh[2], hh[3]};
                    o[i] = __builtin_amdgcn_mfma_f32_32x32x16_bf16(vf, __builtin_bit_cast(bf16x8, pw[ks]), o[i], 0, 0, 0);
                }
        }
        if (t + 1 < NT) ATT_STORE(b ^ 1);
        __syncthreads();
    }
    linv = __builtin_amdgcn_rcpf(swap_sum(lsum));
#undef ATT_LOAD
#undef ATT_STORE
}

__device__ __forceinline__ void diff_unit(ATT_LAS char* lds, int b, int h, int qb, const bf16_t* QD, const bf16_t* KD, const bf16_t* VD, bf16_t* OD, const float* subln, float lam) {
    int tid_ = threadIdx.x; asm volatile("" : "+v"(tid_)); const int tid = tid_, lane = tid & 63, wid = __builtin_amdgcn_readfirstlane(tid >> 6), r32 = lane & 31, hi = lane >> 5;
    const size_t row0 = (size_t)b * SEQ_LEN, qrow = row0 + qb * 256 + wid * 32 + r32;
    const int NT = 4 * qb + 4, myNT = 4 * qb + (wid >> 1) + 1;
    f32x16 o1[4], o2[4]; float li1, li2;
    attn_pass<64, 128, false>(lds, QD + qrow * 1024 + (2 * h) * 64 + hi * 8, KD + row0 * 1024 + (2 * h) * 64, nullptr, VD + row0 * 1024 + h * 128, NT, myNT, o1, li1);
    attn_pass<64, 128, false>(lds, QD + qrow * 1024 + (2 * h + 1) * 64 + hi * 8, KD + row0 * 1024 + (2 * h + 1) * 64, nullptr, VD + row0 * 1024 + h * 128, NT, myNT, o2, li2);
    const float c2 = lam * li2; float ss = 0.f;
#pragma unroll
    for (int i = 0; i < 4; ++i)
#pragma unroll
        for (int r = 0; r < 16; ++r) { const float v = o1[i][r] * li1 - o2[i][r] * c2; o1[i][r] = v; ss += v * v; }
    ss = swap_sum(ss);
    const float rstd = __builtin_amdgcn_rsqf(ss * (1.f / 128.f) + NEPS) * 0.8f;
    bf16_t* op = OD + qrow * 1024 + h * 128 + 4 * hi;
#pragma unroll
    for (int i = 0; i < 4; ++i)
#pragma unroll
        for (int rq = 0; rq < 4; ++rq) { const int dv = 32 * i + 8 * rq; const f32x4 g = *(const f32x4*)(subln + dv + 4 * hi);
            u32x2 w; w.x = pg8::pk2(o1[i][4 * rq] * rstd * g[0], o1[i][4 * rq + 1] * rstd * g[1]); w.y = pg8::pk2(o1[i][4 * rq + 2] * rstd * g[2], o1[i][4 * rq + 3] * rstd * g[3]);
            *(u32x2*)(op + dv) = w; }
}
__device__ __forceinline__ void mla_unit(ATT_LAS char* lds, int b, int h, int qb, const bf16_t* QM, const bf16_t* KVM, const bf16_t* KR, bf16_t* OM) {
    int tid_ = threadIdx.x; asm volatile("" : "+v"(tid_)); const int tid = tid_, lane = tid & 63, wid = __builtin_amdgcn_readfirstlane(tid >> 6), r32 = lane & 31, hi = lane >> 5;
    const size_t row0 = (size_t)b * SEQ_LEN, qrow = row0 + qb * 256 + wid * 32 + r32;
    const int NT = 4 * qb + 4, myNT = 4 * qb + (wid >> 1) + 1;
    f32x16 o[2]; float li;
    attn_pass<96, 64, true>(lds, QM + qrow * 768 + h * 96 + hi * 8, KVM + row0 * 1024 + h * 128, KR + row0 * 32, KVM + row0 * 1024 + h * 128 + 64, NT, myNT, o, li);
    bf16_t* op = OM + qrow * 512 + h * 64 + 4 * hi;
#pragma unroll
    for (int i = 0; i < 2; ++i)
#pragma unroll
        for (int rq = 0; rq < 4; ++rq) { const int dv = 32 * i + 8 * rq;
            u32x2 w; w.x = pg8::pk2(o[i][4 * rq] * li, o[i][4 * rq + 1] * li); w.y = pg8::pk2(o[i][4 * rq + 2] * li, o[i][4 * rq + 3] * li);
            *(u32x2*)(op + dv) = w; }
}
}
#define LAS __attribute__((address_space(3)))
typedef unsigned short bf16;
typedef float f32x4 __attribute__((ext_vector_type(4)));
typedef unsigned v4u __attribute__((ext_vector_type(4)));
typedef unsigned v2u __attribute__((ext_vector_type(2)));
constexpr int NWAVES = 8, LDS_BYTES = 147456;
constexpr size_t MiB = 1ull << 20;
constexpr size_t WS_TABD = 0, WS_TABM = 128 * 1024, WS_LAM = 384 * 1024, WS_BAR = 512 * 1024;
constexpr size_t WS_SSQ = 1 * MiB, WS_SSKV = 2 * MiB, WS_SS1 = 3 * MiB, WS_SS2 = 5 * MiB, WS_SS3 = 7 * MiB;
constexpr size_t WS_WIN = 10 * MiB, WS_WGU = WS_WIN + 5888ull * 1024 * 2, WS_WDN = WS_WGU + 5632ull * 1024 * 2, WS_WOD = WS_WDN + 1024ull * 2816 * 2, WS_WOUT = WS_WOD + 2 * MiB,
                 WS_WPG = WS_WOUT + 2 * MiB, WS_WOM = WS_WPG + 2 * MiB, WS_WUQ = WS_WOM + 1 * MiB, WS_WUKV = WS_WUQ + 768ull * 384 * 2, WS_WPLE = WS_WUKV + 1024ull * 256 * 2, WS_WEND = WS_WPLE + 1024ull * 256 * 2;
static_assert(WS_WEND <= 47 * MiB, "weights");
constexpr size_t WS_PB = 47 * MiB;
constexpr size_t WS_XN = 64 * MiB, WS_QM = 64 * MiB, WS_X1B = 64 * MiB;
constexpr size_t WS_QD = 128 * MiB, WS_KD = 192 * MiB, WS_VD = 256 * MiB, WS_KVM = 320 * MiB;
constexpr size_t WS_T = 192 * MiB, WS_MG = 320 * MiB;
constexpr size_t WS_HID = 128 * MiB, WS_X2B = 304 * MiB;
constexpr size_t WS_X3B = 384 * MiB, WS_T2B = 448 * MiB;
constexpr size_t WS_CKV = 384 * MiB, WS_CQ = 400 * MiB, WS_KR = 424 * MiB, WS_OM = 426 * MiB;
constexpr size_t WS_END = 512 * MiB;

#define XB_TMO      128
#define XB_XCNT(j)  (256  + 64 * (j))
#define XB_XSUB(j)  (1280 + 64 * (j))
#define XB_XGEN(j)  (2304 + 64 * (j))
#define XB_TOP      3328
#define XB_TOPGEN   3392
#define XCD_BAR_WORDS 3456
#define XB_SPIN_CAP (1u << 18)

__device__ __forceinline__ unsigned xb_ld(unsigned* p)              { return __hip_atomic_load(p, __ATOMIC_RELAXED, __HIP_MEMORY_SCOPE_AGENT); }
__device__ __forceinline__ unsigned xb_add(unsigned* p, unsigned v) { return __hip_atomic_fetch_add(p, v, __ATOMIC_RELAXED, __HIP_MEMORY_SCOPE_AGENT); }
__device__ __forceinline__ unsigned xb_xcc_id() { return (unsigned)__builtin_amdgcn_s_getreg((3 << 11) | 20) & 0xFu; }
#define XB_SPIN(cond, bar) do { unsigned _sp = 0; while (cond) { __builtin_amdgcn_s_sleep(1); \
    if ((++_sp & 255u) == 0u) { if (xb_ld(&(bar)[XB_TMO])) break; if (_sp > XB_SPIN_CAP) { atomicAdd(&(bar)[XB_TMO], 1u); break; } } } } while (0)

struct XcdBarrier {
    unsigned* bar; unsigned x;
    volatile LAS unsigned* st;
};

__device__ __forceinline__ XcdBarrier xcd_barrier_post(unsigned* bar, volatile LAS unsigned* st) {
    XcdBarrier b; b.bar = bar; b.x = xb_xcc_id(); b.st = st;
    if (threadIdx.x == 0) (void)xb_add(&bar[XB_XCNT(b.x)], 1u);
    return b;
}
__device__ __forceinline__ void xcd_barrier_complete(unsigned* bar, unsigned x, unsigned& nloc, unsigned& nx) {
    const unsigned G = gridDim.x * gridDim.y * gridDim.z;
    unsigned sum, cnt, mine, sp = 0u;
    for (;;) {
        sum = 0u; cnt = 0u; mine = 0u;
#pragma unroll
        for (unsigned j = 0; j < 16; ++j) { const unsigned c = xb_ld(&bar[XB_XCNT(j)]); sum += c; cnt += (c > 0u) ? 1u : 0u; mine = (j == x) ? c : mine; }
        if (sum == G) break;
        __builtin_amdgcn_s_sleep(1);
        if ((++sp & 255u) == 0u) { if (xb_ld(&bar[XB_TMO])) break; if (sp > XB_SPIN_CAP) { atomicAdd(&bar[XB_TMO], 1u); break; } }
    }
    nloc = mine > 0u ? mine : 1u; nx = cnt > 0u ? cnt : 1u;
}

__device__ __forceinline__ void xcd_barrier(const XcdBarrier& b) {
    asm volatile("s_waitcnt vmcnt(0)" ::: "memory");
    __syncthreads();
    if (threadIdx.x == 0) {
        unsigned* bar = b.bar;
        __builtin_amdgcn_s_waitcnt(0);
        unsigned nloc = b.st[0], nx = b.st[1];
        if (nloc == 0u) { xcd_barrier_complete(bar, b.x, nloc, nx); b.st[0] = nloc; b.st[1] = nx; }
        const unsigned old = xb_add(&bar[XB_XSUB(b.x)], 1u);
        const unsigned gen = old / nloc;
        if (old + 1u == (gen + 1u) * nloc) {
            __builtin_amdgcn_fence(__ATOMIC_RELEASE, "agent");
            asm volatile("s_waitcnt vmcnt(0)" ::: "memory");
            const unsigned og = xb_add(&bar[XB_TOP], 1u);
            const unsigned tg = og / nx;
            if (og + 1u == (tg + 1u) * nx) xb_add(&bar[XB_TOPGEN], 1u);
            else XB_SPIN(xb_ld(&bar[XB_TOPGEN]) == tg, bar);
            __builtin_amdgcn_fence(__ATOMIC_ACQUIRE, "agent");
            xb_add(&bar[XB_XGEN(b.x)], 1u);
            asm volatile("s_waitcnt vmcnt(0)" ::: "memory");
        } else {
            XB_SPIN(xb_ld(&bar[XB_XGEN(b.x)]) == gen, bar);
            __builtin_amdgcn_fence(__ATOMIC_ACQUIRE, "agent");
            asm volatile("s_waitcnt vmcnt(0)" ::: "memory");
        }
    }
    __syncthreads();
}

struct Args {
    const float *x, *p, *attn_norm, *w_in, *b_gate, *lam_q1, *lam_k1, *lam_q2, *lam_k2, *diff_subln, *w_o_diff, *q_norm, *w_uq, *kv_norm, *w_ukv, *w_o_mla, *w_out, *ffn_norm,
        *w_ffn_gate, *w_ffn_up, *w_ffn_down, *ple_norm, *w_ple_gate, *b_ple_gate, *w_ple, *final_norm;
    float* out; unsigned char* ws;
};

__device__ __forceinline__ float wave_sum(float v) {
#pragma unroll
    for (int o = 1; o < 64; o <<= 1) v += __shfl_xor(v, o);
    return v;
}
__device__ __forceinline__ void wprep_item(int kind, const float* W, const float* W2, int ld, int K, int Nout, const float* gain, bf16* WT, int item, LAS float* scr, int lane) {
    const int nnb = Nout / 64, kb = item / nnb, nb = item % nnb, k0 = kb * 64, n0 = nb * 64, n = n0 + lane;
    const float* base = W; int col = n;
    if (kind == 1) {
        if (n < 2048) { const int hl = n & 63; col = (n & ~63) + (hl < 16 ? ((hl & 1) ? (hl >> 1) + 8 : (hl >> 1)) : hl); }
        else if (n < 3072) col = n;
        else if (n < 5120) col = 3744 + (n - 3072);
        else if (n < 5376) col = 3456 + (n - 5120);
        else if (n < 5760) col = 3072 + (n - 5376);
        else if (n < 5792) { const int hl = n - 5760; col = 3712 + ((hl & 1) ? (hl >> 1) + 16 : (hl >> 1)); }
        else col = -1;
    } else if (kind == 2) { const int h = n / 96, hl = n % 96; int s = hl; if (hl >= 64) { const int r = hl - 64; s = 64 + ((r & 1) ? (r >> 1) + 16 : (r >> 1)); } col = h * 96 + s;
    } else if (kind == 3) { const int pn = n >> 8, r = n & 255; if (r < 128) col = pn * 128 + r; else { base = W2; col = pn * 128 + (r - 128); } }
#pragma unroll 32
    for (int kk = 0; kk < 64; ++kk) { float v = (col >= 0) ? base[(size_t)(k0 + kk) * ld + col] : 0.f; if (gain) v *= gain[k0 + kk]; scr[kk * 65 + lane] = v; }
    asm volatile("s_waitcnt lgkmcnt(0)" ::: "memory");
    const int c = lane & 7;
#pragma unroll
    for (int j = 0; j < 8; ++j) { const int nn = (lane >> 3) + 8 * j; const LAS float* s = scr + (8 * c) * 65 + nn;
        v4u o; o.x = pg8::pk2(s[0], s[65]); o.y = pg8::pk2(s[2 * 65], s[3 * 65]); o.z = pg8::pk2(s[4 * 65], s[5 * 65]); o.w = pg8::pk2(s[6 * 65], s[7 * 65]);
        *(v4u*)(WT + (size_t)(n0 + nn) * K + k0 + 8 * c) = o; }
    asm volatile("s_waitcnt lgkmcnt(0)" ::: "memory");
}


#define WSP(T, off) ((T*)(a.ws + (off)))
#define tabD WSP(float, WS_TABD)
#define tabM WSP(float, WS_TABM)
#define lamp WSP(float, WS_LAM)
#define SSQ WSP(float, WS_SSQ)
#define SSKV WSP(float, WS_SSKV)
#define SS1 WSP(float, WS_SS1)
#define SS2 WSP(float, WS_SS2)
#define SS3 WSP(float, WS_SS3)
#define Win WSP(bf16, WS_WIN)
#define Wgu WSP(bf16, WS_WGU)
#define Wdn WSP(bf16, WS_WDN)
#define Wod WSP(bf16, WS_WOD)
#define Wout WSP(bf16, WS_WOUT)
#define Wpg WSP(bf16, WS_WPG)
#define Wom WSP(bf16, WS_WOM)
#define Wuq WSP(bf16, WS_WUQ)
#define Wukv WSP(bf16, WS_WUKV)
#define Wple WSP(bf16, WS_WPLE)
#define PB WSP(bf16, WS_PB)
#define XN WSP(bf16, WS_XN)
#define QM WSP(bf16, WS_QM)
#define X1B WSP(bf16, WS_X1B)
#define QD WSP(bf16, WS_QD)
#define KD WSP(bf16, WS_KD)
#define VD WSP(bf16, WS_VD)
#define KVM WSP(bf16, WS_KVM)
#define MG WSP(bf16, WS_MG)
#define HID WSP(bf16, WS_HID)
#define X2B WSP(bf16, WS_X2B)
#define CKV WSP(bf16, WS_CKV)
#define CQ WSP(bf16, WS_CQ)
#define KR WSP(bf16, WS_KR)
#define OM WSP(bf16, WS_OM)
#define TBUF WSP(bf16, WS_T)
#define X3B WSP(bf16, WS_X3B)
#define T2B WSP(bf16, WS_T2B)
#define SA ((bf16*)a.out)
#define SB ((bf16*)a.out + (size_t)M_TOK * 1024)
template <class E> __device__ __forceinline__ void run_gemm(LAS unsigned char* lds, const bf16* A, const bf16* Bt, int N, int K, const E& e) {
    asm volatile("" : "+s"(K));
    pg8::Gemm g{A, Bt, M_TOK, N, K}; pg8::StaticOrder S; S.init(M_TOK, N, (int)gridDim.x, (int)blockIdx.x);
    pg8::gemm_phase<E, pg8::StaticOrder, true, true>(lds, g, S, e);
}

__global__ void __launch_bounds__(NWAVES * 64, 2) fwd_megakernel(Args a) {
    extern __shared__ __attribute__((aligned(16))) unsigned char lds_raw[];
    cg::grid_group grid = cg::this_grid();
    LAS unsigned char* lds = (LAS unsigned char*)lds_raw;
    int tid0_ = threadIdx.x; asm volatile("" : "+v"(tid0_)); const int tid = tid0_, lane = tid & 63, wave = __builtin_amdgcn_readfirstlane(tid >> 6);
    const int G = gridDim.x, gw = blockIdx.x * NWAVES + wave, NGW = G * NWAVES;
    volatile LAS unsigned* bst = (volatile LAS unsigned*)(lds + (LDS_BYTES - 64));
    if (tid < 2) bst[tid] = 0u;
    __syncthreads();
    const XcdBarrier xbar = xcd_barrier_post((unsigned*)(a.ws + WS_BAR), bst);
#if !defined(SKIP_P0)
    {
        LAS float* scr = (LAS float*)(lds + wave * 16640);
        constexpr int I0 = 16 * 92, I1 = I0 + 16 * 88, I2 = I1 + 44 * 16, I3 = I2 + 256, I4 = I3 + 256, I5 = I4 + 256, I6 = I5 + 128, I7 = I6 + 72, I8 = I7 + 64, I9 = I8 + 64;
        for (int it = gw; it < I9; it += NGW) {
            if (it < I0)      wprep_item(1, a.w_in, nullptr, 5792, 1024, 5888, nullptr, Win, it, scr, lane);
            else if (it < I1) wprep_item(3, a.w_ffn_gate, a.w_ffn_up, 2816, 1024, 5632, a.ffn_norm, Wgu, it - I0, scr, lane);
            else if (it < I2) wprep_item(0, a.w_ffn_down, nullptr, 1024, 2816, 1024, nullptr, Wdn, it - I1, scr, lane);
            else if (it < I3) wprep_item(0, a.w_o_diff, nullptr, 1024, 1024, 1024, nullptr, Wod, it - I2, scr, lane);
            else if (it < I4) wprep_item(0, a.w_out, nullptr, 1024, 1024, 1024, nullptr, Wout, it - I3, scr, lane);
            else if (it < I5) wprep_item(0, a.w_ple_gate, nullptr, 1024, 1024, 1024, a.ple_norm, Wpg, it - I4, scr, lane);
            else if (it < I6) wprep_item(0, a.w_o_mla, nullptr, 1024, 512, 1024, nullptr, Wom, it - I5, scr, lane);
            else if (it < I7) wprep_item(2, a.w_uq, nullptr, 768, 384, 768, a.q_norm, Wuq, it - I6, scr, lane);
            else if (it < I8) wprep_item(0, a.w_ukv, nullptr, 1024, 256, 1024, a.kv_norm, Wukv, it - I7, scr, lane);
            else              wprep_item(0, a.w_ple, nullptr, 1024, 256, 1024, nullptr, Wple, it - I8, scr, lane);
        }
        for (int r0 = gw * 4; r0 < M_TOK; r0 += NGW * 4) {
            f32x4 v[4][4]; float s[4];
#pragma unroll
            for (int q = 0; q < 4; ++q) { const f32x4* xr = (const f32x4*)(a.x + (size_t)(r0 + q) * 1024) + lane; s[q] = 0.f;
#pragma unroll
                for (int j = 0; j < 4; ++j) v[q][j] = xr[64 * j]; }
#pragma unroll
            for (int q = 0; q < 4; ++q) {
#pragma unroll
                for (int j = 0; j < 4; ++j) s[q] += pg8::sq4(v[q][j]);
                const float rstd = __builtin_amdgcn_rsqf(wave_sum(s[q]) * (1.f / 1024.f) + NEPS);
                v2u* o8 = (v2u*)(XN + (size_t)(r0 + q) * 1024) + lane;
#pragma unroll
                for (int j = 0; j < 4; ++j) { const f32x4 g = ((const f32x4*)a.attn_norm)[lane + 64 * j]; const f32x4 y = v[q][j] * rstd * g; v2u w; w.x = pg8::pk2(y[0], y[1]); w.y = pg8::pk2(y[2], y[3]); o8[64 * j] = w; } }
        }
        { const int gt = blockIdx.x * 512 + tid, GT = G * 512;
          for (int i = gt; i < M_TOK * 256 / 8; i += GT) { const f32x4 p0 = ((const f32x4*)a.p)[2 * i], p1 = ((const f32x4*)a.p)[2 * i + 1]; pg8::st8(PB + (size_t)i * 8, p0, p1); }
          for (int i = gt; i < 2048 * 24; i += GT) {
              const int pos = i / 24, f = i % 24; const bool dm = f < 8; const int fi = dm ? f : f - 8;
              const float invf = dm ? __builtin_amdgcn_exp2f(-18.931568569324174f * (float)fi * 0.125f) : __builtin_amdgcn_exp2f(-13.287712379549449f * (float)fi * 0.0625f);
              const float ang = (float)pos * invf; const double rev = (double)ang * 0.15915494309189535; const float fr = (float)(rev - floor(rev));
              const float cs = __builtin_amdgcn_cosf(fr), sn = __builtin_amdgcn_sinf(fr);
              float* dst = dm ? tabD + ((size_t)pos * 8 + fi) * 2 : tabM + ((size_t)pos * 16 + fi) * 2; dst[0] = cs; dst[1] = sn;
          }
          if (blockIdx.x == 0 && wave == 0) { const float s1 = wave_sum(a.lam_q1[lane] * a.lam_k1[lane]), s2 = wave_sum(a.lam_q2[lane] * a.lam_k2[lane]); if (lane == 0) lamp[0] = __expf(s1) - __expf(s2) + 0.2f; }
        }
    }
    xcd_barrier(xbar);
    if (a.ws == nullptr) grid.sync();
    #endif

#if !defined(SKIP_P1)
    { pg8::EpiInProj e{QD, KD, VD, SA, SB, CKV, CQ, KR, SSQ, SSKV, a.b_gate, tabD, tabM}; run_gemm(lds, XN, Win, 5888, 1024, e); }
    xcd_barrier(xbar);
    #endif

#if !defined(SKIP_P2)
    { pg8::EpiQUp e{SSQ, tabM, QM}; run_gemm(lds, CQ, Wuq, 768, 384, e); }
    { pg8::EpiKVUp e{SSKV, KVM}; run_gemm(lds, CKV, Wukv, 1024, 256, e); }
    xcd_barrier(xbar);
    #endif

#if !defined(SKIP_P3)
    {
        const float lam = lamp[0];
        for (int i = blockIdx.x; i < 2048; i += G) {
            const int type = i >> 10, rem = i & 1023, j = rem >> 8, half = (rem >> 7) & 1, bh = rem & 127;
            const int qb = half ? (j == 0 ? 6 : j == 1 ? 4 : j == 2 ? 3 : 1) : (j == 0 ? 7 : j == 1 ? 5 : j == 2 ? 2 : 0);
            if (type == 0) att::diff_unit((ATT_LAS char*)lds, bh >> 3, bh & 7, qb, QD, KD, VD, QD, a.diff_subln, lam);
            else           att::mla_unit((ATT_LAS char*)lds, bh >> 3, bh & 7, qb, QM, KVM, KR, OM);
        }
    }
    xcd_barrier(xbar);
    #endif

#if !defined(SKIP_P4)
    { pg8::EpiOutA e{SA, TBUF}; run_gemm(lds, QD, Wod, 1024, 1024, e); }
    { pg8::EpiOutB e{SB, TBUF, MG}; run_gemm(lds, OM, Wom, 1024, 512, e); }
    xcd_barrier(xbar);
    #endif

#if !defined(SKIP_P5)
    { pg8::EpiResid<false> e{a.x, X1B, SS1}; run_gemm(lds, MG, Wout, 1024, 1024, e); }
    xcd_barrier(xbar);
    #endif

#if !defined(SKIP_P6)
    { pg8::EpiSwiGLU e{SS1, HID}; run_gemm(lds, X1B, Wgu, 5632, 1024, e); }
    xcd_barrier(xbar);
    #endif

#if !defined(SKIP_P7)
    { pg8::EpiResid<true> e{X1B, X2B, SS2}; run_gemm(lds, HID, Wdn, 1024, 2816, e); }
    xcd_barrier(xbar);
    #endif

#if !defined(SKIP_P8)
    { pg8::EpiPleA e{T2B}; run_gemm(lds, PB, Wple, 1024, 256, e); }
    { pg8::EpiPleB e{SS2, a.b_ple_gate, X2B, T2B, X3B, SS3}; run_gemm(lds, X2B, Wpg, 1024, 1024, e); }
    xcd_barrier(xbar);
    #endif

#if !defined(SKIP_P9)
    { int t9_ = threadIdx.x; asm volatile("" : "+v"(t9_)); const int lane = t9_ & 63, gw = blockIdx.x * NWAVES + __builtin_amdgcn_readfirstlane(t9_ >> 6), NGW = gridDim.x * NWAVES;
    for (int r0 = gw * 4; r0 < M_TOK; r0 += NGW * 4) {
        v4u w[4][2]; float s[4];
#pragma unroll
        for (int q = 0; q < 4; ++q) { const v4u* xr = (const v4u*)(X3B + (size_t)(r0 + q) * 1024) + lane; w[q][0] = xr[0]; w[q][1] = xr[64]; s[q] = (lane < 16) ? SS3[(size_t)(r0 + q) * 16 + lane] : 0.f; }
#pragma unroll
        for (int q = 0; q < 4; ++q) { const float rstd = __builtin_amdgcn_rsqf(wave_sum(s[q]) * (1.f / 1024.f) + NEPS);
#pragma unroll
            for (int j = 0; j < 2; ++j) { const int c = (lane + 64 * j) * 8; const f32x4 g0 = *(const f32x4*)(a.final_norm + c), g1 = *(const f32x4*)(a.final_norm + c + 4); const v4u ww = w[q][j];
                f32x4 x0, x1; x0[0] = __uint_as_float(ww.x << 16); x0[1] = __uint_as_float(ww.x & 0xffff0000u); x0[2] = __uint_as_float(ww.y << 16); x0[3] = __uint_as_float(ww.y & 0xffff0000u);
                x1[0] = __uint_as_float(ww.z << 16); x1[1] = __uint_as_float(ww.z & 0xffff0000u); x1[2] = __uint_as_float(ww.w << 16); x1[3] = __uint_as_float(ww.w & 0xffff0000u);
                float* o = a.out + (size_t)(r0 + q) * 1024 + c; *(f32x4*)o = x0 * rstd * g0; *(f32x4*)(o + 4) = x1 * rstd * g1; } }
    } }
#endif
}

extern "C" void kernel_launch(void* const* d_in, const int* in_sizes, int n_in, void* d_out, int out_size, void* d_ws, size_t ws_size, hipStream_t stream) {
    static int grid = 0;
    if (grid == 0) {
        if (n_in != 26 || out_size != M_TOK * 1024 || ws_size < WS_END) { fprintf(stderr, "kernel_launch: unexpected shapes (n_in %d out %d ws %zu)\n", n_in, out_size, ws_size); grid = -1; return; }
        int dev = 0, cus = 0, per_cu = 0;
        (void)hipGetDevice(&dev); (void)hipDeviceGetAttribute(&cus, hipDeviceAttributeMultiprocessorCount, dev);
        (void)hipFuncSetAttribute((const void*)fwd_megakernel, hipFuncAttributeMaxDynamicSharedMemorySize, LDS_BYTES);
        if (hipOccupancyMaxActiveBlocksPerMultiprocessor(&per_cu, (const void*)fwd_megakernel, NWAVES * 64, LDS_BYTES) != hipSuccess || per_cu < 1) per_cu = 1;
        (void)hipGetLastError();
        grid = cus * per_cu;
    }
    if (grid < 0) return;
    Args a{};
    const float** f = (const float**)&a;
    for (int i = 0; i < 26; ++i) f[i] = (const float*)d_in[i];
    a.out = (float*)d_out; a.ws = (unsigned char*)d_ws;
    (void)hipMemsetAsync((char*)d_ws + WS_BAR, 0, 16384, stream);
    void* args[] = {&a};
    hipError_t e = hipLaunchCooperativeKernel((const void*)fwd_megakernel, dim3(grid), dim3(NWAVES * 64), args, LDS_BYTES, stream);
    if (e != hipSuccess) fprintf(stderr, "cooperative launch failed: %s (grid %d)\n", hipGetErrorString(e), grid);
}
```

```cpp
#include <hip/hip_runtime.h>
#include <hip/hip_cooperative_groups.h>
#include <cstdio>
#include <cstdint>
namespace cg = cooperative_groups;

constexpr int M_TOK = 32768, SEQ_LEN = 2048;
constexpr float NEPS = 1e-6f;
constexpr float LOG2E_F = 1.4426950408889634f;
constexpr float QS_D = 0.125f * LOG2E_F;
constexpr float QS_M = 0.10206207261596575f * LOG2E_F;
namespace pg8 {
#define PG8_LAS __attribute__((address_space(3)))
typedef unsigned short bf16_t;
typedef short bf16x8 __attribute__((ext_vector_type(8)));
typedef float f32x4 __attribute__((ext_vector_type(4)));
typedef unsigned u32x4 __attribute__((ext_vector_type(4)));
constexpr int BM = 256, BK = 64, HALF = 128, HTB = HALF * BK * 2  , STAGE_BYTES = 8 * HTB, NXCD = 8, WGM = 8;

__host__ __device__ __forceinline__ int lds_byte(int r, int c) { const int st = (r >> 4) * 2 + (c >> 5), rr = r & 15, cc = c & 31, ob = rr * 64 + cc * 2; return st * 1024 + (ob ^ (((ob >> 9) & 1) << 5)); }
__host__ __device__ __forceinline__ void stage_rc(int b, int& R, int& C) { const int st = b / 1024, sb = b % 1024, swz = sb ^ (((sb >> 9) & 1) << 5); R = (st >> 1) * 16 + swz / 64; C = (st & 1) * 32 + (swz % 64) / 2; }
__host__ __device__ __forceinline__ int perm32(int rho) { const int n = rho >> 4, i = rho & 15; return 8 * (i >> 2) + 4 * n + (i & 3); }

struct Unit { int pm, pn; };
struct Gemm { const bf16_t* A; const bf16_t* Bt; int M, N, K; };

struct StaticOrder {
    int nM, nN, nwg, G, c;
    __host__ __device__ void init(int M, int N, int G_, int c_) { nM = M / BM; nN = N / BM; nwg = nM * nN; G = G_; c = c_; }
    __host__ __device__ bool next(int i, Unit& u) const {
        const long L = (long)i * G + c; if (L >= nwg) return false;
        int wgid = (int)L; { const int q = nwg / NXCD, r = nwg % NXCD, xcd = wgid % NXCD, off = wgid / NXCD; wgid = (xcd < r ? xcd * (q + 1) : r * (q + 1) + (xcd - r) * q) + off; }
        const int nig = WGM * nN, gid = wgid / nig, fm = gid * WGM, gsz = (nM - fm) < WGM ? (nM - fm) : WGM;
        u.pm = fm + ((wgid % nig) % gsz); u.pn = (wgid % nig) / gsz; return true;
    }
    __device__ __forceinline__ void a_ready(const Unit&) const {}
    __device__ __forceinline__ void done(const Unit&) const {}
};

typedef unsigned u32x4 __attribute__((ext_vector_type(4)));
typedef unsigned u32x2 __attribute__((ext_vector_type(2)));
typedef float f32x2 __attribute__((ext_vector_type(2)));
typedef __bf16 bf16x2_t __attribute__((ext_vector_type(2)));
__device__ __forceinline__ unsigned pk2(float lo, float hi) { f32x2 v = {lo, hi}; bf16x2_t b = __builtin_convertvector(v, bf16x2_t); return __builtin_bit_cast(unsigned, b); }
__device__ __forceinline__ void st8(bf16_t* p, f32x4 a, f32x4 b) { u32x4 w; w.x = pk2(a[0], a[1]); w.y = pk2(a[2], a[3]); w.z = pk2(b[0], b[1]); w.w = pk2(b[2], b[3]); *(u32x4*)p = w; }
__device__ __forceinline__ void ld8(const bf16_t* p, f32x4& a, f32x4& b) { const u32x4 w = *(const u32x4*)p;
    a[0] = __uint_as_float(w.x << 16); a[1] = __uint_as_float(w.x & 0xffff0000u); a[2] = __uint_as_float(w.y << 16); a[3] = __uint_as_float(w.y & 0xffff0000u);
    b[0] = __uint_as_float(w.z << 16); b[1] = __uint_as_float(w.z & 0xffff0000u); b[2] = __uint_as_float(w.w << 16); b[3] = __uint_as_float(w.w & 0xffff0000u); }
__device__ __forceinline__ void up8(const u32x4 w, f32x4& a, f32x4& b) {
    a[0] = __uint_as_float(w.x << 16); a[1] = __uint_as_float(w.x & 0xffff0000u); a[2] = __uint_as_float(w.y << 16); a[3] = __uint_as_float(w.y & 0xffff0000u);
    b[0] = __uint_as_float(w.z << 16); b[1] = __uint_as_float(w.z & 0xffff0000u); b[2] = __uint_as_float(w.w << 16); b[3] = __uint_as_float(w.w & 0xffff0000u); }
__device__ __forceinline__ float sigm(float x) { return __builtin_amdgcn_rcpf(1.f + __expf(-x)); }
__device__ __forceinline__ f32x4 sigm4(f32x4 x) { f32x4 o; o[0] = sigm(x[0]); o[1] = sigm(x[1]); o[2] = sigm(x[2]); o[3] = sigm(x[3]); return o; }
__device__ __forceinline__ float quad_sum(float s) { s += __shfl_xor(s, 16); s += __shfl_xor(s, 32); return s; }
__device__ __forceinline__ float sq4(f32x4 v) { return (v[0] * v[0] + v[1] * v[1]) + (v[2] * v[2] + v[3] * v[3]); }
__device__ __forceinline__ f32x4 rope4(f32x4 v, f32x4 t) { f32x4 o; o[0] = v[0] * t[0] - v[1] * t[1]; o[1] = v[1] * t[0] + v[0] * t[1]; o[2] = v[2] * t[2] - v[3] * t[3]; o[3] = v[3] * t[2] + v[2] * t[3]; return o; }
#define EPI_FENCE() asm volatile("" ::: "memory")
#define EPI_LOOP_AM _Pragma("unroll") for (int ai = 0; ai < 2; ++ai) _Pragma("unroll") for (int m = 0; m < 4; ++m)

struct EpiInProj {
    static constexpr bool PERM = true, AFTER_DRAIN = false;
    bf16_t *QD, *KD, *VD, *SA, *SB, *CKV, *CQ, *KR; float *SSQ, *SSKV; const float* bgate; const float* tabD; const float* tabM;
    __device__ __forceinline__ void operator()(const f32x4 (&acc)[2][2][4][2], const Unit& u, int wr, int wc, int fr, int fq) const {
        const int pn = u.pn, rbase = u.pm * BM + wr * 64 + fr, lc = wc * 32 + fq * 8;
        if (pn < 8) {
            bf16_t* dst = (pn < 4 ? QD : KD) + (pn & 3) * 256 + lc; const float sc = pn < 4 ? QS_D : 1.f;
            const bool rp = ((wc & 1) == 0) && (fq < 2);
            EPI_LOOP_AM { const int row = rbase + ai * HALF + m * 16; f32x4 t0 = {1.f, 0.f, 1.f, 0.f}, t1 = t0;
                if (rp) { const f32x4* tp = (const f32x4*)(tabD + ((size_t)(row & (SEQ_LEN - 1)) * 8 + 4 * fq) * 2); t0 = tp[0]; t1 = tp[1]; }
#pragma unroll
                for (int bj = 0; bj < 2; ++bj) st8(dst + (size_t)row * 1024 + bj * HALF, rope4(acc[ai][bj][m][0], t0) * sc, rope4(acc[ai][bj][m][1], t1) * sc);
                EPI_FENCE(); }
        } else if (pn < 12) {
            bf16_t* dst = VD + (pn - 8) * 256 + lc;
            EPI_LOOP_AM { const int row = rbase + ai * HALF + m * 16;
#pragma unroll
                for (int bj = 0; bj < 2; ++bj) st8(dst + (size_t)row * 1024 + bj * HALF, acc[ai][bj][m][0], acc[ai][bj][m][1]); }
        } else if (pn < 20) {
            const int t = (pn - 12) & 3; bf16_t* dst = (pn < 16 ? SA : SB) + t * 256 + lc; const float* bp = bgate + (pn < 16 ? 0 : 1024) + t * 256 + lc;
            f32x4 b[2][2];
#pragma unroll
            for (int bj = 0; bj < 2; ++bj) { b[bj][0] = *(const f32x4*)(bp + bj * HALF); b[bj][1] = *(const f32x4*)(bp + bj * HALF + 4); }
            EPI_LOOP_AM { const int row = rbase + ai * HALF + m * 16;
#pragma unroll
                for (int bj = 0; bj < 2; ++bj) st8(dst + (size_t)row * 1024 + bj * HALF, sigm4(acc[ai][bj][m][0] + b[bj][0]), sigm4(acc[ai][bj][m][1] + b[bj][1])); }
        } else if (pn == 20) {
            EPI_LOOP_AM { const int row = rbase + ai * HALF + m * 16; float s = 0.f;
#pragma unroll
                for (int bj = 0; bj < 2; ++bj) { st8(CKV + (size_t)row * 256 + bj * HALF + lc, acc[ai][bj][m][0], acc[ai][bj][m][1]); s += sq4(acc[ai][bj][m][0]) + sq4(acc[ai][bj][m][1]); }
                s = quad_sum(s); if (fq == 0) SSKV[(size_t)row * 4 + wc] = s; }
        } else if (pn == 21) {
            EPI_LOOP_AM { const int row = rbase + ai * HALF + m * 16; float s = 0.f;
#pragma unroll
                for (int bj = 0; bj < 2; ++bj) { st8(CQ + (size_t)row * 384 + bj * HALF + lc, acc[ai][bj][m][0], acc[ai][bj][m][1]); s += sq4(acc[ai][bj][m][0]) + sq4(acc[ai][bj][m][1]); }
                s = quad_sum(s); if (fq == 0) SSQ[(size_t)row * 8 + wc] = s; }
        } else {
            EPI_LOOP_AM { const int row = rbase + ai * HALF + m * 16;
                st8(CQ + (size_t)row * 384 + 256 + lc, acc[ai][0][m][0], acc[ai][0][m][1]);
                float s = sq4(acc[ai][0][m][0]) + sq4(acc[ai][0][m][1]); s = quad_sum(s); if (fq == 0) SSQ[(size_t)row * 8 + 4 + wc] = s;
                if (wc == 0) { const f32x4* tp = (const f32x4*)(tabM + ((size_t)(row & (SEQ_LEN - 1)) * 16 + 4 * fq) * 2);
                    st8(KR + (size_t)row * 32 + fq * 8, rope4(acc[ai][1][m][0], tp[0]), rope4(acc[ai][1][m][1], tp[1])); }
                EPI_FENCE(); }
        }
    }
};
struct EpiQUp {
    static constexpr bool PERM = true, AFTER_DRAIN = false;
    const float* SSQ; const float* tabM; bf16_t* QM;
    __device__ __forceinline__ void operator()(const f32x4 (&acc)[2][2][4][2], const Unit& u, int wr, int wc, int fr, int fq) const {
        const int rbase = u.pm * BM + wr * 64 + fr, c0 = u.pn * BM + wc * 32 + fq * 8;
        const int hl0 = c0 % 96, hl1 = (c0 + HALF) % 96;
        EPI_LOOP_AM { const int row = rbase + ai * HALF + m * 16;
            const f32x4 s0 = *(const f32x4*)(SSQ + (size_t)row * 8), s1 = *(const f32x4*)(SSQ + (size_t)row * 8 + 4);
            const float rstd = __builtin_amdgcn_rsqf(((s0[0] + s0[1]) + (s0[2] + s0[3]) + (s1[0] + s1[1]) + (s1[2] + s1[3])) * (1.f / 384.f) + NEPS) * QS_M;
            const float* tb = tabM + (size_t)(row & (SEQ_LEN - 1)) * 32;
#pragma unroll
            for (int bj = 0; bj < 2; ++bj) { const int hl = bj ? hl1 : hl0; const bool rp = hl >= 64; const f32x4 id = {1.f, 0.f, 1.f, 0.f};
                const f32x4* tp = (const f32x4*)(tb + (rp ? hl - 64 : 0)); const f32x4 t0 = rp ? tp[0] : id, t1 = rp ? tp[1] : id;
                st8(QM + (size_t)row * 768 + c0 + bj * HALF, rope4(acc[ai][bj][m][0] * rstd, t0), rope4(acc[ai][bj][m][1] * rstd, t1)); EPI_FENCE(); }
            }
    }
};
struct EpiKVUp {
    static constexpr bool PERM = true, AFTER_DRAIN = false;
    const float* SSKV; bf16_t* KVM;
    __device__ __forceinline__ void operator()(const f32x4 (&acc)[2][2][4][2], const Unit& u, int wr, int wc, int fr, int fq) const {
        const int rbase = u.pm * BM + wr * 64 + fr, c0 = u.pn * BM + wc * 32 + fq * 8;
        EPI_LOOP_AM { const int row = rbase + ai * HALF + m * 16;
            const f32x4 s0 = *(const f32x4*)(SSKV + (size_t)row * 4);
            const float rstd = __builtin_amdgcn_rsqf(((s0[0] + s0[1]) + (s0[2] + s0[3])) * (1.f / 256.f) + NEPS);
#pragma unroll
            for (int bj = 0; bj < 2; ++bj) st8(KVM + (size_t)row * 1024 + c0 + bj * HALF, acc[ai][bj][m][0] * rstd, acc[ai][bj][m][1] * rstd);
            EPI_FENCE(); }
    }
};
struct EpiOutA {
    static constexpr bool PERM = true, AFTER_DRAIN = false;
    const bf16_t* SA; bf16_t* T;
    __device__ __forceinline__ void operator()(const f32x4 (&acc)[2][2][4][2], const Unit& u, int wr, int wc, int fr, int fq) const {
        const int rbase = u.pm * BM + wr * 64 + fr, c0 = u.pn * BM + wc * 32 + fq * 8;
#pragma unroll
        for (int ai = 0; ai < 2; ++ai) { u32x4 g[4][2];
#pragma unroll
            for (int m = 0; m < 4; ++m)
#pragma unroll
                for (int bj = 0; bj < 2; ++bj) g[m][bj] = *(const u32x4*)(SA + (size_t)(rbase + ai * HALF + m * 16) * 1024 + c0 + bj * HALF);
            EPI_FENCE();
#pragma unroll
            for (int m = 0; m < 4; ++m)
#pragma unroll
                for (int bj = 0; bj < 2; ++bj) { f32x4 g0, g1; up8(g[m][bj], g0, g1); st8(T + (size_t)(rbase + ai * HALF + m * 16) * 1024 + c0 + bj * HALF, acc[ai][bj][m][0] * g0, acc[ai][bj][m][1] * g1); }
            EPI_FENCE(); }
    }
};
struct EpiOutB {
    static constexpr bool PERM = true, AFTER_DRAIN = false;
    const bf16_t* SB; const bf16_t* T; bf16_t* MG;
    __device__ __forceinline__ void operator()(const f32x4 (&acc)[2][2][4][2], const Unit& u, int wr, int wc, int fr, int fq) const {
        const int rbase = u.pm * BM + wr * 64 + fr, c0 = u.pn * BM + wc * 32 + fq * 8;
#pragma unroll
        for (int ai = 0; ai < 2; ++ai) { u32x4 g[4][2], t[4][2];
#pragma unroll
            for (int m = 0; m < 4; ++m)
#pragma unroll
                for (int bj = 0; bj < 2; ++bj) { const size_t o = (size_t)(rbase + ai * HALF + m * 16) * 1024 + c0 + bj * HALF; g[m][bj] = *(const u32x4*)(SB + o); t[m][bj] = *(const u32x4*)(T + o); }
            EPI_FENCE();
#pragma unroll
            for (int m = 0; m < 4; ++m)
#pragma unroll
                for (int bj = 0; bj < 2; ++bj) { f32x4 g0, g1, t0, t1; up8(g[m][bj], g0, g1); up8(t[m][bj], t0, t1);
                    st8(MG + (size_t)(rbase + ai * HALF + m * 16) * 1024 + c0 + bj * HALF, t0 + acc[ai][bj][m][0] * g0, t1 + acc[ai][bj][m][1] * g1); }
            EPI_FENCE(); }
    }
};
template <bool RES_BF16> struct EpiResid {
    static constexpr bool PERM = true, AFTER_DRAIN = false;
    const void* res; bf16_t* xb; float* SS;
    __device__ __forceinline__ void operator()(const f32x4 (&acc)[2][2][4][2], const Unit& u, int wr, int wc, int fr, int fq) const {
        const int rbase = u.pm * BM + wr * 64 + fr, c0 = u.pn * BM + wc * 32 + fq * 8;
        if constexpr (RES_BF16) {
#pragma unroll
            for (int ai = 0; ai < 2; ++ai) { u32x4 r[4][2];
#pragma unroll
                for (int m = 0; m < 4; ++m)
#pragma unroll
                    for (int bj = 0; bj < 2; ++bj) r[m][bj] = *(const u32x4*)((const bf16_t*)res + (size_t)(rbase + ai * HALF + m * 16) * 1024 + c0 + bj * HALF);
                EPI_FENCE();
#pragma unroll
                for (int m = 0; m < 4; ++m) { const int row = rbase + ai * HALF + m * 16; float s = 0.f;
#pragma unroll
                    for (int bj = 0; bj < 2; ++bj) { f32x4 r0, r1; up8(r[m][bj], r0, r1); const f32x4 v0 = r0 + acc[ai][bj][m][0], v1 = r1 + acc[ai][bj][m][1];
                        st8(xb + (size_t)row * 1024 + c0 + bj * HALF, v0, v1); s += sq4(v0) + sq4(v1); }
                    s = quad_sum(s); if (fq == 0) SS[(size_t)row * 16 + u.pn * 4 + wc] = s; }
                EPI_FENCE(); }
        } else {
#pragma unroll
            for (int ai = 0; ai < 2; ++ai)
#pragma unroll
                for (int mp = 0; mp < 2; ++mp) { f32x4 r[2][2][2];
#pragma unroll
                    for (int mm = 0; mm < 2; ++mm)
#pragma unroll
                        for (int bj = 0; bj < 2; ++bj) { const float* p = (const float*)res + (size_t)(rbase + ai * HALF + (2 * mp + mm) * 16) * 1024 + c0 + bj * HALF; r[mm][bj][0] = *(const f32x4*)p; r[mm][bj][1] = *(const f32x4*)(p + 4); }
                    EPI_FENCE();
#pragma unroll
                    for (int mm = 0; mm < 2; ++mm) { const int m = 2 * mp + mm, row = rbase + ai * HALF + m * 16; float s = 0.f;
#pragma unroll
                        for (int bj = 0; bj < 2; ++bj) { const f32x4 v0 = r[mm][bj][0] + acc[ai][bj][m][0], v1 = r[mm][bj][1] + acc[ai][bj][m][1];
                            st8(xb + (size_t)row * 1024 + c0 + bj * HALF, v0, v1); s += sq4(v0) + sq4(v1); }
                        s = quad_sum(s); if (fq == 0) SS[(size_t)row * 16 + u.pn * 4 + wc] = s; }
                    EPI_FENCE(); }
        }
    }
};
__device__ __forceinline__ float rstd16(const float* ss) { const f32x4 a = *(const f32x4*)ss, b = *(const f32x4*)(ss + 4), c = *(const f32x4*)(ss + 8), d = *(const f32x4*)(ss + 12);
    const f32x4 t = (a + b) + (c + d); return __builtin_amdgcn_rsqf(((t[0] + t[1]) + (t[2] + t[3])) * (1.f / 1024.f) + NEPS); }
struct EpiSwiGLU {
    static constexpr bool PERM = true, AFTER_DRAIN = false;
    const float* SS; bf16_t* HID;
    __device__ __forceinline__ void operator()(const f32x4 (&acc)[2][2][4][2], const Unit& u, int wr, int wc, int fr, int fq) const {
        const int rbase = u.pm * BM + wr * 64 + fr, c0 = u.pn * HALF + wc * 32 + fq * 8;
        EPI_LOOP_AM { const int row = rbase + ai * HALF + m * 16; const float rstd = rstd16(SS + (size_t)row * 16);
            const f32x4 g0 = acc[ai][0][m][0] * rstd, g1 = acc[ai][0][m][1] * rstd, u0 = acc[ai][1][m][0] * rstd, u1 = acc[ai][1][m][1] * rstd;
            st8(HID + (size_t)row * 2816 + c0, g0 * sigm4(g0) * u0, g1 * sigm4(g1) * u1);
            EPI_FENCE(); }
    }
};
struct EpiPleA {
    static constexpr bool PERM = true, AFTER_DRAIN = false;
    bf16_t* T;
    __device__ __forceinline__ void operator()(const f32x4 (&acc)[2][2][4][2], const Unit& u, int wr, int wc, int fr, int fq) const {
        const int rbase = u.pm * BM + wr * 64 + fr, c0 = u.pn * BM + wc * 32 + fq * 8;
        EPI_LOOP_AM { const int row = rbase + ai * HALF + m * 16;
#pragma unroll
            for (int bj = 0; bj < 2; ++bj) st8(T + (size_t)row * 1024 + c0 + bj * HALF, acc[ai][bj][m][0], acc[ai][bj][m][1]); }
    }
};
struct EpiPleB {
    static constexpr bool PERM = true, AFTER_DRAIN = false;
    const float* SS2; const float* bias; const bf16_t* X2; const bf16_t* T2; bf16_t* X3; float* SS3;
    __device__ __forceinline__ void operator()(const f32x4 (&acc)[2][2][4][2], const Unit& u, int wr, int wc, int fr, int fq) const {
        const int rbase = u.pm * BM + wr * 64 + fr, c0 = u.pn * BM + wc * 32 + fq * 8;
#pragma unroll
        for (int ai = 0; ai < 2; ++ai)
#pragma unroll
          for (int mp = 0; mp < 2; ++mp) { u32x4 x[2][2], t[2][2]; float rs[2];
#pragma unroll
            for (int mm = 0; mm < 2; ++mm) { const int row = rbase + ai * HALF + (2 * mp + mm) * 16;
#pragma unroll
                for (int bj = 0; bj < 2; ++bj) { const size_t o = (size_t)row * 1024 + c0 + bj * HALF; x[mm][bj] = *(const u32x4*)(X2 + o); t[mm][bj] = *(const u32x4*)(T2 + o); }
                rs[mm] = rstd16(SS2 + (size_t)row * 16); }
            EPI_FENCE();
#pragma unroll
            for (int mm = 0; mm < 2; ++mm) { const int m = 2 * mp + mm, row = rbase + ai * HALF + m * 16; float s = 0.f;
#pragma unroll
                for (int bj = 0; bj < 2; ++bj) { const f32x4 b0 = *(const f32x4*)(bias + c0 + bj * HALF), b1 = *(const f32x4*)(bias + c0 + bj * HALF + 4);
                    f32x4 x0, x1, t0, t1; up8(x[mm][bj], x0, x1); up8(t[mm][bj], t0, t1);
                    const f32x4 v0 = x0 + t0 * sigm4(acc[ai][bj][m][0] * rs[mm] + b0), v1 = x1 + t1 * sigm4(acc[ai][bj][m][1] * rs[mm] + b1);
                    st8(X3 + (size_t)row * 1024 + c0 + bj * HALF, v0, v1); s += sq4(v0) + sq4(v1); }
                s = quad_sum(s); if (fq == 0) SS3[(size_t)row * 16 + u.pn * 4 + wc] = s; }
            EPI_FENCE(); }
    }
};
template <class Epi, class Sched, bool ALIGN_EPI = false, bool SP2 = false>
__device__ __forceinline__ void gemm_phase(PG8_LAS unsigned char* lds, const Gemm g, const Sched& S, const Epi& E) {
    int tid_ = threadIdx.x; asm volatile("" : "+v"(tid_)); const int tid = tid_, wid = __builtin_amdgcn_readfirstlane(tid >> 6), lane = tid & 63, wr = wid >> 2, wc = wid & 3, fr = lane & 15, fq = lane >> 4;
    const int K = g.K, nt = K / BK;
    unsigned voffA[2], voffB[2];
#pragma unroll
    for (int i = 0; i < 2; ++i) { int R, C; stage_rc(tid * 16 + i * 8192, R, C); const int Rb = Epi::PERM ? ((R & ~31) + perm32(R & 31)) : R;
        voffA[i] = (unsigned)(R * K + C) * 2u; voffB[i] = (unsigned)(Rb * K + C) * 2u; }
    const size_t kstep = (size_t)(BK * 2);
    const size_t hstep = (size_t)HALF * K * 2;
    const size_t tstep = 2 * hstep;
    const unsigned ldsw = (unsigned)wid * 1024u;
    const int aoff = lds_byte(wr * 64 + fr, fq * 8), boff = lds_byte(wc * 32 + fr, fq * 8);
#define PG8_SA(b, h) (((b) * 2 + (h)) * HTB)
#define PG8_SB(b, h) ((4 + (b) * 2 + (h)) * HTB)
#define PG8_STAGE(bufoff, gbase, voff) do { _Pragma("unroll") for (int _i = 0; _i < 2; ++_i) \
        __builtin_amdgcn_global_load_lds((const unsigned*)((const char*)(gbase) + (voff)[_i]), (PG8_LAS unsigned*)(lds + (bufoff) + ldsw + _i * 8192), 16, 0, 0); } while (0)
#define PG8_LDA(dst, b, h) do { _Pragma("unroll") for (int m = 0; m < 4; ++m) _Pragma("unroll") for (int k = 0; k < 2; ++k) dst[m][k] = *(const PG8_LAS bf16x8*)(lds + PG8_SA(b, h) + aoff + m * 2048 + k * 1024); } while (0)
#define PG8_LDB(dst, b, h) do { _Pragma("unroll") for (int n = 0; n < 2; ++n) _Pragma("unroll") for (int k = 0; k < 2; ++k) dst[n][k] = *(const PG8_LAS bf16x8*)(lds + PG8_SB(b, h) + boff + n * 2048 + k * 1024); } while (0)
#define PG8_MMA(ai, bj, At, Bt) do { __builtin_amdgcn_s_setprio(1); _Pragma("unroll") for (int m = 0; m < 4; ++m) _Pragma("unroll") for (int n = 0; n < 2; ++n) _Pragma("unroll") for (int k = 0; k < 2; ++k) \
        acc[ai][bj][m][n] = __builtin_amdgcn_mfma_f32_16x16x32_bf16(Bt[n][k], At[m][k], acc[ai][bj][m][n], 0, 0, 0); __builtin_amdgcn_s_setprio(0); } while (0)
#define PG8_WAIT_V(n) asm volatile("s_waitcnt vmcnt(" #n ")" ::: "memory")
#define PG8_WAIT_L(n) asm volatile("s_waitcnt lgkmcnt(" #n ")" ::: "memory")
#define PG8_BAR __builtin_amdgcn_s_barrier()
#define PG8_SCHED __builtin_amdgcn_sched_barrier(0)
    Unit cur, nxt; int ui = 0;
    if (!S.next(0, cur)) return;
    f32x4 acc[2][2][4][2];
#pragma unroll
    for (int a = 0; a < 2; ++a)
#pragma unroll
        for (int b = 0; b < 2; ++b)
#pragma unroll
            for (int m = 0; m < 4; ++m)
#pragma unroll
                for (int n = 0; n < 2; ++n) acc[a][b][m][n] = (f32x4){0.f, 0.f, 0.f, 0.f};
    bf16x8 At[4][2], B0[2][2], B1[2][2];
    const char* cA = (const char*)g.A + (size_t)cur.pm * tstep; const char* cB = (const char*)g.Bt + (size_t)cur.pn * tstep;
    S.a_ready(cur);
    if constexpr (SP2) {
        PG8_STAGE(PG8_SB(0, 0), cB, voffB); PG8_STAGE(PG8_SB(0, 1), cB + hstep, voffB); PG8_STAGE(PG8_SA(0, 0), cA, voffA); PG8_STAGE(PG8_SA(0, 1), cA + hstep, voffA);
        if (wr == 1) PG8_BAR;
        PG8_WAIT_V(2); PG8_BAR;
        PG8_STAGE(PG8_SB(1, 0), cB + kstep, voffB); PG8_STAGE(PG8_SA(1, 0), cA + kstep, voffA); PG8_STAGE(PG8_SB(1, 1), cB + hstep + kstep, voffB);
        PG8_WAIT_V(6); PG8_BAR;
    } else {
        PG8_STAGE(PG8_SB(0, 0), cB, voffB); PG8_STAGE(PG8_SA(0, 0), cA, voffA); PG8_STAGE(PG8_SB(0, 1), cB + hstep, voffB); PG8_STAGE(PG8_SA(0, 1), cA + hstep, voffA);
        if (wr == 1) PG8_BAR;
        PG8_WAIT_V(4); PG8_BAR;
        PG8_STAGE(PG8_SB(1, 0), cB + kstep, voffB); PG8_STAGE(PG8_SA(1, 0), cA + kstep, voffA); PG8_STAGE(PG8_SB(1, 1), cB + hstep + kstep, voffB);
        PG8_WAIT_V(6); PG8_BAR;
    }
    for (;;) {
        const bool has_next = S.next(ui + 1, nxt);
        const char* nA = has_next ? (const char*)g.A + (size_t)nxt.pm * tstep : cA; const char* nB = has_next ? (const char*)g.Bt + (size_t)nxt.pn * tstep : cB;
        for (int t = 0; t < nt; t += 2) {
            const bool last = (t == nt - 2);
            const char* a1 = cA + (size_t)(t + 1) * kstep;
            const char* a2 = last ? nA : cA + (size_t)(t + 2) * kstep; const char* b2 = last ? nB : cB + (size_t)(t + 2) * kstep;
            const char* a3 = a2 + kstep; const char* b3 = b2 + kstep;
            if (last && has_next) S.a_ready(nxt);
            if constexpr (SP2) {
            PG8_LDB(B0, 0, 0); PG8_LDB(B1, 0, 1); PG8_SCHED; PG8_LDA(At, 0, 0); PG8_STAGE(PG8_SA(1, 1), a1 + hstep, voffA);
            PG8_WAIT_V(8); PG8_WAIT_L(0); PG8_BAR; PG8_MMA(0, 0, At, B0); PG8_MMA(0, 1, At, B1); PG8_BAR; PG8_SCHED;
            PG8_LDA(At, 0, 1); PG8_STAGE(PG8_SB(0, 0), b2, voffB); PG8_STAGE(PG8_SB(0, 1), b2 + hstep, voffB); PG8_STAGE(PG8_SA(0, 0), a2, voffA);
            PG8_WAIT_V(8); PG8_WAIT_L(0); PG8_BAR; PG8_MMA(1, 0, At, B0); PG8_MMA(1, 1, At, B1); PG8_BAR; PG8_SCHED;
            PG8_LDB(B0, 1, 0); PG8_LDB(B1, 1, 1); PG8_SCHED; PG8_LDA(At, 1, 0); PG8_STAGE(PG8_SA(0, 1), a2 + hstep, voffA);
            PG8_WAIT_V(8); PG8_WAIT_L(0); PG8_BAR; PG8_MMA(0, 0, At, B0); PG8_MMA(0, 1, At, B1); PG8_BAR; PG8_SCHED;
            PG8_LDA(At, 1, 1); PG8_STAGE(PG8_SB(1, 0), b3, voffB); PG8_STAGE(PG8_SB(1, 1), b3 + hstep, voffB); PG8_STAGE(PG8_SA(1, 0), a3, voffA);
            PG8_WAIT_V(8); PG8_WAIT_L(0); PG8_BAR; PG8_MMA(1, 0, At, B0); PG8_MMA(1, 1, At, B1); PG8_BAR; PG8_SCHED;
            } else {
            PG8_LDB(B0, 0, 0); PG8_SCHED; PG8_LDA(At, 0, 0); PG8_STAGE(PG8_SA(1, 1), a1 + hstep, voffA);
            PG8_WAIT_L(8); PG8_BAR; PG8_WAIT_L(0); PG8_MMA(0, 0, At, B0); PG8_BAR; PG8_SCHED;
            PG8_LDB(B1, 0, 1); PG8_STAGE(PG8_SB(0, 0), b2, voffB);
            PG8_BAR; PG8_WAIT_L(0); PG8_MMA(0, 1, At, B1); PG8_BAR;
            PG8_LDA(At, 0, 1); PG8_STAGE(PG8_SA(0, 0), a2, voffA);
            PG8_BAR; PG8_WAIT_L(0); PG8_MMA(1, 0, At, B0); PG8_BAR; PG8_SCHED;
            PG8_STAGE(PG8_SB(0, 1), b2 + hstep, voffB);
            PG8_WAIT_V(6); PG8_BAR; PG8_MMA(1, 1, At, B1); PG8_BAR;
            PG8_LDB(B0, 1, 0); PG8_SCHED; PG8_LDA(At, 1, 0); PG8_STAGE(PG8_SA(0, 1), a2 + hstep, voffA);
            PG8_WAIT_L(8); PG8_BAR; PG8_WAIT_L(0); PG8_MMA(0, 0, At, B0); PG8_BAR; PG8_SCHED;
            PG8_LDB(B1, 1, 1); PG8_STAGE(PG8_SB(1, 0), b3, voffB);
            PG8_BAR; PG8_WAIT_L(0); PG8_MMA(0, 1, At, B1); PG8_BAR;
            PG8_LDA(At, 1, 1); PG8_STAGE(PG8_SA(1, 0), a3, voffA);
            PG8_BAR; PG8_WAIT_L(0); PG8_MMA(1, 0, At, B0); PG8_BAR; PG8_SCHED;
            PG8_STAGE(PG8_SB(1, 1), b3 + hstep, voffB);
            PG8_WAIT_V(6); PG8_BAR; PG8_MMA(1, 1, At, B1); PG8_BAR;
            }
        }
        if constexpr (ALIGN_EPI) { if (wr == 0) PG8_BAR; }
        if constexpr (!Epi::AFTER_DRAIN) { E(acc, cur, wr, wc, fr, fq); S.done(cur); }
        if (!has_next) break;
#pragma unroll
        for (int a = 0; a < 2; ++a)
#pragma unroll
            for (int b = 0; b < 2; ++b)
#pragma unroll
                for (int m = 0; m < 4; ++m)
#pragma unroll
                    for (int n = 0; n < 2; ++n) acc[a][b][m][n] = (f32x4){0.f, 0.f, 0.f, 0.f};
        cur = nxt; cA = nA; cB = nB; ++ui;
        if constexpr (ALIGN_EPI) { if (wr == 1) PG8_BAR; }
    }
    PG8_WAIT_V(0);
    if constexpr (!ALIGN_EPI) { if (wr == 0) PG8_BAR; }
    PG8_BAR;
    if constexpr (Epi::AFTER_DRAIN) { E.fused(acc, cur, wr, wc, fr, fq, lds, wid, lane); S.done(cur); }
#undef PG8_SA
#undef PG8_SB
#undef PG8_STAGE
#undef PG8_LDA
#undef PG8_LDB
#undef PG8_MMA
#undef PG8_WAIT_V
#undef PG8_WAIT_L
#undef PG8_BAR
#undef PG8_SCHED
}
}
namespace att {
#define ATT_LAS __attribute__((address_space(3)))
typedef unsigned short bf16_t;
typedef short bf16x8 __attribute__((ext_vector_type(8)));
typedef short s16x4 __attribute__((ext_vector_type(4)));
typedef float f32x16 __attribute__((ext_vector_type(16)));
typedef float f32x4 __attribute__((ext_vector_type(4)));
typedef unsigned u32x4 __attribute__((ext_vector_type(4)));
typedef unsigned u32x2 __attribute__((ext_vector_type(2)));
constexpr int KB0 = 0, KBSZ = 12288, VB0 = 24576, VBSZ = 16384;
__device__ __forceinline__ float swap_max(float m) { auto rr = __builtin_amdgcn_permlane32_swap(__float_as_uint(m), __float_as_uint(m), false, false); return fmaxf(__uint_as_float(rr[0]), __uint_as_float(rr[1])); }
__device__ __forceinline__ float swap_sum(float m) { auto rr = __builtin_amdgcn_permlane32_swap(__float_as_uint(m), __float_as_uint(m), false, false); return __uint_as_float(rr[0]) + __uint_as_float(rr[1]); }
__device__ __forceinline__ s16x4 vtr(const ATT_LAS char* p) { return __builtin_bit_cast(s16x4, __builtin_amdgcn_ds_read_tr16_b64_v4i16((ATT_LAS s16x4*)p)); }
__device__ __forceinline__ float max3f(float a, float b, float c) { float r; asm("v_max3_f32 %0, %1, %2, %3" : "=v"(r) : "v"(a), "v"(b), "v"(c)); return r; }
__device__ __forceinline__ float fadd_s(float a, float b) { float r; asm("v_add_f32_e32 %0, %1, %2" : "=v"(r) : "v"(a), "v"(b)); return r; }
__device__ __forceinline__ int crow(int r, int hi) { return (r & 3) + 8 * (r >> 2) + 4 * hi; }

template <int DQK, int DV, bool MLA>
__device__ __forceinline__ void attn_pass(ATT_LAS char* lds, const bf16_t* qp, const bf16_t* kg, const bf16_t* krg, const bf16_t* vg, int NT, int myNT, f32x16 (&o)[DV / 32], float& linv) {
    int tid_ = threadIdx.x; asm volatile("" : "+v"(tid_)); const int tid = tid_, lane = tid & 63, wid = __builtin_amdgcn_readfirstlane(tid >> 6), r32 = lane & 31, hi = lane >> 5;
    bf16x8 qr[DQK / 16];
#pragma unroll
    for (int d0 = 0; d0 < DQK / 16; ++d0) qr[d0] = *(const bf16x8*)(qp + d0 * 16);
    const bf16_t* ksrc = kg + (size_t)lane * 1024 + wid * 8;
    const bf16_t* krsrc = krg + (size_t)lane * 32 + (wid & 3) * 8;
    const bf16_t* vsrc = vg + (size_t)(16 * (wid & 3) + (lane >> 2)) * 1024 + (wid >> 2) * 32 + (lane & 3) * 8;
    const int sto = wid * 1024 + lane * 16;
    u32x4 kr0 = {0u, 0u, 0u, 0u}, kr1 = kr0, vr0 = kr0, vr1 = kr0;
#define ATT_LOAD(t) do { kr0 = *(const u32x4*)(ksrc + (size_t)(t) * 65536); if (MLA) { if (wid < 4) kr1 = *(const u32x4*)(krsrc + (size_t)(t) * 2048); } \
        vr0 = *(const u32x4*)(vsrc + (size_t)(t) * 65536); if (DV == 128) vr1 = *(const u32x4*)(vsrc + (size_t)(t) * 65536 + 64); } while (0)
#define ATT_STORE(b) do { *(ATT_LAS u32x4*)(lds + KB0 + (b) * KBSZ + sto) = kr0; if (MLA) { if (wid < 4) *(ATT_LAS u32x4*)(lds + KB0 + (b) * KBSZ + 8192 + sto) = kr1; } \
        *(ATT_LAS u32x4*)(lds + VB0 + (b) * VBSZ + sto) = vr0; if (DV == 128) *(ATT_LAS u32x4*)(lds + VB0 + (b) * VBSZ + 8192 + sto) = vr1; } while (0)
#pragma unroll
    for (int i = 0; i < DV / 32; ++i)
#pragma unroll
        for (int r = 0; r < 16; ++r) o[i][r] = 0.f;
    float mref = 0.f, lsum = 0.f;
    ATT_LOAD(0); ATT_STORE(0); __syncthreads();
    for (int t = 0; t < NT; ++t) {
        const int b = t & 1;
        if (t + 1 < NT) ATT_LOAD(t + 1);
        if (t < myNT) {
            const ATT_LAS char* kp = lds + KB0 + b * KBSZ + hi * 1024 + r32 * 16;
            f32x16 p0, p1;
#pragma unroll
            for (int r = 0; r < 16; ++r) { p0[r] = -mref; p1[r] = -mref; }
#pragma unroll
            for (int d0 = 0; d0 < DQK / 16; ++d0) {
                const bf16x8 k0 = *(const ATT_LAS bf16x8*)(kp + d0 * 2048), k1 = *(const ATT_LAS bf16x8*)(kp + d0 * 2048 + 512);
                p0 = __builtin_amdgcn_mfma_f32_32x32x16_bf16(k0, qr[d0], p0, 0, 0, 0);
                p1 = __builtin_amdgcn_mfma_f32_32x32x16_bf16(k1, qr[d0], p1, 0, 0, 0);
            }
            asm volatile("s_nop 15\n\ts_nop 7" : "+v"(p0), "+v"(p1));
            float mxa = max3f(p0[0], p0[1], p1[0]), mxb = max3f(p0[2], p0[3], p1[1]); mxa = max3f(mxa, p1[2], p1[3]);
#pragma unroll
            for (int r = 4; r < 16; r += 4) { mxa = max3f(mxa, p0[r], p0[r + 1]); mxb = max3f(mxb, p0[r + 2], p0[r + 3]); mxa = max3f(mxa, p1[r], p1[r + 1]); mxb = max3f(mxb, p1[r + 2], p1[r + 3]); }
            float mx = swap_max(max3f(mxa, mxb, mxb));
            if (__any(mx > 8.f)) {
                const float dl = fmaxf(mx, 0.f), al = __builtin_amdgcn_exp2f(-dl);
                lsum *= al;
#pragma unroll
                for (int i = 0; i < DV / 32; ++i)
#pragma unroll
                    for (int r = 0; r < 16; ++r) o[i][r] *= al;
#pragma unroll
                for (int r = 0; r < 16; ++r) { p0[r] -= dl; p1[r] -= dl; }
                mref += dl;
            }
            float ls = 0.f;
#pragma unroll
            for (int r = 0; r < 16; ++r) { p0[r] = __builtin_amdgcn_exp2f(p0[r]); p1[r] = __builtin_amdgcn_exp2f(p1[r]); ls += p0[r] + p1[r]; }
            lsum += ls;
            u32x4 pw[4];
#pragma unroll
            for (int j = 0; j < 4; ++j) { pw[0][j] = pg8::pk2(p0[2 * j], p0[2 * j + 1]); pw[1][j] = pg8::pk2(p0[8 + 2 * j], p0[9 + 2 * j]); pw[2][j] = pg8::pk2(p1[2 * j], p1[2 * j + 1]); pw[3][j] = pg8::pk2(p1[8 + 2 * j], p1[9 + 2 * j]); }
            const ATT_LAS char* vp = lds + VB0 + b * VBSZ + ((lane >> 4) & 1) * 32 + (lane & 3) * 8 + (4 * hi + ((lane & 15) >> 2)) * 64;
#pragma unroll
            for (int i = 0; i < DV / 32; ++i)
#pragma unroll
                for (int ks = 0; ks < 4; ++ks) {
                    const s16x4 lo = vtr(vp + i * 4096 + ks * 1024), hh = vtr(vp + i * 4096 + ks * 1024 + 512);
                    const bf16x8 vf = {lo[0], lo[1], lo[2], lo[3], hh[0], hh[1], hh[2], hh[3]};
                    o[i] = __builtin_amdgcn_mfma_f32_32x32x16_bf16(vf, __builtin_bit_cast(bf16x8, pw[ks]), o[i], 0, 0, 0);
                }
        }
        if (t + 1 < NT) ATT_STORE(b ^ 1);
        __syncthreads();
    }
    linv = __builtin_amdgcn_rcpf(swap_sum(lsum));
#undef ATT_LOAD
#undef ATT_STORE
}

__device__ __forceinline__ void diff_unit(ATT_LAS char* lds, int b, int h, int qb, const bf16_t* QD, const bf16_t* KD, const bf16_t* VD, bf16_t* OD, const float* subln, float lam) {
    int tid_ = threadIdx.x; asm volatile("" : "+v"(tid_)); const int tid = tid_, lane = tid & 63, wid = __builtin_amdgcn_readfirstlane(tid >> 6), r32 = lane & 31, hi = lane >> 5;
    const size_t row0 = (size_t)b * SEQ_LEN, qrow = row0 + qb * 256 + wid * 32 + r32;
    const int NT = 4 * qb + 4, myNT = 4 * qb + (wid >> 1) + 1;
    f32x16 o1[4], o2[4]; float li1, li2;
    attn_pass<64, 128, false>(lds, QD + qrow * 1024 + (2 * h) * 64 + hi * 8, KD + row0 * 1024 + (2 * h) * 64, nullptr, VD + row0 * 1024 + h * 128, NT, myNT, o1, li1);
    attn_pass<64, 128, false>(lds, QD + qrow * 1024 + (2 * h + 1) * 64 + hi * 8, KD + row0 * 1024 + (2 * h + 1) * 64, nullptr, VD + row0 * 1024 + h * 128, NT, myNT, o2, li2);
    const float c2 = lam * li2; float ss = 0.f;
#pragma unroll
    for (int i = 0; i < 4; ++i)
#pragma unroll
        for (int r = 0; r < 16; ++r) { const float v = o1[i][r] * li1 - o2[i][r] * c2; o1[i][r] = v; ss += v * v; }
    ss = swap_sum(ss);
    const float rstd = __builtin_amdgcn_rsqf(ss * (1.f / 128.f) + NEPS) * 0.8f;
    bf16_t* op = OD + qrow * 1024 + h * 128 + 4 * hi;
#pragma unroll
    for (int i = 0; i < 4; ++i)
#pragma unroll
        for (int rq = 0; rq < 4; ++rq) { const int dv = 32 * i + 8 * rq; const f32x4 g = *(const f32x4*)(subln + dv + 4 * hi);
            u32x2 w; w.x = pg8::pk2(o1[i][4 * rq] * rstd * g[0], o1[i][4 * rq + 1] * rstd * g[1]); w.y = pg8::pk2(o1[i][4 * rq + 2] * rstd * g[2], o1[i][4 * rq + 3] * rstd * g[3]);
            *(u32x2*)(op + dv) = w; }
}
__device__ __forceinline__ void mla_unit(ATT_LAS char* lds, int b, int h, int qb, const bf16_t* QM, const bf16_t* KVM, const bf16_t* KR, bf16_t* OM) {
    int tid_ = threadIdx.x; asm volatile("" : "+v"(tid_)); const int tid = tid_, lane = tid & 63, wid = __builtin_amdgcn_readfirstlane(tid >> 6), r32 = lane & 31, hi = lane >> 5;
    const size_t row0 = (size_t)b * SEQ_LEN, qrow = row0 + qb * 256 + wid * 32 + r32;
    const int NT = 4 * qb + 4, myNT = 4 * qb + (wid >> 1) + 1;
    f32x16 o[2]; float li;
    attn_pass<96, 64, true>(lds, QM + qrow * 768 + h * 96 + hi * 8, KVM + row0 * 1024 + h * 128, KR + row0 * 32, KVM + row0 * 1024 + h * 128 + 64, NT, myNT, o, li);
    bf16_t* op = OM + qrow * 512 + h * 64 + 4 * hi;
#pragma unroll
    for (int i = 0; i < 2; ++i)
#pragma unroll
        for (int rq = 0; rq < 4; ++rq) { const int dv = 32 * i + 8 * rq;
            u32x2 w; w.x = pg8::pk2(o[i][4 * rq] * li, o[i][4 * rq + 1] * li); w.y = pg8::pk2(o[i][4 * rq + 2] * li, o[i][4 * rq + 3] * li);
            *(u32x2*)(op + dv) = w; }
}
}
#define LAS __attribute__((address_space(3)))
typedef unsigned short bf16;
typedef float f32x4 __attribute__((ext_vector_type(4)));
typedef unsigned v4u __attribute__((ext_vector_type(4)));
typedef unsigned v2u __attribute__((ext_vector_type(2)));
constexpr int NWAVES = 8, LDS_BYTES = 147456;
constexpr size_t MiB = 1ull << 20;
constexpr size_t WS_TABD = 0, WS_TABM = 128 * 1024, WS_LAM = 384 * 1024, WS_BAR = 512 * 1024;
constexpr size_t WS_SSQ = 1 * MiB, WS_SSKV = 2 * MiB, WS_SS1 = 3 * MiB, WS_SS2 = 5 * MiB, WS_SS3 = 7 * MiB;
constexpr size_t WS_WIN = 10 * MiB, WS_WGU = WS_WIN + 5888ull * 1024 * 2, WS_WDN = WS_WGU + 5632ull * 1024 * 2, WS_WOD = WS_WDN + 1024ull * 2816 * 2, WS_WOUT = WS_WOD + 2 * MiB,
                 WS_WPG = WS_WOUT + 2 * MiB, WS_WOM = WS_WPG + 2 * MiB, WS_WUQ = WS_WOM + 1 * MiB, WS_WUKV = WS_WUQ + 768ull * 384 * 2, WS_WPLE = WS_WUKV + 1024ull * 256 * 2, WS_WEND = WS_WPLE + 1024ull * 256 * 2;
static_assert(WS_WEND <= 47 * MiB, "weights");
constexpr size_t WS_PB = 47 * MiB;
constexpr size_t WS_XN = 64 * MiB, WS_QM = 64 * MiB, WS_X1B = 64 * MiB;
constexpr size_t WS_QD = 128 * MiB, WS_KD = 192 * MiB, WS_VD = 256 * MiB, WS_KVM = 320 * MiB;
constexpr size_t WS_T = 192 * MiB, WS_MG = 320 * MiB;
constexpr size_t WS_HID = 128 * MiB, WS_X2B = 304 * MiB;
constexpr size_t WS_X3B = 384 * MiB, WS_T2B = 448 * MiB;
constexpr size_t WS_CKV = 384 * MiB, WS_CQ = 400 * MiB, WS_KR = 424 * MiB, WS_OM = 426 * MiB;
constexpr size_t WS_END = 512 * MiB;

#define XB_TMO      128
#define XB_XCNT(j)  (256  + 64 * (j))
#define XB_XSUB(j)  (1280 + 64 * (j))
#define XB_XGEN(j)  (2304 + 64 * (j))
#define XB_TOP      3328
#define XB_TOPGEN   3392
#define XCD_BAR_WORDS 3456
#define XB_SPIN_CAP (1u << 18)

__device__ __forceinline__ unsigned xb_ld(unsigned* p)              { return __hip_atomic_load(p, __ATOMIC_RELAXED, __HIP_MEMORY_SCOPE_AGENT); }
__device__ __forceinline__ unsigned xb_add(unsigned* p, unsigned v) { return __hip_atomic_fetch_add(p, v, __ATOMIC_RELAXED, __HIP_MEMORY_SCOPE_AGENT); }
__device__ __forceinline__ unsigned xb_xcc_id() { return (unsigned)__builtin_amdgcn_s_getreg((3 << 11) | 20) & 0xFu; }
#define XB_SPIN(cond, bar) do { unsigned _sp = 0; while (cond) { __builtin_amdgcn_s_sleep(1); \
    if ((++_sp & 255u) == 0u) { if (xb_ld(&(bar)[XB_TMO])) break; if (_sp > XB_SPIN_CAP) { atomicAdd(&(bar)[XB_TMO], 1u); break; } } } } while (0)

struct XcdBarrier {
    unsigned* bar; unsigned x;
    volatile LAS unsigned* st;
};

__device__ __forceinline__ XcdBarrier xcd_barrier_post(unsigned* bar, volatile LAS unsigned* st) {
    XcdBarrier b; b.bar = bar; b.x = xb_xcc_id(); b.st = st;
    if (threadIdx.x == 0) (void)xb_add(&bar[XB_XCNT(b.x)], 1u);
    return b;
}
__device__ __forceinline__ void xcd_barrier_complete(unsigned* bar, unsigned x, unsigned& nloc, unsigned& nx) {
    const unsigned G = gridDim.x * gridDim.y * gridDim.z;
    unsigned sum, cnt, mine, sp = 0u;
    for (;;) {
        sum = 0u; cnt = 0u; mine = 0u;
#pragma unroll
        for (unsigned j = 0; j < 16; ++j) { const unsigned c = xb_ld(&bar[XB_XCNT(j)]); sum += c; cnt += (c > 0u) ? 1u : 0u; mine = (j == x) ? c : mine; }
        if (sum == G) break;
        __builtin_amdgcn_s_sleep(1);
        if ((++sp & 255u) == 0u) { if (xb_ld(&bar[XB_TMO])) break; if (sp > XB_SPIN_CAP) { atomicAdd(&bar[XB_TMO], 1u); break; } }
    }
    nloc = mine > 0u ? mine : 1u; nx = cnt > 0u ? cnt : 1u;
}

__device__ __forceinline__ void xcd_barrier(const XcdBarrier& b) {
    asm volatile("s_waitcnt vmcnt(0)" ::: "memory");
    __syncthreads();
    if (threadIdx.x == 0) {
        unsigned* bar = b.bar;
        __builtin_amdgcn_s_waitcnt(0);
        unsigned nloc = b.st[0], nx = b.st[1];
        if (nloc == 0u) { xcd_barrier_complete(bar, b.x, nloc, nx); b.st[0] = nloc; b.st[1] = nx; }
        const unsigned old = xb_add(&bar[XB_XSUB(b.x)], 1u);
        const unsigned gen = old / nloc;
        if (old + 1u == (gen + 1u) * nloc) {
            __builtin_amdgcn_fence(__ATOMIC_RELEASE, "agent");
            asm volatile("s_waitcnt vmcnt(0)" ::: "memory");
            const unsigned og = xb_add(&bar[XB_TOP], 1u);
            const unsigned tg = og / nx;
            if (og + 1u == (tg + 1u) * nx) xb_add(&bar[XB_TOPGEN], 1u);
            else XB_SPIN(xb_ld(&bar[XB_TOPGEN]) == tg, bar);
            __builtin_amdgcn_fence(__ATOMIC_ACQUIRE, "agent");
            xb_add(&bar[XB_XGEN(b.x)], 1u);
            asm volatile("s_waitcnt vmcnt(0)" ::: "memory");
        } else {
            XB_SPIN(xb_ld(&bar[XB_XGEN(b.x)]) == gen, bar);
            __builtin_amdgcn_fence(__ATOMIC_ACQUIRE, "agent");
            asm volatile("s_waitcnt vmcnt(0)" ::: "memory");
        }
    }
    __syncthreads();
}

struct Args {
    const float *x, *p, *attn_norm, *w_in, *b_gate, *lam_q1, *lam_k1, *lam_q2, *lam_k2, *diff_subln, *w_o_diff, *q_norm, *w_uq, *kv_norm, *w_ukv, *w_o_mla, *w_out, *ffn_norm,
        *w_ffn_gate, *w_ffn_up, *w_ffn_down, *ple_norm, *w_ple_gate, *b_ple_gate, *w_ple, *final_norm;
    float* out; unsigned char* ws;
};

__device__ __forceinline__ float wave_sum(float v) {
#pragma unroll
    for (int o = 1; o < 64; o <<= 1) v += __shfl_xor(v, o);
    return v;
}
__device__ __forceinline__ void wprep_item(int kind, const float* W, const float* W2, int ld, int K, int Nout, const float* gain, bf16* WT, int item, LAS float* scr, int lane) {
    const int nnb = Nout / 64, kb = item / nnb, nb = item % nnb, k0 = kb * 64, n0 = nb * 64, n = n0 + lane;
    const float* base = W; int col = n;
    if (kind == 1) {
        if (n < 2048) { const int hl = n & 63; col = (n & ~63) + (hl < 16 ? ((hl & 1) ? (hl >> 1) + 8 : (hl >> 1)) : hl); }
        else if (n < 3072) col = n;
        else if (n < 5120) col = 3744 + (n - 3072);
        else if (n < 5376) col = 3456 + (n - 5120);
        else if (n < 5760) col = 3072 + (n - 5376);
        else if (n < 5792) { const int hl = n - 5760; col = 3712 + ((hl & 1) ? (hl >> 1) + 16 : (hl >> 1)); }
        else col = -1;
    } else if (kind == 2) { const int h = n / 96, hl = n % 96; int s = hl; if (hl >= 64) { const int r = hl - 64; s = 64 + ((r & 1) ? (r >> 1) + 16 : (r >> 1)); } col = h * 96 + s;
    } else if (kind == 3) { const int pn = n >> 8, r = n & 255; if (r < 128) col = pn * 128 + r; else { base = W2; col = pn * 128 + (r - 128); } }
#pragma unroll 32
    for (int kk = 0; kk < 64; ++kk) { float v = (col >= 0) ? base[(size_t)(k0 + kk) * ld + col] : 0.f; if (gain) v *= gain[k0 + kk]; scr[kk * 65 + lane] = v; }
    asm volatile("s_waitcnt lgkmcnt(0)" ::: "memory");
    const int c = lane & 7;
#pragma unroll
    for (int j = 0; j < 8; ++j) { const int nn = (lane >> 3) + 8 * j; const LAS float* s = scr + (8 * c) * 65 + nn;
        v4u o; o.x = pg8::pk2(s[0], s[65]); o.y = pg8::pk2(s[2 * 65], s[3 * 65]); o.z = pg8::pk2(s[4 * 65], s[5 * 65]); o.w = pg8::pk2(s[6 * 65], s[7 * 65]);
        *(v4u*)(WT + (size_t)(n0 + nn) * K + k0 + 8 * c) = o; }
    asm volatile("s_waitcnt lgkmcnt(0)" ::: "memory");
}


#define WSP(T, off) ((T*)(a.ws + (off)))
#define tabD WSP(float, WS_TABD)
#define tabM WSP(float, WS_TABM)
#define lamp WSP(float, WS_LAM)
#define SSQ WSP(float, WS_SSQ)
#define SSKV WSP(float, WS_SSKV)
#define SS1 WSP(float, WS_SS1)
#define SS2 WSP(float, WS_SS2)
#define SS3 WSP(float, WS_SS3)
#define Win WSP(bf16, WS_WIN)
#define Wgu WSP(bf16, WS_WGU)
#define Wdn WSP(bf16, WS_WDN)
#define Wod WSP(bf16, WS_WOD)
#define Wout WSP(bf16, WS_WOUT)
#define Wpg WSP(bf16, WS_WPG)
#define Wom WSP(bf16, WS_WOM)
#define Wuq WSP(bf16, WS_WUQ)
#define Wukv WSP(bf16, WS_WUKV)
#define Wple WSP(bf16, WS_WPLE)
#define PB WSP(bf16, WS_PB)
#define XN WSP(bf16, WS_XN)
#define QM WSP(bf16, WS_QM)
#define X1B WSP(bf16, WS_X1B)
#define QD WSP(bf16, WS_QD)
#define KD WSP(bf16, WS_KD)
#define VD WSP(bf16, WS_VD)
#define KVM WSP(bf16, WS_KVM)
#define MG WSP(bf16, WS_MG)
#define HID WSP(bf16, WS_HID)
#define X2B WSP(bf16, WS_X2B)
#define CKV WSP(bf16, WS_CKV)
#define CQ WSP(bf16, WS_CQ)
#define KR WSP(bf16, WS_KR)
#define OM WSP(bf16, WS_OM)
#define TBUF WSP(bf16, WS_T)
#define X3B WSP(bf16, WS_X3B)
#define T2B WSP(bf16, WS_T2B)
#define SA ((bf16*)a.out)
#define SB ((bf16*)a.out + (size_t)M_TOK * 1024)
template <class E> __device__ __forceinline__ void run_gemm(LAS unsigned char* lds, const bf16* A, const bf16* Bt, int N, int K, const E& e) {
    asm volatile("" : "+s"(K));
    pg8::Gemm g{A, Bt, M_TOK, N, K}; pg8::StaticOrder S; S.init(M_TOK, N, (int)gridDim.x, (int)blockIdx.x);
    pg8::gemm_phase<E, pg8::StaticOrder, true, true>(lds, g, S, e);
}

__global__ void __launch_bounds__(NWAVES * 64, 2) fwd_megakernel(Args a) {
    extern __shared__ __attribute__((aligned(16))) unsigned char lds_raw[];
    cg::grid_group grid = cg::this_grid();
    LAS unsigned char* lds = (LAS unsigned char*)lds_raw;
    int tid0_ = threadIdx.x; asm volatile("" : "+v"(tid0_)); const int tid = tid0_, lane = tid & 63, wave = __builtin_amdgcn_readfirstlane(tid >> 6);
    const int G = gridDim.x, gw = blockIdx.x * NWAVES + wave, NGW = G * NWAVES;
    volatile LAS unsigned* bst = (volatile LAS unsigned*)(lds + (LDS_BYTES - 64));
    if (tid < 2) bst[tid] = 0u;
    __syncthreads();
    const XcdBarrier xbar = xcd_barrier_post((unsigned*)(a.ws + WS_BAR), bst);
#if !defined(SKIP_P0)
    {
        LAS float* scr = (LAS float*)(lds + wave * 16640);
        constexpr int I0 = 16 * 92, I1 = I0 + 16 * 88, I2 = I1 + 44 * 16, I3 = I2 + 256, I4 = I3 + 256, I5 = I4 + 256, I6 = I5 + 128, I7 = I6 + 72, I8 = I7 + 64, I9 = I8 + 64;
        for (int it = gw; it < I9; it += NGW) {
            if (it < I0)      wprep_item(1, a.w_in, nullptr, 5792, 1024, 5888, nullptr, Win, it, scr, lane);
            else if (it < I1) wprep_item(3, a.w_ffn_gate, a.w_ffn_up, 2816, 1024, 5632, a.ffn_norm, Wgu, it - I0, scr, lane);
            else if (it < I2) wprep_item(0, a.w_ffn_down, nullptr, 1024, 2816, 1024, nullptr, Wdn, it - I1, scr, lane);
            else if (it < I3) wprep_item(0, a.w_o_diff, nullptr, 1024, 1024, 1024, nullptr, Wod, it - I2, scr, lane);
            else if (it < I4) wprep_item(0, a.w_out, nullptr, 1024, 1024, 1024, nullptr, Wout, it - I3, scr, lane);
            else if (it < I5) wprep_item(0, a.w_ple_gate, nullptr, 1024, 1024, 1024, a.ple_norm, Wpg, it - I4, scr, lane);
            else if (it < I6) wprep_item(0, a.w_o_mla, nullptr, 1024, 512, 1024, nullptr, Wom, it - I5, scr, lane);
            else if (it < I7) wprep_item(2, a.w_uq, nullptr, 768, 384, 768, a.q_norm, Wuq, it - I6, scr, lane);
            else if (it < I8) wprep_item(0, a.w_ukv, nullptr, 1024, 256, 1024, a.kv_norm, Wukv, it - I7, scr, lane);
            else              wprep_item(0, a.w_ple, nullptr, 1024, 256, 1024, nullptr, Wple, it - I8, scr, lane);
        }
        for (int r0 = gw * 4; r0 < M_TOK; r0 += NGW * 4) {
            f32x4 v[4][4]; float s[4];
#pragma unroll
            for (int q = 0; q < 4; ++q) { const f32x4* xr = (const f32x4*)(a.x + (size_t)(r0 + q) * 1024) + lane; s[q] = 0.f;
#pragma unroll
                for (int j = 0; j < 4; ++j) v[q][j] = xr[64 * j]; }
#pragma unroll
            for (int q = 0; q < 4; ++q) {
#pragma unroll
                for (int j = 0; j < 4; ++j) s[q] += pg8::sq4(v[q][j]);
                const float rstd = __builtin_amdgcn_rsqf(wave_sum(s[q]) * (1.f / 1024.f) + NEPS);
                v2u* o8 = (v2u*)(XN + (size_t)(r0 + q) * 1024) + lane;
#pragma unroll
                for (int j = 0; j < 4; ++j) { const f32x4 g = ((const f32x4*)a.attn_norm)[lane + 64 * j]; const f32x4 y = v[q][j] * rstd * g; v2u w; w.x = pg8::pk2(y[0], y[1]); w.y = pg8::pk2(y[2], y[3]); o8[64 * j] = w; } }
        }
        { const int gt = blockIdx.x * 512 + tid, GT = G * 512;
          for (int i = gt; i < M_TOK * 256 / 8; i += GT) { const f32x4 p0 = ((const f32x4*)a.p)[2 * i], p1 = ((const f32x4*)a.p)[2 * i + 1]; pg8::st8(PB + (size_t)i * 8, p0, p1); }
          for (int i = gt; i < 2048 * 24; i += GT) {
              const int pos = i / 24, f = i % 24; const bool dm = f < 8; const int fi = dm ? f : f - 8;
              const float invf = dm ? __builtin_amdgcn_exp2f(-18.931568569324174f * (float)fi * 0.125f) : __builtin_amdgcn_exp2f(-13.287712379549449f * (float)fi * 0.0625f);
              const float ang = (float)pos * invf; const double rev = (double)ang * 0.15915494309189535; const float fr = (float)(rev - floor(rev));
              const float cs = __builtin_amdgcn_cosf(fr), sn = __builtin_amdgcn_sinf(fr);
              float* dst = dm ? tabD + ((size_t)pos * 8 + fi) * 2 : tabM + ((size_t)pos * 16 + fi) * 2; dst[0] = cs; dst[1] = sn;
          }
          if (blockIdx.x == 0 && wave == 0) { const float s1 = wave_sum(a.lam_q1[lane] * a.lam_k1[lane]), s2 = wave_sum(a.lam_q2[lane] * a.lam_k2[lane]); if (lane == 0) lamp[0] = __expf(s1) - __expf(s2) + 0.2f; }
        }
    }
    xcd_barrier(xbar);
    if (a.ws == nullptr) grid.sync();
    #endif

#if !defined(SKIP_P1)
    { pg8::EpiInProj e{QD, KD, VD, SA, SB, CKV, CQ, KR, SSQ, SSKV, a.b_gate, tabD, tabM}; run_gemm(lds, XN, Win, 5888, 1024, e); }
    xcd_barrier(xbar);
    #endif

#if !defined(SKIP_P2)
    { pg8::EpiQUp e{SSQ, tabM, QM}; run_gemm(lds, CQ, Wuq, 768, 384, e); }
    { pg8::EpiKVUp e{SSKV, KVM}; run_gemm(lds, CKV, Wukv, 1024, 256, e); }
    xcd_barrier(xbar);
    #endif

#if !defined(SKIP_P3)
    {
        const float lam = lamp[0];
        for (int i = blockIdx.x; i < 2048; i += G) {
            const int type = i >> 10, rem = i & 1023, j = rem >> 8, half = (rem >> 7) & 1, bh = rem & 127;
            const int qb = half ? (j == 0 ? 6 : j == 1 ? 4 : j == 2 ? 3 : 1) : (j == 0 ? 7 : j == 1 ? 5 : j == 2 ? 2 : 0);
            if (type == 0) att::diff_unit((ATT_LAS char*)lds, bh >> 3, bh & 7, qb, QD, KD, VD, QD, a.diff_subln, lam);
            else           att::mla_unit((ATT_LAS char*)lds, bh >> 3, bh & 7, qb, QM, KVM, KR, OM);
        }
    }
    xcd_barrier(xbar);
    #endif

#if !defined(SKIP_P4)
    { pg8::EpiOutA e{SA, TBUF}; run_gemm(lds, QD, Wod, 1024, 1024, e); }
    { pg8::EpiOutB e{SB, TBUF, MG}; run_gemm(lds, OM, Wom, 1024, 512, e); }
    xcd_barrier(xbar);
    #endif

#if !defined(SKIP_P5)
    { pg8::EpiResid<false> e{a.x, X1B, SS1}; run_gemm(lds, MG, Wout, 1024, 1024, e); }
    xcd_barrier(xbar);
    #endif

#if !defined(SKIP_P6)
    { pg8::EpiSwiGLU e{SS1, HID}; run_gemm(lds, X1B, Wgu, 5632, 1024, e); }
    xcd_barrier(xbar);
    #endif

#if !defined(SKIP_P7)
    { pg8::EpiResid<true> e{X1B, X2B, SS2}; run_gemm(lds, HID, Wdn, 1024, 2816, e); }
    xcd_barrier(xbar);
    #endif

#if !defined(SKIP_P8)
    { pg8::EpiPleA e{T2B}; run_gemm(lds, PB, Wple, 1024, 256, e); }
    { pg8::EpiPleB e{SS2, a.b_ple_gate, X2B, T2B, X3B, SS3}; run_gemm(lds, X2B, Wpg, 1024, 1024, e); }
    xcd_barrier(xbar);
    #endif

#if !defined(SKIP_P9)
    { int t9_ = threadIdx.x; asm volatile("" : "+v"(t9_)); const int lane = t9_ & 63, gw = blockIdx.x * NWAVES + __builtin_amdgcn_readfirstlane(t9_ >> 6), NGW = gridDim.x * NWAVES;
    for (int r0 = gw * 4; r0 < M_TOK; r0 += NGW * 4) {
        v4u w[4][2]; float s[4];
#pragma unroll
        for (int q = 0; q < 4; ++q) { const v4u* xr = (const v4u*)(X3B + (size_t)(r0 + q) * 1024) + lane; w[q][0] = xr[0]; w[q][1] = xr[64]; s[q] = (lane < 16) ? SS3[(size_t)(r0 + q) * 16 + lane] : 0.f; }
#pragma unroll
        for (int q = 0; q < 4; ++q) { const float rstd = __builtin_amdgcn_rsqf(wave_sum(s[q]) * (1.f / 1024.f) + NEPS);
#pragma unroll
            for (int j = 0; j < 2; ++j) { const int c = (lane + 64 * j) * 8; const f32x4 g0 = *(const f32x4*)(a.final_norm + c), g1 = *(const f32x4*)(a.final_norm + c + 4); const v4u ww = w[q][j];
                f32x4 x0, x1; x0[0] = __uint_as_float(ww.x << 16); x0[1] = __uint_as_float(ww.x & 0xffff0000u); x0[2] = __uint_as_float(ww.y << 16); x0[3] = __uint_as_float(ww.y & 0xffff0000u);
                x1[0] = __uint_as_float(ww.z << 16); x1[1] = __uint_as_float(ww.z & 0xffff0000u); x1[2] = __uint_as_float(ww.w << 16); x1[3] = __uint_as_float(ww.w & 0xffff0000u);
                float* o = a.out + (size_t)(r0 + q) * 1024 + c; *(f32x4*)o = x0 * rstd * g0; *(f32x4*)(o + 4) = x1 * rstd * g1; } }
    } }
#endif
}

extern "C" void kernel_launch(void* const* d_in, const int* in_sizes, int n_in, void* d_out, int out_size, void* d_ws, size_t ws_size, hipStream_t stream) {
    static int grid = 0;
    if (grid == 0) {
        if (n_in != 26 || out_size != M_TOK * 1024 || ws_size < WS_END) { fprintf(stderr, "kernel_launch: unexpected shapes (n_in %d out %d ws %zu)\n", n_in, out_size, ws_size); grid = -1; return; }
        int dev = 0, cus = 0, per_cu = 0;
        (void)hipGetDevice(&dev); (void)hipDeviceGetAttribute(&cus, hipDeviceAttributeMultiprocessorCount, dev);
        (void)hipFuncSetAttribute((const void*)fwd_megakernel, hipFuncAttributeMaxDynamicSharedMemorySize, LDS_BYTES);
        if (hipOccupancyMaxActiveBlocksPerMultiprocessor(&per_cu, (const void*)fwd_megakernel, NWAVES * 64, LDS_BYTES) != hipSuccess || per_cu < 1) per_cu = 1;
        (void)hipGetLastError();
        grid = cus * per_cu;
    }
    if (grid < 0) return;
    Args a{};
    const float** f = (const float**)&a;
    for (int i = 0; i < 26; ++i) f[i] = (const float*)d_in[i];
    a.out = (float*)d_out; a.ws = (unsigned char*)d_ws;
    (void)hipMemsetAsync((char*)d_ws + WS_BAR, 0, 16384, stream);
    void* args[] = {&a};
    hipError_t e = hipLaunchCooperativeKernel((const void*)fwd_megakernel, dim3(grid), dim3(NWAVES * 64), args, LDS_BYTES, stream);
    if (e != hipSuccess) fprintf(stderr, "cooperative launch failed: %s (grid %d)\n", hipGetErrorString(e), grid);
}
```

```cpp
#include <hip/hip_runtime.h>
#include <hip/hip_cooperative_groups.h>
#include <cstdio>
#include <cstdint>
namespace cg = cooperative_groups;

constexpr int M_TOK = 32768, SEQ_LEN = 2048;
constexpr float NEPS = 1e-6f;
constexpr float LOG2E_F = 1.4426950408889634f;
constexpr float QS_D = 0.125f * LOG2E_F;
constexpr float QS_M = 0.10206207261596575f * LOG2E_F;
namespace pg8 {
#define PG8_LAS __attribute__((address_space(3)))
typedef unsigned short bf16_t;
typedef short bf16x8 __attribute__((ext_vector_type(8)));
typedef float f32x4 __attribute__((ext_vector_type(4)));
typedef unsigned u32x4 __attribute__((ext_vector_type(4)));
constexpr int BM = 256, BK = 64, HALF = 128, HTB = HALF * BK * 2  , STAGE_BYTES = 8 * HTB, NXCD = 8, WGM = 8;

__host__ __device__ __forceinline__ int lds_byte(int r, int c) { const int st = (r >> 4) * 2 + (c >> 5), rr = r & 15, cc = c & 31, ob = rr * 64 + cc * 2; return st * 1024 + (ob ^ (((ob >> 9) & 1) << 5)); }
__host__ __device__ __forceinline__ void stage_rc(int b, int& R, int& C) { const int st = b / 1024, sb = b % 1024, swz = sb ^ (((sb >> 9) & 1) << 5); R = (st >> 1) * 16 + swz / 64; C = (st & 1) * 32 + (swz % 64) / 2; }
__host__ __device__ __forceinline__ int perm32(int rho) { const int n = rho >> 4, i = rho & 15; return 8 * (i >> 2) + 4 * n + (i & 3); }

struct Unit { int pm, pn; };
struct Gemm { const bf16_t* A; const bf16_t* Bt; int M, N, K; };

struct StaticOrder {
    int nM, nN, nwg, G, c;
    __host__ __device__ void init(int M, int N, int G_, int c_) { nM = M / BM; nN = N / BM; nwg = nM * nN; G = G_; c = c_; }
    __host__ __device__ bool next(int i, Unit& u) const {
        const long L = (long)i * G + c; if (L >= nwg) return false;
        int wgid = (int)L; { const int q = nwg / NXCD, r = nwg % NXCD, xcd = wgid % NXCD, off = wgid / NXCD; wgid = (xcd < r ? xcd * (q + 1) : r * (q + 1) + (xcd - r) * q) + off; }
        const int nig = WGM * nN, gid = wgid / nig, fm = gid * WGM, gsz = (nM - fm) < WGM ? (nM - fm) : WGM;
        u.pm = fm + ((wgid % nig) % gsz); u.pn = (wgid % nig) / gsz; return true;
    }
    __device__ __forceinline__ void a_ready(const Unit&) const {}
    __device__ __forceinline__ void done(const Unit&) const {}
};

typedef unsigned u32x4 __attribute__((ext_vector_type(4)));
typedef unsigned u32x2 __attribute__((ext_vector_type(2)));
typedef float f32x2 __attribute__((ext_vector_type(2)));
typedef __bf16 bf16x2_t __attribute__((ext_vector_type(2)));
__device__ __forceinline__ unsigned pk2(float lo, float hi) { f32x2 v = {lo, hi}; bf16x2_t b = __builtin_convertvector(v, bf16x2_t); return __builtin_bit_cast(unsigned, b); }
__device__ __forceinline__ void st8(bf16_t* p, f32x4 a, f32x4 b) { u32x4 w; w.x = pk2(a[0], a[1]); w.y = pk2(a[2], a[3]); w.z = pk2(b[0], b[1]); w.w = pk2(b[2], b[3]); *(u32x4*)p = w; }
__device__ __forceinline__ void ld8(const bf16_t* p, f32x4& a, f32x4& b) { const u32x4 w = *(const u32x4*)p;
    a[0] = __uint_as_float(w.x << 16); a[1] = __uint_as_float(w.x & 0xffff0000u); a[2] = __uint_as_float(w.y << 16); a[3] = __uint_as_float(w.y & 0xffff0000u);
    b[0] = __uint_as_float(w.z << 16); b[1] = __uint_as_float(w.z & 0xffff0000u); b[2] = __uint_as_float(w.w << 16); b[3] = __uint_as_float(w.w & 0xffff0000u); }
__device__ __forceinline__ void up8(const u32x4 w, f32x4& a, f32x4& b) {
    a[0] = __uint_as_float(w.x << 16); a[1] = __uint_as_float(w.x & 0xffff0000u); a[2] = __uint_as_float(w.y << 16); a[3] = __uint_as_float(w.y & 0xffff0000u);
    b[0] = __uint_as_float(w.z << 16); b[1] = __uint_as_float(w.z & 0xffff0000u); b[2] = __uint_as_float(w.w << 16); b[3] = __uint_as_float(w.w & 0xffff0000u); }
__device__ __forceinline__ float sigm(float x) { return __builtin_amdgcn_rcpf(1.f + __expf(-x)); }
__device__ __forceinline__ f32x4 sigm4(f32x4 x) { f32x4 o; o[0] = sigm(x[0]); o[1] = sigm(x[1]); o[2] = sigm(x[2]); o[3] = sigm(x[3]); return o; }
__device__ __forceinline__ float quad_sum(float s) { s += __shfl_xor(s, 16); s += __shfl_xor(s, 32); return s; }
__device__ __forceinline__ float sq4(f32x4 v) { return (v[0] * v[0] + v[1] * v[1]) + (v[2] * v[2] + v[3] * v[3]); }
__device__ __forceinline__ f32x4 rope4(f32x4 v, f32x4 t) { f32x4 o; o[0] = v[0] * t[0] - v[1] * t[1]; o[1] = v[1] * t[0] + v[0] * t[1]; o[2] = v[2] * t[2] - v[3] * t[3]; o[3] = v[3] * t[2] + v[2] * t[3]; return o; }
#define EPI_FENCE() asm volatile("" ::: "memory")
#define EPI_LOOP_AM _Pragma("unroll") for (int ai = 0; ai < 2; ++ai) _Pragma("unroll") for (int m = 0; m < 4; ++m)

struct EpiInProj {
    static constexpr bool PERM = true, AFTER_DRAIN = false;
    bf16_t *QD, *KD, *VD, *SA, *SB, *CKV, *CQ, *KR; float *SSQ, *SSKV; const float* bgate; const float* tabD; const float* tabM;
    __device__ __forceinline__ void operator()(const f32x4 (&acc)[2][2][4][2], const Unit& u, int wr, int wc, int fr, int fq) const {
        const int pn = u.pn, rbase = u.pm * BM + wr * 64 + fr, lc = wc * 32 + fq * 8;
        if (pn < 8) {
            bf16_t* dst = (pn < 4 ? QD : KD) + (pn & 3) * 256 + lc; const float sc = pn < 4 ? QS_D : 1.f;
            const bool rp = ((wc & 1) == 0) && (fq < 2);
            EPI_LOOP_AM { const int row = rbase + ai * HALF + m * 16; f32x4 t0 = {1.f, 0.f, 1.f, 0.f}, t1 = t0;
                if (rp) { const f32x4* tp = (const f32x4*)(tabD + ((size_t)(row & (SEQ_LEN - 1)) * 8 + 4 * fq) * 2); t0 = tp[0]; t1 = tp[1]; }
#pragma unroll
                for (int bj = 0; bj < 2; ++bj) st8(dst + (size_t)row * 1024 + bj * HALF, rope4(acc[ai][bj][m][0], t0) * sc, rope4(acc[ai][bj][m][1], t1) * sc);
                EPI_FENCE(); }
        } else if (pn < 12) {
            bf16_t* dst = VD + (pn - 8) * 256 + lc;
            EPI_LOOP_AM { const int row = rbase + ai * HALF + m * 16;
#pragma unroll
                for (int bj = 0; bj < 2; ++bj) st8(dst + (size_t)row * 1024 + bj * HALF, acc[ai][bj][m][0], acc[ai][bj][m][1]); }
        } else if (pn < 20) {
            const int t = (pn - 12) & 3; bf16_t* dst = (pn < 16 ? SA : SB) + t * 256 + lc; const float* bp = bgate + (pn < 16 ? 0 : 1024) + t * 256 + lc;
            f32x4 b[2][2];
#pragma unroll
            for (int bj = 0; bj < 2; ++bj) { b[bj][0] = *(const f32x4*)(bp + bj * HALF); b[bj][1] = *(const f32x4*)(bp + bj * HALF + 4); }
            EPI_LOOP_AM { const int row = rbase + ai * HALF + m * 16;
#pragma unroll
                for (int bj = 0; bj < 2; ++bj) st8(dst + (size_t)row * 1024 + bj * HALF, sigm4(acc[ai][bj][m][0] + b[bj][0]), sigm4(acc[ai][bj][m][1] + b[bj][1])); }
        } else if (pn == 20) {
            EPI_LOOP_AM { const int row = rbase + ai * HALF + m * 16; float s = 0.f;
#pragma unroll
                for (int bj = 0; bj < 2; ++bj) { st8(CKV + (size_t)row * 256 + bj * HALF + lc, acc[ai][bj][m][0], acc[ai][bj][m][1]); s += sq4(acc[ai][bj][m][0]) + sq4(acc[ai][bj][m][1]); }
                s = quad_sum(s); if (fq == 0) SSKV[(size_t)row * 4 + wc] = s; }
        } else if (pn == 21) {
            EPI_LOOP_AM { const int row = rbase + ai * HALF + m * 16; float s = 0.f;
#pragma unroll
                for (int bj = 0; bj < 2; ++bj) { st8(CQ + (size_t)row * 384 + bj * HALF + lc, acc[ai][bj][m][0], acc[ai][bj][m][1]); s += sq4(acc[ai][bj][m][0]) + sq4(acc[ai][bj][m][1]); }
                s = quad_sum(s); if (fq == 0) SSQ[(size_t)row * 8 + wc] = s; }
        } else {
            EPI_LOOP_AM { const int row = rbase + ai * HALF + m * 16;
                st8(CQ + (size_t)row * 384 + 256 + lc, acc[ai][0][m][0], acc[ai][0][m][1]);
                float s = sq4(acc[ai][0][m][0]) + sq4(acc[ai][0][m][1]); s = quad_sum(s); if (fq == 0) SSQ[(size_t)row * 8 + 4 + wc] = s;
                if (wc == 0) { const f32x4* tp = (const f32x4*)(tabM + ((size_t)(row & (SEQ_LEN - 1)) * 16 + 4 * fq) * 2);
                    st8(KR + (size_t)row * 32 + fq * 8, rope4(acc[ai][1][m][0], tp[0]), rope4(acc[ai][1][m][1], tp[1])); }
                EPI_FENCE(); }
        }
    }
};
struct EpiQUp {
    static constexpr bool PERM = true, AFTER_DRAIN = false;
    const float* SSQ; const float* tabM; bf16_t* QM;
    __device__ __forceinline__ void operator()(const f32x4 (&acc)[2][2][4][2], const Unit& u, int wr, int wc, int fr, int fq) const {
        const int rbase = u.pm * BM + wr * 64 + fr, c0 = u.pn * BM + wc * 32 + fq * 8;
        const int hl0 = c0 % 96, hl1 = (c0 + HALF) % 96;
        EPI_LOOP_AM { const int row = rbase + ai * HALF + m * 16;
            const f32x4 s0 = *(const f32x4*)(SSQ + (size_t)row * 8), s1 = *(const f32x4*)(SSQ + (size_t)row * 8 + 4);
            const float rstd = __builtin_amdgcn_rsqf(((s0[0] + s0[1]) + (s0[2] + s0[3]) + (s1[0] + s1[1]) + (s1[2] + s1[3])) * (1.f / 384.f) + NEPS) * QS_M;
            const float* tb = tabM + (size_t)(row & (SEQ_LEN - 1)) * 32;
#pragma unroll
            for (int bj = 0; bj < 2; ++bj) { const int hl = bj ? hl1 : hl0; const bool rp = hl >= 64; const f32x4 id = {1.f, 0.f, 1.f, 0.f};
                const f32x4* tp = (const f32x4*)(tb + (rp ? hl - 64 : 0)); const f32x4 t0 = rp ? tp[0] : id, t1 = rp ? tp[1] : id;
                st8(QM + (size_t)row * 768 + c0 + bj * HALF, rope4(acc[ai][bj][m][0] * rstd, t0), rope4(acc[ai][bj][m][1] * rstd, t1)); EPI_FENCE(); }
            }
    }
};
struct EpiKVUp {
    static constexpr bool PERM = true, AFTER_DRAIN = false;
    const float* SSKV; bf16_t* KVM;
    __device__ __forceinline__ void operator()(const f32x4 (&acc)[2][2][4][2], const Unit& u, int wr, int wc, int fr, int fq) const {
        const int rbase = u.pm * BM + wr * 64 + fr, c0 = u.pn * BM + wc * 32 + fq * 8;
        EPI_LOOP_AM { const int row = rbase + ai * HALF + m * 16;
            const f32x4 s0 = *(const f32x4*)(SSKV + (size_t)row * 4);
            const float rstd = __builtin_amdgcn_rsqf(((s0[0] + s0[1]) + (s0[2] + s0[3])) * (1.f / 256.f) + NEPS);
#pragma unroll
            for (int bj = 0; bj < 2; ++bj) st8(KVM + (size_t)row * 1024 + c0 + bj * HALF, acc[ai][bj][m][0] * rstd, acc[ai][bj][m][1] * rstd);
            EPI_FENCE(); }
    }
};
struct EpiOutA {
    static constexpr bool PERM = true, AFTER_DRAIN = false;
    const bf16_t* SA; bf16_t* T;
    __device__ __forceinline__ void operator()(const f32x4 (&acc)[2][2][4][2], const Unit& u, int wr, int wc, int fr, int fq) const {
        const int rbase = u.pm * BM + wr * 64 + fr, c0 = u.pn * BM + wc * 32 + fq * 8;
#pragma unroll
        for (int ai = 0; ai < 2; ++ai) { u32x4 g[4][2];
#pragma unroll
            for (int m = 0; m < 4; ++m)
#pragma unroll
                for (int bj = 0; bj < 2; ++bj) g[m][bj] = *(const u32x4*)(SA + (size_t)(rbase + ai * HALF + m * 16) * 1024 + c0 + bj * HALF);
            EPI_FENCE();
#pragma unroll
            for (int m = 0; m < 4; ++m)
#pragma unroll
                for (int bj = 0; bj < 2; ++bj) { f32x4 g0, g1; up8(g[m][bj], g0, g1); st8(T + (size_t)(rbase + ai * HALF + m * 16) * 1024 + c0 + bj * HALF, acc[ai][bj][m][0] * g0, acc[ai][bj][m][1] * g1); }
            EPI_FENCE(); }
    }
};
struct EpiOutB {
    static constexpr bool PERM = true, AFTER_DRAIN = false;
    const bf16_t* SB; const bf16_t* T; bf16_t* MG;
    __device__ __forceinline__ void operator()(const f32x4 (&acc)[2][2][4][2], const Unit& u, int wr, int wc, int fr, int fq) const {
        const int rbase = u.pm * BM + wr * 64 + fr, c0 = u.pn * BM + wc * 32 + fq * 8;
#pragma unroll
        for (int ai = 0; ai < 2; ++ai) { u32x4 g[4][2], t[4][2];
#pragma unroll
            for (int m = 0; m < 4; ++m)
#pragma unroll
                for (int bj = 0; bj < 2; ++bj) { const size_t o = (size_t)(rbase + ai * HALF + m * 16) * 1024 + c0 + bj * HALF; g[m][bj] = *(const u32x4*)(SB + o); t[m][bj] = *(const u32x4*)(T + o); }
            EPI_FENCE();
#pragma unroll
            for (int m = 0; m < 4; ++m)
#pragma unroll
                for (int bj = 0; bj < 2; ++bj) { f32x4 g0, g1, t0, t1; up8(g[m][bj], g0, g1); up8(t[m][bj], t0, t1);
                    st8(MG + (size_t)(rbase + ai * HALF + m * 16) * 1024 + c0 + bj * HALF, t0 + acc[ai][bj][m][0] * g0, t1 + acc[ai][bj][m][1] * g1); }
            EPI_FENCE(); }
    }
};
template <bool RES_BF16> struct EpiResid {
    static constexpr bool PERM = true, AFTER_DRAIN = false;
    const void* res; bf16_t* xb; float* SS;
    __device__ __forceinline__ void operator()(const f32x4 (&acc)[2][2][4][2], const Unit& u, int wr, int wc, int fr, int fq) const {
        const int rbase = u.pm * BM + wr * 64 + fr, c0 = u.pn * BM + wc * 32 + fq * 8;
        if constexpr (RES_BF16) {
#pragma unroll
            for (int ai = 0; ai < 2; ++ai) { u32x4 r[4][2];
#pragma unroll
                for (int m = 0; m < 4; ++m)
#pragma unroll
                    for (int bj = 0; bj < 2; ++bj) r[m][bj] = *(const u32x4*)((const bf16_t*)res + (size_t)(rbase + ai * HALF + m * 16) * 1024 + c0 + bj * HALF);
                EPI_FENCE();
#pragma unroll
                for (int m = 0; m < 4; ++m) { const int row = rbase + ai * HALF + m * 16; float s = 0.f;
#pragma unroll
                    for (int bj = 0; bj < 2; ++bj) { f32x4 r0, r1; up8(r[m][bj], r0, r1); const f32x4 v0 = r0 + acc[ai][bj][m][0], v1 = r1 + acc[ai][bj][m][1];
                        st8(xb + (size_t)row * 1024 + c0 + bj * HALF, v0, v1); s += sq4(v0) + sq4(v1); }
                    s = quad_sum(s); if (fq == 0) SS[(size_t)row * 16 + u.pn * 4 + wc] = s; }
                EPI_FENCE(); }
        } else {
#pragma unroll
            for (int ai = 0; ai < 2; ++ai)
#pragma unroll
                for (int mp = 0; mp < 2; ++mp) { f32x4 r[2][2][2];
#pragma unroll
                    for (int mm = 0; mm < 2; ++mm)
#pragma unroll
                        for (int bj = 0; bj < 2; ++bj) { const float* p = (const float*)res + (size_t)(rbase + ai * HALF + (2 * mp + mm) * 16) * 1024 + c0 + bj * HALF; r[mm][bj][0] = *(const f32x4*)p; r[mm][bj][1] = *(const f32x4*)(p + 4); }
                    EPI_FENCE();
#pragma unroll
                    for (int mm = 0; mm < 2; ++mm) { const int m = 2 * mp + mm, row = rbase + ai * HALF + m * 16; float s = 0.f;
#pragma unroll
                        for (int bj = 0; bj < 2; ++bj) { const f32x4 v0 = r[mm][bj][0] + acc[ai][bj][m][0], v1 = r[mm][bj][1] + acc[ai][bj][m][1];
                            st8(xb + (size_t)row * 1024 + c0 + bj * HALF, v0, v1); s += sq4(v0) + sq4(v1); }
                        s = quad_sum(s); if (fq == 0) SS[(size_t)row * 16 + u.pn * 4 + wc] = s; }
                    EPI_FENCE(); }
        }
    }
};
__device__ __forceinline__ float rstd16(const float* ss) { const f32x4 a = *(const f32x4*)ss, b = *(const f32x4*)(ss + 4), c = *(const f32x4*)(ss + 8), d = *(const f32x4*)(ss + 12);
    const f32x4 t = (a + b) + (c + d); return __builtin_amdgcn_rsqf(((t[0] + t[1]) + (t[2] + t[3])) * (1.f / 1024.f) + NEPS); }
struct EpiSwiGLU {
    static constexpr bool PERM = true, AFTER_DRAIN = false;
    const float* SS; bf16_t* HID;
    __device__ __forceinline__ void operator()(const f32x4 (&acc)[2][2][4][2], const Unit& u, int wr, int wc, int fr, int fq) const {
        const int rbase = u.pm * BM + wr * 64 + fr, c0 = u.pn * HALF + wc * 32 + fq * 8;
        EPI_LOOP_AM { const int row = rbase + ai * HALF + m * 16; const float rstd = rstd16(SS + (size_t)row * 16);
            const f32x4 g0 = acc[ai][0][m][0] * rstd, g1 = acc[ai][0][m][1] * rstd, u0 = acc[ai][1][m][0] * rstd, u1 = acc[ai][1][m][1] * rstd;
            st8(HID + (size_t)row * 2816 + c0, g0 * sigm4(g0) * u0, g1 * sigm4(g1) * u1);
            EPI_FENCE(); }
    }
};
struct EpiPleA {
    static constexpr bool PERM = true, AFTER_DRAIN = false;
    bf16_t* T;
    __device__ __forceinline__ void operator()(const f32x4 (&acc)[2][2][4][2], const Unit& u, int wr, int wc, int fr, int fq) const {
        const int rbase = u.pm * BM + wr * 64 + fr, c0 = u.pn * BM + wc * 32 + fq * 8;
        EPI_LOOP_AM { const int row = rbase + ai * HALF + m * 16;
#pragma unroll
            for (int bj = 0; bj < 2; ++bj) st8(T + (size_t)row * 1024 + c0 + bj * HALF, acc[ai][bj][m][0], acc[ai][bj][m][1]); }
    }
};
struct EpiPleB {
    static constexpr bool PERM = true, AFTER_DRAIN = false;
    const float* SS2; const float* bias; const bf16_t* X2; const bf16_t* T2; bf16_t* X3; float* SS3;
    __device__ __forceinline__ void operator()(const f32x4 (&acc)[2][2][4][2], const Unit& u, int wr, int wc, int fr, int fq) const {
        const int rbase = u.pm * BM + wr * 64 + fr, c0 = u.pn * BM + wc * 32 + fq * 8;
#pragma unroll
        for (int ai = 0; ai < 2; ++ai)
#pragma unroll
          for (int mp = 0; mp < 2; ++mp) { u32x4 x[2][2], t[2][2]; float rs[2];
#pragma unroll
            for (int mm = 0; mm < 2; ++mm) { const int row = rbase + ai * HALF + (2 * mp + mm) * 16;
#pragma unroll
                for (int bj = 0; bj < 2; ++bj) { const size_t o = (size_t)row * 1024 + c0 + bj * HALF; x[mm][bj] = *(const u32x4*)(X2 + o); t[mm][bj] = *(const u32x4*)(T2 + o); }
                rs[mm] = rstd16(SS2 + (size_t)row * 16); }
            EPI_FENCE();
#pragma unroll
            for (int mm = 0; mm < 2; ++mm) { const int m = 2 * mp + mm, row = rbase + ai * HALF + m * 16; float s = 0.f;
#pragma unroll
                for (int bj = 0; bj < 2; ++bj) { const f32x4 b0 = *(const f32x4*)(bias + c0 + bj * HALF), b1 = *(const f32x4*)(bias + c0 + bj * HALF + 4);
                    f32x4 x0, x1, t0, t1; up8(x[mm][bj], x0, x1); up8(t[mm][bj], t0, t1);
                    const f32x4 v0 = x0 + t0 * sigm4(acc[ai][bj][m][0] * rs[mm] + b0), v1 = x1 + t1 * sigm4(acc[ai][bj][m][1] * rs[mm] + b1);
                    st8(X3 + (size_t)row * 1024 + c0 + bj * HALF, v0, v1); s += sq4(v0) + sq4(v1); }
                s = quad_sum(s); if (fq == 0) SS3[(size_t)row * 16 + u.pn * 4 + wc] = s; }
            EPI_FENCE(); }
    }
};
template <class Epi, class Sched, bool ALIGN_EPI = false, bool SP2 = false>
__device__ __forceinline__ void gemm_phase(PG8_LAS unsigned char* lds, const Gemm g, const Sched& S, const Epi& E) {
    int tid_ = threadIdx.x; asm volatile("" : "+v"(tid_)); const int tid = tid_, wid = __builtin_amdgcn_readfirstlane(tid >> 6), lane = tid & 63, wr = wid >> 2, wc = wid & 3, fr = lane & 15, fq = lane >> 4;
    const int K = g.K, nt = K / BK;
    unsigned voffA[2], voffB[2];
#pragma unroll
    for (int i = 0; i < 2; ++i) { int R, C; stage_rc(tid * 16 + i * 8192, R, C); const int Rb = Epi::PERM ? ((R & ~31) + perm32(R & 31)) : R;
        voffA[i] = (unsigned)(R * K + C) * 2u; voffB[i] = (unsigned)(Rb * K + C) * 2u; }
    const size_t kstep = (size_t)(BK * 2);
    const size_t hstep = (size_t)HALF * K * 2;
    const size_t tstep = 2 * hstep;
    const unsigned ldsw = (unsigned)wid * 1024u;
    const int aoff = lds_byte(wr * 64 + fr, fq * 8), boff = lds_byte(wc * 32 + fr, fq * 8);
#define PG8_SA(b, h) (((b) * 2 + (h)) * HTB)
#define PG8_SB(b, h) ((4 + (b) * 2 + (h)) * HTB)
#define PG8_STAGE(bufoff, gbase, voff) do { _Pragma("unroll") for (int _i = 0; _i < 2; ++_i) \
        __builtin_amdgcn_global_load_lds((const unsigned*)((const char*)(gbase) + (voff)[_i]), (PG8_LAS unsigned*)(lds + (bufoff) + ldsw + _i * 8192), 16, 0, 0); } while (0)
#define PG8_LDA(dst, b, h) do { _Pragma("unroll") for (int m = 0; m < 4; ++m) _Pragma("unroll") for (int k = 0; k < 2; ++k) dst[m][k] = *(const PG8_LAS bf16x8*)(lds + PG8_SA(b, h) + aoff + m * 2048 + k * 1024); } while (0)
#define PG8_LDB(dst, b, h) do { _Pragma("unroll") for (int n = 0; n < 2; ++n) _Pragma("unroll") for (int k = 0; k < 2; ++k) dst[n][k] = *(const PG8_LAS bf16x8*)(lds + PG8_SB(b, h) + boff + n * 2048 + k * 1024); } while (0)
#define PG8_MMA(ai, bj, At, Bt) do { __builtin_amdgcn_s_setprio(1); _Pragma("unroll") for (int m = 0; m < 4; ++m) _Pragma("unroll") for (int n = 0; n < 2; ++n) _Pragma("unroll") for (int k = 0; k < 2; ++k) \
        acc[ai][bj][m][n] = __builtin_amdgcn_mfma_f32_16x16x32_bf16(Bt[n][k], At[m][k], acc[ai][bj][m][n], 0, 0, 0); __builtin_amdgcn_s_setprio(0); } while (0)
#define PG8_WAIT_V(n) asm volatile("s_waitcnt vmcnt(" #n ")" ::: "memory")
#define PG8_WAIT_L(n) asm volatile("s_waitcnt lgkmcnt(" #n ")" ::: "memory")
#define PG8_BAR __builtin_amdgcn_s_barrier()
#define PG8_SCHED __builtin_amdgcn_sched_barrier(0)
    Unit cur, nxt; int ui = 0;
    if (!S.next(0, cur)) return;
    f32x4 acc[2][2][4][2];
#pragma unroll
    for (int a = 0; a < 2; ++a)
#pragma unroll
        for (int b = 0; b < 2; ++b)
#pragma unroll
            for (int m = 0; m < 4; ++m)
#pragma unroll
                for (int n = 0; n < 2; ++n) acc[a][b][m][n] = (f32x4){0.f, 0.f, 0.f, 0.f};
    bf16x8 At[4][2], B0[2][2], B1[2][2];
    const char* cA = (const char*)g.A + (size_t)cur.pm * tstep; const char* cB = (const char*)g.Bt + (size_t)cur.pn * tstep;
    S.a_ready(cur);
    if constexpr (SP2) {
        PG8_STAGE(PG8_SB(0, 0), cB, voffB); PG8_STAGE(PG8_SB(0, 1), cB + hstep, voffB); PG8_STAGE(PG8_SA(0, 0), cA, voffA); PG8_STAGE(PG8_SA(0, 1), cA + hstep, voffA);
        if (wr == 1) PG8_BAR;
        PG8_WAIT_V(2); PG8_BAR;
        PG8_STAGE(PG8_SB(1, 0), cB + kstep, voffB); PG8_STAGE(PG8_SA(1, 0), cA + kstep, voffA); PG8_STAGE(PG8_SB(1, 1), cB + hstep + kstep, voffB);
        PG8_WAIT_V(6); PG8_BAR;
    } else {
        PG8_STAGE(PG8_SB(0, 0), cB, voffB); PG8_STAGE(PG8_SA(0, 0), cA, voffA); PG8_STAGE(PG8_SB(0, 1), cB + hstep, voffB); PG8_STAGE(PG8_SA(0, 1), cA + hstep, voffA);
        if (wr == 1) PG8_BAR;
        PG8_WAIT_V(4); PG8_BAR;
        PG8_STAGE(PG8_SB(1, 0), cB + kstep, voffB); PG8_STAGE(PG8_SA(1, 0), cA + kstep, voffA); PG8_STAGE(PG8_SB(1, 1), cB + hstep + kstep, voffB);
        PG8_WAIT_V(6); PG8_BAR;
    }
    for (;;) {
        const bool has_next = S.next(ui + 1, nxt);
        const char* nA = has_next ? (const char*)g.A + (size_t)nxt.pm * tstep : cA; const char* nB = has_next ? (const char*)g.Bt + (size_t)nxt.pn * tstep : cB;
        for (int t = 0; t < nt; t += 2) {
            const bool last = (t == nt - 2);
            const char* a1 = cA + (size_t)(t + 1) * kstep;
            const char* a2 = last ? nA : cA + (size_t)(t + 2) * kstep; const char* b2 = last ? nB : cB + (size_t)(t + 2) * kstep;
            const char* a3 = a2 + kstep; const char* b3 = b2 + kstep;
            if (last && has_next) S.a_ready(nxt);
            if constexpr (SP2) {
            PG8_LDB(B0, 0, 0); PG8_LDB(B1, 0, 1); PG8_SCHED; PG8_LDA(At, 0, 0); PG8_STAGE(PG8_SA(1, 1), a1 + hstep, voffA);
            PG8_WAIT_V(8); PG8_WAIT_L(0); PG8_BAR; PG8_MMA(0, 0, At, B0); PG8_MMA(0, 1, At, B1); PG8_BAR; PG8_SCHED;
            PG8_LDA(At, 0, 1); PG8_STAGE(PG8_SB(0, 0), b2, voffB); PG8_STAGE(PG8_SB(0, 1), b2 + hstep, voffB); PG8_STAGE(PG8_SA(0, 0), a2, voffA);
            PG8_WAIT_V(8); PG8_WAIT_L(0); PG8_BAR; PG8_MMA(1, 0, At, B0); PG8_MMA(1, 1, At, B1); PG8_BAR; PG8_SCHED;
            PG8_LDB(B0, 1, 0); PG8_LDB(B1, 1, 1); PG8_SCHED; PG8_LDA(At, 1, 0); PG8_STAGE(PG8_SA(0, 1), a2 + hstep, voffA);
            PG8_WAIT_V(8); PG8_WAIT_L(0); PG8_BAR; PG8_MMA(0, 0, At, B0); PG8_MMA(0, 1, At, B1); PG8_BAR; PG8_SCHED;
            PG8_LDA(At, 1, 1); PG8_STAGE(PG8_SB(1, 0), b3, voffB); PG8_STAGE(PG8_SB(1, 1), b3 + hstep, voffB); PG8_STAGE(PG8_SA(1, 0), a3, voffA);
            PG8_WAIT_V(8); PG8_WAIT_L(0); PG8_BAR; PG8_MMA(1, 0, At, B0); PG8_MMA(1, 1, At, B1); PG8_BAR; PG8_SCHED;
            } else {
            PG8_LDB(B0, 0, 0); PG8_SCHED; PG8_LDA(At, 0, 0); PG8_STAGE(PG8_SA(1, 1), a1 + hstep, voffA);
            PG8_WAIT_L(8); PG8_BAR; PG8_WAIT_L(0); PG8_MMA(0, 0, At, B0); PG8_BAR; PG8_SCHED;
            PG8_LDB(B1, 0, 1); PG8_STAGE(PG8_SB(0, 0), b2, voffB);
            PG8_BAR; PG8_WAIT_L(0); PG8_MMA(0, 1, At, B1); PG8_BAR;
            PG8_LDA(At, 0, 1); PG8_STAGE(PG8_SA(0, 0), a2, voffA);
            PG8_BAR; PG8_WAIT_L(0); PG8_MMA(1, 0, At, B0); PG8_BAR; PG8_SCHED;
            PG8_STAGE(PG8_SB(0, 1), b2 + hstep, voffB);
            PG8_WAIT_V(6); PG8_BAR; PG8_MMA(1, 1, At, B1); PG8_BAR;
            PG8_LDB(B0, 1, 0); PG8_SCHED; PG8_LDA(At, 1, 0); PG8_STAGE(PG8_SA(0, 1), a2 + hstep, voffA);
            PG8_WAIT_L(8); PG8_BAR; PG8_WAIT_L(0); PG8_MMA(0, 0, At, B0); PG8_BAR; PG8_SCHED;
            PG8_LDB(B1, 1, 1); PG8_STAGE(PG8_SB(1, 0), b3, voffB);
            PG8_BAR; PG8_WAIT_L(0); PG8_MMA(0, 1, At, B1); PG8_BAR;
            PG8_LDA(At, 1, 1); PG8_STAGE(PG8_SA(1, 0), a3, voffA);
            PG8_BAR; PG8_WAIT_L(0); PG8_MMA(1, 0, At, B0); PG8_BAR; PG8_SCHED;
            PG8_STAGE(PG8_SB(1, 1), b3 + hstep, voffB);
            PG8_WAIT_V(6); PG8_BAR; PG8_MMA(1, 1, At, B1); PG8_BAR;
            }
        }
        if constexpr (ALIGN_EPI) { if (wr == 0) PG8_BAR; }
        if constexpr (!Epi::AFTER_DRAIN) { E(acc, cur, wr, wc, fr, fq); S.done(cur); }
        if (!has_next) break;
#pragma unroll
        for (int a = 0; a < 2; ++a)
#pragma unroll
            for (int b = 0; b < 2; ++b)
#pragma unroll
                for (int m = 0; m < 4; ++m)
#pragma unroll
                    for (int n = 0; n < 2; ++n) acc[a][b][m][n] = (f32x4){0.f, 0.f, 0.f, 0.f};
        cur = nxt; cA = nA; cB = nB; ++ui;
        if constexpr (ALIGN_EPI) { if (wr == 1) PG8_BAR; }
    }
    PG8_WAIT_V(0);
    if constexpr (!ALIGN_EPI) { if (wr == 0) PG8_BAR; }
    PG8_BAR;
    if constexpr (Epi::AFTER_DRAIN) { E.fused(acc, cur, wr, wc, fr, fq, lds, wid, lane); S.done(cur); }
#undef PG8_SA
#undef PG8_SB
#undef PG8_STAGE
#undef PG8_LDA
#undef PG8_LDB
#undef PG8_MMA
#undef PG8_WAIT_V
#undef PG8_WAIT_L
#undef PG8_BAR
#undef PG8_SCHED
}
}
namespace att {
#define ATT_LAS __attribute__((address_space(3)))
typedef unsigned short bf16_t;
typedef short bf16x8 __attribute__((ext_vector_type(8)));
typedef short s16x4 __attribute__((ext_vector_type(4)));
typedef float f32x16 __attribute__((ext_vector_type(16)));
typedef float f32x4 __attribute__((ext_vector_type(4)));
typedef unsigned u32x4 __attribute__((ext_vector_type(4)));
typedef unsigned u32x2 __attribute__((ext_vector_type(2)));
constexpr int KB0 = 0, KBSZ = 12288, VB0 = 24576, VBSZ = 16384;
__device__ __forceinline__ float swap_max(float m) { auto rr = __builtin_amdgcn_permlane32_swap(__float_as_uint(m), __float_as_uint(m), false, false); return fmaxf(__uint_as_float(rr[0]), __uint_as_float(rr[1])); }
__device__ __forceinline__ float swap_sum(float m) { auto rr = __builtin_amdgcn_permlane32_swap(__float_as_uint(m), __float_as_uint(m), false, false); return __uint_as_float(rr[0]) + __uint_as_float(rr[1]); }
__device__ __forceinline__ s16x4 vtr(const ATT_LAS char* p) { return __builtin_bit_cast(s16x4, __builtin_amdgcn_ds_read_tr16_b64_v4i16((ATT_LAS s16x4*)p)); }
__device__ __forceinline__ float max3f(float a, float b, float c) { float r; asm("v_max3_f32 %0, %1, %2, %3" : "=v"(r) : "v"(a), "v"(b), "v"(c)); return r; }
__device__ __forceinline__ int crow(int r, int hi) { return (r & 3) + 8 * (r >> 2) + 4 * hi; }

template <int DQK, int DV, bool MLA>
__device__ __forceinline__ void attn_pass(ATT_LAS char* lds, const bf16_t* qp, const bf16_t* kg, const bf16_t* krg, const bf16_t* vg, int NT, int myNT, f32x16 (&o)[DV / 32], float& linv) {
    int tid_ = threadIdx.x; asm volatile("" : "+v"(tid_)); const int tid = tid_, lane = tid & 63, wid = __builtin_amdgcn_readfirstlane(tid >> 6), r32 = lane & 31, hi = lane >> 5;
    bf16x8 qr[DQK / 16];
#pragma unroll
    for (int d0 = 0; d0 < DQK / 16; ++d0) qr[d0] = *(const bf16x8*)(qp + d0 * 16);
    const bf16_t* ksrc = kg + (size_t)lane * 1024 + wid * 8;
    const bf16_t* krsrc = krg + (size_t)lane * 32 + (wid & 3) * 8;
    const bf16_t* vsrc = vg + (size_t)(16 * (wid & 3) + (lane >> 2)) * 1024 + (wid >> 2) * 32 + (lane & 3) * 8;
    const int sto = wid * 1024 + lane * 16;
    u32x4 kr0 = {0u, 0u, 0u, 0u}, kr1 = kr0, vr0 = kr0, vr1 = kr0;
#define ATT_LOAD(t) do { kr0 = *(const u32x4*)(ksrc + (size_t)(t) * 65536); if (MLA) { if (wid < 4) kr1 = *(const u32x4*)(krsrc + (size_t)(t) * 2048); } \
        vr0 = *(const u32x4*)(vsrc + (size_t)(t) * 65536); if (DV == 128) vr1 = *(const u32x4*)(vsrc + (size_t)(t) * 65536 + 64); } while (0)
#define ATT_STORE(b) do { *(ATT_LAS u32x4*)(lds + KB0 + (b) * KBSZ + sto) = kr0; if (MLA) { if (wid < 4) *(ATT_LAS u32x4*)(lds + KB0 + (b) * KBSZ + 8192 + sto) = kr1; } \
        *(ATT_LAS u32x4*)(lds + VB0 + (b) * VBSZ + sto) = vr0; if (DV == 128) *(ATT_LAS u32x4*)(lds + VB0 + (b) * VBSZ + 8192 + sto) = vr1; } while (0)
#pragma unroll
    for (int i = 0; i < DV / 32; ++i)
#pragma unroll
        for (int r = 0; r < 16; ++r) o[i][r] = 0.f;
    float mref = 0.f, lsum = 0.f;
    ATT_LOAD(0); ATT_STORE(0); __syncthreads();
    for (int t = 0; t < NT; ++t) {
        const int b = t & 1;
        if (t + 1 < NT) ATT_LOAD(t + 1);
        if (t < myNT) {
            const ATT_LAS char* kp = lds + KB0 + b * KBSZ + hi * 1024 + r32 * 16;
            f32x16 p0, p1;
#pragma unroll
            for (int r = 0; r < 16; ++r) { p0[r] = -mref; p1[r] = -mref; }
#pragma unroll
            for (int d0 = 0; d0 < DQK / 16; ++d0) {
                const bf16x8 k0 = *(const ATT_LAS bf16x8*)(kp + d0 * 2048), k1 = *(const ATT_LAS bf16x8*)(kp + d0 * 2048 + 512);
                p0 = __builtin_amdgcn_mfma_f32_32x32x16_bf16(k0, qr[d0], p0, 0, 0, 0);
                p1 = __builtin_amdgcn_mfma_f32_32x32x16_bf16(k1, qr[d0], p1, 0, 0, 0);
            }
            asm volatile("s_nop 15\n\ts_nop 7" : "+v"(p0), "+v"(p1));
            float mxa = max3f(p0[0], p0[1], p1[0]), mxb = max3f(p0[2], p0[3], p1[1]); mxa = max3f(mxa, p1[2], p1[3]);
#pragma unroll
            for (int r = 4; r < 16; r += 4) { mxa = max3f(mxa, p0[r], p0[r + 1]); mxb = max3f(mxb, p0[r + 2], p0[r + 3]); mxa = max3f(mxa, p1[r], p1[r + 1]); mxb = max3f(mxb, p1[r + 2], p1[r + 3]); }
            float mx = swap_max(max3f(mxa, mxb, mxb));
            if (__any(mx > 8.f)) {
                const float dl = fmaxf(mx, 0.f), al = __builtin_amdgcn_exp2f(-dl);
                lsum *= al;
#pragma unroll
                for (int i = 0; i < DV / 32; ++i)
#pragma unroll
                    for (int r = 0; r < 16; ++r) o[i][r] *= al;
#pragma unroll
                for (int r = 0; r < 16; ++r) { p0[r] -= dl; p1[r] -= dl; }
                mref += dl;
            }
            float ls = 0.f;
#pragma unroll
            for (int r = 0; r < 16; ++r) { p0[r] = __builtin_amdgcn_exp2f(p0[r]); p1[r] = __builtin_amdgcn_exp2f(p1[r]); ls += p0[r] + p1[r]; }
            lsum += ls;
            u32x4 pw[4];
#pragma unroll
            for (int j = 0; j < 4; ++j) { pw[0][j] = pg8::pk2(p0[2 * j], p0[2 * j + 1]); pw[1][j] = pg8::pk2(p0[8 + 2 * j], p0[9 + 2 * j]); pw[2][j] = pg8::pk2(p1[2 * j], p1[2 * j + 1]); pw[3][j] = pg8::pk2(p1[8 + 2 * j], p1[9 + 2 * j]); }
            const ATT_LAS char* vp = lds + VB0 + b * VBSZ + ((lane >> 4) & 1) * 32 + (lane & 3) * 8 + (4 * hi + ((lane & 15) >> 2)) * 64;
#pragma unroll
            for (int i = 0; i < DV / 32; ++i)
#pragma unroll
                for (int ks = 0; ks < 4; ++ks) {
                    const s16x4 lo = vtr(vp + i * 4096 + ks * 1024), hh = vtr(vp + i * 4096 + ks * 1024 + 512);
                    const bf16x8 vf = {lo[0], lo[1], lo[2], lo[3], hh[0], hh[1], hh[2], hh[3]};
                    o[i] = __builtin_amdgcn_mfma_f32_32x32x16_bf16(vf, __builtin_bit_cast(bf16x8, pw[ks]), o[i], 0, 0, 0);
                }
        }
        if (t + 1 < NT) ATT_STORE(b ^ 1);
        __syncthreads();
    }
    linv = __builtin_amdgcn_rcpf(swap_sum(lsum));
#undef ATT_LOAD
#undef ATT_STORE
}

__device__ __forceinline__ void diff_unit(ATT_LAS char* lds, int b, int h, int qb, const bf16_t* QD, const bf16_t* KD, const bf16_t* VD, bf16_t* OD, const float* subln, float lam) {
    int tid_ = threadIdx.x; asm volatile("" : "+v"(tid_)); const int tid = tid_, lane = tid & 63, wid = __builtin_amdgcn_readfirstlane(tid >> 6), r32 = lane & 31, hi = lane >> 5;
    const size_t row0 = (size_t)b * SEQ_LEN, qrow = row0 + qb * 256 + wid * 32 + r32;
    const int NT = 4 * qb + 4, myNT = 4 * qb + (wid >> 1) + 1;
    f32x16 o1[4], o2[4]; float li1, li2;
    attn_pass<64, 128, false>(lds, QD + qrow * 1024 + (2 * h) * 64 + hi * 8, KD + row0 * 1024 + (2 * h) * 64, nullptr, VD + row0 * 1024 + h * 128, NT, myNT, o1, li1);
    attn_pass<64, 128, false>(lds, QD + qrow * 1024 + (2 * h + 1) * 64 + hi * 8, KD + row0 * 1024 + (2 * h + 1) * 64, nullptr, VD + row0 * 1024 + h * 128, NT, myNT, o2, li2);
    const float c2 = lam * li2; float ss = 0.f;
#pragma unroll
    for (int i = 0; i < 4; ++i)
#pragma unroll
        for (int r = 0; r < 16; ++r) { const float v = o1[i][r] * li1 - o2[i][r] * c2; o1[i][r] = v; ss += v * v; }
    ss = swap_sum(ss);
    const float rstd = __builtin_amdgcn_rsqf(ss * (1.f / 128.f) + NEPS) * 0.8f;
    bf16_t* op = OD + qrow * 1024 + h * 128 + 4 * hi;
#pragma unroll
    for (int i = 0; i < 4; ++i)
#pragma unroll
        for (int rq = 0; rq < 4; ++rq) { const int dv = 32 * i + 8 * rq; const f32x4 g = *(const f32x4*)(subln + dv + 4 * hi);
            u32x2 w; w.x = pg8::pk2(o1[i][4 * rq] * rstd * g[0], o1[i][4 * rq + 1] * rstd * g[1]); w.y = pg8::pk2(o1[i][4 * rq + 2] * rstd * g[2], o1[i][4 * rq + 3] * rstd * g[3]);
            *(u32x2*)(op + dv) = w; }
}
__device__ __forceinline__ void mla_unit(ATT_LAS char* lds, int b, int h, int qb, const bf16_t* QM, const bf16_t* KVM, const bf16_t* KR, bf16_t* OM) {
    int tid_ = threadIdx.x; asm volatile("" : "+v"(tid_)); const int tid = tid_, lane = tid & 63, wid = __builtin_amdgcn_readfirstlane(tid >> 6), r32 = lane & 31, hi = lane >> 5;
    const size_t row0 = (size_t)b * SEQ_LEN, qrow = row0 + qb * 256 + wid * 32 + r32;
    const int NT = 4 * qb + 4, myNT = 4 * qb + (wid >> 1) + 1;
    f32x16 o[2]; float li;
    attn_pass<96, 64, true>(lds, QM + qrow * 768 + h * 96 + hi * 8, KVM + row0 * 1024 + h * 128, KR + row0 * 32, KVM + row0 * 1024 + h * 128 + 64, NT, myNT, o, li);
    bf16_t* op = OM + qrow * 512 + h * 64 + 4 * hi;
#pragma unroll
    for (int i = 0; i < 2; ++i)
#pragma unroll
        for (int rq = 0; rq < 4; ++rq) { const int dv = 32 * i + 8 * rq;
            u32x2 w; w.x = pg8::pk2(o[i][4 * rq] * li, o[i][4 * rq + 1] * li); w.y = pg8::pk2(o[i][4 * rq + 2] * li, o[i][4 * rq + 3] * li);
            *(u32x2*)(op + dv) = w; }
}
}
#define LAS __attribute__((address_space(3)))
typedef unsigned short bf16;
typedef float f32x4 __attribute__((ext_vector_type(4)));
typedef unsigned v4u __attribute__((ext_vector_type(4)));
typedef unsigned v2u __attribute__((ext_vector_type(2)));
constexpr int NWAVES = 8, LDS_BYTES = 147456;
constexpr size_t MiB = 1ull << 20;
constexpr size_t WS_TABD = 0, WS_TABM = 128 * 1024, WS_LAM = 384 * 1024, WS_BAR = 512 * 1024;
constexpr size_t WS_SSQ = 1 * MiB, WS_SSKV = 2 * MiB, WS_SS1 = 3 * MiB, WS_SS2 = 5 * MiB, WS_SS3 = 7 * MiB;
constexpr size_t WS_WIN = 10 * MiB, WS_WGU = WS_WIN + 5888ull * 1024 * 2, WS_WDN = WS_WGU + 5632ull * 1024 * 2, WS_WOD = WS_WDN + 1024ull * 2816 * 2, WS_WOUT = WS_WOD + 2 * MiB,
                 WS_WPG = WS_WOUT + 2 * MiB, WS_WOM = WS_WPG + 2 * MiB, WS_WUQ = WS_WOM + 1 * MiB, WS_WUKV = WS_WUQ + 768ull * 384 * 2, WS_WPLE = WS_WUKV + 1024ull * 256 * 2, WS_WEND = WS_WPLE + 1024ull * 256 * 2;
static_assert(WS_WEND <= 47 * MiB, "weights");
constexpr size_t WS_PB = 47 * MiB;
constexpr size_t WS_XN = 64 * MiB, WS_QM = 64 * MiB, WS_X1B = 64 * MiB;
constexpr size_t WS_QD = 128 * MiB, WS_KD = 192 * MiB, WS_VD = 256 * MiB, WS_KVM = 320 * MiB;
constexpr size_t WS_T = 192 * MiB, WS_MG = 320 * MiB;
constexpr size_t WS_HID = 128 * MiB, WS_X2B = 304 * MiB;
constexpr size_t WS_X3B = 384 * MiB, WS_T2B = 448 * MiB;
constexpr size_t WS_CKV = 384 * MiB, WS_CQ = 400 * MiB, WS_KR = 424 * MiB, WS_OM = 426 * MiB;
constexpr size_t WS_END = 512 * MiB;

#define XB_TMO      128
#define XB_XCNT(j)  (256  + 64 * (j))
#define XB_XSUB(j)  (1280 + 64 * (j))
#define XB_XGEN(j)  (2304 + 64 * (j))
#define XB_TOP      3328
#define XB_TOPGEN   3392
#define XCD_BAR_WORDS 3456
#define XB_SPIN_CAP (1u << 18)

__device__ __forceinline__ unsigned xb_ld(unsigned* p)              { return __hip_atomic_load(p, __ATOMIC_RELAXED, __HIP_MEMORY_SCOPE_AGENT); }
__device__ __forceinline__ unsigned xb_add(unsigned* p, unsigned v) { return __hip_atomic_fetch_add(p, v, __ATOMIC_RELAXED, __HIP_MEMORY_SCOPE_AGENT); }
__device__ __forceinline__ unsigned xb_xcc_id() { return (unsigned)__builtin_amdgcn_s_getreg((3 << 11) | 20) & 0xFu; }
#define XB_SPIN(cond, bar) do { unsigned _sp = 0; while (cond) { __builtin_amdgcn_s_sleep(1); \
    if ((++_sp & 255u) == 0u) { if (xb_ld(&(bar)[XB_TMO])) break; if (_sp > XB_SPIN_CAP) { atomicAdd(&(bar)[XB_TMO], 1u); break; } } } } while (0)

struct XcdBarrier {
    unsigned* bar; unsigned x;
    volatile LAS unsigned* st;
};

__device__ __forceinline__ XcdBarrier xcd_barrier_post(unsigned* bar, volatile LAS unsigned* st) {
    XcdBarrier b; b.bar = bar; b.x = xb_xcc_id(); b.st = st;
    if (threadIdx.x == 0) (void)xb_add(&bar[XB_XCNT(b.x)], 1u);
    return b;
}
__device__ __forceinline__ void xcd_barrier_complete(unsigned* bar, unsigned x, unsigned& nloc, unsigned& nx) {
    const unsigned G = gridDim.x * gridDim.y * gridDim.z;
    unsigned sum, cnt, mine, sp = 0u;
    for (;;) {
        sum = 0u; cnt = 0u; mine = 0u;
#pragma unroll
        for (unsigned j = 0; j < 16; ++j) { const unsigned c = xb_ld(&bar[XB_XCNT(j)]); sum += c; cnt += (c > 0u) ? 1u : 0u; mine = (j == x) ? c : mine; }
        if (sum == G) break;
        __builtin_amdgcn_s_sleep(1);
        if ((++sp & 255u) == 0u) { if (xb_ld(&bar[XB_TMO])) break; if (sp > XB_SPIN_CAP) { atomicAdd(&bar[XB_TMO], 1u); break; } }
    }
    nloc = mine > 0u ? mine : 1u; nx = cnt > 0u ? cnt : 1u;
}

__device__ __forceinline__ void xcd_barrier(const XcdBarrier& b) {
    asm volatile("s_waitcnt vmcnt(0)" ::: "memory");
    __syncthreads();
    if (threadIdx.x == 0) {
        unsigned* bar = b.bar;
        __builtin_amdgcn_s_waitcnt(0);
        unsigned nloc = b.st[0], nx = b.st[1];
        if (nloc == 0u) { xcd_barrier_complete(bar, b.x, nloc, nx); b.st[0] = nloc; b.st[1] = nx; }
        const unsigned old = xb_add(&bar[XB_XSUB(b.x)], 1u);
        const unsigned gen = old / nloc;
        if (old + 1u == (gen + 1u) * nloc) {
            __builtin_amdgcn_fence(__ATOMIC_RELEASE, "agent");
            asm volatile("s_waitcnt vmcnt(0)" ::: "memory");
            const unsigned og = xb_add(&bar[XB_TOP], 1u);
            const unsigned tg = og / nx;
            if (og + 1u == (tg + 1u) * nx) xb_add(&bar[XB_TOPGEN], 1u);
            else XB_SPIN(xb_ld(&bar[XB_TOPGEN]) == tg, bar);
            __builtin_amdgcn_fence(__ATOMIC_ACQUIRE, "agent");
            xb_add(&bar[XB_XGEN(b.x)], 1u);
            asm volatile("s_waitcnt vmcnt(0)" ::: "memory");
        } else {
            XB_SPIN(xb_ld(&bar[XB_XGEN(b.x)]) == gen, bar);
            __builtin_amdgcn_fence(__ATOMIC_ACQUIRE, "agent");
            asm volatile("s_waitcnt vmcnt(0)" ::: "memory");
        }
    }
    __syncthreads();
}

struct Args {
    const float *x, *p, *attn_norm, *w_in, *b_gate, *lam_q1, *lam_k1, *lam_q2, *lam_k2, *diff_subln, *w_o_diff, *q_norm, *w_uq, *kv_norm, *w_ukv, *w_o_mla, *w_out, *ffn_norm,
        *w_ffn_gate, *w_ffn_up, *w_ffn_down, *ple_norm, *w_ple_gate, *b_ple_gate, *w_ple, *final_norm;
    float* out; unsigned char* ws;
};

__device__ __forceinline__ float wave_sum(float v) {
#pragma unroll
    for (int o = 1; o < 64; o <<= 1) v += __shfl_xor(v, o);
    return v;
}
__device__ __forceinline__ void wprep_item(int kind, const float* W, const float* W2, int ld, int K, int Nout, const float* gain, bf16* WT, int item, LAS float* scr, int lane) {
    const int nnb = Nout / 32, kb = item / nnb, nb = item % nnb, k0 = kb * 64, n0 = nb * 32, nl = lane & 31, ks = lane >> 5, n = n0 + nl;
    const float* base = W; int col = n;
    if (kind == 1) {
        if (n < 2048) { const int hl = n & 63; col = (n & ~63) + (hl < 16 ? ((hl & 1) ? (hl >> 1) + 8 : (hl >> 1)) : hl); }
        else if (n < 3072) col = n;
        else if (n < 5120) col = 3744 + (n - 3072);
        else if (n < 5376) col = 3456 + (n - 5120);
        else if (n < 5760) col = 3072 + (n - 5376);
        else if (n < 5792) { const int hl = n - 5760; col = 3712 + ((hl & 1) ? (hl >> 1) + 16 : (hl >> 1)); }
        else col = -1;
    } else if (kind == 2) { const int h = n / 96, hl = n % 96; int s = hl; if (hl >= 64) { const int r = hl - 64; s = 64 + ((r & 1) ? (r >> 1) + 16 : (r >> 1)); } col = h * 96 + s;
    } else if (kind == 3) { const int pn = n >> 8, r = n & 255; if (r < 128) col = pn * 128 + r; else { base = W2; col = pn * 128 + (r - 128); } }
    const float* src = base + (size_t)(k0 + ks) * ld + (col >= 0 ? col : 0);
    float v[32];
#pragma unroll
    for (int i = 0; i < 32; ++i) v[i] = src[(size_t)(2 * i) * ld];
    if (col < 0) {
#pragma unroll
        for (int i = 0; i < 32; ++i) v[i] = 0.f;
    }
    if (gain) { const float* gp = gain + k0 + ks;
#pragma unroll
        for (int i = 0; i < 32; ++i) v[i] *= gp[2 * i]; }
#pragma unroll
    for (int i = 0; i < 32; ++i) scr[(2 * i + ks) * 33 + nl] = v[i];
    asm volatile("s_waitcnt lgkmcnt(0)" ::: "memory");
    const int c = lane & 7;
#pragma unroll
    for (int j = 0; j < 4; ++j) { const int nn = (lane >> 3) + 8 * j; const LAS float* s = scr + (8 * c) * 33 + nn;
        v4u o; o.x = pg8::pk2(s[0], s[33]); o.y = pg8::pk2(s[2 * 33], s[3 * 33]); o.z = pg8::pk2(s[4 * 33], s[5 * 33]); o.w = pg8::pk2(s[6 * 33], s[7 * 33]);
        *(v4u*)(WT + (size_t)(n0 + nn) * K + k0 + 8 * c) = o; }
    asm volatile("s_waitcnt lgkmcnt(0)" ::: "memory");
}

#define WSP(T, off) ((T*)(a.ws + (off)))
#define tabD WSP(float, WS_TABD)
#define tabM WSP(float, WS_TABM)
#define lamp WSP(float, WS_LAM)
#define SSQ WSP(float, WS_SSQ)
#define SSKV WSP(float, WS_SSKV)
#define SS1 WSP(float, WS_SS1)
#define SS2 WSP(float, WS_SS2)
#define SS3 WSP(float, WS_SS3)
#define Win WSP(bf16, WS_WIN)
#define Wgu WSP(bf16, WS_WGU)
#define Wdn WSP(bf16, WS_WDN)
#define Wod WSP(bf16, WS_WOD)
#define Wout WSP(bf16, WS_WOUT)
#define Wpg WSP(bf16, WS_WPG)
#define Wom WSP(bf16, WS_WOM)
#define Wuq WSP(bf16, WS_WUQ)
#define Wukv WSP(bf16, WS_WUKV)
#define Wple WSP(bf16, WS_WPLE)
#define PB WSP(bf16, WS_PB)
#define XN WSP(bf16, WS_XN)
#define QM WSP(bf16, WS_QM)
#define X1B WSP(bf16, WS_X1B)
#define QD WSP(bf16, WS_QD)
#define KD WSP(bf16, WS_KD)
#define VD WSP(bf16, WS_VD)
#define KVM WSP(bf16, WS_KVM)
#define MG WSP(bf16, WS_MG)
#define HID WSP(bf16, WS_HID)
#define X2B WSP(bf16, WS_X2B)
#define CKV WSP(bf16, WS_CKV)
#define CQ WSP(bf16, WS_CQ)
#define KR WSP(bf16, WS_KR)
#define OM WSP(bf16, WS_OM)
#define TBUF WSP(bf16, WS_T)
#define X3B WSP(bf16, WS_X3B)
#define T2B WSP(bf16, WS_T2B)
#define SA ((bf16*)a.out)
#define SB ((bf16*)a.out + (size_t)M_TOK * 1024)
template <class E> __device__ __forceinline__ void run_gemm(LAS unsigned char* lds, const bf16* A, const bf16* Bt, int N, int K, const E& e) {
    asm volatile("" : "+s"(K));
    pg8::Gemm g{A, Bt, M_TOK, N, K}; pg8::StaticOrder S; S.init(M_TOK, N, (int)gridDim.x, (int)blockIdx.x);
    pg8::gemm_phase<E, pg8::StaticOrder, true, true>(lds, g, S, e);
}

__global__ void __launch_bounds__(NWAVES * 64, 2) fwd_megakernel(Args a) {
    extern __shared__ __attribute__((aligned(16))) unsigned char lds_raw[];
    cg::grid_group grid = cg::this_grid();
    LAS unsigned char* lds = (LAS unsigned char*)lds_raw;
    int tid0_ = threadIdx.x; asm volatile("" : "+v"(tid0_)); const int tid = tid0_, lane = tid & 63, wave = __builtin_amdgcn_readfirstlane(tid >> 6);
    const int G = gridDim.x, gw = blockIdx.x * NWAVES + wave, NGW = G * NWAVES;
    volatile LAS unsigned* bst = (volatile LAS unsigned*)(lds + (LDS_BYTES - 64));
    if (tid < 2) bst[tid] = 0u;
    __syncthreads();
    const XcdBarrier xbar = xcd_barrier_post((unsigned*)(a.ws + WS_BAR), bst);
#if !defined(SKIP_P0)
    {
        LAS float* scr = (LAS float*)(lds + wave * 8448);
        constexpr int I0 = 16 * 184, I1 = I0 + 16 * 176, I2 = I1 + 44 * 32, I3 = I2 + 512, I4 = I3 + 512, I5 = I4 + 512, I6 = I5 + 256, I7 = I6 + 144, I8 = I7 + 128, I9 = I8 + 128;
        for (int it = gw; it < I9; it += NGW) {
            if (it < I0)      wprep_item(1, a.w_in, nullptr, 5792, 1024, 5888, nullptr, Win, it, scr, lane);
            else if (it < I1) wprep_item(3, a.w_ffn_gate, a.w_ffn_up, 2816, 1024, 5632, a.ffn_norm, Wgu, it - I0, scr, lane);
            else if (it < I2) wprep_item(0, a.w_ffn_down, nullptr, 1024, 2816, 1024, nullptr, Wdn, it - I1, scr, lane);
            else if (it < I3) wprep_item(0, a.w_o_diff, nullptr, 1024, 1024, 1024, nullptr, Wod, it - I2, scr, lane);
            else if (it < I4) wprep_item(0, a.w_out, nullptr, 1024, 1024, 1024, nullptr, Wout, it - I3, scr, lane);
            else if (it < I5) wprep_item(0, a.w_ple_gate, nullptr, 1024, 1024, 1024, a.ple_norm, Wpg, it - I4, scr, lane);
            else if (it < I6) wprep_item(0, a.w_o_mla, nullptr, 1024, 512, 1024, nullptr, Wom, it - I5, scr, lane);
            else if (it < I7) wprep_item(2, a.w_uq, nullptr, 768, 384, 768, a.q_norm, Wuq, it - I6, scr, lane);
            else if (it < I8) wprep_item(0, a.w_ukv, nullptr, 1024, 256, 1024, a.kv_norm, Wukv, it - I7, scr, lane);
            else              wprep_item(0, a.w_ple, nullptr, 1024, 256, 1024, nullptr, Wple, it - I8, scr, lane);
        }
        for (int r0 = gw * 4; r0 < M_TOK; r0 += NGW * 4) {
            f32x4 v[4][4]; float s[4];
#pragma unroll
            for (int q = 0; q < 4; ++q) { const f32x4* xr = (const f32x4*)(a.x + (size_t)(r0 + q) * 1024) + lane; s[q] = 0.f;
#pragma unroll
                for (int j = 0; j < 4; ++j) v[q][j] = xr[64 * j]; }
            f32x4 pq[4];
#pragma unroll
            for (int q = 0; q < 4; ++q) pq[q] = ((const f32x4*)(a.p + (size_t)(r0 + q) * 256))[lane];
#pragma unroll
            for (int q = 0; q < 4; ++q) {
#pragma unroll
                for (int j = 0; j < 4; ++j) s[q] += pg8::sq4(v[q][j]);
                const float rstd = __builtin_amdgcn_rsqf(wave_sum(s[q]) * (1.f / 1024.f) + NEPS);
                v2u* o8 = (v2u*)(XN + (size_t)(r0 + q) * 1024) + lane;
#pragma unroll
                for (int j = 0; j < 4; ++j) { const f32x4 g = ((const f32x4*)a.attn_norm)[lane + 64 * j]; const f32x4 y = v[q][j] * rstd * g; v2u w; w.x = pg8::pk2(y[0], y[1]); w.y = pg8::pk2(y[2], y[3]); o8[64 * j] = w; }
                v2u wp; wp.x = pg8::pk2(pq[q][0], pq[q][1]); wp.y = pg8::pk2(pq[q][2], pq[q][3]); ((v2u*)(PB + (size_t)(r0 + q) * 256))[lane] = wp; }
        }
        { const int gt = blockIdx.x * 512 + tid, GT = G * 512;
          for (int i = gt; i < 2048 * 24; i += GT) {
              const int pos = i / 24, f = i % 24; const bool dm = f < 8; const int fi = dm ? f : f - 8;
              const float invf = dm ? __builtin_amdgcn_exp2f(-18.931568569324174f * (float)fi * 0.125f) : __builtin_amdgcn_exp2f(-13.287712379549449f * (float)fi * 0.0625f);
              const float ang = (float)pos * invf; const double rev = (double)ang * 0.15915494309189535; const float fr = (float)(rev - floor(rev));
              const float cs = __builtin_amdgcn_cosf(fr), sn = __builtin_amdgcn_sinf(fr);
              float* dst = dm ? tabD + ((size_t)pos * 8 + fi) * 2 : tabM + ((size_t)pos * 16 + fi) * 2; dst[0] = cs; dst[1] = sn;
          }
          if (blockIdx.x == 0 && wave == 0) { const float s1 = wave_sum(a.lam_q1[lane] * a.lam_k1[lane]), s2 = wave_sum(a.lam_q2[lane] * a.lam_k2[lane]); if (lane == 0) lamp[0] = __expf(s1) - __expf(s2) + 0.2f; }
        }
    }
    xcd_barrier(xbar);
    if (a.ws == nullptr) grid.sync();
    #endif

#if !defined(SKIP_P1)
    { pg8::EpiInProj e{QD, KD, VD, SA, SB, CKV, CQ, KR, SSQ, SSKV, a.b_gate, tabD, tabM}; run_gemm(lds, XN, Win, 5888, 1024, e); }
    xcd_barrier(xbar);
    #endif

#if !defined(SKIP_P2)
    { pg8::EpiQUp e{SSQ, tabM, QM}; run_gemm(lds, CQ, Wuq, 768, 384, e); }
    { pg8::EpiKVUp e{SSKV, KVM}; run_gemm(lds, CKV, Wukv, 1024, 256, e); }
    xcd_barrier(xbar);
    #endif

#if !defined(SKIP_P3)
    {
        const float lam = lamp[0];
        for (int i = blockIdx.x; i < 2048; i += G) {
            const int type = i >> 10, rem = i & 1023, j = rem >> 8, half = (rem >> 7) & 1, bh = rem & 127;
            const int qb = half ? (j == 0 ? 6 : j == 1 ? 4 : j == 2 ? 3 : 1) : (j == 0 ? 7 : j == 1 ? 5 : j == 2 ? 2 : 0);
            if (type == 0) att::diff_unit((ATT_LAS char*)lds, bh >> 3, bh & 7, qb, QD, KD, VD, QD, a.diff_subln, lam);
            else           att::mla_unit((ATT_LAS char*)lds, bh >> 3, bh & 7, qb, QM, KVM, KR, OM);
        }
    }
    xcd_barrier(xbar);
    #endif

#if !defined(SKIP_P4)
    { pg8::EpiOutA e{SA, TBUF}; run_gemm(lds, QD, Wod, 1024, 1024, e); }
    { pg8::EpiOutB e{SB, TBUF, MG}; run_gemm(lds, OM, Wom, 1024, 512, e); }
    xcd_barrier(xbar);
    #endif

#if !defined(SKIP_P5)
    { pg8::EpiResid<false> e{a.x, X1B, SS1}; run_gemm(lds, MG, Wout, 1024, 1024, e); }
    xcd_barrier(xbar);
    #endif

#if !defined(SKIP_P6)
    { pg8::EpiSwiGLU e{SS1, HID}; run_gemm(lds, X1B, Wgu, 5632, 1024, e); }
    xcd_barrier(xbar);
    #endif

#if !defined(SKIP_P7)
    { pg8::EpiResid<true> e{X1B, X2B, SS2}; run_gemm(lds, HID, Wdn, 1024, 2816, e); }
    xcd_barrier(xbar);
    #endif

#if !defined(SKIP_P8)
    { pg8::EpiPleA e{T2B}; run_gemm(lds, PB, Wple, 1024, 256, e); }
    { pg8::EpiPleB e{SS2, a.b_ple_gate, X2B, T2B, X3B, SS3}; run_gemm(lds, X2B, Wpg, 1024, 1024, e); }
    xcd_barrier(xbar);
    #endif

#if !defined(SKIP_P9)
    { int t9_ = threadIdx.x; asm volatile("" : "+v"(t9_)); const int lane = t9_ & 63, gw = blockIdx.x * NWAVES + __builtin_amdgcn_readfirstlane(t9_ >> 6), NGW = gridDim.x * NWAVES;
    for (int r0 = gw * 4; r0 < M_TOK; r0 += NGW * 4) {
        v4u w[4][2]; float s[4];
#pragma unroll
        for (int q = 0; q < 4; ++q) { const v4u* xr = (const v4u*)(X3B + (size_t)(r0 + q) * 1024) + lane; w[q][0] = xr[0]; w[q][1] = xr[64]; s[q] = (lane < 16) ? SS3[(size_t)(r0 + q) * 16 + lane] : 0.f; }
#pragma unroll
        for (int q = 0; q < 4; ++q) { const float rstd = __builtin_amdgcn_rsqf(wave_sum(s[q]) * (1.f / 1024.f) + NEPS);
#pragma unroll
            for (int j = 0; j < 2; ++j) { const int c = (lane + 64 * j) * 8; const f32x4 g0 = *(const f32x4*)(a.final_norm + c), g1 = *(const f32x4*)(a.final_norm + c + 4); const v4u ww = w[q][j];
                f32x4 x0, x1; x0[0] = __uint_as_float(ww.x << 16); x0[1] = __uint_as_float(ww.x & 0xffff0000u); x0[2] = __uint_as_float(ww.y << 16); x0[3] = __uint_as_float(ww.y & 0xffff0000u);
                x1[0] = __uint_as_float(ww.z << 16); x1[1] = __uint_as_float(ww.z & 0xffff0000u); x1[2] = __uint_as_float(ww.w << 16); x1[3] = __uint_as_float(ww.w & 0xffff0000u);
                float* o = a.out + (size_t)(r0 + q) * 1024 + c; *(f32x4*)o = x0 * rstd * g0; *(f32x4*)(o + 4) = x1 * rstd * g1; } }
    } }
#endif
}

extern "C" void kernel_launch(void* const* d_in, const int* in_sizes, int n_in, void* d_out, int out_size, void* d_ws, size_t ws_size, hipStream_t stream) {
    static int grid = 0;
    if (grid == 0) {
        if (n_in != 26 || out_size != M_TOK * 1024 || ws_size < WS_END) { fprintf(stderr, "kernel_launch: unexpected shapes (n_in %d out %d ws %zu)\n", n_in, out_size, ws_size); grid = -1; return; }
        int dev = 0, cus = 0, per_cu = 0;
        (void)hipGetDevice(&dev); (void)hipDeviceGetAttribute(&cus, hipDeviceAttributeMultiprocessorCount, dev);
        (void)hipFuncSetAttribute((const void*)fwd_megakernel, hipFuncAttributeMaxDynamicSharedMemorySize, LDS_BYTES);
        if (hipOccupancyMaxActiveBlocksPerMultiprocessor(&per_cu, (const void*)fwd_megakernel, NWAVES * 64, LDS_BYTES) != hipSuccess || per_cu < 1) per_cu = 1;
        (void)hipGetLastError();
        grid = cus * per_cu;
    }
    if (grid < 0) return;
    Args a{};
    const float** f = (const float**)&a;
    for (int i = 0; i < 26; ++i) f[i] = (const float*)d_in[i];
    a.out = (float*)d_out; a.ws = (unsigned char*)d_ws;
    (void)hipMemsetAsync((char*)d_ws + WS_BAR, 0, 16384, stream);
    void* args[] = {&a};
    hipError_t e = hipLaunchCooperativeKernel((const void*)fwd_megakernel, dim3(grid), dim3(NWAVES * 64), args, LDS_BYTES, stream);
    if (e != hipSuccess) fprintf(stderr, "cooperative launch failed: %s (grid %d)\n", hipGetErrorString(e), grid);
}
```

```cpp
#include <hip/hip_runtime.h>
#include <hip/hip_cooperative_groups.h>
#include <cstdio>
#include <cstdint>
namespace cg = cooperative_groups;

constexpr int M_TOK = 32768, SEQ_LEN = 2048;
constexpr float NEPS = 1e-6f;
constexpr float LOG2E_F = 1.4426950408889634f;
constexpr float QS_D = 0.125f * LOG2E_F;
constexpr float QS_M = 0.10206207261596575f * LOG2E_F;
namespace pg8 {
#define PG8_LAS __attribute__((address_space(3)))
typedef unsigned short bf16_t;
typedef short bf16x8 __attribute__((ext_vector_type(8)));
typedef float f32x4 __attribute__((ext_vector_type(4)));
typedef unsigned u32x4 __attribute__((ext_vector_type(4)));
constexpr int BM = 256, BK = 64, HALF = 128, HTB = HALF * BK * 2  , STAGE_BYTES = 8 * HTB, NXCD = 8, WGM = 8;

__host__ __device__ __forceinline__ int lds_byte(int r, int c) { const int st = (r >> 4) * 2 + (c >> 5), rr = r & 15, cc = c & 31, ob = rr * 64 + cc * 2; return st * 1024 + (ob ^ (((ob >> 9) & 1) << 5)); }
__host__ __device__ __forceinline__ void stage_rc(int b, int& R, int& C) { const int st = b / 1024, sb = b % 1024, swz = sb ^ (((sb >> 9) & 1) << 5); R = (st >> 1) * 16 + swz / 64; C = (st & 1) * 32 + (swz % 64) / 2; }
__host__ __device__ __forceinline__ int perm32(int rho) { const int n = rho >> 4, i = rho & 15; return 8 * (i >> 2) + 4 * n + (i & 3); }

struct Unit { int pm, pn; };
struct Gemm { const bf16_t* A; const bf16_t* Bt; int M, N, K; };

struct StaticOrder {
    int nM, nN, nwg, G, c;
    __host__ __device__ void init(int M, int N, int G_, int c_) { nM = M / BM; nN = N / BM; nwg = nM * nN; G = G_; c = c_; }
    __host__ __device__ bool next(int i, Unit& u) const {
        const long L = (long)i * G + c; if (L >= nwg) return false;
        int wgid = (int)L; { const int q = nwg / NXCD, r = nwg % NXCD, xcd = wgid % NXCD, off = wgid / NXCD; wgid = (xcd < r ? xcd * (q + 1) : r * (q + 1) + (xcd - r) * q) + off; }
        const int nig = WGM * nN, gid = wgid / nig, fm = gid * WGM, gsz = (nM - fm) < WGM ? (nM - fm) : WGM;
        u.pm = fm + ((wgid % nig) % gsz); u.pn = (wgid % nig) / gsz; return true;
    }
    __device__ __forceinline__ void a_ready(const Unit&) const {}
    __device__ __forceinline__ void done(const Unit&) const {}
};

typedef unsigned u32x4 __attribute__((ext_vector_type(4)));
typedef unsigned u32x2 __attribute__((ext_vector_type(2)));
typedef float f32x2 __attribute__((ext_vector_type(2)));
typedef __bf16 bf16x2_t __attribute__((ext_vector_type(2)));
__device__ __forceinline__ unsigned pk2(float lo, float hi) { f32x2 v = {lo, hi}; bf16x2_t b = __builtin_convertvector(v, bf16x2_t); return __builtin_bit_cast(unsigned, b); }
__device__ __forceinline__ void st8(bf16_t* p, f32x4 a, f32x4 b) { u32x4 w; w.x = pk2(a[0], a[1]); w.y = pk2(a[2], a[3]); w.z = pk2(b[0], b[1]); w.w = pk2(b[2], b[3]); *(u32x4*)p = w; }
__device__ __forceinline__ void ld8(const bf16_t* p, f32x4& a, f32x4& b) { const u32x4 w = *(const u32x4*)p;
    a[0] = __uint_as_float(w.x << 16); a[1] = __uint_as_float(w.x & 0xffff0000u); a[2] = __uint_as_float(w.y << 16); a[3] = __uint_as_float(w.y & 0xffff0000u);
    b[0] = __uint_as_float(w.z << 16); b[1] = __uint_as_float(w.z & 0xffff0000u); b[2] = __uint_as_float(w.w << 16); b[3] = __uint_as_float(w.w & 0xffff0000u); }
__device__ __forceinline__ void up8(const u32x4 w, f32x4& a, f32x4& b) {
    a[0] = __uint_as_float(w.x << 16); a[1] = __uint_as_float(w.x & 0xffff0000u); a[2] = __uint_as_float(w.y << 16); a[3] = __uint_as_float(w.y & 0xffff0000u);
    b[0] = __uint_as_float(w.z << 16); b[1] = __uint_as_float(w.z & 0xffff0000u); b[2] = __uint_as_float(w.w << 16); b[3] = __uint_as_float(w.w & 0xffff0000u); }
__device__ __forceinline__ float sigm(float x) { return __builtin_amdgcn_rcpf(1.f + __expf(-x)); }
__device__ __forceinline__ f32x4 sigm4(f32x4 x) { f32x4 o; o[0] = sigm(x[0]); o[1] = sigm(x[1]); o[2] = sigm(x[2]); o[3] = sigm(x[3]); return o; }
__device__ __forceinline__ float quad_sum(float s) { s += __shfl_xor(s, 16); s += __shfl_xor(s, 32); return s; }
__device__ __forceinline__ float sq4(f32x4 v) { return (v[0] * v[0] + v[1] * v[1]) + (v[2] * v[2] + v[3] * v[3]); }
__device__ __forceinline__ f32x4 rope4(f32x4 v, f32x4 t) { f32x4 o; o[0] = v[0] * t[0] - v[1] * t[1]; o[1] = v[1] * t[0] + v[0] * t[1]; o[2] = v[2] * t[2] - v[3] * t[3]; o[3] = v[3] * t[2] + v[2] * t[3]; return o; }
#define EPI_FENCE() asm volatile("" ::: "memory")
#define EPI_LOOP_AM _Pragma("unroll") for (int ai = 0; ai < 2; ++ai) _Pragma("unroll") for (int m = 0; m < 4; ++m)

struct EpiInProj {
    static constexpr bool PERM = true, AFTER_DRAIN = false;
    bf16_t *QD, *KD, *VD, *SA, *SB, *CKV, *CQ, *KR; float *SSQ, *SSKV; const float* bgate; const float* tabD; const float* tabM;
    __device__ __forceinline__ void operator()(const f32x4 (&acc)[2][2][4][2], const Unit& u, int wr, int wc, int fr, int fq) const {
        const int pn = u.pn, rbase = u.pm * BM + wr * 64 + fr, lc = wc * 32 + fq * 8;
        if (pn < 8) {
            bf16_t* dst = (pn < 4 ? QD : KD) + (pn & 3) * 256 + lc; const float sc = pn < 4 ? QS_D : 1.f;
            const bool rp = ((wc & 1) == 0) && (fq < 2);
            EPI_LOOP_AM { const int row = rbase + ai * HALF + m * 16; f32x4 t0 = {1.f, 0.f, 1.f, 0.f}, t1 = t0;
                if (rp) { const f32x4* tp = (const f32x4*)(tabD + ((size_t)(row & (SEQ_LEN - 1)) * 8 + 4 * fq) * 2); t0 = tp[0]; t1 = tp[1]; }
#pragma unroll
                for (int bj = 0; bj < 2; ++bj) st8(dst + (size_t)row * 1024 + bj * HALF, rope4(acc[ai][bj][m][0], t0) * sc, rope4(acc[ai][bj][m][1], t1) * sc);
                EPI_FENCE(); }
        } else if (pn < 12) {
            bf16_t* dst = VD + (pn - 8) * 256 + lc;
            EPI_LOOP_AM { const int row = rbase + ai * HALF + m * 16;
#pragma unroll
                for (int bj = 0; bj < 2; ++bj) st8(dst + (size_t)row * 1024 + bj * HALF, acc[ai][bj][m][0], acc[ai][bj][m][1]); }
        } else if (pn < 20) {
            const int t = (pn - 12) & 3; bf16_t* dst = (pn < 16 ? SA : SB) + t * 256 + lc; const float* bp = bgate + (pn < 16 ? 0 : 1024) + t * 256 + lc;
            f32x4 b[2][2];
#pragma unroll
            for (int bj = 0; bj < 2; ++bj) { b[bj][0] = *(const f32x4*)(bp + bj * HALF); b[bj][1] = *(const f32x4*)(bp + bj * HALF + 4); }
            EPI_LOOP_AM { const int row = rbase + ai * HALF + m * 16;
#pragma unroll
                for (int bj = 0; bj < 2; ++bj) st8(dst + (size_t)row * 1024 + bj * HALF, sigm4(acc[ai][bj][m][0] + b[bj][0]), sigm4(acc[ai][bj][m][1] + b[bj][1])); }
        } else if (pn == 20) {
            EPI_LOOP_AM { const int row = rbase + ai * HALF + m * 16; float s = 0.f;
#pragma unroll
                for (int bj = 0; bj < 2; ++bj) { st8(CKV + (size_t)row * 256 + bj * HALF + lc, acc[ai][bj][m][0], acc[ai][bj][m][1]); s += sq4(acc[ai][bj][m][0]) + sq4(acc[ai][bj][m][1]); }
                s = quad_sum(s); if (fq == 0) SSKV[(size_t)row * 4 + wc] = s; }
        } else if (pn == 21) {
            EPI_LOOP_AM { const int row = rbase + ai * HALF + m * 16; float s = 0.f;
#pragma unroll
                for (int bj = 0; bj < 2; ++bj) { st8(CQ + (size_t)row * 384 + bj * HALF + lc, acc[ai][bj][m][0], acc[ai][bj][m][1]); s += sq4(acc[ai][bj][m][0]) + sq4(acc[ai][bj][m][1]); }
                s = quad_sum(s); if (fq == 0) SSQ[(size_t)row * 8 + wc] = s; }
        } else {
            EPI_LOOP_AM { const int row = rbase + ai * HALF + m * 16;
                st8(CQ + (size_t)row * 384 + 256 + lc, acc[ai][0][m][0], acc[ai][0][m][1]);
                float s = sq4(acc[ai][0][m][0]) + sq4(acc[ai][0][m][1]); s = quad_sum(s); if (fq == 0) SSQ[(size_t)row * 8 + 4 + wc] = s;
                if (wc == 0) { const f32x4* tp = (const f32x4*)(tabM + ((size_t)(row & (SEQ_LEN - 1)) * 16 + 4 * fq) * 2);
                    st8(KR + (size_t)row * 32 + fq * 8, rope4(acc[ai][1][m][0], tp[0]), rope4(acc[ai][1][m][1], tp[1])); }
                EPI_FENCE(); }
        }
    }
};
struct EpiQUp {
    static constexpr bool PERM = true, AFTER_DRAIN = false;
    const float* SSQ; const float* tabM; bf16_t* QM;
    __device__ __forceinline__ void operator()(const f32x4 (&acc)[2][2][4][2], const Unit& u, int wr, int wc, int fr, int fq) const {
        const int rbase = u.pm * BM + wr * 64 + fr, c0 = u.pn * BM + wc * 32 + fq * 8;
        const int hl0 = c0 % 96, hl1 = (c0 + HALF) % 96;
        EPI_LOOP_AM { const int row = rbase + ai * HALF + m * 16;
            const f32x4 s0 = *(const f32x4*)(SSQ + (size_t)row * 8), s1 = *(const f32x4*)(SSQ + (size_t)row * 8 + 4);
            const float rstd = __builtin_amdgcn_rsqf(((s0[0] + s0[1]) + (s0[2] + s0[3]) + (s1[0] + s1[1]) + (s1[2] + s1[3])) * (1.f / 384.f) + NEPS) * QS_M;
            const float* tb = tabM + (size_t)(row & (SEQ_LEN - 1)) * 32;
#pragma unroll
            for (int bj = 0; bj < 2; ++bj) { const int hl = bj ? hl1 : hl0; const bool rp = hl >= 64; const f32x4 id = {1.f, 0.f, 1.f, 0.f};
                const f32x4* tp = (const f32x4*)(tb + (rp ? hl - 64 : 0)); const f32x4 t0 = rp ? tp[0] : id, t1 = rp ? tp[1] : id;
                st8(QM + (size_t)row * 768 + c0 + bj * HALF, rope4(acc[ai][bj][m][0] * rstd, t0), rope4(acc[ai][bj][m][1] * rstd, t1)); EPI_FENCE(); }
            }
    }
};
struct EpiKVUp {
    static constexpr bool PERM = true, AFTER_DRAIN = false;
    const float* SSKV; bf16_t* KVM;
    __device__ __forceinline__ void operator()(const f32x4 (&acc)[2][2][4][2], const Unit& u, int wr, int wc, int fr, int fq) const {
        const int rbase = u.pm * BM + wr * 64 + fr, c0 = u.pn * BM + wc * 32 + fq * 8;
        EPI_LOOP_AM { const int row = rbase + ai * HALF + m * 16;
            const f32x4 s0 = *(const f32x4*)(SSKV + (size_t)row * 4);
            const float rstd = __builtin_amdgcn_rsqf(((s0[0] + s0[1]) + (s0[2] + s0[3])) * (1.f / 256.f) + NEPS);
#pragma unroll
            for (int bj = 0; bj < 2; ++bj) st8(KVM + (size_t)row * 1024 + c0 + bj * HALF, acc[ai][bj][m][0] * rstd, acc[ai][bj][m][1] * rstd);
            EPI_FENCE(); }
    }
};
struct EpiOutA {
    static constexpr bool PERM = true, AFTER_DRAIN = false;
    const bf16_t* SA; bf16_t* T;
    __device__ __forceinline__ void operator()(const f32x4 (&acc)[2][2][4][2], const Unit& u, int wr, int wc, int fr, int fq) const {
        const int rbase = u.pm * BM + wr * 64 + fr, c0 = u.pn * BM + wc * 32 + fq * 8;
#pragma unroll
        for (int ai = 0; ai < 2; ++ai) { u32x4 g[4][2];
#pragma unroll
            for (int m = 0; m < 4; ++m)
#pragma unroll
                for (int bj = 0; bj < 2; ++bj) g[m][bj] = *(const u32x4*)(SA + (size_t)(rbase + ai * HALF + m * 16) * 1024 + c0 + bj * HALF);
            EPI_FENCE();
#pragma unroll
            for (int m = 0; m < 4; ++m)
#pragma unroll
                for (int bj = 0; bj < 2; ++bj) { f32x4 g0, g1; up8(g[m][bj], g0, g1); st8(T + (size_t)(rbase + ai * HALF + m * 16) * 1024 + c0 + bj * HALF, acc[ai][bj][m][0] * g0, acc[ai][bj][m][1] * g1); }
            EPI_FENCE(); }
    }
};
struct EpiOutB {
    static constexpr bool PERM = true, AFTER_DRAIN = false;
    const bf16_t* SB; const bf16_t* T; bf16_t* MG;
    __device__ __forceinline__ void operator()(const f32x4 (&acc)[2][2][4][2], const Unit& u, int wr, int wc, int fr, int fq) const {
        const int rbase = u.pm * BM + wr * 64 + fr, c0 = u.pn * BM + wc * 32 + fq * 8;
#pragma unroll
        for (int ai = 0; ai < 2; ++ai) { u32x4 g[4][2], t[4][2];
#pragma unroll
            for (int m = 0; m < 4; ++m)
#pragma unroll
                for (int bj = 0; bj < 2; ++bj) { const size_t o = (size_t)(rbase + ai * HALF + m * 16) * 1024 + c0 + bj * HALF; g[m][bj] = *(const u32x4*)(SB + o); t[m][bj] = *(const u32x4*)(T + o); }
            EPI_FENCE();
#pragma unroll
            for (int m = 0; m < 4; ++m)
#pragma unroll
                for (int bj = 0; bj < 2; ++bj) { f32x4 g0, g1, t0, t1; up8(g[m][bj], g0, g1); up8(t[m][bj], t0, t1);
                    st8(MG + (size_t)(rbase + ai * HALF + m * 16) * 1024 + c0 + bj * HALF, t0 + acc[ai][bj][m][0] * g0, t1 + acc[ai][bj][m][1] * g1); }
            EPI_FENCE(); }
    }
};
template <bool RES_BF16> struct EpiResid {
    static constexpr bool PERM = true, AFTER_DRAIN = false;
    const void* res; bf16_t* xb; float* SS;
    __device__ __forceinline__ void operator()(const f32x4 (&acc)[2][2][4][2], const Unit& u, int wr, int wc, int fr, int fq) const {
        const int rbase = u.pm * BM + wr * 64 + fr, c0 = u.pn * BM + wc * 32 + fq * 8;
        if constexpr (RES_BF16) {
#pragma unroll
            for (int ai = 0; ai < 2; ++ai) { u32x4 r[4][2];
#pragma unroll
                for (int m = 0; m < 4; ++m)
#pragma unroll
                    for (int bj = 0; bj < 2; ++bj) r[m][bj] = *(const u32x4*)((const bf16_t*)res + (size_t)(rbase + ai * HALF + m * 16) * 1024 + c0 + bj * HALF);
                EPI_FENCE();
#pragma unroll
                for (int m = 0; m < 4; ++m) { const int row = rbase + ai * HALF + m * 16; float s = 0.f;
#pragma unroll
                    for (int bj = 0; bj < 2; ++bj) { f32x4 r0, r1; up8(r[m][bj], r0, r1); const f32x4 v0 = r0 + acc[ai][bj][m][0], v1 = r1 + acc[ai][bj][m][1];
                        st8(xb + (size_t)row * 1024 + c0 + bj * HALF, v0, v1); s += sq4(v0) + sq4(v1); }
                    s = quad_sum(s); if (fq == 0) SS[(size_t)row * 16 + u.pn * 4 + wc] = s; }
                EPI_FENCE(); }
        } else {
#pragma unroll
            for (int ai = 0; ai < 2; ++ai)
#pragma unroll
                for (int mp = 0; mp < 2; ++mp) { f32x4 r[2][2][2];
#pragma unroll
                    for (int mm = 0; mm < 2; ++mm)
#pragma unroll
                        for (int bj = 0; bj < 2; ++bj) { const float* p = (const float*)res + (size_t)(rbase + ai * HALF + (2 * mp + mm) * 16) * 1024 + c0 + bj * HALF; r[mm][bj][0] = *(const f32x4*)p; r[mm][bj][1] = *(const f32x4*)(p + 4); }
                    EPI_FENCE();
#pragma unroll
                    for (int mm = 0; mm < 2; ++mm) { const int m = 2 * mp + mm, row = rbase + ai * HALF + m * 16; float s = 0.f;
#pragma unroll
                        for (int bj = 0; bj < 2; ++bj) { const f32x4 v0 = r[mm][bj][0] + acc[ai][bj][m][0], v1 = r[mm][bj][1] + acc[ai][bj][m][1];
                            st8(xb + (size_t)row * 1024 + c0 + bj * HALF, v0, v1); s += sq4(v0) + sq4(v1); }
                        s = quad_sum(s); if (fq == 0) SS[(size_t)row * 16 + u.pn * 4 + wc] = s; }
                    EPI_FENCE(); }
        }
    }
};
__device__ __forceinline__ float rstd16(const float* ss) { const f32x4 a = *(const f32x4*)ss, b = *(const f32x4*)(ss + 4), c = *(const f32x4*)(ss + 8), d = *(const f32x4*)(ss + 12);
    const f32x4 t = (a + b) + (c + d); return __builtin_amdgcn_rsqf(((t[0] + t[1]) + (t[2] + t[3])) * (1.f / 1024.f) + NEPS); }
struct EpiSwiGLU {
    static constexpr bool PERM = true, AFTER_DRAIN = false;
    const float* SS; bf16_t* HID;
    __device__ __forceinline__ void operator()(const f32x4 (&acc)[2][2][4][2], const Unit& u, int wr, int wc, int fr, int fq) const {
        const int rbase = u.pm * BM + wr * 64 + fr, c0 = u.pn * HALF + wc * 32 + fq * 8;
        EPI_LOOP_AM { const int row = rbase + ai * HALF + m * 16; const float rstd = rstd16(SS + (size_t)row * 16);
            const f32x4 g0 = acc[ai][0][m][0] * rstd, g1 = acc[ai][0][m][1] * rstd, u0 = acc[ai][1][m][0] * rstd, u1 = acc[ai][1][m][1] * rstd;
            st8(HID + (size_t)row * 2816 + c0, g0 * sigm4(g0) * u0, g1 * sigm4(g1) * u1);
            EPI_FENCE(); }
    }
};
struct EpiPleA {
    static constexpr bool PERM = true, AFTER_DRAIN = false;
    bf16_t* T;
    __device__ __forceinline__ void operator()(const f32x4 (&acc)[2][2][4][2], const Unit& u, int wr, int wc, int fr, int fq) const {
        const int rbase = u.pm * BM + wr * 64 + fr, c0 = u.pn * BM + wc * 32 + fq * 8;
        EPI_LOOP_AM { const int row = rbase + ai * HALF + m * 16;
#pragma unroll
            for (int bj = 0; bj < 2; ++bj) st8(T + (size_t)row * 1024 + c0 + bj * HALF, acc[ai][bj][m][0], acc[ai][bj][m][1]); }
    }
};
struct EpiPleB {
    static constexpr bool PERM = true, AFTER_DRAIN = false;
    const float* SS2; const float* bias; const bf16_t* X2; const bf16_t* T2; bf16_t* X3; float* SS3;
    __device__ __forceinline__ void operator()(const f32x4 (&acc)[2][2][4][2], const Unit& u, int wr, int wc, int fr, int fq) const {
        const int rbase = u.pm * BM + wr * 64 + fr, c0 = u.pn * BM + wc * 32 + fq * 8;
#pragma unroll
        for (int ai = 0; ai < 2; ++ai)
#pragma unroll
          for (int mp = 0; mp < 2; ++mp) { u32x4 x[2][2], t[2][2]; float rs[2];
#pragma unroll
            for (int mm = 0; mm < 2; ++mm) { const int row = rbase + ai * HALF + (2 * mp + mm) * 16;
#pragma unroll
                for (int bj = 0; bj < 2; ++bj) { const size_t o = (size_t)row * 1024 + c0 + bj * HALF; x[mm][bj] = *(const u32x4*)(X2 + o); t[mm][bj] = *(const u32x4*)(T2 + o); }
                rs[mm] = rstd16(SS2 + (size_t)row * 16); }
            EPI_FENCE();
#pragma unroll
            for (int mm = 0; mm < 2; ++mm) { const int m = 2 * mp + mm, row = rbase + ai * HALF + m * 16; float s = 0.f;
#pragma unroll
                for (int bj = 0; bj < 2; ++bj) { const f32x4 b0 = *(const f32x4*)(bias + c0 + bj * HALF), b1 = *(const f32x4*)(bias + c0 + bj * HALF + 4);
                    f32x4 x0, x1, t0, t1; up8(x[mm][bj], x0, x1); up8(t[mm][bj], t0, t1);
                    const f32x4 v0 = x0 + t0 * sigm4(acc[ai][bj][m][0] * rs[mm] + b0), v1 = x1 + t1 * sigm4(acc[ai][bj][m][1] * rs[mm] + b1);
                    st8(X3 + (size_t)row * 1024 + c0 + bj * HALF, v0, v1); s += sq4(v0) + sq4(v1); }
                s = quad_sum(s); if (fq == 0) SS3[(size_t)row * 16 + u.pn * 4 + wc] = s; }
            EPI_FENCE(); }
    }
};
template <class Epi, class Sched, bool ALIGN_EPI = false, bool SP2 = false>
__device__ __forceinline__ void gemm_phase(PG8_LAS unsigned char* lds, const Gemm g, const Sched& S, const Epi& E) {
    int tid_ = threadIdx.x; asm volatile("" : "+v"(tid_)); const int tid = tid_, wid = __builtin_amdgcn_readfirstlane(tid >> 6), lane = tid & 63, wr = wid >> 2, wc = wid & 3, fr = lane & 15, fq = lane >> 4;
    const int K = g.K, nt = K / BK;
    unsigned voffA[2], voffB[2];
#pragma unroll
    for (int i = 0; i < 2; ++i) { int R, C; stage_rc(tid * 16 + i * 8192, R, C); const int Rb = Epi::PERM ? ((R & ~31) + perm32(R & 31)) : R;
        voffA[i] = (unsigned)(R * K + C) * 2u; voffB[i] = (unsigned)(Rb * K + C) * 2u; }
    const size_t kstep = (size_t)(BK * 2);
    const size_t hstep = (size_t)HALF * K * 2;
    const size_t tstep = 2 * hstep;
    const unsigned ldsw = (unsigned)wid * 1024u;
    const int aoff = lds_byte(wr * 64 + fr, fq * 8), boff = lds_byte(wc * 32 + fr, fq * 8);
#define PG8_SA(b, h) (((b) * 2 + (h)) * HTB)
#define PG8_SB(b, h) ((4 + (b) * 2 + (h)) * HTB)
#define PG8_STAGE(bufoff, gbase, voff) do { _Pragma("unroll") for (int _i = 0; _i < 2; ++_i) \
        __builtin_amdgcn_global_load_lds((const unsigned*)((const char*)(gbase) + (voff)[_i]), (PG8_LAS unsigned*)(lds + (bufoff) + ldsw + _i * 8192), 16, 0, 0); } while (0)
#define PG8_LDA(dst, b, h) do { _Pragma("unroll") for (int m = 0; m < 4; ++m) _Pragma("unroll") for (int k = 0; k < 2; ++k) dst[m][k] = *(const PG8_LAS bf16x8*)(lds + PG8_SA(b, h) + aoff + m * 2048 + k * 1024); } while (0)
#define PG8_LDB(dst, b, h) do { _Pragma("unroll") for (int n = 0; n < 2; ++n) _Pragma("unroll") for (int k = 0; k < 2; ++k) dst[n][k] = *(const PG8_LAS bf16x8*)(lds + PG8_SB(b, h) + boff + n * 2048 + k * 1024); } while (0)
#define PG8_MMA(ai, bj, At, Bt) do { __builtin_amdgcn_s_setprio(1); _Pragma("unroll") for (int m = 0; m < 4; ++m) _Pragma("unroll") for (int n = 0; n < 2; ++n) _Pragma("unroll") for (int k = 0; k < 2; ++k) \
        acc[ai][bj][m][n] = __builtin_amdgcn_mfma_f32_16x16x32_bf16(Bt[n][k], At[m][k], acc[ai][bj][m][n], 0, 0, 0); __builtin_amdgcn_s_setprio(0); } while (0)
#define PG8_WAIT_V(n) asm volatile("s_waitcnt vmcnt(" #n ")" ::: "memory")
#define PG8_WAIT_L(n) asm volatile("s_waitcnt lgkmcnt(" #n ")" ::: "memory")
#define PG8_BAR __builtin_amdgcn_s_barrier()
#define PG8_SCHED __builtin_amdgcn_sched_barrier(0)
    Unit cur, nxt; int ui = 0;
    if (!S.next(0, cur)) return;
    f32x4 acc[2][2][4][2];
#pragma unroll
    for (int a = 0; a < 2; ++a)
#pragma unroll
        for (int b = 0; b < 2; ++b)
#pragma unroll
            for (int m = 0; m < 4; ++m)
#pragma unroll
                for (int n = 0; n < 2; ++n) acc[a][b][m][n] = (f32x4){0.f, 0.f, 0.f, 0.f};
    bf16x8 At[4][2], B0[2][2], B1[2][2];
    const char* cA = (const char*)g.A + (size_t)cur.pm * tstep; const char* cB = (const char*)g.Bt + (size_t)cur.pn * tstep;
    S.a_ready(cur);
    if constexpr (SP2) {
        PG8_STAGE(PG8_SB(0, 0), cB, voffB); PG8_STAGE(PG8_SB(0, 1), cB + hstep, voffB); PG8_STAGE(PG8_SA(0, 0), cA, voffA); PG8_STAGE(PG8_SA(0, 1), cA + hstep, voffA);
        if (wr == 1) PG8_BAR;
        PG8_WAIT_V(2); PG8_BAR;
        PG8_STAGE(PG8_SB(1, 0), cB + kstep, voffB); PG8_STAGE(PG8_SA(1, 0), cA + kstep, voffA); PG8_STAGE(PG8_SB(1, 1), cB + hstep + kstep, voffB);
        PG8_WAIT_V(6); PG8_BAR;
    } else {
        PG8_STAGE(PG8_SB(0, 0), cB, voffB); PG8_STAGE(PG8_SA(0, 0), cA, voffA); PG8_STAGE(PG8_SB(0, 1), cB + hstep, voffB); PG8_STAGE(PG8_SA(0, 1), cA + hstep, voffA);
        if (wr == 1) PG8_BAR;
        PG8_WAIT_V(4); PG8_BAR;
        PG8_STAGE(PG8_SB(1, 0), cB + kstep, voffB); PG8_STAGE(PG8_SA(1, 0), cA + kstep, voffA); PG8_STAGE(PG8_SB(1, 1), cB + hstep + kstep, voffB);
        PG8_WAIT_V(6); PG8_BAR;
    }
    for (;;) {
        const bool has_next = S.next(ui + 1, nxt);
        const char* nA = has_next ? (const char*)g.A + (size_t)nxt.pm * tstep : cA; const char* nB = has_next ? (const char*)g.Bt + (size_t)nxt.pn * tstep : cB;
        for (int t = 0; t < nt; t += 2) {
            const bool last = (t == nt - 2);
            const char* a1 = cA + (size_t)(t + 1) * kstep;
            const char* a2 = last ? nA : cA + (size_t)(t + 2) * kstep; const char* b2 = last ? nB : cB + (size_t)(t + 2) * kstep;
            const char* a3 = a2 + kstep; const char* b3 = b2 + kstep;
            if (last && has_next) S.a_ready(nxt);
            if constexpr (SP2) {
            PG8_LDB(B0, 0, 0); PG8_LDB(B1, 0, 1); PG8_SCHED; PG8_LDA(At, 0, 0); PG8_STAGE(PG8_SA(1, 1), a1 + hstep, voffA);
            PG8_WAIT_V(8); PG8_WAIT_L(0); PG8_BAR; PG8_MMA(0, 0, At, B0); PG8_MMA(0, 1, At, B1); PG8_BAR; PG8_SCHED;
            PG8_LDA(At, 0, 1); PG8_STAGE(PG8_SB(0, 0), b2, voffB); PG8_STAGE(PG8_SB(0, 1), b2 + hstep, voffB); PG8_STAGE(PG8_SA(0, 0), a2, voffA);
            PG8_WAIT_V(8); PG8_WAIT_L(0); PG8_BAR; PG8_MMA(1, 0, At, B0); PG8_MMA(1, 1, At, B1); PG8_BAR; PG8_SCHED;
            PG8_LDB(B0, 1, 0); PG8_LDB(B1, 1, 1); PG8_SCHED; PG8_LDA(At, 1, 0); PG8_STAGE(PG8_SA(0, 1), a2 + hstep, voffA);
            PG8_WAIT_V(8); PG8_WAIT_L(0); PG8_BAR; PG8_MMA(0, 0, At, B0); PG8_MMA(0, 1, At, B1); PG8_BAR; PG8_SCHED;
            PG8_LDA(At, 1, 1); PG8_STAGE(PG8_SB(1, 0), b3, voffB); PG8_STAGE(PG8_SB(1, 1), b3 + hstep, voffB); PG8_STAGE(PG8_SA(1, 0), a3, voffA);
            PG8_WAIT_V(8); PG8_WAIT_L(0); PG8_BAR; PG8_MMA(1, 0, At, B0); PG8_MMA(1, 1, At, B1); PG8_BAR; PG8_SCHED;
            } else {
            PG8_LDB(B0, 0, 0); PG8_SCHED; PG8_LDA(At, 0, 0); PG8_STAGE(PG8_SA(1, 1), a1 + hstep, voffA);
            PG8_WAIT_L(8); PG8_BAR; PG8_WAIT_L(0); PG8_MMA(0, 0, At, B0); PG8_BAR; PG8_SCHED;
            PG8_LDB(B1, 0, 1); PG8_STAGE(PG8_SB(0, 0), b2, voffB);
            PG8_BAR; PG8_WAIT_L(0); PG8_MMA(0, 1, At, B1); PG8_BAR;
            PG8_LDA(At, 0, 1); PG8_STAGE(PG8_SA(0, 0), a2, voffA);
            PG8_BAR; PG8_WAIT_L(0); PG8_MMA(1, 0, At, B0); PG8_BAR; PG8_SCHED;
            PG8_STAGE(PG8_SB(0, 1), b2 + hstep, voffB);
            PG8_WAIT_V(6); PG8_BAR; PG8_MMA(1, 1, At, B1); PG8_BAR;
            PG8_LDB(B0, 1, 0); PG8_SCHED; PG8_LDA(At, 1, 0); PG8_STAGE(PG8_SA(0, 1), a2 + hstep, voffA);
            PG8_WAIT_L(8); PG8_BAR; PG8_WAIT_L(0); PG8_MMA(0, 0, At, B0); PG8_BAR; PG8_SCHED;
            PG8_LDB(B1, 1, 1); PG8_STAGE(PG8_SB(1, 0), b3, voffB);
            PG8_BAR; PG8_WAIT_L(0); PG8_MMA(0, 1, At, B1); PG8_BAR;
            PG8_LDA(At, 1, 1); PG8_STAGE(PG8_SA(1, 0), a3, voffA);
            PG8_BAR; PG8_WAIT_L(0); PG8_MMA(1, 0, At, B0); PG8_BAR; PG8_SCHED;
            PG8_STAGE(PG8_SB(1, 1), b3 + hstep, voffB);
            PG8_WAIT_V(6); PG8_BAR; PG8_MMA(1, 1, At, B1); PG8_BAR;
            }
        }
        if constexpr (ALIGN_EPI) { if (wr == 0) PG8_BAR; }
        if constexpr (!Epi::AFTER_DRAIN) { E(acc, cur, wr, wc, fr, fq); S.done(cur); }
        if (!has_next) break;
#pragma unroll
        for (int a = 0; a < 2; ++a)
#pragma unroll
            for (int b = 0; b < 2; ++b)
#pragma unroll
                for (int m = 0; m < 4; ++m)
#pragma unroll
                    for (int n = 0; n < 2; ++n) acc[a][b][m][n] = (f32x4){0.f, 0.f, 0.f, 0.f};
        cur = nxt; cA = nA; cB = nB; ++ui;
        if constexpr (ALIGN_EPI) { if (wr == 1) PG8_BAR; }
    }
    PG8_WAIT_V(0);
    if constexpr (!ALIGN_EPI) { if (wr == 0) PG8_BAR; }
    PG8_BAR;
    if constexpr (Epi::AFTER_DRAIN) { E.fused(acc, cur, wr, wc, fr, fq, lds, wid, lane); S.done(cur); }
#undef PG8_SA
#undef PG8_SB
#undef PG8_STAGE
#undef PG8_LDA
#undef PG8_LDB
#undef PG8_MMA
#undef PG8_WAIT_V
#undef PG8_WAIT_L
#undef PG8_BAR
#undef PG8_SCHED
}
}
namespace att {
#define ATT_LAS __attribute__((address_space(3)))
typedef unsigned short bf16_t;
typedef short bf16x8 __attribute__((ext_vector_type(8)));
typedef short s16x4 __attribute__((ext_vector_type(4)));
typedef float f32x16 __attribute__((ext_vector_type(16)));
typedef float f32x4 __attribute__((ext_vector_type(4)));
typedef unsigned u32x4 __attribute__((ext_vector_type(4)));
typedef unsigned u32x2 __attribute__((ext_vector_type(2)));
constexpr int KB0 = 0, KBSZ = 12288, VB0 = 24576, VBSZ = 16384;
__device__ __forceinline__ float swap_max(float m) { auto rr = __builtin_amdgcn_permlane32_swap(__float_as_uint(m), __float_as_uint(m), false, false); return fmaxf(__uint_as_float(rr[0]), __uint_as_float(rr[1])); }
__device__ __forceinline__ float swap_sum(float m) { auto rr = __builtin_amdgcn_permlane32_swap(__float_as_uint(m), __float_as_uint(m), false, false); return __uint_as_float(rr[0]) + __uint_as_float(rr[1]); }
__device__ __forceinline__ s16x4 vtr(const ATT_LAS char* p) { return __builtin_bit_cast(s16x4, __builtin_amdgcn_ds_read_tr16_b64_v4i16((ATT_LAS s16x4*)p)); }
__device__ __forceinline__ float max3f(float a, float b, float c) { float r; asm("v_max3_f32 %0, %1, %2, %3" : "=v"(r) : "v"(a), "v"(b), "v"(c)); return r; }
__device__ __forceinline__ int crow(int r, int hi) { return (r & 3) + 8 * (r >> 2) + 4 * hi; }

template <int DQK, int DV, bool MLA>
__device__ __forceinline__ void attn_pass(ATT_LAS char* lds, const bf16_t* qp, const bf16_t* kg, const bf16_t* krg, const bf16_t* vg, int NT, int myNT, f32x16 (&o)[DV / 32], float& linv) {
    int tid_ = threadIdx.x; asm volatile("" : "+v"(tid_)); const int tid = tid_, lane = tid & 63, wid = __builtin_amdgcn_readfirstlane(tid >> 6), r32 = lane & 31, hi = lane >> 5;
    bf16x8 qr[DQK / 16];
#pragma unroll
    for (int d0 = 0; d0 < DQK / 16; ++d0) qr[d0] = *(const bf16x8*)(qp + d0 * 16);
    const bf16_t* ksrc = kg + (size_t)lane * 1024 + wid * 8;
    const bf16_t* krsrc = krg + (size_t)lane * 32 + (wid & 3) * 8;
    const bf16_t* vsrc = vg + (size_t)(16 * (wid & 3) + (lane >> 2)) * 1024 + (wid >> 2) * 32 + (lane & 3) * 8;
    const int sto = wid * 1024 + lane * 16;
    u32x4 kr0 = {0u, 0u, 0u, 0u}, kr1 = kr0, vr0 = kr0, vr1 = kr0;
#define ATT_LOAD(t) do { kr0 = *(const u32x4*)(ksrc + (size_t)(t) * 65536); if (MLA) { if (wid < 4) kr1 = *(const u32x4*)(krsrc + (size_t)(t) * 2048); } \
        vr0 = *(const u32x4*)(vsrc + (size_t)(t) * 65536); if (DV == 128) vr1 = *(const u32x4*)(vsrc + (size_t)(t) * 65536 + 64); } while (0)
#define ATT_STORE(b) do { *(ATT_LAS u32x4*)(lds + KB0 + (b) * KBSZ + sto) = kr0; if (MLA) { if (wid < 4) *(ATT_LAS u32x4*)(lds + KB0 + (b) * KBSZ + 8192 + sto) = kr1; } \
        *(ATT_LAS u32x4*)(lds + VB0 + (b) * VBSZ + sto) = vr0; if (DV == 128) *(ATT_LAS u32x4*)(lds + VB0 + (b) * VBSZ + 8192 + sto) = vr1; } while (0)
#pragma unroll
    for (int i = 0; i < DV / 32; ++i)
#pragma unroll
        for (int r = 0; r < 16; ++r) o[i][r] = 0.f;
    float mref = 0.f, lsum = 0.f;
    ATT_LOAD(0); ATT_STORE(0); __syncthreads();
    for (int t = 0; t < NT; ++t) {
        const int b = t & 1;
        if (t + 1 < NT) ATT_LOAD(t + 1);
        if (t < myNT) {
            const ATT_LAS char* kp = lds + KB0 + b * KBSZ + hi * 1024 + r32 * 16;
            f32x16 p0, p1;
#pragma unroll
            for (int r = 0; r < 16; ++r) { p0[r] = -mref; p1[r] = -mref; }
#pragma unroll
            for (int d0 = 0; d0 < DQK / 16; ++d0) {
                const bf16x8 k0 = *(const ATT_LAS bf16x8*)(kp + d0 * 2048), k1 = *(const ATT_LAS bf16x8*)(kp + d0 * 2048 + 512);
                p0 = __builtin_amdgcn_mfma_f32_32x32x16_bf16(k0, qr[d0], p0, 0, 0, 0);
                p1 = __builtin_amdgcn_mfma_f32_32x32x16_bf16(k1, qr[d0], p1, 0, 0, 0);
            }
            asm volatile("s_nop 15\n\ts_nop 7" : "+v"(p0), "+v"(p1));
            float mxa = max3f(p0[0], p0[1], p1[0]), mxb = max3f(p0[2], p0[3], p1[1]); mxa = max3f(mxa, p1[2], p1[3]);
#pragma unroll
            for (int r = 4; r < 16; r += 4) { mxa = max3f(mxa, p0[r], p0[r + 1]); mxb = max3f(mxb, p0[r + 2], p0[r + 3]); mxa = max3f(mxa, p1[r], p1[r + 1]); mxb = max3f(mxb, p1[r + 2], p1[r + 3]); }
            float mx = swap_max(max3f(mxa, mxb, mxb));
            if (__any(mx > 8.f)) {
                const float dl = fmaxf(mx, 0.f), al = __builtin_amdgcn_exp2f(-dl);
                lsum *= al;
#pragma unroll
                for (int i = 0; i < DV / 32; ++i)
#pragma unroll
                    for (int r = 0; r < 16; ++r) o[i][r] *= al;
#pragma unroll
                for (int r = 0; r < 16; ++r) { p0[r] -= dl; p1[r] -= dl; }
                mref += dl;
            }
            float ls = 0.f;
#pragma unroll
            for (int r = 0; r < 16; ++r) { p0[r] = __builtin_amdgcn_exp2f(p0[r]); p1[r] = __builtin_amdgcn_exp2f(p1[r]); ls += p0[r] + p1[r]; }
            lsum += ls;
            u32x4 pw[4];
#pragma unroll
            for (int j = 0; j < 4; ++j) { pw[0][j] = pg8::pk2(p0[2 * j], p0[2 * j + 1]); pw[1][j] = pg8::pk2(p0[8 + 2 * j], p0[9 + 2 * j]); pw[2][j] = pg8::pk2(p1[2 * j], p1[2 * j + 1]); pw[3][j] = pg8::pk2(p1[8 + 2 * j], p1[9 + 2 * j]); }
            const ATT_LAS char* vp = lds + VB0 + b * VBSZ + ((lane >> 4) & 1) * 32 + (lane & 3) * 8 + (4 * hi + ((lane & 15) >> 2)) * 64;
#pragma unroll
            for (int i = 0; i < DV / 32; ++i)
#pragma unroll
                for (int ks = 0; ks < 4; ++ks) {
                    const s16x4 lo = vtr(vp + i * 4096 + ks * 1024), hh = vtr(vp + i * 4096 + ks * 1024 + 512);
                    const bf16x8 vf = {lo[0], lo[1], lo[2], lo[3], hh[0], hh[1], hh[2], hh[3]};
                    o[i] = __builtin_amdgcn_mfma_f32_32x32x16_bf16(vf, __builtin_bit_cast(bf16x8, pw[ks]), o[i], 0, 0, 0);
                }
        }
        if (t + 1 < NT) ATT_STORE(b ^ 1);
        __syncthreads();
    }
    linv = __builtin_amdgcn_rcpf(swap_sum(lsum));
#undef ATT_LOAD
#undef ATT_STORE
}

__device__ __forceinline__ void qk_softmax64(const ATT_LAS char* kbuf, const ATT_LAS char* qimg, float& mref, float& lsum, f32x16 (&o)[4], u32x4 (&pw)[4], int r32, int hi) {
    const ATT_LAS char* kp = kbuf + hi * 1024 + r32 * 16;
    f32x16 p0, p1;
#pragma unroll
    for (int r = 0; r < 16; ++r) { p0[r] = -mref; p1[r] = -mref; }
#pragma unroll
    for (int d0 = 0; d0 < 4; ++d0) {
        const bf16x8 k0 = *(const ATT_LAS bf16x8*)(kp + d0 * 2048), k1 = *(const ATT_LAS bf16x8*)(kp + d0 * 2048 + 512), q = *(const ATT_LAS bf16x8*)(qimg + d0 * 1024);
        p0 = __builtin_amdgcn_mfma_f32_32x32x16_bf16(k0, q, p0, 0, 0, 0);
        p1 = __builtin_amdgcn_mfma_f32_32x32x16_bf16(k1, q, p1, 0, 0, 0);
    }
    asm volatile("s_nop 15\n\ts_nop 7" : "+v"(p0), "+v"(p1));
    float mxa = max3f(p0[0], p0[1], p1[0]), mxb = max3f(p0[2], p0[3], p1[1]); mxa = max3f(mxa, p1[2], p1[3]);
#pragma unroll
    for (int r = 4; r < 16; r += 4) { mxa = max3f(mxa, p0[r], p0[r + 1]); mxb = max3f(mxb, p0[r + 2], p0[r + 3]); mxa = max3f(mxa, p1[r], p1[r + 1]); mxb = max3f(mxb, p1[r + 2], p1[r + 3]); }
    const float mx = swap_max(max3f(mxa, mxb, mxb));
    if (__any(mx > 8.f)) {
        const float dl = fmaxf(mx, 0.f), al = __builtin_amdgcn_exp2f(-dl);
        lsum *= al;
#pragma unroll
        for (int i = 0; i < 4; ++i)
#pragma unroll
            for (int r = 0; r < 16; ++r) o[i][r] *= al;
#pragma unroll
        for (int r = 0; r < 16; ++r) { p0[r] -= dl; p1[r] -= dl; }
        mref += dl;
    }
    float ls = 0.f;
#pragma unroll
    for (int r = 0; r < 16; ++r) { p0[r] = __builtin_amdgcn_exp2f(p0[r]); p1[r] = __builtin_amdgcn_exp2f(p1[r]); ls += p0[r] + p1[r]; }
    lsum += ls;
#pragma unroll
    for (int j = 0; j < 4; ++j) { pw[0][j] = pg8::pk2(p0[2 * j], p0[2 * j + 1]); pw[1][j] = pg8::pk2(p0[8 + 2 * j], p0[9 + 2 * j]); pw[2][j] = pg8::pk2(p1[2 * j], p1[2 * j + 1]); pw[3][j] = pg8::pk2(p1[8 + 2 * j], p1[9 + 2 * j]); }
}
__device__ __forceinline__ void diff_unit(ATT_LAS char* lds, int b, int h, int qb, const bf16_t* QD, const bf16_t* KD, const bf16_t* VD, bf16_t* OD, const float* subln, float lam) {
    int tid_ = threadIdx.x; asm volatile("" : "+v"(tid_)); const int tid = tid_, lane = tid & 63, wid = __builtin_amdgcn_readfirstlane(tid >> 6), r32 = lane & 31, hi = lane >> 5;
    const size_t row0 = (size_t)b * SEQ_LEN, qrow = row0 + qb * 256 + wid * 32 + r32;
    const int NT = 4 * qb + 4, myNT = 4 * qb + (wid >> 1) + 1;
    constexpr int DKB0 = 0, DKBSZ = 16384, DVB0 = 32768, DVBSZ = 16384;
    ATT_LAS char* qimg = lds + 65536 + wid * 8192 + hi * 512 + r32 * 16;
    { const bf16_t* qp = QD + qrow * 1024 + (2 * h) * 64 + hi * 8;
#pragma unroll
      for (int d0 = 0; d0 < 4; ++d0) { *(ATT_LAS bf16x8*)(qimg + d0 * 1024) = *(const bf16x8*)(qp + d0 * 16); *(ATT_LAS bf16x8*)(qimg + 4096 + d0 * 1024) = *(const bf16x8*)(qp + 64 + d0 * 16); } }
    const bf16_t* ksrc = KD + row0 * 1024 + (2 * h) * 64 + (size_t)lane * 1024 + wid * 8;
    const bf16_t* vsrc = VD + row0 * 1024 + h * 128 + (size_t)(16 * (wid & 3) + (lane >> 2)) * 1024 + (wid >> 2) * 32 + (lane & 3) * 8;
    const int sto = wid * 1024 + lane * 16;
    const int vlane = ((lane >> 4) & 1) * 32 + (lane & 3) * 8 + (4 * hi + ((lane & 15) >> 2)) * 64;
    u32x4 ka, kb, va, vb;
#define DF_LOAD(t) do { ka = *(const u32x4*)(ksrc + (size_t)(t) * 65536); kb = *(const u32x4*)(ksrc + (size_t)(t) * 65536 + 64); va = *(const u32x4*)(vsrc + (size_t)(t) * 65536); vb = *(const u32x4*)(vsrc + (size_t)(t) * 65536 + 64); } while (0)
#define DF_STORE(bf) do { *(ATT_LAS u32x4*)(lds + DKB0 + (bf) * DKBSZ + sto) = ka; *(ATT_LAS u32x4*)(lds + DKB0 + (bf) * DKBSZ + 8192 + sto) = kb; \
        *(ATT_LAS u32x4*)(lds + DVB0 + (bf) * DVBSZ + sto) = va; *(ATT_LAS u32x4*)(lds + DVB0 + (bf) * DVBSZ + 8192 + sto) = vb; } while (0)
    f32x16 o1[4], o2[4];
#pragma unroll
    for (int i = 0; i < 4; ++i)
#pragma unroll
        for (int r = 0; r < 16; ++r) { o1[i][r] = 0.f; o2[i][r] = 0.f; }
    float m1 = 0.f, l1 = 0.f, m2 = 0.f, l2 = 0.f;
    DF_LOAD(0); DF_STORE(0); __syncthreads();
    for (int t = 0; t < NT; ++t) {
        const int bf = t & 1;
        if (t + 1 < NT) DF_LOAD(t + 1);
        if (t < myNT) {
            u32x4 pwa[4], pwb[4];
            qk_softmax64(lds + DKB0 + bf * DKBSZ, qimg, m1, l1, o1, pwa, r32, hi);
            qk_softmax64(lds + DKB0 + bf * DKBSZ + 8192, qimg + 4096, m2, l2, o2, pwb, r32, hi);
            const ATT_LAS char* vp = lds + DVB0 + bf * DVBSZ + vlane;
#pragma unroll
            for (int i = 0; i < 4; ++i)
#pragma unroll
                for (int ks = 0; ks < 4; ++ks) {
                    const s16x4 lo = vtr(vp + i * 4096 + ks * 1024), hh = vtr(vp + i * 4096 + ks * 1024 + 512);
                    const bf16x8 vf = {lo[0], lo[1], lo[2], lo[3], hh[0], hh[1], hh[2], hh[3]};
                    o1[i] = __builtin_amdgcn_mfma_f32_32x32x16_bf16(vf, __builtin_bit_cast(bf16x8, pwa[ks]), o1[i], 0, 0, 0);
                    o2[i] = __builtin_amdgcn_mfma_f32_32x32x16_bf16(vf, __builtin_bit_cast(bf16x8, pwb[ks]), o2[i], 0, 0, 0);
                }
        }
        if (t + 1 < NT) DF_STORE(bf ^ 1);
        __syncthreads();
    }
#undef DF_LOAD
#undef DF_STORE
    const float li1 = __builtin_amdgcn_rcpf(swap_sum(l1)), c2 = lam * __builtin_amdgcn_rcpf(swap_sum(l2)); float ss = 0.f;
#pragma unroll
    for (int i = 0; i < 4; ++i)
#pragma unroll
        for (int r = 0; r < 16; ++r) { const float v = o1[i][r] * li1 - o2[i][r] * c2; o1[i][r] = v; ss += v * v; }
    ss = swap_sum(ss);
    const float rstd = __builtin_amdgcn_rsqf(ss * (1.f / 128.f) + NEPS) * 0.8f;
    bf16_t* op = OD + qrow * 1024 + h * 128 + 4 * hi;
#pragma unroll
    for (int i = 0; i < 4; ++i)
#pragma unroll
        for (int rq = 0; rq < 4; ++rq) { const int dv = 32 * i + 8 * rq; const f32x4 g = *(const f32x4*)(subln + dv + 4 * hi);
            u32x2 w; w.x = pg8::pk2(o1[i][4 * rq] * rstd * g[0], o1[i][4 * rq + 1] * rstd * g[1]); w.y = pg8::pk2(o1[i][4 * rq + 2] * rstd * g[2], o1[i][4 * rq + 3] * rstd * g[3]);
            *(u32x2*)(op + dv) = w; }
}
__device__ __forceinline__ void mla_unit(ATT_LAS char* lds, int b, int h, int qb, const bf16_t* QM, const bf16_t* KVM, const bf16_t* KR, bf16_t* OM) {
    int tid_ = threadIdx.x; asm volatile("" : "+v"(tid_)); const int tid = tid_, lane = tid & 63, wid = __builtin_amdgcn_readfirstlane(tid >> 6), r32 = lane & 31, hi = lane >> 5;
    const size_t row0 = (size_t)b * SEQ_LEN, qrow = row0 + qb * 256 + wid * 32 + r32;
    const int NT = 4 * qb + 4, myNT = 4 * qb + (wid >> 1) + 1;
    f32x16 o[2]; float li;
    attn_pass<96, 64, true>(lds, QM + qrow * 768 + h * 96 + hi * 8, KVM + row0 * 1024 + h * 128, KR + row0 * 32, KVM + row0 * 1024 + h * 128 + 64, NT, myNT, o, li);
    bf16_t* op = OM + qrow * 512 + h * 64 + 4 * hi;
#pragma unroll
    for (int i = 0; i < 2; ++i)
#pragma unroll
        for (int rq = 0; rq < 4; ++rq) { const int dv = 32 * i + 8 * rq;
            u32x2 w; w.x = pg8::pk2(o[i][4 * rq] * li, o[i][4 * rq + 1] * li); w.y = pg8::pk2(o[i][4 * rq + 2] * li, o[i][4 * rq + 3] * li);
            *(u32x2*)(op + dv) = w; }
}
}
#define LAS __attribute__((address_space(3)))
typedef unsigned short bf16;
typedef float f32x4 __attribute__((ext_vector_type(4)));
typedef unsigned v4u __attribute__((ext_vector_type(4)));
typedef unsigned v2u __attribute__((ext_vector_type(2)));
constexpr int NWAVES = 8, LDS_BYTES = 147456;
constexpr size_t MiB = 1ull << 20;
constexpr size_t WS_TABD = 0, WS_TABM = 128 * 1024, WS_LAM = 384 * 1024, WS_BAR = 512 * 1024;
constexpr size_t WS_SSQ = 1 * MiB, WS_SSKV = 2 * MiB, WS_SS1 = 3 * MiB, WS_SS2 = 5 * MiB, WS_SS3 = 7 * MiB;
constexpr size_t WS_WIN = 10 * MiB, WS_WGU = WS_WIN + 5888ull * 1024 * 2, WS_WDN = WS_WGU + 5632ull * 1024 * 2, WS_WOD = WS_WDN + 1024ull * 2816 * 2, WS_WOUT = WS_WOD + 2 * MiB,
                 WS_WPG = WS_WOUT + 2 * MiB, WS_WOM = WS_WPG + 2 * MiB, WS_WUQ = WS_WOM + 1 * MiB, WS_WUKV = WS_WUQ + 768ull * 384 * 2, WS_WPLE = WS_WUKV + 1024ull * 256 * 2, WS_WEND = WS_WPLE + 1024ull * 256 * 2;
static_assert(WS_WEND <= 47 * MiB, "weights");
constexpr size_t WS_PB = 47 * MiB;
constexpr size_t WS_XN = 64 * MiB, WS_QM = 64 * MiB, WS_X1B = 64 * MiB;
constexpr size_t WS_QD = 128 * MiB, WS_KD = 192 * MiB, WS_VD = 256 * MiB, WS_KVM = 320 * MiB;
constexpr size_t WS_T = 192 * MiB, WS_MG = 320 * MiB;
constexpr size_t WS_HID = 128 * MiB, WS_X2B = 304 * MiB;
constexpr size_t WS_X3B = 384 * MiB, WS_T2B = 448 * MiB;
constexpr size_t WS_CKV = 384 * MiB, WS_CQ = 400 * MiB, WS_KR = 424 * MiB, WS_OM = 426 * MiB;
constexpr size_t WS_END = 512 * MiB;

#define XB_TMO      128
#define XB_XCNT(j)  (256  + 64 * (j))
#define XB_XSUB(j)  (1280 + 64 * (j))
#define XB_XGEN(j)  (2304 + 64 * (j))
#define XB_TOP      3328
#define XB_TOPGEN   3392
#define XCD_BAR_WORDS 3456
#define XB_SPIN_CAP (1u << 18)

__device__ __forceinline__ unsigned xb_ld(unsigned* p)              { return __hip_atomic_load(p, __ATOMIC_RELAXED, __HIP_MEMORY_SCOPE_AGENT); }
__device__ __forceinline__ unsigned xb_add(unsigned* p, unsigned v) { return __hip_atomic_fetch_add(p, v, __ATOMIC_RELAXED, __HIP_MEMORY_SCOPE_AGENT); }
__device__ __forceinline__ unsigned xb_xcc_id() { return (unsigned)__builtin_amdgcn_s_getreg((3 << 11) | 20) & 0xFu; }
#define XB_SPIN(cond, bar) do { unsigned _sp = 0; while (cond) { __builtin_amdgcn_s_sleep(1); \
    if ((++_sp & 255u) == 0u) { if (xb_ld(&(bar)[XB_TMO])) break; if (_sp > XB_SPIN_CAP) { atomicAdd(&(bar)[XB_TMO], 1u); break; } } } } while (0)

struct XcdBarrier {
    unsigned* bar; unsigned x;
    volatile LAS unsigned* st;
};

__device__ __forceinline__ XcdBarrier xcd_barrier_post(unsigned* bar, volatile LAS unsigned* st) {
    XcdBarrier b; b.bar = bar; b.x = xb_xcc_id(); b.st = st;
    if (threadIdx.x == 0) (void)xb_add(&bar[XB_XCNT(b.x)], 1u);
    return b;
}
__device__ __forceinline__ void xcd_barrier_complete(unsigned* bar, unsigned x, unsigned& nloc, unsigned& nx) {
    const unsigned G = gridDim.x * gridDim.y * gridDim.z;
    unsigned sum, cnt, mine, sp = 0u;
    for (;;) {
        sum = 0u; cnt = 0u; mine = 0u;
#pragma unroll
        for (unsigned j = 0; j < 16; ++j) { const unsigned c = xb_ld(&bar[XB_XCNT(j)]); sum += c; cnt += (c > 0u) ? 1u : 0u; mine = (j == x) ? c : mine; }
        if (sum == G) break;
        __builtin_amdgcn_s_sleep(1);
        if ((++sp & 255u) == 0u) { if (xb_ld(&bar[XB_TMO])) break; if (sp > XB_SPIN_CAP) { atomicAdd(&bar[XB_TMO], 1u); break; } }
    }
    nloc = mine > 0u ? mine : 1u; nx = cnt > 0u ? cnt : 1u;
}

__device__ __forceinline__ void xcd_barrier(const XcdBarrier& b) {
    asm volatile("s_waitcnt vmcnt(0)" ::: "memory");
    __syncthreads();
    if (threadIdx.x == 0) {
        unsigned* bar = b.bar;
        __builtin_amdgcn_s_waitcnt(0);
        unsigned nloc = b.st[0], nx = b.st[1];
        if (nloc == 0u) { xcd_barrier_complete(bar, b.x, nloc, nx); b.st[0] = nloc; b.st[1] = nx; }
        const unsigned old = xb_add(&bar[XB_XSUB(b.x)], 1u);
        const unsigned gen = old / nloc;
        if (old + 1u == (gen + 1u) * nloc) {
            __builtin_amdgcn_fence(__ATOMIC_RELEASE, "agent");
            asm volatile("s_waitcnt vmcnt(0)" ::: "memory");
            const unsigned og = xb_add(&bar[XB_TOP], 1u);
            const unsigned tg = og / nx;
            if (og + 1u == (tg + 1u) * nx) xb_add(&bar[XB_TOPGEN], 1u);
            else XB_SPIN(xb_ld(&bar[XB_TOPGEN]) == tg, bar);
            __builtin_amdgcn_fence(__ATOMIC_ACQUIRE, "agent");
            xb_add(&bar[XB_XGEN(b.x)], 1u);
            asm volatile("s_waitcnt vmcnt(0)" ::: "memory");
        } else {
            XB_SPIN(xb_ld(&bar[XB_XGEN(b.x)]) == gen, bar);
            __builtin_amdgcn_fence(__ATOMIC_ACQUIRE, "agent");
            asm volatile("s_waitcnt vmcnt(0)" ::: "memory");
        }
    }
    __syncthreads();
}

struct Args {
    const float *x, *p, *attn_norm, *w_in, *b_gate, *lam_q1, *lam_k1, *lam_q2, *lam_k2, *diff_subln, *w_o_diff, *q_norm, *w_uq, *kv_norm, *w_ukv, *w_o_mla, *w_out, *ffn_norm,
        *w_ffn_gate, *w_ffn_up, *w_ffn_down, *ple_norm, *w_ple_gate, *b_ple_gate, *w_ple, *final_norm;
    float* out; unsigned char* ws;
};

__device__ __forceinline__ float wave_sum(float v) {
#pragma unroll
    for (int o = 1; o < 64; o <<= 1) v += __shfl_xor(v, o);
    return v;
}
__device__ __forceinline__ void wprep_item(int kind, const float* W, const float* W2, int ld, int K, int Nout, const float* gain, bf16* WT, int item, LAS float* scr, int lane) {
    const int nnb = Nout / 32, kb = item / nnb, nb = item % nnb, k0 = kb * 64, n0 = nb * 32, nl = lane & 31, ks = lane >> 5, n = n0 + nl;
    const float* base = W; int col = n;
    if (kind == 1) {
        if (n < 2048) { const int hl = n & 63; col = (n & ~63) + (hl < 16 ? ((hl & 1) ? (hl >> 1) + 8 : (hl >> 1)) : hl); }
        else if (n < 3072) col = n;
        else if (n < 5120) col = 3744 + (n - 3072);
        else if (n < 5376) col = 3456 + (n - 5120);
        else if (n < 5760) col = 3072 + (n - 5376);
        else if (n < 5792) { const int hl = n - 5760; col = 3712 + ((hl & 1) ? (hl >> 1) + 16 : (hl >> 1)); }
        else col = -1;
    } else if (kind == 2) { const int h = n / 96, hl = n % 96; int s = hl; if (hl >= 64) { const int r = hl - 64; s = 64 + ((r & 1) ? (r >> 1) + 16 : (r >> 1)); } col = h * 96 + s;
    } else if (kind == 3) { const int pn = n >> 8, r = n & 255; if (r < 128) col = pn * 128 + r; else { base = W2; col = pn * 128 + (r - 128); } }
    const float* src = base + (size_t)(k0 + ks) * ld + (col >= 0 ? col : 0);
    float v[32];
#pragma unroll
    for (int i = 0; i < 32; ++i) v[i] = src[(size_t)(2 * i) * ld];
    if (col < 0) {
#pragma unroll
        for (int i = 0; i < 32; ++i) v[i] = 0.f;
    }
    if (gain) { const float* gp = gain + k0 + ks;
#pragma unroll
        for (int i = 0; i < 32; ++i) v[i] *= gp[2 * i]; }
#pragma unroll
    for (int i = 0; i < 32; ++i) scr[(2 * i + ks) * 33 + nl] = v[i];
    asm volatile("s_waitcnt lgkmcnt(0)" ::: "memory");
    const int c = lane & 7;
#pragma unroll
    for (int j = 0; j < 4; ++j) { const int nn = (lane >> 3) + 8 * j; const LAS float* s = scr + (8 * c) * 33 + nn;
        v4u o; o.x = pg8::pk2(s[0], s[33]); o.y = pg8::pk2(s[2 * 33], s[3 * 33]); o.z = pg8::pk2(s[4 * 33], s[5 * 33]); o.w = pg8::pk2(s[6 * 33], s[7 * 33]);
        *(v4u*)(WT + (size_t)(n0 + nn) * K + k0 + 8 * c) = o; }
    asm volatile("s_waitcnt lgkmcnt(0)" ::: "memory");
}

#define WSP(T, off) ((T*)(a.ws + (off)))
#define tabD WSP(float, WS_TABD)
#define tabM WSP(float, WS_TABM)
#define lamp WSP(float, WS_LAM)
#define SSQ WSP(float, WS_SSQ)
#define SSKV WSP(float, WS_SSKV)
#define SS1 WSP(float, WS_SS1)
#define SS2 WSP(float, WS_SS2)
#define SS3 WSP(float, WS_SS3)
#define Win WSP(bf16, WS_WIN)
#define Wgu WSP(bf16, WS_WGU)
#define Wdn WSP(bf16, WS_WDN)
#define Wod WSP(bf16, WS_WOD)
#define Wout WSP(bf16, WS_WOUT)
#define Wpg WSP(bf16, WS_WPG)
#define Wom WSP(bf16, WS_WOM)
#define Wuq WSP(bf16, WS_WUQ)
#define Wukv WSP(bf16, WS_WUKV)
#define Wple WSP(bf16, WS_WPLE)
#define PB WSP(bf16, WS_PB)
#define XN WSP(bf16, WS_XN)
#define QM WSP(bf16, WS_QM)
#define X1B WSP(bf16, WS_X1B)
#define QD WSP(bf16, WS_QD)
#define KD WSP(bf16, WS_KD)
#define VD WSP(bf16, WS_VD)
#define KVM WSP(bf16, WS_KVM)
#define MG WSP(bf16, WS_MG)
#define HID WSP(bf16, WS_HID)
#define X2B WSP(bf16, WS_X2B)
#define CKV WSP(bf16, WS_CKV)
#define CQ WSP(bf16, WS_CQ)
#define KR WSP(bf16, WS_KR)
#define OM WSP(bf16, WS_OM)
#define TBUF WSP(bf16, WS_T)
#define X3B WSP(bf16, WS_X3B)
#define T2B WSP(bf16, WS_T2B)
#define SA ((bf16*)a.out)
#define SB ((bf16*)a.out + (size_t)M_TOK * 1024)
template <class E> __device__ __forceinline__ void run_gemm(LAS unsigned char* lds, const bf16* A, const bf16* Bt, int N, int K, const E& e) {
    asm volatile("" : "+s"(K));
    pg8::Gemm g{A, Bt, M_TOK, N, K}; pg8::StaticOrder S; S.init(M_TOK, N, (int)gridDim.x, (int)blockIdx.x);
    pg8::gemm_phase<E, pg8::StaticOrder, true, true>(lds, g, S, e);
}

__global__ void __launch_bounds__(NWAVES * 64, 2) fwd_megakernel(Args a) {
    extern __shared__ __attribute__((aligned(16))) unsigned char lds_raw[];
    cg::grid_group grid = cg::this_grid();
    LAS unsigned char* lds = (LAS unsigned char*)lds_raw;
    int tid0_ = threadIdx.x; asm volatile("" : "+v"(tid0_)); const int tid = tid0_, lane = tid & 63, wave = __builtin_amdgcn_readfirstlane(tid >> 6);
    const int G = gridDim.x, gw = blockIdx.x * NWAVES + wave, NGW = G * NWAVES;
    volatile LAS unsigned* bst = (volatile LAS unsigned*)(lds + (LDS_BYTES - 64));
    if (tid < 2) bst[tid] = 0u;
    __syncthreads();
    const XcdBarrier xbar = xcd_barrier_post((unsigned*)(a.ws + WS_BAR), bst);
#if !defined(SKIP_P0)
    {
        LAS float* scr = (LAS float*)(lds + wave * 8448);
        constexpr int I0 = 16 * 184, I1 = I0 + 16 * 176, I2 = I1 + 44 * 32, I3 = I2 + 512, I4 = I3 + 512, I5 = I4 + 512, I6 = I5 + 256, I7 = I6 + 144, I8 = I7 + 128, I9 = I8 + 128;
        for (int it = gw; it < I9; it += NGW) {
            if (it < I0)      wprep_item(1, a.w_in, nullptr, 5792, 1024, 5888, nullptr, Win, it, scr, lane);
            else if (it < I1) wprep_item(3, a.w_ffn_gate, a.w_ffn_up, 2816, 1024, 5632, a.ffn_norm, Wgu, it - I0, scr, lane);
            else if (it < I2) wprep_item(0, a.w_ffn_down, nullptr, 1024, 2816, 1024, nullptr, Wdn, it - I1, scr, lane);
            else if (it < I3) wprep_item(0, a.w_o_diff, nullptr, 1024, 1024, 1024, nullptr, Wod, it - I2, scr, lane);
            else if (it < I4) wprep_item(0, a.w_out, nullptr, 1024, 1024, 1024, nullptr, Wout, it - I3, scr, lane);
            else if (it < I5) wprep_item(0, a.w_ple_gate, nullptr, 1024, 1024, 1024, a.ple_norm, Wpg, it - I4, scr, lane);
            else if (it < I6) wprep_item(0, a.w_o_mla, nullptr, 1024, 512, 1024, nullptr, Wom, it - I5, scr, lane);
            else if (it < I7) wprep_item(2, a.w_uq, nullptr, 768, 384, 768, a.q_norm, Wuq, it - I6, scr, lane);
            else if (it < I8) wprep_item(0, a.w_ukv, nullptr, 1024, 256, 1024, a.kv_norm, Wukv, it - I7, scr, lane);
            else              wprep_item(0, a.w_ple, nullptr, 1024, 256, 1024, nullptr, Wple, it - I8, scr, lane);
        }
        for (int r0 = gw * 4; r0 < M_TOK; r0 += NGW * 4) {
            f32x4 v[4][4]; float s[4];
#pragma unroll
            for (int q = 0; q < 4; ++q) { const f32x4* xr = (const f32x4*)(a.x + (size_t)(r0 + q) * 1024) + lane; s[q] = 0.f;
#pragma unroll
                for (int j = 0; j < 4; ++j) v[q][j] = xr[64 * j]; }
            f32x4 pq[4];
#pragma unroll
            for (int q = 0; q < 4; ++q) pq[q] = ((const f32x4*)(a.p + (size_t)(r0 + q) * 256))[lane];
#pragma unroll
            for (int q = 0; q < 4; ++q) {
#pragma unroll
                for (int j = 0; j < 4; ++j) s[q] += pg8::sq4(v[q][j]);
                const float rstd = __builtin_amdgcn_rsqf(wave_sum(s[q]) * (1.f / 1024.f) + NEPS);
                v2u* o8 = (v2u*)(XN + (size_t)(r0 + q) * 1024) + lane;
#pragma unroll
                for (int j = 0; j < 4; ++j) { const f32x4 g = ((const f32x4*)a.attn_norm)[lane + 64 * j]; const f32x4 y = v[q][j] * rstd * g; v2u w; w.x = pg8::pk2(y[0], y[1]); w.y = pg8::pk2(y[2], y[3]); o8[64 * j] = w; }
                v2u wp; wp.x = pg8::pk2(pq[q][0], pq[q][1]); wp.y = pg8::pk2(pq[q][2], pq[q][3]); ((v2u*)(PB + (size_t)(r0 + q) * 256))[lane] = wp; }
        }
        { const int gt = blockIdx.x * 512 + tid, GT = G * 512;
          for (int i = gt; i < 2048 * 24; i += GT) {
              const int pos = i / 24, f = i % 24; const bool dm = f < 8; const int fi = dm ? f : f - 8;
              const float invf = dm ? __builtin_amdgcn_exp2f(-18.931568569324174f * (float)fi * 0.125f) : __builtin_amdgcn_exp2f(-13.287712379549449f * (float)fi * 0.0625f);
              const float ang = (float)pos * invf; const double rev = (double)ang * 0.15915494309189535; const float fr = (float)(rev - floor(rev));
              const float cs = __builtin_amdgcn_cosf(fr), sn = __builtin_amdgcn_sinf(fr);
              float* dst = dm ? tabD + ((size_t)pos * 8 + fi) * 2 : tabM + ((size_t)pos * 16 + fi) * 2; dst[0] = cs; dst[1] = sn;
          }
          if (blockIdx.x == 0 && wave == 0) { const float s1 = wave_sum(a.lam_q1[lane] * a.lam_k1[lane]), s2 = wave_sum(a.lam_q2[lane] * a.lam_k2[lane]); if (lane == 0) lamp[0] = __expf(s1) - __expf(s2) + 0.2f; }
        }
    }
    xcd_barrier(xbar);
    if (a.ws == nullptr) grid.sync();
    #endif

#if !defined(SKIP_P1)
    { pg8::EpiInProj e{QD, KD, VD, SA, SB, CKV, CQ, KR, SSQ, SSKV, a.b_gate, tabD, tabM}; run_gemm(lds, XN, Win, 5888, 1024, e); }
    xcd_barrier(xbar);
    #endif

#if !defined(SKIP_P2)
    { pg8::EpiQUp e{SSQ, tabM, QM}; run_gemm(lds, CQ, Wuq, 768, 384, e); }
    { pg8::EpiKVUp e{SSKV, KVM}; run_gemm(lds, CKV, Wukv, 1024, 256, e); }
    xcd_barrier(xbar);
    #endif

#if !defined(SKIP_P3)
    {
        const float lam = lamp[0];
        for (int i = blockIdx.x; i < 2048; i += G) {
            const int type = i >> 10, rem = i & 1023, j = rem >> 8, half = (rem >> 7) & 1, bh = rem & 127;
            const int qb = half ? (j == 0 ? 6 : j == 1 ? 4 : j == 2 ? 3 : 1) : (j == 0 ? 7 : j == 1 ? 5 : j == 2 ? 2 : 0);
            if (type == 0) att::diff_unit((ATT_LAS char*)lds, bh >> 3, bh & 7, qb, QD, KD, VD, QD, a.diff_subln, lam);
            else           att::mla_unit((ATT_LAS char*)lds, bh >> 3, bh & 7, qb, QM, KVM, KR, OM);
        }
    }
    xcd_barrier(xbar);
    #endif

#if !defined(SKIP_P4)
    { pg8::EpiOutA e{SA, TBUF}; run_gemm(lds, QD, Wod, 1024, 1024, e); }
    { pg8::EpiOutB e{SB, TBUF, MG}; run_gemm(lds, OM, Wom, 1024, 512, e); }
    xcd_barrier(xbar);
    #endif

#if !defined(SKIP_P5)
    { pg8::EpiResid<false> e{a.x, X1B, SS1}; run_gemm(lds, MG, Wout, 1024, 1024, e); }
    xcd_barrier(xbar);
    #endif

#if !defined(SKIP_P6)
    { pg8::EpiSwiGLU e{SS1, HID}; run_gemm(lds, X1B, Wgu, 5632, 1024, e); }
    xcd_barrier(xbar);
    #endif

#if !defined(SKIP_P7)
    { pg8::EpiResid<true> e{X1B, X2B, SS2}; run_gemm(lds, HID, Wdn, 1024, 2816, e); }
    xcd_barrier(xbar);
    #endif

#if !defined(SKIP_P8)
    { pg8::EpiPleA e{T2B}; run_gemm(lds, PB, Wple, 1024, 256, e); }
    { pg8::EpiPleB e{SS2, a.b_ple_gate, X2B, T2B, X3B, SS3}; run_gemm(lds, X2B, Wpg, 1024, 1024, e); }
    xcd_barrier(xbar);
    #endif

#if !defined(SKIP_P9)
    { int t9_ = threadIdx.x; asm volatile("" : "+v"(t9_)); const int lane = t9_ & 63, gw = blockIdx.x * NWAVES + __builtin_amdgcn_readfirstlane(t9_ >> 6), NGW = gridDim.x * NWAVES;
    for (int r0 = gw * 4; r0 < M_TOK; r0 += NGW * 4) {
        v4u w[4][2]; float s[4];
#pragma unroll
        for (int q = 0; q < 4; ++q) { const v4u* xr = (const v4u*)(X3B + (size_t)(r0 + q) * 1024) + lane; w[q][0] = xr[0]; w[q][1] = xr[64]; s[q] = (lane < 16) ? SS3[(size_t)(r0 + q) * 16 + lane] : 0.f; }
#pragma unroll
        for (int q = 0; q < 4; ++q) { const float rstd = __builtin_amdgcn_rsqf(wave_sum(s[q]) * (1.f / 1024.f) + NEPS);
#pragma unroll
            for (int j = 0; j < 2; ++j) { const int c = (lane + 64 * j) * 8; const f32x4 g0 = *(const f32x4*)(a.final_norm + c), g1 = *(const f32x4*)(a.final_norm + c + 4); const v4u ww = w[q][j];
                f32x4 x0, x1; x0[0] = __uint_as_float(ww.x << 16); x0[1] = __uint_as_float(ww.x & 0xffff0000u); x0[2] = __uint_as_float(ww.y << 16); x0[3] = __uint_as_float(ww.y & 0xffff0000u);
                x1[0] = __uint_as_float(ww.z << 16); x1[1] = __uint_as_float(ww.z & 0xffff0000u); x1[2] = __uint_as_float(ww.w << 16); x1[3] = __uint_as_float(ww.w & 0xffff0000u);
                float* o = a.out + (size_t)(r0 + q) * 1024 + c; *(f32x4*)o = x0 * rstd * g0; *(f32x4*)(o + 4) = x1 * rstd * g1; } }
    } }
#endif
}

extern "C" void kernel_launch(void* const* d_in, const int* in_sizes, int n_in, void* d_out, int out_size, void* d_ws, size_t ws_size, hipStream_t stream) {
    static int grid = 0;
    if (grid == 0) {
        if (n_in != 26 || out_size != M_TOK * 1024 || ws_size < WS_END) { fprintf(stderr, "kernel_launch: unexpected shapes (n_in %d out %d ws %zu)\n", n_in, out_size, ws_size); grid = -1; return; }
        int dev = 0, cus = 0, per_cu = 0;
        (void)hipGetDevice(&dev); (void)hipDeviceGetAttribute(&cus, hipDeviceAttributeMultiprocessorCount, dev);
        (void)hipFuncSetAttribute((const void*)fwd_megakernel, hipFuncAttributeMaxDynamicSharedMemorySize, LDS_BYTES);
        if (hipOccupancyMaxActiveBlocksPerMultiprocessor(&per_cu, (const void*)fwd_megakernel, NWAVES * 64, LDS_BYTES) != hipSuccess || per_cu < 1) per_cu = 1;
        (void)hipGetLastError();
        grid = cus * per_cu;
    }
    if (grid < 0) return;
    Args a{};
    const float** f = (const float**)&a;
    for (int i = 0; i < 26; ++i) f[i] = (const float*)d_in[i];
    a.out = (float*)d_out; a.ws = (unsigned char*)d_ws;
    (void)hipMemsetAsync((char*)d_ws + WS_BAR, 0, 16384, stream);
    void* args[] = {&a};
    hipError_t e = hipLaunchCooperativeKernel((const void*)fwd_megakernel, dim3(grid), dim3(NWAVES * 64), args, LDS_BYTES, stream);
    if (e != hipSuccess) fprintf(stderr, "cooperative launch failed: %s (grid %d)\n", hipGetErrorString(e), grid);
}
```

```cpp
#include <hip/hip_runtime.h>
#include <hip/hip_cooperative_groups.h>
#include <cstdio>
#include <cstdint>
namespace cg = cooperative_groups;

constexpr int M_TOK = 32768, SEQ_LEN = 2048;
constexpr float NEPS = 1e-6f;
constexpr float LOG2E_F = 1.4426950408889634f;
constexpr float QS_D = 0.125f * LOG2E_F;
constexpr float QS_M = 0.10206207261596575f * LOG2E_F;
namespace pg8 {
#define PG8_LAS __attribute__((address_space(3)))
typedef unsigned short bf16_t;
typedef short bf16x8 __attribute__((ext_vector_type(8)));
typedef float f32x4 __attribute__((ext_vector_type(4)));
typedef unsigned u32x4 __attribute__((ext_vector_type(4)));
constexpr int BM = 256, BK = 64, HALF = 128, HTB = HALF * BK * 2  , STAGE_BYTES = 8 * HTB, NXCD = 8, WGM = 8;

__host__ __device__ __forceinline__ int lds_byte(int r, int c) { const int st = (r >> 4) * 2 + (c >> 5), rr = r & 15, cc = c & 31, ob = rr * 64 + cc * 2; return st * 1024 + (ob ^ (((ob >> 9) & 1) << 5)); }
__host__ __device__ __forceinline__ void stage_rc(int b, int& R, int& C) { const int st = b / 1024, sb = b % 1024, swz = sb ^ (((sb >> 9) & 1) << 5); R = (st >> 1) * 16 + swz / 64; C = (st & 1) * 32 + (swz % 64) / 2; }
__host__ __device__ __forceinline__ int perm32(int rho) { const int n = rho >> 4, i = rho & 15; return 8 * (i >> 2) + 4 * n + (i & 3); }

struct Unit { int pm, pn; };
struct Gemm { const bf16_t* A; const bf16_t* Bt; int M, N, K; };

struct StaticOrder {
    int nM, nN, nwg, G, c;
    __host__ __device__ void init(int M, int N, int G_, int c_) { nM = M / BM; nN = N / BM; nwg = nM * nN; G = G_; c = c_; }
    __host__ __device__ bool next(int i, Unit& u) const {
        const long L = (long)i * G + c; if (L >= nwg) return false;
        int wgid = (int)L; { const int q = nwg / NXCD, r = nwg % NXCD, xcd = wgid % NXCD, off = wgid / NXCD; wgid = (xcd < r ? xcd * (q + 1) : r * (q + 1) + (xcd - r) * q) + off; }
        const int nig = WGM * nN, gid = wgid / nig, fm = gid * WGM, gsz = (nM - fm) < WGM ? (nM - fm) : WGM;
        u.pm = fm + ((wgid % nig) % gsz); u.pn = (wgid % nig) / gsz; return true;
    }
    __device__ __forceinline__ void a_ready(const Unit&) const {}
    __device__ __forceinline__ void done(const Unit&) const {}
};

typedef unsigned u32x4 __attribute__((ext_vector_type(4)));
typedef unsigned u32x2 __attribute__((ext_vector_type(2)));
typedef float f32x2 __attribute__((ext_vector_type(2)));
typedef __bf16 bf16x2_t __attribute__((ext_vector_type(2)));
__device__ __forceinline__ unsigned pk2(float lo, float hi) { f32x2 v = {lo, hi}; bf16x2_t b = __builtin_convertvector(v, bf16x2_t); return __builtin_bit_cast(unsigned, b); }
__device__ __forceinline__ void st8(bf16_t* p, f32x4 a, f32x4 b) { u32x4 w; w.x = pk2(a[0], a[1]); w.y = pk2(a[2], a[3]); w.z = pk2(b[0], b[1]); w.w = pk2(b[2], b[3]); *(u32x4*)p = w; }
__device__ __forceinline__ void ld8(const bf16_t* p, f32x4& a, f32x4& b) { const u32x4 w = *(const u32x4*)p;
    a[0] = __uint_as_float(w.x << 16); a[1] = __uint_as_float(w.x & 0xffff0000u); a[2] = __uint_as_float(w.y << 16); a[3] = __uint_as_float(w.y & 0xffff0000u);
    b[0] = __uint_as_float(w.z << 16); b[1] = __uint_as_float(w.z & 0xffff0000u); b[2] = __uint_as_float(w.w << 16); b[3] = __uint_as_float(w.w & 0xffff0000u); }
__device__ __forceinline__ void up8(const u32x4 w, f32x4& a, f32x4& b) {
    a[0] = __uint_as_float(w.x << 16); a[1] = __uint_as_float(w.x & 0xffff0000u); a[2] = __uint_as_float(w.y << 16); a[3] = __uint_as_float(w.y & 0xffff0000u);
    b[0] = __uint_as_float(w.z << 16); b[1] = __uint_as_float(w.z & 0xffff0000u); b[2] = __uint_as_float(w.w << 16); b[3] = __uint_as_float(w.w & 0xffff0000u); }
__device__ __forceinline__ float sigm(float x) { return __builtin_amdgcn_rcpf(1.f + __expf(-x)); }
__device__ __forceinline__ f32x4 sigm4(f32x4 x) { f32x4 o; o[0] = sigm(x[0]); o[1] = sigm(x[1]); o[2] = sigm(x[2]); o[3] = sigm(x[3]); return o; }
__device__ __forceinline__ float quad_sum(float s) { s += __shfl_xor(s, 16); s += __shfl_xor(s, 32); return s; }
__device__ __forceinline__ float sq4(f32x4 v) { return (v[0] * v[0] + v[1] * v[1]) + (v[2] * v[2] + v[3] * v[3]); }
__device__ __forceinline__ f32x4 rope4(f32x4 v, f32x4 t) { f32x4 o; o[0] = v[0] * t[0] - v[1] * t[1]; o[1] = v[1] * t[0] + v[0] * t[1]; o[2] = v[2] * t[2] - v[3] * t[3]; o[3] = v[3] * t[2] + v[2] * t[3]; return o; }
#define EPI_FENCE() asm volatile("" ::: "memory")
#define EPI_LOOP_AM _Pragma("unroll") for (int ai = 0; ai < 2; ++ai) _Pragma("unroll") for (int m = 0; m < 4; ++m)

struct EpiInProj {
    static constexpr bool PERM = true, AFTER_DRAIN = false;
    bf16_t *QD, *KD, *VD, *SA, *SB, *CKV, *CQ, *KR; float *SSQ, *SSKV; const float* bgate; const float* tabD; const float* tabM;
    __device__ __forceinline__ void operator()(const f32x4 (&acc)[2][2][4][2], const Unit& u, int wr, int wc, int fr, int fq) const {
        const int pn = u.pn, rbase = u.pm * BM + wr * 64 + fr, lc = wc * 32 + fq * 8;
        if (pn < 8) {
            bf16_t* dst = (pn < 4 ? QD : KD) + (pn & 3) * 256 + lc; const float sc = pn < 4 ? QS_D : 1.f;
            const bool rp = ((wc & 1) == 0) && (fq < 2);
            EPI_LOOP_AM { const int row = rbase + ai * HALF + m * 16; f32x4 t0 = {1.f, 0.f, 1.f, 0.f}, t1 = t0;
                if (rp) { const f32x4* tp = (const f32x4*)(tabD + ((size_t)(row & (SEQ_LEN - 1)) * 8 + 4 * fq) * 2); t0 = tp[0]; t1 = tp[1]; }
#pragma unroll
                for (int bj = 0; bj < 2; ++bj) st8(dst + (size_t)row * 1024 + bj * HALF, rope4(acc[ai][bj][m][0], t0) * sc, rope4(acc[ai][bj][m][1], t1) * sc);
                EPI_FENCE(); }
        } else if (pn < 12) {
            bf16_t* dst = VD + (pn - 8) * 256 + lc;
            EPI_LOOP_AM { const int row = rbase + ai * HALF + m * 16;
#pragma unroll
                for (int bj = 0; bj < 2; ++bj) st8(dst + (size_t)row * 1024 + bj * HALF, acc[ai][bj][m][0], acc[ai][bj][m][1]); }
        } else if (pn < 20) {
            const int t = (pn - 12) & 3; bf16_t* dst = (pn < 16 ? SA : SB) + t * 256 + lc; const float* bp = bgate + (pn < 16 ? 0 : 1024) + t * 256 + lc;
            f32x4 b[2][2];
#pragma unroll
            for (int bj = 0; bj < 2; ++bj) { b[bj][0] = *(const f32x4*)(bp + bj * HALF); b[bj][1] = *(const f32x4*)(bp + bj * HALF + 4); }
            EPI_LOOP_AM { const int row = rbase + ai * HALF + m * 16;
#pragma unroll
                for (int bj = 0; bj < 2; ++bj) st8(dst + (size_t)row * 1024 + bj * HALF, sigm4(acc[ai][bj][m][0] + b[bj][0]), sigm4(acc[ai][bj][m][1] + b[bj][1])); }
        } else if (pn == 20) {
            EPI_LOOP_AM { const int row = rbase + ai * HALF + m * 16; float s = 0.f;
#pragma unroll
                for (int bj = 0; bj < 2; ++bj) { st8(CKV + (size_t)row * 256 + bj * HALF + lc, acc[ai][bj][m][0], acc[ai][bj][m][1]); s += sq4(acc[ai][bj][m][0]) + sq4(acc[ai][bj][m][1]); }
                s = quad_sum(s); if (fq == 0) SSKV[(size_t)row * 4 + wc] = s; }
        } else if (pn == 21) {
            EPI_LOOP_AM { const int row = rbase + ai * HALF + m * 16; float s = 0.f;
#pragma unroll
                for (int bj = 0; bj < 2; ++bj) { st8(CQ + (size_t)row * 384 + bj * HALF + lc, acc[ai][bj][m][0], acc[ai][bj][m][1]); s += sq4(acc[ai][bj][m][0]) + sq4(acc[ai][bj][m][1]); }
                s = quad_sum(s); if (fq == 0) SSQ[(size_t)row * 8 + wc] = s; }
        } else {
            EPI_LOOP_AM { const int row = rbase + ai * HALF + m * 16;
                st8(CQ + (size_t)row * 384 + 256 + lc, acc[ai][0][m][0], acc[ai][0][m][1]);
                float s = sq4(acc[ai][0][m][0]) + sq4(acc[ai][0][m][1]); s = quad_sum(s); if (fq == 0) SSQ[(size_t)row * 8 + 4 + wc] = s;
                if (wc == 0) { const f32x4* tp = (const f32x4*)(tabM + ((size_t)(row & (SEQ_LEN - 1)) * 16 + 4 * fq) * 2);
                    st8(KR + (size_t)row * 32 + fq * 8, rope4(acc[ai][1][m][0], tp[0]), rope4(acc[ai][1][m][1], tp[1])); }
                EPI_FENCE(); }
        }
    }
};
struct EpiQUp {
    static constexpr bool PERM = true, AFTER_DRAIN = false;
    const float* SSQ; const float* tabM; bf16_t* QM;
    __device__ __forceinline__ void operator()(const f32x4 (&acc)[2][2][4][2], const Unit& u, int wr, int wc, int fr, int fq) const {
        const int rbase = u.pm * BM + wr * 64 + fr, c0 = u.pn * BM + wc * 32 + fq * 8;
        const int hl0 = c0 % 96, hl1 = (c0 + HALF) % 96;
        EPI_LOOP_AM { const int row = rbase + ai * HALF + m * 16;
            const f32x4 s0 = *(const f32x4*)(SSQ + (size_t)row * 8), s1 = *(const f32x4*)(SSQ + (size_t)row * 8 + 4);
            const float rstd = __builtin_amdgcn_rsqf(((s0[0] + s0[1]) + (s0[2] + s0[3]) + (s1[0] + s1[1]) + (s1[2] + s1[3])) * (1.f / 384.f) + NEPS) * QS_M;
            const float* tb = tabM + (size_t)(row & (SEQ_LEN - 1)) * 32;
#pragma unroll
            for (int bj = 0; bj < 2; ++bj) { const int hl = bj ? hl1 : hl0; const bool rp = hl >= 64; const f32x4 id = {1.f, 0.f, 1.f, 0.f};
                const f32x4* tp = (const f32x4*)(tb + (rp ? hl - 64 : 0)); const f32x4 t0 = rp ? tp[0] : id, t1 = rp ? tp[1] : id;
                st8(QM + (size_t)row * 768 + c0 + bj * HALF, rope4(acc[ai][bj][m][0] * rstd, t0), rope4(acc[ai][bj][m][1] * rstd, t1)); EPI_FENCE(); }
            }
    }
};
struct EpiKVUp {
    static constexpr bool PERM = true, AFTER_DRAIN = false;
    const float* SSKV; bf16_t* KVM;
    __device__ __forceinline__ void operator()(const f32x4 (&acc)[2][2][4][2], const Unit& u, int wr, int wc, int fr, int fq) const {
        const int rbase = u.pm * BM + wr * 64 + fr, c0 = u.pn * BM + wc * 32 + fq * 8;
        EPI_LOOP_AM { const int row = rbase + ai * HALF + m * 16;
            const f32x4 s0 = *(const f32x4*)(SSKV + (size_t)row * 4);
            const float rstd = __builtin_amdgcn_rsqf(((s0[0] + s0[1]) + (s0[2] + s0[3])) * (1.f / 256.f) + NEPS);
#pragma unroll
            for (int bj = 0; bj < 2; ++bj) st8(KVM + (size_t)row * 1024 + c0 + bj * HALF, acc[ai][bj][m][0] * rstd, acc[ai][bj][m][1] * rstd);
            EPI_FENCE(); }
    }
};
struct EpiOutA {
    static constexpr bool PERM = true, AFTER_DRAIN = false;
    const bf16_t* SA; bf16_t* T;
    __device__ __forceinline__ void operator()(const f32x4 (&acc)[2][2][4][2], const Unit& u, int wr, int wc, int fr, int fq) const {
        const int rbase = u.pm * BM + wr * 64 + fr, c0 = u.pn * BM + wc * 32 + fq * 8;
#pragma unroll
        for (int ai = 0; ai < 2; ++ai) { u32x4 g[4][2];
#pragma unroll
            for (int m = 0; m < 4; ++m)
#pragma unroll
                for (int bj = 0; bj < 2; ++bj) g[m][bj] = *(const u32x4*)(SA + (size_t)(rbase + ai * HALF + m * 16) * 1024 + c0 + bj * HALF);
            EPI_FENCE();
#pragma unroll
            for (int m = 0; m < 4; ++m)
#pragma unroll
                for (int bj = 0; bj < 2; ++bj) { f32x4 g0, g1; up8(g[m][bj], g0, g1); st8(T + (size_t)(rbase + ai * HALF + m * 16) * 1024 + c0 + bj * HALF, acc[ai][bj][m][0] * g0, acc[ai][bj][m][1] * g1); }
            EPI_FENCE(); }
    }
};
struct EpiOutB {
    static constexpr bool PERM = true, AFTER_DRAIN = false;
    const bf16_t* SB; const bf16_t* T; bf16_t* MG;
    __device__ __forceinline__ void operator()(const f32x4 (&acc)[2][2][4][2], const Unit& u, int wr, int wc, int fr, int fq) const {
        const int rbase = u.pm * BM + wr * 64 + fr, c0 = u.pn * BM + wc * 32 + fq * 8;
#pragma unroll
        for (int ai = 0; ai < 2; ++ai) { u32x4 g[4][2], t[4][2];
#pragma unroll
            for (int m = 0; m < 4; ++m)
#pragma unroll
                for (int bj = 0; bj < 2; ++bj) { const size_t o = (size_t)(rbase + ai * HALF + m * 16) * 1024 + c0 + bj * HALF; g[m][bj] = *(const u32x4*)(SB + o); t[m][bj] = *(const u32x4*)(T + o); }
            EPI_FENCE();
#pragma unroll
            for (int m = 0; m < 4; ++m)
#pragma unroll
                for (int bj = 0; bj < 2; ++bj) { f32x4 g0, g1, t0, t1; up8(g[m][bj], g0, g1); up8(t[m][bj], t0, t1);
                    st8(MG + (size_t)(rbase + ai * HALF + m * 16) * 1024 + c0 + bj * HALF, t0 + acc[ai][bj][m][0] * g0, t1 + acc[ai][bj][m][1] * g1); }
            EPI_FENCE(); }
    }
};
template <bool RES_BF16> struct EpiResid {
    static constexpr bool PERM = true, AFTER_DRAIN = false;
    const void* res; bf16_t* xb; float* SS;
    __device__ __forceinline__ void operator()(const f32x4 (&acc)[2][2][4][2], const Unit& u, int wr, int wc, int fr, int fq) const {
        const int rbase = u.pm * BM + wr * 64 + fr, c0 = u.pn * BM + wc * 32 + fq * 8;
        if constexpr (RES_BF16) {
#pragma unroll
            for (int ai = 0; ai < 2; ++ai) { u32x4 r[4][2];
#pragma unroll
                for (int m = 0; m < 4; ++m)
#pragma unroll
                    for (int bj = 0; bj < 2; ++bj) r[m][bj] = *(const u32x4*)((const bf16_t*)res + (size_t)(rbase + ai * HALF + m * 16) * 1024 + c0 + bj * HALF);
                EPI_FENCE();
#pragma unroll
                for (int m = 0; m < 4; ++m) { const int row = rbase + ai * HALF + m * 16; float s = 0.f;
#pragma unroll
                    for (int bj = 0; bj < 2; ++bj) { f32x4 r0, r1; up8(r[m][bj], r0, r1); const f32x4 v0 = r0 + acc[ai][bj][m][0], v1 = r1 + acc[ai][bj][m][1];
                        st8(xb + (size_t)row * 1024 + c0 + bj * HALF, v0, v1); s += sq4(v0) + sq4(v1); }
                    s = quad_sum(s); if (fq == 0) SS[(size_t)row * 16 + u.pn * 4 + wc] = s; }
                EPI_FENCE(); }
        } else {
#pragma unroll
            for (int ai = 0; ai < 2; ++ai)
#pragma unroll
                for (int mp = 0; mp < 2; ++mp) { f32x4 r[2][2][2];
#pragma unroll
                    for (int mm = 0; mm < 2; ++mm)
#pragma unroll
                        for (int bj = 0; bj < 2; ++bj) { const float* p = (const float*)res + (size_t)(rbase + ai * HALF + (2 * mp + mm) * 16) * 1024 + c0 + bj * HALF; r[mm][bj][0] = *(const f32x4*)p; r[mm][bj][1] = *(const f32x4*)(p + 4); }
                    EPI_FENCE();
#pragma unroll
                    for (int mm = 0; mm < 2; ++mm) { const int m = 2 * mp + mm, row = rbase + ai * HALF + m * 16; float s = 0.f;
#pragma unroll
                        for (int bj = 0; bj < 2; ++bj) { const f32x4 v0 = r[mm][bj][0] + acc[ai][bj][m][0], v1 = r[mm][bj][1] + acc[ai][bj][m][1];
                            st8(xb + (size_t)row * 1024 + c0 + bj * HALF, v0, v1); s += sq4(v0) + sq4(v1); }
                        s = quad_sum(s); if (fq == 0) SS[(size_t)row * 16 + u.pn * 4 + wc] = s; }
                    EPI_FENCE(); }
        }
    }
};
__device__ __forceinline__ float rstd16(const float* ss) { const f32x4 a = *(const f32x4*)ss, b = *(const f32x4*)(ss + 4), c = *(const f32x4*)(ss + 8), d = *(const f32x4*)(ss + 12);
    const f32x4 t = (a + b) + (c + d); return __builtin_amdgcn_rsqf(((t[0] + t[1]) + (t[2] + t[3])) * (1.f / 1024.f) + NEPS); }
struct EpiSwiGLU {
    static constexpr bool PERM = true, AFTER_DRAIN = false;
    const float* SS; bf16_t* HID;
    __device__ __forceinline__ void operator()(const f32x4 (&acc)[2][2][4][2], const Unit& u, int wr, int wc, int fr, int fq) const {
        const int rbase = u.pm * BM + wr * 64 + fr, c0 = u.pn * HALF + wc * 32 + fq * 8;
        EPI_LOOP_AM { const int row = rbase + ai * HALF + m * 16; const float rstd = rstd16(SS + (size_t)row * 16);
            const f32x4 g0 = acc[ai][0][m][0] * rstd, g1 = acc[ai][0][m][1] * rstd, u0 = acc[ai][1][m][0] * rstd, u1 = acc[ai][1][m][1] * rstd;
            st8(HID + (size_t)row * 2816 + c0, g0 * sigm4(g0) * u0, g1 * sigm4(g1) * u1);
            EPI_FENCE(); }
    }
};
struct EpiPleA {
    static constexpr bool PERM = true, AFTER_DRAIN = false;
    bf16_t* T;
    __device__ __forceinline__ void operator()(const f32x4 (&acc)[2][2][4][2], const Unit& u, int wr, int wc, int fr, int fq) const {
        const int rbase = u.pm * BM + wr * 64 + fr, c0 = u.pn * BM + wc * 32 + fq * 8;
        EPI_LOOP_AM { const int row = rbase + ai * HALF + m * 16;
#pragma unroll
            for (int bj = 0; bj < 2; ++bj) st8(T + (size_t)row * 1024 + c0 + bj * HALF, acc[ai][bj][m][0], acc[ai][bj][m][1]); }
    }
};
struct EpiPleB {
    static constexpr bool PERM = true, AFTER_DRAIN = false;
    const float* SS2; const float* bias; const bf16_t* X2; const bf16_t* T2; bf16_t* X3; float* SS3;
    __device__ __forceinline__ void operator()(const f32x4 (&acc)[2][2][4][2], const Unit& u, int wr, int wc, int fr, int fq) const {
        const int rbase = u.pm * BM + wr * 64 + fr, c0 = u.pn * BM + wc * 32 + fq * 8;
#pragma unroll
        for (int ai = 0; ai < 2; ++ai)
#pragma unroll
          for (int mp = 0; mp < 2; ++mp) { u32x4 x[2][2], t[2][2]; float rs[2];
#pragma unroll
            for (int mm = 0; mm < 2; ++mm) { const int row = rbase + ai * HALF + (2 * mp + mm) * 16;
#pragma unroll
                for (int bj = 0; bj < 2; ++bj) { const size_t o = (size_t)row * 1024 + c0 + bj * HALF; x[mm][bj] = *(const u32x4*)(X2 + o); t[mm][bj] = *(const u32x4*)(T2 + o); }
                rs[mm] = rstd16(SS2 + (size_t)row * 16); }
            EPI_FENCE();
#pragma unroll
            for (int mm = 0; mm < 2; ++mm) { const int m = 2 * mp + mm, row = rbase + ai * HALF + m * 16; float s = 0.f;
#pragma unroll
                for (int bj = 0; bj < 2; ++bj) { const f32x4 b0 = *(const f32x4*)(bias + c0 + bj * HALF), b1 = *(const f32x4*)(bias + c0 + bj * HALF + 4);
                    f32x4 x0, x1, t0, t1; up8(x[mm][bj], x0, x1); up8(t[mm][bj], t0, t1);
                    const f32x4 v0 = x0 + t0 * sigm4(acc[ai][bj][m][0] * rs[mm] + b0), v1 = x1 + t1 * sigm4(acc[ai][bj][m][1] * rs[mm] + b1);
                    st8(X3 + (size_t)row * 1024 + c0 + bj * HALF, v0, v1); s += sq4(v0) + sq4(v1); }
                s = quad_sum(s); if (fq == 0) SS3[(size_t)row * 16 + u.pn * 4 + wc] = s; }
            EPI_FENCE(); }
    }
};
template <class Epi, class Sched, bool ALIGN_EPI = false, bool SP2 = false>
__device__ __forceinline__ void gemm_phase(PG8_LAS unsigned char* lds, const Gemm g, const Sched& S, const Epi& E) {
    int tid_ = threadIdx.x; asm volatile("" : "+v"(tid_)); const int tid = tid_, wid = __builtin_amdgcn_readfirstlane(tid >> 6), lane = tid & 63, wr = wid >> 2, wc = wid & 3, fr = lane & 15, fq = lane >> 4;
    const int K = g.K, nt = K / BK;
    unsigned voffA[2], voffB[2];
#pragma unroll
    for (int i = 0; i < 2; ++i) { int R, C; stage_rc(tid * 16 + i * 8192, R, C); const int Rb = Epi::PERM ? ((R & ~31) + perm32(R & 31)) : R;
        voffA[i] = (unsigned)(R * K + C) * 2u; voffB[i] = (unsigned)(Rb * K + C) * 2u; }
    const size_t kstep = (size_t)(BK * 2);
    const size_t hstep = (size_t)HALF * K * 2;
    const size_t tstep = 2 * hstep;
    const unsigned ldsw = (unsigned)wid * 1024u;
    const int aoff = lds_byte(wr * 64 + fr, fq * 8), boff = lds_byte(wc * 32 + fr, fq * 8);
#define PG8_SA(b, h) (((b) * 2 + (h)) * HTB)
#define PG8_SB(b, h) ((4 + (b) * 2 + (h)) * HTB)
#define PG8_STAGE(bufoff, gbase, voff) do { _Pragma("unroll") for (int _i = 0; _i < 2; ++_i) \
        __builtin_amdgcn_global_load_lds((const unsigned*)((const char*)(gbase) + (voff)[_i]), (PG8_LAS unsigned*)(lds + (bufoff) + ldsw + _i * 8192), 16, 0, 0); } while (0)
#define PG8_LDA(dst, b, h) do { _Pragma("unroll") for (int m = 0; m < 4; ++m) _Pragma("unroll") for (int k = 0; k < 2; ++k) dst[m][k] = *(const PG8_LAS bf16x8*)(lds + PG8_SA(b, h) + aoff + m * 2048 + k * 1024); } while (0)
#define PG8_LDB(dst, b, h) do { _Pragma("unroll") for (int n = 0; n < 2; ++n) _Pragma("unroll") for (int k = 0; k < 2; ++k) dst[n][k] = *(const PG8_LAS bf16x8*)(lds + PG8_SB(b, h) + boff + n * 2048 + k * 1024); } while (0)
#define PG8_MMA(ai, bj, At, Bt) do { __builtin_amdgcn_s_setprio(1); _Pragma("unroll") for (int m = 0; m < 4; ++m) _Pragma("unroll") for (int n = 0; n < 2; ++n) _Pragma("unroll") for (int k = 0; k < 2; ++k) \
        acc[ai][bj][m][n] = __builtin_amdgcn_mfma_f32_16x16x32_bf16(Bt[n][k], At[m][k], acc[ai][bj][m][n], 0, 0, 0); __builtin_amdgcn_s_setprio(0); } while (0)
#define PG8_WAIT_V(n) asm volatile("s_waitcnt vmcnt(" #n ")" ::: "memory")
#define PG8_WAIT_L(n) asm volatile("s_waitcnt lgkmcnt(" #n ")" ::: "memory")
#define PG8_BAR __builtin_amdgcn_s_barrier()
#define PG8_SCHED __builtin_amdgcn_sched_barrier(0)
    Unit cur, nxt; int ui = 0;
    if (!S.next(0, cur)) return;
    f32x4 acc[2][2][4][2];
#pragma unroll
    for (int a = 0; a < 2; ++a)
#pragma unroll
        for (int b = 0; b < 2; ++b)
#pragma unroll
            for (int m = 0; m < 4; ++m)
#pragma unroll
                for (int n = 0; n < 2; ++n) acc[a][b][m][n] = (f32x4){0.f, 0.f, 0.f, 0.f};
    bf16x8 At[4][2], B0[2][2], B1[2][2];
    const char* cA = (const char*)g.A + (size_t)cur.pm * tstep; const char* cB = (const char*)g.Bt + (size_t)cur.pn * tstep;
    S.a_ready(cur);
    if constexpr (SP2) {
        PG8_STAGE(PG8_SB(0, 0), cB, voffB); PG8_STAGE(PG8_SB(0, 1), cB + hstep, voffB); PG8_STAGE(PG8_SA(0, 0), cA, voffA); PG8_STAGE(PG8_SA(0, 1), cA + hstep, voffA);
        if (wr == 1) PG8_BAR;
        PG8_WAIT_V(2); PG8_BAR;
        PG8_STAGE(PG8_SB(1, 0), cB + kstep, voffB); PG8_STAGE(PG8_SA(1, 0), cA + kstep, voffA); PG8_STAGE(PG8_SB(1, 1), cB + hstep + kstep, voffB);
        PG8_WAIT_V(6); PG8_BAR;
    } else {
        PG8_STAGE(PG8_SB(0, 0), cB, voffB); PG8_STAGE(PG8_SA(0, 0), cA, voffA); PG8_STAGE(PG8_SB(0, 1), cB + hstep, voffB); PG8_STAGE(PG8_SA(0, 1), cA + hstep, voffA);
        if (wr == 1) PG8_BAR;
        PG8_WAIT_V(4); PG8_BAR;
        PG8_STAGE(PG8_SB(1, 0), cB + kstep, voffB); PG8_STAGE(PG8_SA(1, 0), cA + kstep, voffA); PG8_STAGE(PG8_SB(1, 1), cB + hstep + kstep, voffB);
        PG8_WAIT_V(6); PG8_BAR;
    }
    for (;;) {
        const bool has_next = S.next(ui + 1, nxt);
        const char* nA = has_next ? (const char*)g.A + (size_t)nxt.pm * tstep : cA; const char* nB = has_next ? (const char*)g.Bt + (size_t)nxt.pn * tstep : cB;
        for (int t = 0; t < nt; t += 2) {
            const bool last = (t == nt - 2);
            const char* a1 = cA + (size_t)(t + 1) * kstep;
            const char* a2 = last ? nA : cA + (size_t)(t + 2) * kstep; const char* b2 = last ? nB : cB + (size_t)(t + 2) * kstep;
            const char* a3 = a2 + kstep; const char* b3 = b2 + kstep;
            if (last && has_next) S.a_ready(nxt);
            if constexpr (SP2) {
            PG8_LDB(B0, 0, 0); PG8_LDB(B1, 0, 1); PG8_SCHED; PG8_LDA(At, 0, 0); PG8_STAGE(PG8_SA(1, 1), a1 + hstep, voffA);
            PG8_WAIT_V(8); PG8_WAIT_L(0); PG8_BAR; PG8_MMA(0, 0, At, B0); PG8_MMA(0, 1, At, B1); PG8_BAR; PG8_SCHED;
            PG8_LDA(At, 0, 1); PG8_STAGE(PG8_SB(0, 0), b2, voffB); PG8_STAGE(PG8_SB(0, 1), b2 + hstep, voffB); PG8_STAGE(PG8_SA(0, 0), a2, voffA);
            PG8_WAIT_V(8); PG8_WAIT_L(0); PG8_BAR; PG8_MMA(1, 0, At, B0); PG8_MMA(1, 1, At, B1); PG8_BAR; PG8_SCHED;
            PG8_LDB(B0, 1, 0); PG8_LDB(B1, 1, 1); PG8_SCHED; PG8_LDA(At, 1, 0); PG8_STAGE(PG8_SA(0, 1), a2 + hstep, voffA);
            PG8_WAIT_V(8); PG8_WAIT_L(0); PG8_BAR; PG8_MMA(0, 0, At, B0); PG8_MMA(0, 1, At, B1); PG8_BAR; PG8_SCHED;
            PG8_LDA(At, 1, 1); PG8_STAGE(PG8_SB(1, 0), b3, voffB); PG8_STAGE(PG8_SB(1, 1), b3 + hstep, voffB); PG8_STAGE(PG8_SA(1, 0), a3, voffA);
            PG8_WAIT_V(8); PG8_WAIT_L(0); PG8_BAR; PG8_MMA(1, 0, At, B0); PG8_MMA(1, 1, At, B1); PG8_BAR; PG8_SCHED;
            } else {
            PG8_LDB(B0, 0, 0); PG8_SCHED; PG8_LDA(At, 0, 0); PG8_STAGE(PG8_SA(1, 1), a1 + hstep, voffA);
            PG8_WAIT_L(8); PG8_BAR; PG8_WAIT_L(0); PG8_MMA(0, 0, At, B0); PG8_BAR; PG8_SCHED;
            PG8_LDB(B1, 0, 1); PG8_STAGE(PG8_SB(0, 0), b2, voffB);
            PG8_BAR; PG8_WAIT_L(0); PG8_MMA(0, 1, At, B1); PG8_BAR;
            PG8_LDA(At, 0, 1); PG8_STAGE(PG8_SA(0, 0), a2, voffA);
            PG8_BAR; PG8_WAIT_L(0); PG8_MMA(1, 0, At, B0); PG8_BAR; PG8_SCHED;
            PG8_STAGE(PG8_SB(0, 1), b2 + hstep, voffB);
            PG8_WAIT_V(6); PG8_BAR; PG8_MMA(1, 1, At, B1); PG8_BAR;
            PG8_LDB(B0, 1, 0); PG8_SCHED; PG8_LDA(At, 1, 0); PG8_STAGE(PG8_SA(0, 1), a2 + hstep, voffA);
            PG8_WAIT_L(8); PG8_BAR; PG8_WAIT_L(0); PG8_MMA(0, 0, At, B0); PG8_BAR; PG8_SCHED;
            PG8_LDB(B1, 1, 1); PG8_STAGE(PG8_SB(1, 0), b3, voffB);
            PG8_BAR; PG8_WAIT_L(0); PG8_MMA(0, 1, At, B1); PG8_BAR;
            PG8_LDA(At, 1, 1); PG8_STAGE(PG8_SA(1, 0), a3, voffA);
            PG8_BAR; PG8_WAIT_L(0); PG8_MMA(1, 0, At, B0); PG8_BAR; PG8_SCHED;
            PG8_STAGE(PG8_SB(1, 1), b3 + hstep, voffB);
            PG8_WAIT_V(6); PG8_BAR; PG8_MMA(1, 1, At, B1); PG8_BAR;
            }
        }
        if constexpr (ALIGN_EPI) { if (wr == 0) PG8_BAR; }
        if constexpr (!Epi::AFTER_DRAIN) { E(acc, cur, wr, wc, fr, fq); S.done(cur); }
        if (!has_next) break;
#pragma unroll
        for (int a = 0; a < 2; ++a)
#pragma unroll
            for (int b = 0; b < 2; ++b)
#pragma unroll
                for (int m = 0; m < 4; ++m)
#pragma unroll
                    for (int n = 0; n < 2; ++n) acc[a][b][m][n] = (f32x4){0.f, 0.f, 0.f, 0.f};
        cur = nxt; cA = nA; cB = nB; ++ui;
        if constexpr (ALIGN_EPI) { if (wr == 1) PG8_BAR; }
    }
    PG8_WAIT_V(0);
    if constexpr (!ALIGN_EPI) { if (wr == 0) PG8_BAR; }
    PG8_BAR;
    if constexpr (Epi::AFTER_DRAIN) { E.fused(acc, cur, wr, wc, fr, fq, lds, wid, lane); S.done(cur); }
#undef PG8_SA
#undef PG8_SB
#undef PG8_STAGE
#undef PG8_LDA
#undef PG8_LDB
#undef PG8_MMA
#undef PG8_WAIT_V
#undef PG8_WAIT_L
#undef PG8_BAR
#undef PG8_SCHED
}
}
namespace att {
#define ATT_LAS __attribute__((address_space(3)))
typedef unsigned short bf16_t;
typedef short bf16x8 __attribute__((ext_vector_type(8)));
typedef short s16x4 __attribute__((ext_vector_type(4)));
typedef float f32x16 __attribute__((ext_vector_type(16)));
typedef float f32x4 __attribute__((ext_vector_type(4)));
typedef unsigned u32x4 __attribute__((ext_vector_type(4)));
typedef unsigned u32x2 __attribute__((ext_vector_type(2)));
constexpr int KB0 = 0, KBSZ = 12288, VB0 = 24576, VBSZ = 16384;
__device__ __forceinline__ float swap_max(float m) { auto rr = __builtin_amdgcn_permlane32_swap(__float_as_uint(m), __float_as_uint(m), false, false); return fmaxf(__uint_as_float(rr[0]), __uint_as_float(rr[1])); }
__device__ __forceinline__ float swap_sum(float m) { auto rr = __builtin_amdgcn_permlane32_swap(__float_as_uint(m), __float_as_uint(m), false, false); return __uint_as_float(rr[0]) + __uint_as_float(rr[1]); }
__device__ __forceinline__ s16x4 vtr(const ATT_LAS char* p) { return __builtin_bit_cast(s16x4, __builtin_amdgcn_ds_read_tr16_b64_v4i16((ATT_LAS s16x4*)p)); }
__device__ __forceinline__ float max3f(float a, float b, float c) { float r; asm("v_max3_f32 %0, %1, %2, %3" : "=v"(r) : "v"(a), "v"(b), "v"(c)); return r; }
__device__ __forceinline__ int crow(int r, int hi) { return (r & 3) + 8 * (r >> 2) + 4 * hi; }

template <int DQK, int DV, bool MLA>
__device__ __forceinline__ void attn_pass(ATT_LAS char* lds, const bf16_t* qp, const bf16_t* kg, const bf16_t* krg, const bf16_t* vg, int NT, int myNT, f32x16 (&o)[DV / 32], float& linv) {
    int tid_ = threadIdx.x; asm volatile("" : "+v"(tid_)); const int tid = tid_, lane = tid & 63, wid = __builtin_amdgcn_readfirstlane(tid >> 6), r32 = lane & 31, hi = lane >> 5;
    bf16x8 qr[DQK / 16];
#pragma unroll
    for (int d0 = 0; d0 < DQK / 16; ++d0) qr[d0] = *(const bf16x8*)(qp + d0 * 16);
    const bf16_t* ksrc = kg + (size_t)lane * 1024 + wid * 8;
    const bf16_t* krsrc = krg + (size_t)lane * 32 + (wid & 3) * 8;
    const bf16_t* vsrc = vg + (size_t)(16 * (wid & 3) + (lane >> 2)) * 1024 + (wid >> 2) * 32 + (lane & 3) * 8;
    const int sto = wid * 1024 + lane * 16;
    u32x4 kr0 = {0u, 0u, 0u, 0u}, kr1 = kr0, vr0 = kr0, vr1 = kr0;
#define ATT_LOAD(t) do { kr0 = *(const u32x4*)(ksrc + (size_t)(t) * 65536); if (MLA) { if (wid < 4) kr1 = *(const u32x4*)(krsrc + (size_t)(t) * 2048); } \
        vr0 = *(const u32x4*)(vsrc + (size_t)(t) * 65536); if (DV == 128) vr1 = *(const u32x4*)(vsrc + (size_t)(t) * 65536 + 64); } while (0)
#define ATT_STORE(b) do { *(ATT_LAS u32x4*)(lds + KB0 + (b) * KBSZ + sto) = kr0; if (MLA) { if (wid < 4) *(ATT_LAS u32x4*)(lds + KB0 + (b) * KBSZ + 8192 + sto) = kr1; } \
        *(ATT_LAS u32x4*)(lds + VB0 + (b) * VBSZ + sto) = vr0; if (DV == 128) *(ATT_LAS u32x4*)(lds + VB0 + (b) * VBSZ + 8192 + sto) = vr1; } while (0)
#pragma unroll
    for (int i = 0; i < DV / 32; ++i)
#pragma unroll
        for (int r = 0; r < 16; ++r) o[i][r] = 0.f;
    float mref = 0.f, lsum = 0.f;
    ATT_LOAD(0); ATT_STORE(0); __syncthreads();
    for (int t = 0; t < NT; ++t) {
        const int b = t & 1;
        if (t + 1 < NT) ATT_LOAD(t + 1);
        if (t < myNT) {
            const ATT_LAS char* kp = lds + KB0 + b * KBSZ + hi * 1024 + r32 * 16;
            f32x16 p0, p1;
#pragma unroll
            for (int r = 0; r < 16; ++r) { p0[r] = -mref; p1[r] = -mref; }
#pragma unroll
            for (int d0 = 0; d0 < DQK / 16; ++d0) {
                const bf16x8 k0 = *(const ATT_LAS bf16x8*)(kp + d0 * 2048), k1 = *(const ATT_LAS bf16x8*)(kp + d0 * 2048 + 512);
                p0 = __builtin_amdgcn_mfma_f32_32x32x16_bf16(k0, qr[d0], p0, 0, 0, 0);
                p1 = __builtin_amdgcn_mfma_f32_32x32x16_bf16(k1, qr[d0], p1, 0, 0, 0);
            }
            asm volatile("s_nop 15\n\ts_nop 7" : "+v"(p0), "+v"(p1));
            float mxa = max3f(p0[0], p0[1], p1[0]), mxb = max3f(p0[2], p0[3], p1[1]); mxa = max3f(mxa, p1[2], p1[3]);
#pragma unroll
            for (int r = 4; r < 16; r += 4) { mxa = max3f(mxa, p0[r], p0[r + 1]); mxb = max3f(mxb, p0[r + 2], p0[r + 3]); mxa = max3f(mxa, p1[r], p1[r + 1]); mxb = max3f(mxb, p1[r + 2], p1[r + 3]); }
            float mx = swap_max(max3f(mxa, mxb, mxb));
            if (__any(mx > 8.f)) {
                const float dl = fmaxf(mx, 0.f), al = __builtin_amdgcn_exp2f(-dl);
                lsum *= al;
#pragma unroll
                for (int i = 0; i < DV / 32; ++i)
#pragma unroll
                    for (int r = 0; r < 16; ++r) o[i][r] *= al;
#pragma unroll
                for (int r = 0; r < 16; ++r) { p0[r] -= dl; p1[r] -= dl; }
                mref += dl;
            }
            float ls = 0.f;
#pragma unroll
            for (int r = 0; r < 16; ++r) { p0[r] = __builtin_amdgcn_exp2f(p0[r]); p1[r] = __builtin_amdgcn_exp2f(p1[r]); ls += p0[r] + p1[r]; }
            lsum += ls;
            u32x4 pw[4];
#pragma unroll
            for (int j = 0; j < 4; ++j) { pw[0][j] = pg8::pk2(p0[2 * j], p0[2 * j + 1]); pw[1][j] = pg8::pk2(p0[8 + 2 * j], p0[9 + 2 * j]); pw[2][j] = pg8::pk2(p1[2 * j], p1[2 * j + 1]); pw[3][j] = pg8::pk2(p1[8 + 2 * j], p1[9 + 2 * j]); }
            const ATT_LAS char* vp = lds + VB0 + b * VBSZ + ((lane >> 4) & 1) * 32 + (lane & 3) * 8 + (4 * hi + ((lane & 15) >> 2)) * 64;
#pragma unroll
            for (int i = 0; i < DV / 32; ++i)
#pragma unroll
                for (int ks = 0; ks < 4; ++ks) {
                    const s16x4 lo = vtr(vp + i * 4096 + ks * 1024), hh = vtr(vp + i * 4096 + ks * 1024 + 512);
                    const bf16x8 vf = {lo[0], lo[1], lo[2], lo[3], hh[0], hh[1], hh[2], hh[3]};
                    o[i] = __builtin_amdgcn_mfma_f32_32x32x16_bf16(vf, __builtin_bit_cast(bf16x8, pw[ks]), o[i], 0, 0, 0);
                }
        }
        if (t + 1 < NT) ATT_STORE(b ^ 1);
        __syncthreads();
    }
    linv = __builtin_amdgcn_rcpf(swap_sum(lsum));
#undef ATT_LOAD
#undef ATT_STORE
}

__device__ __forceinline__ void qk_softmax64(const ATT_LAS char* kbuf, const ATT_LAS char* qimg, float& mref, float& lsum, f32x16 (&o)[4], u32x4 (&pw)[4], int r32, int hi) {
    const ATT_LAS char* kp = kbuf + hi * 1024 + r32 * 16;
    f32x16 p0, p1;
#pragma unroll
    for (int r = 0; r < 16; ++r) { p0[r] = -mref; p1[r] = -mref; }
#pragma unroll
    for (int d0 = 0; d0 < 4; ++d0) {
        const bf16x8 k0 = *(const ATT_LAS bf16x8*)(kp + d0 * 2048), k1 = *(const ATT_LAS bf16x8*)(kp + d0 * 2048 + 512), q = *(const ATT_LAS bf16x8*)(qimg + d0 * 1024);
        p0 = __builtin_amdgcn_mfma_f32_32x32x16_bf16(k0, q, p0, 0, 0, 0);
        p1 = __builtin_amdgcn_mfma_f32_32x32x16_bf16(k1, q, p1, 0, 0, 0);
    }
    asm volatile("s_nop 15\n\ts_nop 7" : "+v"(p0), "+v"(p1));
    float mxa = max3f(p0[0], p0[1], p1[0]), mxb = max3f(p0[2], p0[3], p1[1]); mxa = max3f(mxa, p1[2], p1[3]);
#pragma unroll
    for (int r = 4; r < 16; r += 4) { mxa = max3f(mxa, p0[r], p0[r + 1]); mxb = max3f(mxb, p0[r + 2], p0[r + 3]); mxa = max3f(mxa, p1[r], p1[r + 1]); mxb = max3f(mxb, p1[r + 2], p1[r + 3]); }
    const float mx = swap_max(max3f(mxa, mxb, mxb));
    if (__any(mx > 8.f)) {
        const float dl = fmaxf(mx, 0.f), al = __builtin_amdgcn_exp2f(-dl);
        lsum *= al;
#pragma unroll
        for (int i = 0; i < 4; ++i)
#pragma unroll
            for (int r = 0; r < 16; ++r) o[i][r] *= al;
#pragma unroll
        for (int r = 0; r < 16; ++r) { p0[r] -= dl; p1[r] -= dl; }
        mref += dl;
    }
    float ls = 0.f;
#pragma unroll
    for (int r = 0; r < 16; ++r) { p0[r] = __builtin_amdgcn_exp2f(p0[r]); p1[r] = __builtin_amdgcn_exp2f(p1[r]); ls += p0[r] + p1[r]; }
    lsum += ls;
#pragma unroll
    for (int j = 0; j < 4; ++j) { pw[0][j] = pg8::pk2(p0[2 * j], p0[2 * j + 1]); pw[1][j] = pg8::pk2(p0[8 + 2 * j], p0[9 + 2 * j]); pw[2][j] = pg8::pk2(p1[2 * j], p1[2 * j + 1]); pw[3][j] = pg8::pk2(p1[8 + 2 * j], p1[9 + 2 * j]); }
}
__device__ __forceinline__ void diff_unit(ATT_LAS char* lds, int b, int h, int qb, const bf16_t* QD, const bf16_t* KD, const bf16_t* VD, bf16_t* OD, const float* subln, float lam) {
    int tid_ = threadIdx.x; asm volatile("" : "+v"(tid_)); const int tid = tid_, lane = tid & 63, wid = __builtin_amdgcn_readfirstlane(tid >> 6), r32 = lane & 31, hi = lane >> 5;
    const size_t row0 = (size_t)b * SEQ_LEN, qrow = row0 + qb * 256 + wid * 32 + r32;
    const int NT = 4 * qb + 4, myNT = 4 * qb + (wid >> 1) + 1;
    constexpr int DKB0 = 0, DKBSZ = 16384, DVB0 = 32768, DVBSZ = 16384;
    ATT_LAS char* qimg = lds + 65536 + wid * 8192 + hi * 512 + r32 * 16;
    { const bf16_t* qp = QD + qrow * 1024 + (2 * h) * 64 + hi * 8;
#pragma unroll
      for (int d0 = 0; d0 < 4; ++d0) { *(ATT_LAS bf16x8*)(qimg + d0 * 1024) = *(const bf16x8*)(qp + d0 * 16); *(ATT_LAS bf16x8*)(qimg + 4096 + d0 * 1024) = *(const bf16x8*)(qp + 64 + d0 * 16); } }
    const bf16_t* ksrc = KD + row0 * 1024 + (2 * h) * 64 + (size_t)lane * 1024 + wid * 8;
    const bf16_t* vsrc = VD + row0 * 1024 + h * 128 + (size_t)(16 * (wid & 3) + (lane >> 2)) * 1024 + (wid >> 2) * 32 + (lane & 3) * 8;
    const int sto = wid * 1024 + lane * 16;
    const int vlane = ((lane >> 4) & 1) * 32 + (lane & 3) * 8 + (4 * hi + ((lane & 15) >> 2)) * 64;
    u32x4 ka, kb, va, vb;
#define DF_LOAD(t) do { ka = *(const u32x4*)(ksrc + (size_t)(t) * 65536); kb = *(const u32x4*)(ksrc + (size_t)(t) * 65536 + 64); va = *(const u32x4*)(vsrc + (size_t)(t) * 65536); vb = *(const u32x4*)(vsrc + (size_t)(t) * 65536 + 64); } while (0)
#define DF_STORE(bf) do { *(ATT_LAS u32x4*)(lds + DKB0 + (bf) * DKBSZ + sto) = ka; *(ATT_LAS u32x4*)(lds + DKB0 + (bf) * DKBSZ + 8192 + sto) = kb; \
        *(ATT_LAS u32x4*)(lds + DVB0 + (bf) * DVBSZ + sto) = va; *(ATT_LAS u32x4*)(lds + DVB0 + (bf) * DVBSZ + 8192 + sto) = vb; } while (0)
    f32x16 o1[4], o2[4];
#pragma unroll
    for (int i = 0; i < 4; ++i)
#pragma unroll
        for (int r = 0; r < 16; ++r) { o1[i][r] = 0.f; o2[i][r] = 0.f; }
    float m1 = 0.f, l1 = 0.f, m2 = 0.f, l2 = 0.f;
    DF_LOAD(0); DF_STORE(0); __syncthreads();
    for (int t = 0; t < NT; ++t) {
        const int bf = t & 1;
        if (t + 1 < NT) DF_LOAD(t + 1);
        if (t < myNT) {
            u32x4 pwa[4], pwb[4];
            qk_softmax64(lds + DKB0 + bf * DKBSZ, qimg, m1, l1, o1, pwa, r32, hi);
            qk_softmax64(lds + DKB0 + bf * DKBSZ + 8192, qimg + 4096, m2, l2, o2, pwb, r32, hi);
            const ATT_LAS char* vp = lds + DVB0 + bf * DVBSZ + vlane;
#pragma unroll
            for (int i = 0; i < 4; ++i)
#pragma unroll
                for (int ks = 0; ks < 4; ++ks) {
                    const s16x4 lo = vtr(vp + i * 4096 + ks * 1024), hh = vtr(vp + i * 4096 + ks * 1024 + 512);
                    const bf16x8 vf = {lo[0], lo[1], lo[2], lo[3], hh[0], hh[1], hh[2], hh[3]};
                    o1[i] = __builtin_amdgcn_mfma_f32_32x32x16_bf16(vf, __builtin_bit_cast(bf16x8, pwa[ks]), o1[i], 0, 0, 0);
                    o2[i] = __builtin_amdgcn_mfma_f32_32x32x16_bf16(vf, __builtin_bit_cast(bf16x8, pwb[ks]), o2[i], 0, 0, 0);
                }
        }
        if (t + 1 < NT) DF_STORE(bf ^ 1);
        __syncthreads();
    }
#undef DF_LOAD
#undef DF_STORE
    const float li1 = __builtin_amdgcn_rcpf(swap_sum(l1)), c2 = lam * __builtin_amdgcn_rcpf(swap_sum(l2)); float ss = 0.f;
#pragma unroll
    for (int i = 0; i < 4; ++i)
#pragma unroll
        for (int r = 0; r < 16; ++r) { const float v = o1[i][r] * li1 - o2[i][r] * c2; o1[i][r] = v; ss += v * v; }
    ss = swap_sum(ss);
    const float rstd = __builtin_amdgcn_rsqf(ss * (1.f / 128.f) + NEPS) * 0.8f;
    bf16_t* op = OD + qrow * 1024 + h * 128 + 4 * hi;
#pragma unroll
    for (int i = 0; i < 4; ++i)
#pragma unroll
        for (int rq = 0; rq < 4; ++rq) { const int dv = 32 * i + 8 * rq; const f32x4 g = *(const f32x4*)(subln + dv + 4 * hi);
            u32x2 w; w.x = pg8::pk2(o1[i][4 * rq] * rstd * g[0], o1[i][4 * rq + 1] * rstd * g[1]); w.y = pg8::pk2(o1[i][4 * rq + 2] * rstd * g[2], o1[i][4 * rq + 3] * rstd * g[3]);
            *(u32x2*)(op + dv) = w; }
}
__device__ __forceinline__ void mla_unit(ATT_LAS char* lds, int b, int h, int qb, const bf16_t* QM, const bf16_t* KVM, const bf16_t* KR, bf16_t* OM) {
    int tid_ = threadIdx.x; asm volatile("" : "+v"(tid_)); const int tid = tid_, lane = tid & 63, wid = __builtin_amdgcn_readfirstlane(tid >> 6), r32 = lane & 31, hi = lane >> 5;
    const size_t row0 = (size_t)b * SEQ_LEN, qrow = row0 + qb * 256 + wid * 32 + r32;
    const int NT = 4 * qb + 4, myNT = 4 * qb + (wid >> 1) + 1;
    f32x16 o[2]; float li;
    attn_pass<96, 64, true>(lds, QM + qrow * 768 + h * 96 + hi * 8, KVM + row0 * 1024 + h * 128, KR + row0 * 32, KVM + row0 * 1024 + h * 128 + 64, NT, myNT, o, li);
    bf16_t* op = OM + qrow * 512 + h * 64 + 4 * hi;
#pragma unroll
    for (int i = 0; i < 2; ++i)
#pragma unroll
        for (int rq = 0; rq < 4; ++rq) { const int dv = 32 * i + 8 * rq;
            u32x2 w; w.x = pg8::pk2(o[i][4 * rq] * li, o[i][4 * rq + 1] * li); w.y = pg8::pk2(o[i][4 * rq + 2] * li, o[i][4 * rq + 3] * li);
            *(u32x2*)(op + dv) = w; }
}
}
#define LAS __attribute__((address_space(3)))
typedef unsigned short bf16;
typedef float f32x4 __attribute__((ext_vector_type(4)));
typedef unsigned v4u __attribute__((ext_vector_type(4)));
typedef unsigned v2u __attribute__((ext_vector_type(2)));
constexpr int NWAVES = 8, LDS_BYTES = 147456;
constexpr size_t MiB = 1ull << 20;
constexpr size_t WS_TABD = 0, WS_TABM = 128 * 1024, WS_LAM = 384 * 1024, WS_BAR = 512 * 1024;
constexpr size_t WS_SSQ = 1 * MiB, WS_SSKV = 2 * MiB, WS_SS1 = 3 * MiB, WS_SS2 = 5 * MiB, WS_SS3 = 7 * MiB;
constexpr size_t WS_WIN = 10 * MiB, WS_WGU = WS_WIN + 5888ull * 1024 * 2, WS_WDN = WS_WGU + 5632ull * 1024 * 2, WS_WOD = WS_WDN + 1024ull * 2816 * 2, WS_WOUT = WS_WOD + 2 * MiB,
                 WS_WPG = WS_WOUT + 2 * MiB, WS_WOM = WS_WPG + 2 * MiB, WS_WUQ = WS_WOM + 1 * MiB, WS_WUKV = WS_WUQ + 768ull * 384 * 2, WS_WPLE = WS_WUKV + 1024ull * 256 * 2, WS_WEND = WS_WPLE + 1024ull * 256 * 2;
static_assert(WS_WEND <= 47 * MiB, "weights");
constexpr size_t WS_PB = 47 * MiB;
constexpr size_t WS_XN = 64 * MiB, WS_QM = 64 * MiB, WS_X1B = 64 * MiB;
constexpr size_t WS_QD = 128 * MiB, WS_KD = 192 * MiB, WS_VD = 256 * MiB, WS_KVM = 320 * MiB;
constexpr size_t WS_T = 192 * MiB, WS_MG = 320 * MiB;
constexpr size_t WS_HID = 128 * MiB, WS_X2B = 304 * MiB;
constexpr size_t WS_X3B = 384 * MiB, WS_T2B = 448 * MiB;
constexpr size_t WS_CKV = 384 * MiB, WS_CQ = 400 * MiB, WS_KR = 424 * MiB, WS_OM = 426 * MiB;
constexpr size_t WS_END = 512 * MiB;

#define XB_TMO      128
#define XB_XCNT(j)  (256  + 64 * (j))
#define XB_XSUB(j)  (1280 + 64 * (j))
#define XB_XGEN(j)  (2304 + 64 * (j))
#define XB_TOP      3328
#define XB_TOPGEN   3392
#define XCD_BAR_WORDS 3456
#define XB_SPIN_CAP (1u << 18)

__device__ __forceinline__ unsigned xb_ld(unsigned* p)              { return __hip_atomic_load(p, __ATOMIC_RELAXED, __HIP_MEMORY_SCOPE_AGENT); }
__device__ __forceinline__ unsigned xb_add(unsigned* p, unsigned v) { return __hip_atomic_fetch_add(p, v, __ATOMIC_RELAXED, __HIP_MEMORY_SCOPE_AGENT); }
__device__ __forceinline__ unsigned xb_xcc_id() { return (unsigned)__builtin_amdgcn_s_getreg((3 << 11) | 20) & 0xFu; }
#define XB_SPIN(cond, bar) do { unsigned _sp = 0; while (cond) { __builtin_amdgcn_s_sleep(1); \
    if ((++_sp & 255u) == 0u) { if (xb_ld(&(bar)[XB_TMO])) break; if (_sp > XB_SPIN_CAP) { atomicAdd(&(bar)[XB_TMO], 1u); break; } } } } while (0)

struct XcdBarrier {
    unsigned* bar; unsigned x;
    volatile LAS unsigned* st;
};

__device__ __forceinline__ XcdBarrier xcd_barrier_post(unsigned* bar, volatile LAS unsigned* st) {
    XcdBarrier b; b.bar = bar; b.x = xb_xcc_id(); b.st = st;
    if (threadIdx.x == 0) (void)xb_add(&bar[XB_XCNT(b.x)], 1u);
    return b;
}
__device__ __forceinline__ void xcd_barrier_complete(unsigned* bar, unsigned x, unsigned& nloc, unsigned& nx) {
    const unsigned G = gridDim.x * gridDim.y * gridDim.z;
    unsigned sum, cnt, mine, sp = 0u;
    for (;;) {
        sum = 0u; cnt = 0u; mine = 0u;
#pragma unroll
        for (unsigned j = 0; j < 16; ++j) { const unsigned c = xb_ld(&bar[XB_XCNT(j)]); sum += c; cnt += (c > 0u) ? 1u : 0u; mine = (j == x) ? c : mine; }
        if (sum == G) break;
        __builtin_amdgcn_s_sleep(1);
        if ((++sp & 255u) == 0u) { if (xb_ld(&bar[XB_TMO])) break; if (sp > XB_SPIN_CAP) { atomicAdd(&bar[XB_TMO], 1u); break; } }
    }
    nloc = mine > 0u ? mine : 1u; nx = cnt > 0u ? cnt : 1u;
}

__device__ __forceinline__ void xcd_barrier(const XcdBarrier& b) {
    asm volatile("s_waitcnt vmcnt(0)" ::: "memory");
    __syncthreads();
    if (threadIdx.x == 0) {
        unsigned* bar = b.bar;
        __builtin_amdgcn_s_waitcnt(0);
        unsigned nloc = b.st[0], nx = b.st[1];
        if (nloc == 0u) { xcd_barrier_complete(bar, b.x, nloc, nx); b.st[0] = nloc; b.st[1] = nx; }
        const unsigned old = xb_add(&bar[XB_XSUB(b.x)], 1u);
        const unsigned gen = old / nloc;
        if (old + 1u == (gen + 1u) * nloc) {
            __builtin_amdgcn_fence(__ATOMIC_RELEASE, "agent");
            asm volatile("s_waitcnt vmcnt(0)" ::: "memory");
            const unsigned og = xb_add(&bar[XB_TOP], 1u);
            const unsigned tg = og / nx;
            if (og + 1u == (tg + 1u) * nx) xb_add(&bar[XB_TOPGEN], 1u);
            else XB_SPIN(xb_ld(&bar[XB_TOPGEN]) == tg, bar);
            __builtin_amdgcn_fence(__ATOMIC_ACQUIRE, "agent");
            xb_add(&bar[XB_XGEN(b.x)], 1u);
            asm volatile("s_waitcnt vmcnt(0)" ::: "memory");
        } else {
            XB_SPIN(xb_ld(&bar[XB_XGEN(b.x)]) == gen, bar);
            __builtin_amdgcn_fence(__ATOMIC_ACQUIRE, "agent");
            asm volatile("s_waitcnt vmcnt(0)" ::: "memory");
        }
    }
    __syncthreads();
}

struct Args {
    const float *x, *p, *attn_norm, *w_in, *b_gate, *lam_q1, *lam_k1, *lam_q2, *lam_k2, *diff_subln, *w_o_diff, *q_norm, *w_uq, *kv_norm, *w_ukv, *w_o_mla, *w_out, *ffn_norm,
        *w_ffn_gate, *w_ffn_up, *w_ffn_down, *ple_norm, *w_ple_gate, *b_ple_gate, *w_ple, *final_norm;
    float* out; unsigned char* ws;
};

__device__ __forceinline__ float wave_sum(float v) {
#pragma unroll
    for (int o = 1; o < 64; o <<= 1) v += __shfl_xor(v, o);
    return v;
}
__device__ __forceinline__ void wprep_item(int kind, const float* W, const float* W2, int ld, int K, int Nout, const float* gain, bf16* WT, int item, LAS float* scr, int lane) {
    const int nnb = Nout / 32, kb = item / nnb, nb = item % nnb, k0 = kb * 64, n0 = nb * 32, nl = lane & 31, ks = lane >> 5, n = n0 + nl;
    const float* base = W; int col = n;
    if (kind == 1) {
        if (n < 2048) { const int hl = n & 63; col = (n & ~63) + (hl < 16 ? ((hl & 1) ? (hl >> 1) + 8 : (hl >> 1)) : hl); }
        else if (n < 3072) col = n;
        else if (n < 5120) col = 3744 + (n - 3072);
        else if (n < 5376) col = 3456 + (n - 5120);
        else if (n < 5760) col = 3072 + (n - 5376);
        else if (n < 5792) { const int hl = n - 5760; col = 3712 + ((hl & 1) ? (hl >> 1) + 16 : (hl >> 1)); }
        else col = -1;
    } else if (kind == 2) { const int h = n / 96, hl = n % 96; int s = hl; if (hl >= 64) { const int r = hl - 64; s = 64 + ((r & 1) ? (r >> 1) + 16 : (r >> 1)); } col = h * 96 + s;
    } else if (kind == 3) { const int pn = n >> 8, r = n & 255; if (r < 128) col = pn * 128 + r; else { base = W2; col = pn * 128 + (r - 128); } }
    const float* src = base + (size_t)(k0 + ks) * ld + (col >= 0 ? col : 0);
    float v[32];
#pragma unroll
    for (int i = 0; i < 32; ++i) v[i] = src[(size_t)(2 * i) * ld];
    if (col < 0) {
#pragma unroll
        for (int i = 0; i < 32; ++i) v[i] = 0.f;
    }
    if (gain) { const float* gp = gain + k0 + ks;
#pragma unroll
        for (int i = 0; i < 32; ++i) v[i] *= gp[2 * i]; }
#pragma unroll
    for (int i = 0; i < 32; ++i) scr[(2 * i + ks) * 33 + nl] = v[i];
    asm volatile("s_waitcnt lgkmcnt(0)" ::: "memory");
    const int c = lane & 7;
#pragma unroll
    for (int j = 0; j < 4; ++j) { const int nn = (lane >> 3) + 8 * j; const LAS float* s = scr + (8 * c) * 33 + nn;
        v4u o; o.x = pg8::pk2(s[0], s[33]); o.y = pg8::pk2(s[2 * 33], s[3 * 33]); o.z = pg8::pk2(s[4 * 33], s[5 * 33]); o.w = pg8::pk2(s[6 * 33], s[7 * 33]);
        *(v4u*)(WT + (size_t)(n0 + nn) * K + k0 + 8 * c) = o; }
    asm volatile("s_waitcnt lgkmcnt(0)" ::: "memory");
}

#define WSP(T, off) ((T*)(a.ws + (off)))
#define tabD WSP(float, WS_TABD)
#define tabM WSP(float, WS_TABM)
#define lamp WSP(float, WS_LAM)
#define SSQ WSP(float, WS_SSQ)
#define SSKV WSP(float, WS_SSKV)
#define SS1 WSP(float, WS_SS1)
#define SS2 WSP(float, WS_SS2)
#define SS3 WSP(float, WS_SS3)
#define Win WSP(bf16, WS_WIN)
#define Wgu WSP(bf16, WS_WGU)
#define Wdn WSP(bf16, WS_WDN)
#define Wod WSP(bf16, WS_WOD)
#define Wout WSP(bf16, WS_WOUT)
#define Wpg WSP(bf16, WS_WPG)
#define Wom WSP(bf16, WS_WOM)
#define Wuq WSP(bf16, WS_WUQ)
#define Wukv WSP(bf16, WS_WUKV)
#define Wple WSP(bf16, WS_WPLE)
#define PB WSP(bf16, WS_PB)
#define XN WSP(bf16, WS_XN)
#define QM WSP(bf16, WS_QM)
#define X1B WSP(bf16, WS_X1B)
#define QD WSP(bf16, WS_QD)
#define KD WSP(bf16, WS_KD)
#define VD WSP(bf16, WS_VD)
#define KVM WSP(bf16, WS_KVM)
#define MG WSP(bf16, WS_MG)
#define HID WSP(bf16, WS_HID)
#define X2B WSP(bf16, WS_X2B)
#define CKV WSP(bf16, WS_CKV)
#define CQ WSP(bf16, WS_CQ)
#define KR WSP(bf16, WS_KR)
#define OM WSP(bf16, WS_OM)
#define TBUF WSP(bf16, WS_T)
#define X3B WSP(bf16, WS_X3B)
#define T2B WSP(bf16, WS_T2B)
#define SA ((bf16*)a.out)
#define SB ((bf16*)a.out + (size_t)M_TOK * 1024)
template <class E> __device__ __forceinline__ void run_gemm(LAS unsigned char* lds, const bf16* A, const bf16* Bt, int N, int K, const E& e) {
    asm volatile("" : "+s"(K));
    pg8::Gemm g{A, Bt, M_TOK, N, K}; pg8::StaticOrder S; S.init(M_TOK, N, (int)gridDim.x, (int)blockIdx.x);
    pg8::gemm_phase<E, pg8::StaticOrder, true, true>(lds, g, S, e);
}

__global__ void __launch_bounds__(NWAVES * 64, 2) fwd_megakernel(Args a) {
    extern __shared__ __attribute__((aligned(16))) unsigned char lds_raw[];
    cg::grid_group grid = cg::this_grid();
    LAS unsigned char* lds = (LAS unsigned char*)lds_raw;
    int tid0_ = threadIdx.x; asm volatile("" : "+v"(tid0_)); const int tid = tid0_, lane = tid & 63, wave = __builtin_amdgcn_readfirstlane(tid >> 6);
    const int G = gridDim.x, gw = blockIdx.x * NWAVES + wave, NGW = G * NWAVES;
    volatile LAS unsigned* bst = (volatile LAS unsigned*)(lds + (LDS_BYTES - 64));
    if (tid < 2) bst[tid] = 0u;
    __syncthreads();
    const XcdBarrier xbar = xcd_barrier_post((unsigned*)(a.ws + WS_BAR), bst);
#if !defined(SKIP_P0)
    {
        LAS float* scr = (LAS float*)(lds + wave * 8448);
        constexpr int I0 = 16 * 184, I1 = I0 + 16 * 176, I2 = I1 + 44 * 32, I3 = I2 + 512, I4 = I3 + 512, I5 = I4 + 512, I6 = I5 + 256, I7 = I6 + 144, I8 = I7 + 128, I9 = I8 + 128;
        for (int it = gw; it < I9; it += NGW) {
            if (it < I0)      wprep_item(1, a.w_in, nullptr, 5792, 1024, 5888, nullptr, Win, it, scr, lane);
            else if (it < I1) wprep_item(3, a.w_ffn_gate, a.w_ffn_up, 2816, 1024, 5632, a.ffn_norm, Wgu, it - I0, scr, lane);
            else if (it < I2) wprep_item(0, a.w_ffn_down, nullptr, 1024, 2816, 1024, nullptr, Wdn, it - I1, scr, lane);
            else if (it < I3) wprep_item(0, a.w_o_diff, nullptr, 1024, 1024, 1024, nullptr, Wod, it - I2, scr, lane);
            else if (it < I4) wprep_item(0, a.w_out, nullptr, 1024, 1024, 1024, nullptr, Wout, it - I3, scr, lane);
            else if (it < I5) wprep_item(0, a.w_ple_gate, nullptr, 1024, 1024, 1024, a.ple_norm, Wpg, it - I4, scr, lane);
            else if (it < I6) wprep_item(0, a.w_o_mla, nullptr, 1024, 512, 1024, nullptr, Wom, it - I5, scr, lane);
            else if (it < I7) wprep_item(2, a.w_uq, nullptr, 768, 384, 768, a.q_norm, Wuq, it - I6, scr, lane);
            else if (it < I8) wprep_item(0, a.w_ukv, nullptr, 1024, 256, 1024, a.kv_norm, Wukv, it - I7, scr, lane);
            else              wprep_item(0, a.w_ple, nullptr, 1024, 256, 1024, nullptr, Wple, it - I8, scr, lane);
        }
        for (int r0 = gw * 4; r0 < M_TOK; r0 += NGW * 4) {
            f32x4 v[4][4]; float s[4];
#pragma unroll
            for (int q = 0; q < 4; ++q) { const f32x4* xr = (const f32x4*)(a.x + (size_t)(r0 + q) * 1024) + lane; s[q] = 0.f;
#pragma unroll
                for (int j = 0; j < 4; ++j) v[q][j] = __builtin_nontemporal_load(xr + 64 * j); }
            f32x4 pq[4];
#pragma unroll
            for (int q = 0; q < 4; ++q) pq[q] = __builtin_nontemporal_load((const f32x4*)(a.p + (size_t)(r0 + q) * 256) + lane);
#pragma unroll
            for (int q = 0; q < 4; ++q) {
#pragma unroll
                for (int j = 0; j < 4; ++j) s[q] += pg8::sq4(v[q][j]);
                const float rstd = __builtin_amdgcn_rsqf(wave_sum(s[q]) * (1.f / 1024.f) + NEPS);
                v2u* o8 = (v2u*)(XN + (size_t)(r0 + q) * 1024) + lane;
#pragma unroll
                for (int j = 0; j < 4; ++j) { const f32x4 g = ((const f32x4*)a.attn_norm)[lane + 64 * j]; const f32x4 y = v[q][j] * rstd * g; v2u w; w.x = pg8::pk2(y[0], y[1]); w.y = pg8::pk2(y[2], y[3]); o8[64 * j] = w; }
                v2u wp; wp.x = pg8::pk2(pq[q][0], pq[q][1]); wp.y = pg8::pk2(pq[q][2], pq[q][3]); ((v2u*)(PB + (size_t)(r0 + q) * 256))[lane] = wp; }
        }
        { const int gt = blockIdx.x * 512 + tid, GT = G * 512;
          for (int i = gt; i < 2048 * 24; i += GT) {
              const int pos = i / 24, f = i % 24; const bool dm = f < 8; const int fi = dm ? f : f - 8;
              const float invf = dm ? __builtin_amdgcn_exp2f(-18.931568569324174f * (float)fi * 0.125f) : __builtin_amdgcn_exp2f(-13.287712379549449f * (float)fi * 0.0625f);
              const float ang = (float)pos * invf; const double rev = (double)ang * 0.15915494309189535; const float fr = (float)(rev - floor(rev));
              const float cs = __builtin_amdgcn_cosf(fr), sn = __builtin_amdgcn_sinf(fr);
              float* dst = dm ? tabD + ((size_t)pos * 8 + fi) * 2 : tabM + ((size_t)pos * 16 + fi) * 2; dst[0] = cs; dst[1] = sn;
          }
          if (blockIdx.x == 0 && wave == 0) { const float s1 = wave_sum(a.lam_q1[lane] * a.lam_k1[lane]), s2 = wave_sum(a.lam_q2[lane] * a.lam_k2[lane]); if (lane == 0) lamp[0] = __expf(s1) - __expf(s2) + 0.2f; }
        }
    }
    xcd_barrier(xbar);
    if (a.ws == nullptr) grid.sync();
    #endif

#if !defined(SKIP_P1)
    { pg8::EpiInProj e{QD, KD, VD, SA, SB, CKV, CQ, KR, SSQ, SSKV, a.b_gate, tabD, tabM}; run_gemm(lds, XN, Win, 5888, 1024, e); }
    xcd_barrier(xbar);
    #endif

#if !defined(SKIP_P2)
    { pg8::EpiQUp e{SSQ, tabM, QM}; run_gemm(lds, CQ, Wuq, 768, 384, e); }
    { pg8::EpiKVUp e{SSKV, KVM}; run_gemm(lds, CKV, Wukv, 1024, 256, e); }
    xcd_barrier(xbar);
    #endif

#if !defined(SKIP_P3)
    {
        const float lam = lamp[0];
        for (int i = blockIdx.x; i < 2048; i += G) {
            const int type = i >> 10, rem = i & 1023, j = rem >> 8, half = (rem >> 7) & 1, bh = rem & 127;
            const int qb = half ? (j == 0 ? 6 : j == 1 ? 4 : j == 2 ? 3 : 1) : (j == 0 ? 7 : j == 1 ? 5 : j == 2 ? 2 : 0);
            if (type == 0) att::diff_unit((ATT_LAS char*)lds, bh >> 3, bh & 7, qb, QD, KD, VD, QD, a.diff_subln, lam);
            else           att::mla_unit((ATT_LAS char*)lds, bh >> 3, bh & 7, qb, QM, KVM, KR, OM);
        }
    }
    xcd_barrier(xbar);
    #endif

#if !defined(SKIP_P4)
    { pg8::EpiOutA e{SA, TBUF}; run_gemm(lds, QD, Wod, 1024, 1024, e); }
    { pg8::EpiOutB e{SB, TBUF, MG}; run_gemm(lds, OM, Wom, 1024, 512, e); }
    xcd_barrier(xbar);
    #endif

#if !defined(SKIP_P5)
    { pg8::EpiResid<false> e{a.x, X1B, SS1}; run_gemm(lds, MG, Wout, 1024, 1024, e); }
    xcd_barrier(xbar);
    #endif

#if !defined(SKIP_P6)
    { pg8::EpiSwiGLU e{SS1, HID}; run_gemm(lds, X1B, Wgu, 5632, 1024, e); }
    xcd_barrier(xbar);
    #endif

#if !defined(SKIP_P7)
    { pg8::EpiResid<true> e{X1B, X2B, SS2}; run_gemm(lds, HID, Wdn, 1024, 2816, e); }
    xcd_barrier(xbar);
    #endif

#if !defined(SKIP_P8)
    { pg8::EpiPleA e{T2B}; run_gemm(lds, PB, Wple, 1024, 256, e); }
    { pg8::EpiPleB e{SS2, a.b_ple_gate, X2B, T2B, X3B, SS3}; run_gemm(lds, X2B, Wpg, 1024, 1024, e); }
    xcd_barrier(xbar);
    #endif

#if !defined(SKIP_P9)
    { int t9_ = threadIdx.x; asm volatile("" : "+v"(t9_)); const int lane = t9_ & 63, gw = blockIdx.x * NWAVES + __builtin_amdgcn_readfirstlane(t9_ >> 6), NGW = gridDim.x * NWAVES;
    for (int r0 = gw * 4; r0 < M_TOK; r0 += NGW * 4) {
        v4u w[4][2]; float s[4];
#pragma unroll
        for (int q = 0; q < 4; ++q) { const v4u* xr = (const v4u*)(X3B + (size_t)(r0 + q) * 1024) + lane; w[q][0] = xr[0]; w[q][1] = xr[64]; s[q] = (lane < 16) ? SS3[(size_t)(r0 + q) * 16 + lane] : 0.f; }
#pragma unroll
        for (int q = 0; q < 4; ++q) { const float rstd = __builtin_amdgcn_rsqf(wave_sum(s[q]) * (1.f / 1024.f) + NEPS);
#pragma unroll
            for (int j = 0; j < 2; ++j) { const int c = (lane + 64 * j) * 8; const f32x4 g0 = *(const f32x4*)(a.final_norm + c), g1 = *(const f32x4*)(a.final_norm + c + 4); const v4u ww = w[q][j];
                f32x4 x0, x1; x0[0] = __uint_as_float(ww.x << 16); x0[1] = __uint_as_float(ww.x & 0xffff0000u); x0[2] = __uint_as_float(ww.y << 16); x0[3] = __uint_as_float(ww.y & 0xffff0000u);
                x1[0] = __uint_as_float(ww.z << 16); x1[1] = __uint_as_float(ww.z & 0xffff0000u); x1[2] = __uint_as_float(ww.w << 16); x1[3] = __uint_as_float(ww.w & 0xffff0000u);
                float* o = a.out + (size_t)(r0 + q) * 1024 + c; *(f32x4*)o = x0 * rstd * g0; *(f32x4*)(o + 4) = x1 * rstd * g1; } }
    } }
#endif
}

extern "C" void kernel_launch(void* const* d_in, const int* in_sizes, int n_in, void* d_out, int out_size, void* d_ws, size_t ws_size, hipStream_t stream) {
    static int grid = 0;
    if (grid == 0) {
        if (n_in != 26 || out_size != M_TOK * 1024 || ws_size < WS_END) { fprintf(stderr, "kernel_launch: unexpected shapes (n_in %d out %d ws %zu)\n", n_in, out_size, ws_size); grid = -1; return; }
        int dev = 0, cus = 0, per_cu = 0;
        (void)hipGetDevice(&dev); (void)hipDeviceGetAttribute(&cus, hipDeviceAttributeMultiprocessorCount, dev);
        (void)hipFuncSetAttribute((const void*)fwd_megakernel, hipFuncAttributeMaxDynamicSharedMemorySize, LDS_BYTES);
        if (hipOccupancyMaxActiveBlocksPerMultiprocessor(&per_cu, (const void*)fwd_megakernel, NWAVES * 64, LDS_BYTES) != hipSuccess || per_cu < 1) per_cu = 1;
        (void)hipGetLastError();
        grid = cus * per_cu;
    }
    if (grid < 0) return;
    Args a{};
    const float** f = (const float**)&a;
    for (int i = 0; i < 26; ++i) f[i] = (const float*)d_in[i];
    a.out = (float*)d_out; a.ws = (unsigned char*)d_ws;
    (void)hipMemsetAsync((char*)d_ws + WS_BAR, 0, 16384, stream);
    void* args[] = {&a};
    hipError_t e = hipLaunchCooperativeKernel((const void*)fwd_megakernel, dim3(grid), dim3(NWAVES * 64), args, LDS_BYTES, stream);
    if (e != hipSuccess) fprintf(stderr, "cooperative launch failed: %s (grid %d)\n", hipGetErrorString(e), grid);
}
```

```cpp
#include <hip/hip_runtime.h>
#include <hip/hip_cooperative_groups.h>
#include <cstdio>
#include <cstdint>
namespace cg = cooperative_groups;

constexpr int M_TOK = 32768, SEQ_LEN = 2048;
constexpr float NEPS = 1e-6f;
constexpr float LOG2E_F = 1.4426950408889634f;
constexpr float QS_D = 0.125f * LOG2E_F;
constexpr float QS_M = 0.10206207261596575f * LOG2E_F;
namespace pg8 {
#define PG8_LAS __attribute__((address_space(3)))
typedef unsigned short bf16_t;
typedef short bf16x8 __attribute__((ext_vector_type(8)));
typedef float f32x4 __attribute__((ext_vector_type(4)));
typedef unsigned u32x4 __attribute__((ext_vector_type(4)));
constexpr int BM = 256, BK = 64, HALF = 128, HTB = HALF * BK * 2  , STAGE_BYTES = 8 * HTB, NXCD = 8, WGM = 8;

__host__ __device__ __forceinline__ int lds_byte(int r, int c) { const int st = (r >> 4) * 2 + (c >> 5), rr = r & 15, cc = c & 31, ob = rr * 64 + cc * 2; return st * 1024 + (ob ^ (((ob >> 9) & 1) << 5)); }
__host__ __device__ __forceinline__ void stage_rc(int b, int& R, int& C) { const int st = b / 1024, sb = b % 1024, swz = sb ^ (((sb >> 9) & 1) << 5); R = (st >> 1) * 16 + swz / 64; C = (st & 1) * 32 + (swz % 64) / 2; }
__host__ __device__ __forceinline__ int perm32(int rho) { const int n = rho >> 4, i = rho & 15; return 8 * (i >> 2) + 4 * n + (i & 3); }

struct Unit { int pm, pn; };
struct Gemm { const bf16_t* A; const bf16_t* Bt; int M, N, K; };

struct StaticOrder {
    int nM, nN, nwg, G, c;
    __host__ __device__ void init(int M, int N, int G_, int c_) { nM = M / BM; nN = N / BM; nwg = nM * nN; G = G_; c = c_; }
    __host__ __device__ bool next(int i, Unit& u) const {
        const long L = (long)i * G + c; if (L >= nwg) return false;
        int wgid = (int)L; { const int q = nwg / NXCD, r = nwg % NXCD, xcd = wgid % NXCD, off = wgid / NXCD; wgid = (xcd < r ? xcd * (q + 1) : r * (q + 1) + (xcd - r) * q) + off; }
        const int nig = WGM * nN, gid = wgid / nig, fm = gid * WGM, gsz = (nM - fm) < WGM ? (nM - fm) : WGM;
        u.pm = fm + ((wgid % nig) % gsz); u.pn = (wgid % nig) / gsz; return true;
    }
    __device__ __forceinline__ void a_ready(const Unit&) const {}
    __device__ __forceinline__ void done(const Unit&) const {}
};

typedef unsigned u32x4 __attribute__((ext_vector_type(4)));
typedef unsigned u32x2 __attribute__((ext_vector_type(2)));
typedef float f32x2 __attribute__((ext_vector_type(2)));
typedef __bf16 bf16x2_t __attribute__((ext_vector_type(2)));
__device__ __forceinline__ unsigned pk2(float lo, float hi) { f32x2 v = {lo, hi}; bf16x2_t b = __builtin_convertvector(v, bf16x2_t); return __builtin_bit_cast(unsigned, b); }
__device__ __forceinline__ void st8(bf16_t* p, f32x4 a, f32x4 b) { u32x4 w; w.x = pk2(a[0], a[1]); w.y = pk2(a[2], a[3]); w.z = pk2(b[0], b[1]); w.w = pk2(b[2], b[3]); *(u32x4*)p = w; }
__device__ __forceinline__ void st8nt(bf16_t* p, f32x4 a, f32x4 b) { u32x4 w; w.x = pk2(a[0], a[1]); w.y = pk2(a[2], a[3]); w.z = pk2(b[0], b[1]); w.w = pk2(b[2], b[3]); __builtin_nontemporal_store(w, (u32x4*)p); }
__device__ __forceinline__ void ld8(const bf16_t* p, f32x4& a, f32x4& b) { const u32x4 w = *(const u32x4*)p;
    a[0] = __uint_as_float(w.x << 16); a[1] = __uint_as_float(w.x & 0xffff0000u); a[2] = __uint_as_float(w.y << 16); a[3] = __uint_as_float(w.y & 0xffff0000u);
    b[0] = __uint_as_float(w.z << 16); b[1] = __uint_as_float(w.z & 0xffff0000u); b[2] = __uint_as_float(w.w << 16); b[3] = __uint_as_float(w.w & 0xffff0000u); }
__device__ __forceinline__ void up8(const u32x4 w, f32x4& a, f32x4& b) {
    a[0] = __uint_as_float(w.x << 16); a[1] = __uint_as_float(w.x & 0xffff0000u); a[2] = __uint_as_float(w.y << 16); a[3] = __uint_as_float(w.y & 0xffff0000u);
    b[0] = __uint_as_float(w.z << 16); b[1] = __uint_as_float(w.z & 0xffff0000u); b[2] = __uint_as_float(w.w << 16); b[3] = __uint_as_float(w.w & 0xffff0000u); }
__device__ __forceinline__ float sigm(float x) { return __builtin_amdgcn_rcpf(1.f + __expf(-x)); }
__device__ __forceinline__ f32x4 sigm4(f32x4 x) { f32x4 o; o[0] = sigm(x[0]); o[1] = sigm(x[1]); o[2] = sigm(x[2]); o[3] = sigm(x[3]); return o; }
__device__ __forceinline__ float quad_sum(float s) { s += __shfl_xor(s, 16); s += __shfl_xor(s, 32); return s; }
__device__ __forceinline__ float sq4(f32x4 v) { return (v[0] * v[0] + v[1] * v[1]) + (v[2] * v[2] + v[3] * v[3]); }
__device__ __forceinline__ f32x4 rope4(f32x4 v, f32x4 t) { f32x4 o; o[0] = v[0] * t[0] - v[1] * t[1]; o[1] = v[1] * t[0] + v[0] * t[1]; o[2] = v[2] * t[2] - v[3] * t[3]; o[3] = v[3] * t[2] + v[2] * t[3]; return o; }
#define EPI_FENCE() asm volatile("" ::: "memory")
#define EPI_LOOP_AM _Pragma("unroll") for (int ai = 0; ai < 2; ++ai) _Pragma("unroll") for (int m = 0; m < 4; ++m)

struct EpiInProj {
    static constexpr bool PERM = true, AFTER_DRAIN = false;
    bf16_t *QD, *KD, *VD, *SA, *SB, *CKV, *CQ, *KR; float *SSQ, *SSKV; const float* bgate; const float* tabD; const float* tabM;
    __device__ __forceinline__ void operator()(const f32x4 (&acc)[2][2][4][2], const Unit& u, int wr, int wc, int fr, int fq) const {
        const int pn = u.pn, rbase = u.pm * BM + wr * 64 + fr, lc = wc * 32 + fq * 8;
        if (pn < 8) {
            bf16_t* dst = (pn < 4 ? QD : KD) + (pn & 3) * 256 + lc; const float sc = pn < 4 ? QS_D : 1.f;
            const bool rp = ((wc & 1) == 0) && (fq < 2);
            EPI_LOOP_AM { const int row = rbase + ai * HALF + m * 16; f32x4 t0 = {1.f, 0.f, 1.f, 0.f}, t1 = t0;
                if (rp) { const f32x4* tp = (const f32x4*)(tabD + ((size_t)(row & (SEQ_LEN - 1)) * 8 + 4 * fq) * 2); t0 = tp[0]; t1 = tp[1]; }
#pragma unroll
                for (int bj = 0; bj < 2; ++bj) st8(dst + (size_t)row * 1024 + bj * HALF, rope4(acc[ai][bj][m][0], t0) * sc, rope4(acc[ai][bj][m][1], t1) * sc);
                EPI_FENCE(); }
        } else if (pn < 12) {
            bf16_t* dst = VD + (pn - 8) * 256 + lc;
            EPI_LOOP_AM { const int row = rbase + ai * HALF + m * 16;
#pragma unroll
                for (int bj = 0; bj < 2; ++bj) st8(dst + (size_t)row * 1024 + bj * HALF, acc[ai][bj][m][0], acc[ai][bj][m][1]); }
        } else if (pn < 20) {
            const int t = (pn - 12) & 3; bf16_t* dst = (pn < 16 ? SA : SB) + t * 256 + lc; const float* bp = bgate + (pn < 16 ? 0 : 1024) + t * 256 + lc;
            f32x4 b[2][2];
#pragma unroll
            for (int bj = 0; bj < 2; ++bj) { b[bj][0] = *(const f32x4*)(bp + bj * HALF); b[bj][1] = *(const f32x4*)(bp + bj * HALF + 4); }
            EPI_LOOP_AM { const int row = rbase + ai * HALF + m * 16;
#pragma unroll
                for (int bj = 0; bj < 2; ++bj) st8nt(dst + (size_t)row * 1024 + bj * HALF, sigm4(acc[ai][bj][m][0] + b[bj][0]), sigm4(acc[ai][bj][m][1] + b[bj][1])); }
        } else if (pn == 20) {
            EPI_LOOP_AM { const int row = rbase + ai * HALF + m * 16; float s = 0.f;
#pragma unroll
                for (int bj = 0; bj < 2; ++bj) { st8(CKV + (size_t)row * 256 + bj * HALF + lc, acc[ai][bj][m][0], acc[ai][bj][m][1]); s += sq4(acc[ai][bj][m][0]) + sq4(acc[ai][bj][m][1]); }
                s = quad_sum(s); if (fq == 0) SSKV[(size_t)row * 4 + wc] = s; }
        } else if (pn == 21) {
            EPI_LOOP_AM { const int row = rbase + ai * HALF + m * 16; float s = 0.f;
#pragma unroll
                for (int bj = 0; bj < 2; ++bj) { st8(CQ + (size_t)row * 384 + bj * HALF + lc, acc[ai][bj][m][0], acc[ai][bj][m][1]); s += sq4(acc[ai][bj][m][0]) + sq4(acc[ai][bj][m][1]); }
                s = quad_sum(s); if (fq == 0) SSQ[(size_t)row * 8 + wc] = s; }
        } else {
            EPI_LOOP_AM { const int row = rbase + ai * HALF + m * 16;
                st8(CQ + (size_t)row * 384 + 256 + lc, acc[ai][0][m][0], acc[ai][0][m][1]);
                float s = sq4(acc[ai][0][m][0]) + sq4(acc[ai][0][m][1]); s = quad_sum(s); if (fq == 0) SSQ[(size_t)row * 8 + 4 + wc] = s;
                if (wc == 0) { const f32x4* tp = (const f32x4*)(tabM + ((size_t)(row & (SEQ_LEN - 1)) * 16 + 4 * fq) * 2);
                    st8(KR + (size_t)row * 32 + fq * 8, rope4(acc[ai][1][m][0], tp[0]), rope4(acc[ai][1][m][1], tp[1])); }
                EPI_FENCE(); }
        }
    }
};
struct EpiQUp {
    static constexpr bool PERM = true, AFTER_DRAIN = false;
    const float* SSQ; const float* tabM; bf16_t* QM;
    __device__ __forceinline__ void operator()(const f32x4 (&acc)[2][2][4][2], const Unit& u, int wr, int wc, int fr, int fq) const {
        const int rbase = u.pm * BM + wr * 64 + fr, c0 = u.pn * BM + wc * 32 + fq * 8;
        const int hl0 = c0 % 96, hl1 = (c0 + HALF) % 96;
        EPI_LOOP_AM { const int row = rbase + ai * HALF + m * 16;
            const f32x4 s0 = *(const f32x4*)(SSQ + (size_t)row * 8), s1 = *(const f32x4*)(SSQ + (size_t)row * 8 + 4);
            const float rstd = __builtin_amdgcn_rsqf(((s0[0] + s0[1]) + (s0[2] + s0[3]) + (s1[0] + s1[1]) + (s1[2] + s1[3])) * (1.f / 384.f) + NEPS) * QS_M;
            const float* tb = tabM + (size_t)(row & (SEQ_LEN - 1)) * 32;
#pragma unroll
            for (int bj = 0; bj < 2; ++bj) { const int hl = bj ? hl1 : hl0; const bool rp = hl >= 64; const f32x4 id = {1.f, 0.f, 1.f, 0.f};
                const f32x4* tp = (const f32x4*)(tb + (rp ? hl - 64 : 0)); const f32x4 t0 = rp ? tp[0] : id, t1 = rp ? tp[1] : id;
                st8(QM + (size_t)row * 768 + c0 + bj * HALF, rope4(acc[ai][bj][m][0] * rstd, t0), rope4(acc[ai][bj][m][1] * rstd, t1)); EPI_FENCE(); }
            }
    }
};
struct EpiKVUp {
    static constexpr bool PERM = true, AFTER_DRAIN = false;
    const float* SSKV; bf16_t* KVM;
    __device__ __forceinline__ void operator()(const f32x4 (&acc)[2][2][4][2], const Unit& u, int wr, int wc, int fr, int fq) const {
        const int rbase = u.pm * BM + wr * 64 + fr, c0 = u.pn * BM + wc * 32 + fq * 8;
        EPI_LOOP_AM { const int row = rbase + ai * HALF + m * 16;
            const f32x4 s0 = *(const f32x4*)(SSKV + (size_t)row * 4);
            const float rstd = __builtin_amdgcn_rsqf(((s0[0] + s0[1]) + (s0[2] + s0[3])) * (1.f / 256.f) + NEPS);
#pragma unroll
            for (int bj = 0; bj < 2; ++bj) st8(KVM + (size_t)row * 1024 + c0 + bj * HALF, acc[ai][bj][m][0] * rstd, acc[ai][bj][m][1] * rstd);
            EPI_FENCE(); }
    }
};
struct EpiOutA {
    static constexpr bool PERM = true, AFTER_DRAIN = false;
    const bf16_t* SA; bf16_t* T;
    __device__ __forceinline__ void operator()(const f32x4 (&acc)[2][2][4][2], const Unit& u, int wr, int wc, int fr, int fq) const {
        const int rbase = u.pm * BM + wr * 64 + fr, c0 = u.pn * BM + wc * 32 + fq * 8;
#pragma unroll
        for (int ai = 0; ai < 2; ++ai) { u32x4 g[4][2];
#pragma unroll
            for (int m = 0; m < 4; ++m)
#pragma unroll
                for (int bj = 0; bj < 2; ++bj) g[m][bj] = __builtin_nontemporal_load((const u32x4*)(SA + (size_t)(rbase + ai * HALF + m * 16) * 1024 + c0 + bj * HALF));
            EPI_FENCE();
#pragma unroll
            for (int m = 0; m < 4; ++m)
#pragma unroll
                for (int bj = 0; bj < 2; ++bj) { f32x4 g0, g1; up8(g[m][bj], g0, g1); st8(T + (size_t)(rbase + ai * HALF + m * 16) * 1024 + c0 + bj * HALF, acc[ai][bj][m][0] * g0, acc[ai][bj][m][1] * g1); }
            EPI_FENCE(); }
    }
};
struct EpiOutB {
    static constexpr bool PERM = true, AFTER_DRAIN = false;
    const bf16_t* SB; const bf16_t* T; bf16_t* MG;
    __device__ __forceinline__ void operator()(const f32x4 (&acc)[2][2][4][2], const Unit& u, int wr, int wc, int fr, int fq) const {
        const int rbase = u.pm * BM + wr * 64 + fr, c0 = u.pn * BM + wc * 32 + fq * 8;
#pragma unroll
        for (int ai = 0; ai < 2; ++ai) { u32x4 g[4][2], t[4][2];
#pragma unroll
            for (int m = 0; m < 4; ++m)
#pragma unroll
                for (int bj = 0; bj < 2; ++bj) { const size_t o = (size_t)(rbase + ai * HALF + m * 16) * 1024 + c0 + bj * HALF; g[m][bj] = __builtin_nontemporal_load((const u32x4*)(SB + o)); t[m][bj] = *(const u32x4*)(T + o); }
            EPI_FENCE();
#pragma unroll
            for (int m = 0; m < 4; ++m)
#pragma unroll
                for (int bj = 0; bj < 2; ++bj) { f32x4 g0, g1, t0, t1; up8(g[m][bj], g0, g1); up8(t[m][bj], t0, t1);
                    st8(MG + (size_t)(rbase + ai * HALF + m * 16) * 1024 + c0 + bj * HALF, t0 + acc[ai][bj][m][0] * g0, t1 + acc[ai][bj][m][1] * g1); }
            EPI_FENCE(); }
    }
};
template <bool RES_BF16> struct EpiResid {
    static constexpr bool PERM = true, AFTER_DRAIN = false;
    const void* res; bf16_t* xb; float* SS;
    __device__ __forceinline__ void operator()(const f32x4 (&acc)[2][2][4][2], const Unit& u, int wr, int wc, int fr, int fq) const {
        const int rbase = u.pm * BM + wr * 64 + fr, c0 = u.pn * BM + wc * 32 + fq * 8;
        if constexpr (RES_BF16) {
#pragma unroll
            for (int ai = 0; ai < 2; ++ai) { u32x4 r[4][2];
#pragma unroll
                for (int m = 0; m < 4; ++m)
#pragma unroll
                    for (int bj = 0; bj < 2; ++bj) r[m][bj] = *(const u32x4*)((const bf16_t*)res + (size_t)(rbase + ai * HALF + m * 16) * 1024 + c0 + bj * HALF);
                EPI_FENCE();
#pragma unroll
                for (int m = 0; m < 4; ++m) { const int row = rbase + ai * HALF + m * 16; float s = 0.f;
#pragma unroll
                    for (int bj = 0; bj < 2; ++bj) { f32x4 r0, r1; up8(r[m][bj], r0, r1); const f32x4 v0 = r0 + acc[ai][bj][m][0], v1 = r1 + acc[ai][bj][m][1];
                        st8(xb + (size_t)row * 1024 + c0 + bj * HALF, v0, v1); s += sq4(v0) + sq4(v1); }
                    s = quad_sum(s); if (fq == 0) SS[(size_t)row * 16 + u.pn * 4 + wc] = s; }
                EPI_FENCE(); }
        } else {
#pragma unroll
            for (int ai = 0; ai < 2; ++ai)
#pragma unroll
                for (int mp = 0; mp < 2; ++mp) { f32x4 r[2][2][2];
#pragma unroll
                    for (int mm = 0; mm < 2; ++mm)
#pragma unroll
                        for (int bj = 0; bj < 2; ++bj) { const float* p = (const float*)res + (size_t)(rbase + ai * HALF + (2 * mp + mm) * 16) * 1024 + c0 + bj * HALF; r[mm][bj][0] = __builtin_nontemporal_load((const f32x4*)p); r[mm][bj][1] = __builtin_nontemporal_load((const f32x4*)(p + 4)); }
                    EPI_FENCE();
#pragma unroll
                    for (int mm = 0; mm < 2; ++mm) { const int m = 2 * mp + mm, row = rbase + ai * HALF + m * 16; float s = 0.f;
#pragma unroll
                        for (int bj = 0; bj < 2; ++bj) { const f32x4 v0 = r[mm][bj][0] + acc[ai][bj][m][0], v1 = r[mm][bj][1] + acc[ai][bj][m][1];
                            st8(xb + (size_t)row * 1024 + c0 + bj * HALF, v0, v1); s += sq4(v0) + sq4(v1); }
                        s = quad_sum(s); if (fq == 0) SS[(size_t)row * 16 + u.pn * 4 + wc] = s; }
                    EPI_FENCE(); }
        }
    }
};
__device__ __forceinline__ float rstd16(const float* ss) { const f32x4 a = *(const f32x4*)ss, b = *(const f32x4*)(ss + 4), c = *(const f32x4*)(ss + 8), d = *(const f32x4*)(ss + 12);
    const f32x4 t = (a + b) + (c + d); return __builtin_amdgcn_rsqf(((t[0] + t[1]) + (t[2] + t[3])) * (1.f / 1024.f) + NEPS); }
struct EpiSwiGLU {
    static constexpr bool PERM = true, AFTER_DRAIN = false;
    const float* SS; bf16_t* HID;
    __device__ __forceinline__ void operator()(const f32x4 (&acc)[2][2][4][2], const Unit& u, int wr, int wc, int fr, int fq) const {
        const int rbase = u.pm * BM + wr * 64 + fr, c0 = u.pn * HALF + wc * 32 + fq * 8;
        EPI_LOOP_AM { const int row = rbase + ai * HALF + m * 16; const float rstd = rstd16(SS + (size_t)row * 16);
            const f32x4 g0 = acc[ai][0][m][0] * rstd, g1 = acc[ai][0][m][1] * rstd, u0 = acc[ai][1][m][0] * rstd, u1 = acc[ai][1][m][1] * rstd;
            st8(HID + (size_t)row * 2816 + c0, g0 * sigm4(g0) * u0, g1 * sigm4(g1) * u1);
            EPI_FENCE(); }
    }
};
struct EpiPleA {
    static constexpr bool PERM = true, AFTER_DRAIN = false;
    bf16_t* T;
    __device__ __forceinline__ void operator()(const f32x4 (&acc)[2][2][4][2], const Unit& u, int wr, int wc, int fr, int fq) const {
        const int rbase = u.pm * BM + wr * 64 + fr, c0 = u.pn * BM + wc * 32 + fq * 8;
        EPI_LOOP_AM { const int row = rbase + ai * HALF + m * 16;
#pragma unroll
            for (int bj = 0; bj < 2; ++bj) st8(T + (size_t)row * 1024 + c0 + bj * HALF, acc[ai][bj][m][0], acc[ai][bj][m][1]); }
    }
};
struct EpiPleB {
    static constexpr bool PERM = true, AFTER_DRAIN = false;
    const float* SS2; const float* bias; const bf16_t* X2; const bf16_t* T2; bf16_t* X3; float* SS3;
    __device__ __forceinline__ void operator()(const f32x4 (&acc)[2][2][4][2], const Unit& u, int wr, int wc, int fr, int fq) const {
        const int rbase = u.pm * BM + wr * 64 + fr, c0 = u.pn * BM + wc * 32 + fq * 8;
#pragma unroll
        for (int ai = 0; ai < 2; ++ai)
#pragma unroll
          for (int mp = 0; mp < 2; ++mp) { u32x4 x[2][2], t[2][2]; float rs[2];
#pragma unroll
            for (int mm = 0; mm < 2; ++mm) { const int row = rbase + ai * HALF + (2 * mp + mm) * 16;
#pragma unroll
                for (int bj = 0; bj < 2; ++bj) { const size_t o = (size_t)row * 1024 + c0 + bj * HALF; x[mm][bj] = *(const u32x4*)(X2 + o); t[mm][bj] = *(const u32x4*)(T2 + o); }
                rs[mm] = rstd16(SS2 + (size_t)row * 16); }
            EPI_FENCE();
#pragma unroll
            for (int mm = 0; mm < 2; ++mm) { const int m = 2 * mp + mm, row = rbase + ai * HALF + m * 16; float s = 0.f;
#pragma unroll
                for (int bj = 0; bj < 2; ++bj) { const f32x4 b0 = *(const f32x4*)(bias + c0 + bj * HALF), b1 = *(const f32x4*)(bias + c0 + bj * HALF + 4);
                    f32x4 x0, x1, t0, t1; up8(x[mm][bj], x0, x1); up8(t[mm][bj], t0, t1);
                    const f32x4 v0 = x0 + t0 * sigm4(acc[ai][bj][m][0] * rs[mm] + b0), v1 = x1 + t1 * sigm4(acc[ai][bj][m][1] * rs[mm] + b1);
                    st8(X3 + (size_t)row * 1024 + c0 + bj * HALF, v0, v1); s += sq4(v0) + sq4(v1); }
                s = quad_sum(s); if (fq == 0) SS3[(size_t)row * 16 + u.pn * 4 + wc] = s; }
            EPI_FENCE(); }
    }
};
template <class Epi, class Sched, bool ALIGN_EPI = false, bool SP2 = false>
__device__ __forceinline__ void gemm_phase(PG8_LAS unsigned char* lds, const Gemm g, const Sched& S, const Epi& E) {
    int tid_ = threadIdx.x; asm volatile("" : "+v"(tid_)); const int tid = tid_, wid = __builtin_amdgcn_readfirstlane(tid >> 6), lane = tid & 63, wr = wid >> 2, wc = wid & 3, fr = lane & 15, fq = lane >> 4;
    const int K = g.K, nt = K / BK;
    unsigned voffA[2], voffB[2];
#pragma unroll
    for (int i = 0; i < 2; ++i) { int R, C; stage_rc(tid * 16 + i * 8192, R, C); const int Rb = Epi::PERM ? ((R & ~31) + perm32(R & 31)) : R;
        voffA[i] = (unsigned)(R * K + C) * 2u; voffB[i] = (unsigned)(Rb * K + C) * 2u; }
    const size_t kstep = (size_t)(BK * 2);
    const size_t hstep = (size_t)HALF * K * 2;
    const size_t tstep = 2 * hstep;
    const unsigned ldsw = (unsigned)wid * 1024u;
    const int aoff = lds_byte(wr * 64 + fr, fq * 8), boff = lds_byte(wc * 32 + fr, fq * 8);
#define PG8_SA(b, h) (((b) * 2 + (h)) * HTB)
#define PG8_SB(b, h) ((4 + (b) * 2 + (h)) * HTB)
#define PG8_STAGE(bufoff, gbase, voff) do { _Pragma("unroll") for (int _i = 0; _i < 2; ++_i) \
        __builtin_amdgcn_global_load_lds((const unsigned*)((const char*)(gbase) + (voff)[_i]), (PG8_LAS unsigned*)(lds + (bufoff) + ldsw + _i * 8192), 16, 0, 0); } while (0)
#define PG8_LDA(dst, b, h) do { _Pragma("unroll") for (int m = 0; m < 4; ++m) _Pragma("unroll") for (int k = 0; k < 2; ++k) dst[m][k] = *(const PG8_LAS bf16x8*)(lds + PG8_SA(b, h) + aoff + m * 2048 + k * 1024); } while (0)
#define PG8_LDB(dst, b, h) do { _Pragma("unroll") for (int n = 0; n < 2; ++n) _Pragma("unroll") for (int k = 0; k < 2; ++k) dst[n][k] = *(const PG8_LAS bf16x8*)(lds + PG8_SB(b, h) + boff + n * 2048 + k * 1024); } while (0)
#define PG8_MMA(ai, bj, At, Bt) do { __builtin_amdgcn_s_setprio(1); _Pragma("unroll") for (int m = 0; m < 4; ++m) _Pragma("unroll") for (int n = 0; n < 2; ++n) _Pragma("unroll") for (int k = 0; k < 2; ++k) \
        acc[ai][bj][m][n] = __builtin_amdgcn_mfma_f32_16x16x32_bf16(Bt[n][k], At[m][k], acc[ai][bj][m][n], 0, 0, 0); __builtin_amdgcn_s_setprio(0); } while (0)
#define PG8_WAIT_V(n) asm volatile("s_waitcnt vmcnt(" #n ")" ::: "memory")
#define PG8_WAIT_L(n) asm volatile("s_waitcnt lgkmcnt(" #n ")" ::: "memory")
#define PG8_BAR __builtin_amdgcn_s_barrier()
#define PG8_SCHED __builtin_amdgcn_sched_barrier(0)
    Unit cur, nxt; int ui = 0;
    if (!S.next(0, cur)) return;
    f32x4 acc[2][2][4][2];
#pragma unroll
    for (int a = 0; a < 2; ++a)
#pragma unroll
        for (int b = 0; b < 2; ++b)
#pragma unroll
            for (int m = 0; m < 4; ++m)
#pragma unroll
                for (int n = 0; n < 2; ++n) acc[a][b][m][n] = (f32x4){0.f, 0.f, 0.f, 0.f};
    bf16x8 At[4][2], B0[2][2], B1[2][2];
    const char* cA = (const char*)g.A + (size_t)cur.pm * tstep; const char* cB = (const char*)g.Bt + (size_t)cur.pn * tstep;
    S.a_ready(cur);
    if constexpr (SP2) {
        PG8_STAGE(PG8_SB(0, 0), cB, voffB); PG8_STAGE(PG8_SB(0, 1), cB + hstep, voffB); PG8_STAGE(PG8_SA(0, 0), cA, voffA); PG8_STAGE(PG8_SA(0, 1), cA + hstep, voffA);
        if (wr == 1) PG8_BAR;
        PG8_WAIT_V(2); PG8_BAR;
        PG8_STAGE(PG8_SB(1, 0), cB + kstep, voffB); PG8_STAGE(PG8_SA(1, 0), cA + kstep, voffA); PG8_STAGE(PG8_SB(1, 1), cB + hstep + kstep, voffB);
        PG8_WAIT_V(6); PG8_BAR;
    } else {
        PG8_STAGE(PG8_SB(0, 0), cB, voffB); PG8_STAGE(PG8_SA(0, 0), cA, voffA); PG8_STAGE(PG8_SB(0, 1), cB + hstep, voffB); PG8_STAGE(PG8_SA(0, 1), cA + hstep, voffA);
        if (wr == 1) PG8_BAR;
        PG8_WAIT_V(4); PG8_BAR;
        PG8_STAGE(PG8_SB(1, 0), cB + kstep, voffB); PG8_STAGE(PG8_SA(1, 0), cA + kstep, voffA); PG8_STAGE(PG8_SB(1, 1), cB + hstep + kstep, voffB);
        PG8_WAIT_V(6); PG8_BAR;
    }
    for (;;) {
        const bool has_next = S.next(ui + 1, nxt);
        const char* nA = has_next ? (const char*)g.A + (size_t)nxt.pm * tstep : cA; const char* nB = has_next ? (const char*)g.Bt + (size_t)nxt.pn * tstep : cB;
        for (int t = 0; t < nt; t += 2) {
            const bool last = (t == nt - 2);
            const char* a1 = cA + (size_t)(t + 1) * kstep;
            const char* a2 = last ? nA : cA + (size_t)(t + 2) * kstep; const char* b2 = last ? nB : cB + (size_t)(t + 2) * kstep;
            const char* a3 = a2 + kstep; const char* b3 = b2 + kstep;
            if (last && has_next) S.a_ready(nxt);
            if constexpr (SP2) {
            PG8_LDB(B0, 0, 0); PG8_LDB(B1, 0, 1); PG8_SCHED; PG8_LDA(At, 0, 0); PG8_STAGE(PG8_SA(1, 1), a1 + hstep, voffA);
            PG8_WAIT_V(8); PG8_WAIT_L(0); PG8_BAR; PG8_MMA(0, 0, At, B0); PG8_MMA(0, 1, At, B1); PG8_BAR; PG8_SCHED;
            PG8_LDA(At, 0, 1); PG8_STAGE(PG8_SB(0, 0), b2, voffB); PG8_STAGE(PG8_SB(0, 1), b2 + hstep, voffB); PG8_STAGE(PG8_SA(0, 0), a2, voffA);
            PG8_WAIT_V(8); PG8_WAIT_L(0); PG8_BAR; PG8_MMA(1, 0, At, B0); PG8_MMA(1, 1, At, B1); PG8_BAR; PG8_SCHED;
            PG8_LDB(B0, 1, 0); PG8_LDB(B1, 1, 1); PG8_SCHED; PG8_LDA(At, 1, 0); PG8_STAGE(PG8_SA(0, 1), a2 + hstep, voffA);
            PG8_WAIT_V(8); PG8_WAIT_L(0); PG8_BAR; PG8_MMA(0, 0, At, B0); PG8_MMA(0, 1, At, B1); PG8_BAR; PG8_SCHED;
            PG8_LDA(At, 1, 1); PG8_STAGE(PG8_SB(1, 0), b3, voffB); PG8_STAGE(PG8_SB(1, 1), b3 + hstep, voffB); PG8_STAGE(PG8_SA(1, 0), a3, voffA);
            PG8_WAIT_V(8); PG8_WAIT_L(0); PG8_BAR; PG8_MMA(1, 0, At, B0); PG8_MMA(1, 1, At, B1); PG8_BAR; PG8_SCHED;
            } else {
            PG8_LDB(B0, 0, 0); PG8_SCHED; PG8_LDA(At, 0, 0); PG8_STAGE(PG8_SA(1, 1), a1 + hstep, voffA);
            PG8_WAIT_L(8); PG8_BAR; PG8_WAIT_L(0); PG8_MMA(0, 0, At, B0); PG8_BAR; PG8_SCHED;
            PG8_LDB(B1, 0, 1); PG8_STAGE(PG8_SB(0, 0), b2, voffB);
            PG8_BAR; PG8_WAIT_L(0); PG8_MMA(0, 1, At, B1); PG8_BAR;
            PG8_LDA(At, 0, 1); PG8_STAGE(PG8_SA(0, 0), a2, voffA);
            PG8_BAR; PG8_WAIT_L(0); PG8_MMA(1, 0, At, B0); PG8_BAR; PG8_SCHED;
            PG8_STAGE(PG8_SB(0, 1), b2 + hstep, voffB);
            PG8_WAIT_V(6); PG8_BAR; PG8_MMA(1, 1, At, B1); PG8_BAR;
            PG8_LDB(B0, 1, 0); PG8_SCHED; PG8_LDA(At, 1, 0); PG8_STAGE(PG8_SA(0, 1), a2 + hstep, voffA);
            PG8_WAIT_L(8); PG8_BAR; PG8_WAIT_L(0); PG8_MMA(0, 0, At, B0); PG8_BAR; PG8_SCHED;
            PG8_LDB(B1, 1, 1); PG8_STAGE(PG8_SB(1, 0), b3, voffB);
            PG8_BAR; PG8_WAIT_L(0); PG8_MMA(0, 1, At, B1); PG8_BAR;
            PG8_LDA(At, 1, 1); PG8_STAGE(PG8_SA(1, 0), a3, voffA);
            PG8_BAR; PG8_WAIT_L(0); PG8_MMA(1, 0, At, B0); PG8_BAR; PG8_SCHED;
            PG8_STAGE(PG8_SB(1, 1), b3 + hstep, voffB);
            PG8_WAIT_V(6); PG8_BAR; PG8_MMA(1, 1, At, B1); PG8_BAR;
            }
        }
        if constexpr (ALIGN_EPI) { if (wr == 0) PG8_BAR; }
        if constexpr (!Epi::AFTER_DRAIN) { E(acc, cur, wr, wc, fr, fq); S.done(cur); }
        if (!has_next) break;
#pragma unroll
        for (int a = 0; a < 2; ++a)
#pragma unroll
            for (int b = 0; b < 2; ++b)
#pragma unroll
                for (int m = 0; m < 4; ++m)
#pragma unroll
                    for (int n = 0; n < 2; ++n) acc[a][b][m][n] = (f32x4){0.f, 0.f, 0.f, 0.f};
        cur = nxt; cA = nA; cB = nB; ++ui;
        if constexpr (ALIGN_EPI) { if (wr == 1) PG8_BAR; }
    }
    PG8_WAIT_V(0);
    if constexpr (!ALIGN_EPI) { if (wr == 0) PG8_BAR; }
    PG8_BAR;
    if constexpr (Epi::AFTER_DRAIN) { E.fused(acc, cur, wr, wc, fr, fq, lds, wid, lane); S.done(cur); }
#undef PG8_SA
#undef PG8_SB
#undef PG8_STAGE
#undef PG8_LDA
#undef PG8_LDB
#undef PG8_MMA
#undef PG8_WAIT_V
#undef PG8_WAIT_L
#undef PG8_BAR
#undef PG8_SCHED
}
}
namespace att {
#define ATT_LAS __attribute__((address_space(3)))
typedef unsigned short bf16_t;
typedef short bf16x8 __attribute__((ext_vector_type(8)));
typedef short s16x4 __attribute__((ext_vector_type(4)));
typedef float f32x16 __attribute__((ext_vector_type(16)));
typedef float f32x4 __attribute__((ext_vector_type(4)));
typedef unsigned u32x4 __attribute__((ext_vector_type(4)));
typedef unsigned u32x2 __attribute__((ext_vector_type(2)));
constexpr int KB0 = 0, KBSZ = 12288, VB0 = 24576, VBSZ = 16384;
__device__ __forceinline__ float swap_max(float m) { auto rr = __builtin_amdgcn_permlane32_swap(__float_as_uint(m), __float_as_uint(m), false, false); return fmaxf(__uint_as_float(rr[0]), __uint_as_float(rr[1])); }
__device__ __forceinline__ float swap_sum(float m) { auto rr = __builtin_amdgcn_permlane32_swap(__float_as_uint(m), __float_as_uint(m), false, false); return __uint_as_float(rr[0]) + __uint_as_float(rr[1]); }
__device__ __forceinline__ s16x4 vtr(const ATT_LAS char* p) { return __builtin_bit_cast(s16x4, __builtin_amdgcn_ds_read_tr16_b64_v4i16((ATT_LAS s16x4*)p)); }
__device__ __forceinline__ float max3f(float a, float b, float c) { float r; asm("v_max3_f32 %0, %1, %2, %3" : "=v"(r) : "v"(a), "v"(b), "v"(c)); return r; }
__device__ __forceinline__ int crow(int r, int hi) { return (r & 3) + 8 * (r >> 2) + 4 * hi; }

template <int DQK, int DV, bool MLA>
__device__ __forceinline__ void attn_pass(ATT_LAS char* lds, const bf16_t* qp, const bf16_t* kg, const bf16_t* krg, const bf16_t* vg, int NT, int myNT, f32x16 (&o)[DV / 32], float& linv) {
    int tid_ = threadIdx.x; asm volatile("" : "+v"(tid_)); const int tid = tid_, lane = tid & 63, wid = __builtin_amdgcn_readfirstlane(tid >> 6), r32 = lane & 31, hi = lane >> 5;
    bf16x8 qr[DQK / 16];
#pragma unroll
    for (int d0 = 0; d0 < DQK / 16; ++d0) qr[d0] = *(const bf16x8*)(qp + d0 * 16);
    const bf16_t* ksrc = kg + (size_t)lane * 1024 + wid * 8;
    const bf16_t* krsrc = krg + (size_t)lane * 32 + (wid & 3) * 8;
    const bf16_t* vsrc = vg + (size_t)(16 * (wid & 3) + (lane >> 2)) * 1024 + (wid >> 2) * 32 + (lane & 3) * 8;
    const int sto = wid * 1024 + lane * 16;
    u32x4 kr0 = {0u, 0u, 0u, 0u}, kr1 = kr0, vr0 = kr0, vr1 = kr0;
#define ATT_LOAD(t) do { kr0 = *(const u32x4*)(ksrc + (size_t)(t) * 65536); if (MLA) { if (wid < 4) kr1 = *(const u32x4*)(krsrc + (size_t)(t) * 2048); } \
        vr0 = *(const u32x4*)(vsrc + (size_t)(t) * 65536); if (DV == 128) vr1 = *(const u32x4*)(vsrc + (size_t)(t) * 65536 + 64); } while (0)
#define ATT_STORE(b) do { *(ATT_LAS u32x4*)(lds + KB0 + (b) * KBSZ + sto) = kr0; if (MLA) { if (wid < 4) *(ATT_LAS u32x4*)(lds + KB0 + (b) * KBSZ + 8192 + sto) = kr1; } \
        *(ATT_LAS u32x4*)(lds + VB0 + (b) * VBSZ + sto) = vr0; if (DV == 128) *(ATT_LAS u32x4*)(lds + VB0 + (b) * VBSZ + 8192 + sto) = vr1; } while (0)
#pragma unroll
    for (int i = 0; i < DV / 32; ++i)
#pragma unroll
        for (int r = 0; r < 16; ++r) o[i][r] = 0.f;
    float mref = 0.f, lsum = 0.f;
    ATT_LOAD(0); ATT_STORE(0); __syncthreads();
    for (int t = 0; t < NT; ++t) {
        const int b = t & 1;
        if (t + 1 < NT) ATT_LOAD(t + 1);
        if (t < myNT) {
            const ATT_LAS char* kp = lds + KB0 + b * KBSZ + hi * 1024 + r32 * 16;
            f32x16 p0, p1;
#pragma unroll
            for (int r = 0; r < 16; ++r) { p0[r] = -mref; p1[r] = -mref; }
#pragma unroll
            for (int d0 = 0; d0 < DQK / 16; ++d0) {
                const bf16x8 k0 = *(const ATT_LAS bf16x8*)(kp + d0 * 2048), k1 = *(const ATT_LAS bf16x8*)(kp + d0 * 2048 + 512);
                p0 = __builtin_amdgcn_mfma_f32_32x32x16_bf16(k0, qr[d0], p0, 0, 0, 0);
                p1 = __builtin_amdgcn_mfma_f32_32x32x16_bf16(k1, qr[d0], p1, 0, 0, 0);
            }
            asm volatile("s_nop 15\n\ts_nop 7" : "+v"(p0), "+v"(p1));
            float mxa = max3f(p0[0], p0[1], p1[0]), mxb = max3f(p0[2], p0[3], p1[1]); mxa = max3f(mxa, p1[2], p1[3]);
#pragma unroll
            for (int r = 4; r < 16; r += 4) { mxa = max3f(mxa, p0[r], p0[r + 1]); mxb = max3f(mxb, p0[r + 2], p0[r + 3]); mxa = max3f(mxa, p1[r], p1[r + 1]); mxb = max3f(mxb, p1[r + 2], p1[r + 3]); }
            float mx = swap_max(max3f(mxa, mxb, mxb));
            if (__any(mx > 8.f)) {
                const float dl = fmaxf(mx, 0.f), al = __builtin_amdgcn_exp2f(-dl);
                lsum *= al;
#pragma unroll
                for (int i = 0; i < DV / 32; ++i)
#pragma unroll
                    for (int r = 0; r < 16; ++r) o[i][r] *= al;
#pragma unroll
                for (int r = 0; r < 16; ++r) { p0[r] -= dl; p1[r] -= dl; }
                mref += dl;
            }
            float ls = 0.f;
#pragma unroll
            for (int r = 0; r < 16; ++r) { p0[r] = __builtin_amdgcn_exp2f(p0[r]); p1[r] = __builtin_amdgcn_exp2f(p1[r]); ls += p0[r] + p1[r]; }
            lsum += ls;
            u32x4 pw[4];
#pragma unroll
            for (int j = 0; j < 4; ++j) { pw[0][j] = pg8::pk2(p0[2 * j], p0[2 * j + 1]); pw[1][j] = pg8::pk2(p0[8 + 2 * j], p0[9 + 2 * j]); pw[2][j] = pg8::pk2(p1[2 * j], p1[2 * j + 1]); pw[3][j] = pg8::pk2(p1[8 + 2 * j], p1[9 + 2 * j]); }
            const ATT_LAS char* vp = lds + VB0 + b * VBSZ + ((lane >> 4) & 1) * 32 + (lane & 3) * 8 + (4 * hi + ((lane & 15) >> 2)) * 64;
#pragma unroll
            for (int i = 0; i < DV / 32; ++i)
#pragma unroll
                for (int ks = 0; ks < 4; ++ks) {
                    const s16x4 lo = vtr(vp + i * 4096 + ks * 1024), hh = vtr(vp + i * 4096 + ks * 1024 + 512);
                    const bf16x8 vf = {lo[0], lo[1], lo[2], lo[3], hh[0], hh[1], hh[2], hh[3]};
                    o[i] = __builtin_amdgcn_mfma_f32_32x32x16_bf16(vf, __builtin_bit_cast(bf16x8, pw[ks]), o[i], 0, 0, 0);
                }
        }
        if (t + 1 < NT) ATT_STORE(b ^ 1);
        __syncthreads();
    }
    linv = __builtin_amdgcn_rcpf(swap_sum(lsum));
#undef ATT_LOAD
#undef ATT_STORE
}

__device__ __forceinline__ void qk_softmax64(const ATT_LAS char* kbuf, const ATT_LAS char* qimg, float& mref, float& lsum, f32x16 (&o)[4], u32x4 (&pw)[4], int r32, int hi) {
    const ATT_LAS char* kp = kbuf + hi * 1024 + r32 * 16;
    f32x16 p0, p1;
#pragma unroll
    for (int r = 0; r < 16; ++r) { p0[r] = -mref; p1[r] = -mref; }
#pragma unroll
    for (int d0 = 0; d0 < 4; ++d0) {
        const bf16x8 k0 = *(const ATT_LAS bf16x8*)(kp + d0 * 2048), k1 = *(const ATT_LAS bf16x8*)(kp + d0 * 2048 + 512), q = *(const ATT_LAS bf16x8*)(qimg + d0 * 1024);
        p0 = __builtin_amdgcn_mfma_f32_32x32x16_bf16(k0, q, p0, 0, 0, 0);
        p1 = __builtin_amdgcn_mfma_f32_32x32x16_bf16(k1, q, p1, 0, 0, 0);
    }
    asm volatile("s_nop 15\n\ts_nop 7" : "+v"(p0), "+v"(p1));
    float mxa = max3f(p0[0], p0[1], p1[0]), mxb = max3f(p0[2], p0[3], p1[1]); mxa = max3f(mxa, p1[2], p1[3]);
#pragma unroll
    for (int r = 4; r < 16; r += 4) { mxa = max3f(mxa, p0[r], p0[r + 1]); mxb = max3f(mxb, p0[r + 2], p0[r + 3]); mxa = max3f(mxa, p1[r], p1[r + 1]); mxb = max3f(mxb, p1[r + 2], p1[r + 3]); }
    const float mx = swap_max(max3f(mxa, mxb, mxb));
    if (__any(mx > 8.f)) {
        const float dl = fmaxf(mx, 0.f), al = __builtin_amdgcn_exp2f(-dl);
        lsum *= al;
#pragma unroll
        for (int i = 0; i < 4; ++i)
#pragma unroll
            for (int r = 0; r < 16; ++r) o[i][r] *= al;
#pragma unroll
        for (int r = 0; r < 16; ++r) { p0[r] -= dl; p1[r] -= dl; }
        mref += dl;
    }
    float ls = 0.f;
#pragma unroll
    for (int r = 0; r < 16; ++r) { p0[r] = __builtin_amdgcn_exp2f(p0[r]); p1[r] = __builtin_amdgcn_exp2f(p1[r]); ls += p0[r] + p1[r]; }
    lsum += ls;
#pragma unroll
    for (int j = 0; j < 4; ++j) { pw[0][j] = pg8::pk2(p0[2 * j], p0[2 * j + 1]); pw[1][j] = pg8::pk2(p0[8 + 2 * j], p0[9 + 2 * j]); pw[2][j] = pg8::pk2(p1[2 * j], p1[2 * j + 1]); pw[3][j] = pg8::pk2(p1[8 + 2 * j], p1[9 + 2 * j]); }
}
__device__ __forceinline__ void diff_unit(ATT_LAS char* lds, int b, int h, int qb, const bf16_t* QD, const bf16_t* KD, const bf16_t* VD, bf16_t* OD, const float* subln, float lam) {
    int tid_ = threadIdx.x; asm volatile("" : "+v"(tid_)); const int tid = tid_, lane = tid & 63, wid = __builtin_amdgcn_readfirstlane(tid >> 6), r32 = lane & 31, hi = lane >> 5;
    const size_t row0 = (size_t)b * SEQ_LEN, qrow = row0 + qb * 256 + wid * 32 + r32;
    const int NT = 4 * qb + 4, myNT = 4 * qb + (wid >> 1) + 1;
    constexpr int DKB0 = 0, DKBSZ = 16384, DVB0 = 32768, DVBSZ = 16384;
    ATT_LAS char* qimg = lds + 65536 + wid * 8192 + hi * 512 + r32 * 16;
    { const bf16_t* qp = QD + qrow * 1024 + (2 * h) * 64 + hi * 8;
#pragma unroll
      for (int d0 = 0; d0 < 4; ++d0) { *(ATT_LAS bf16x8*)(qimg + d0 * 1024) = *(const bf16x8*)(qp + d0 * 16); *(ATT_LAS bf16x8*)(qimg + 4096 + d0 * 1024) = *(const bf16x8*)(qp + 64 + d0 * 16); } }
    const bf16_t* ksrc = KD + row0 * 1024 + (2 * h) * 64 + (size_t)lane * 1024 + wid * 8;
    const bf16_t* vsrc = VD + row0 * 1024 + h * 128 + (size_t)(16 * (wid & 3) + (lane >> 2)) * 1024 + (wid >> 2) * 32 + (lane & 3) * 8;
    const int sto = wid * 1024 + lane * 16;
    const int vlane = ((lane >> 4) & 1) * 32 + (lane & 3) * 8 + (4 * hi + ((lane & 15) >> 2)) * 64;
    u32x4 ka, kb, va, vb;
#define DF_LOAD(t) do { ka = *(const u32x4*)(ksrc + (size_t)(t) * 65536); kb = *(const u32x4*)(ksrc + (size_t)(t) * 65536 + 64); va = *(const u32x4*)(vsrc + (size_t)(t) * 65536); vb = *(const u32x4*)(vsrc + (size_t)(t) * 65536 + 64); } while (0)
#define DF_STORE(bf) do { *(ATT_LAS u32x4*)(lds + DKB0 + (bf) * DKBSZ + sto) = ka; *(ATT_LAS u32x4*)(lds + DKB0 + (bf) * DKBSZ + 8192 + sto) = kb; \
        *(ATT_LAS u32x4*)(lds + DVB0 + (bf) * DVBSZ + sto) = va; *(ATT_LAS u32x4*)(lds + DVB0 + (bf) * DVBSZ + 8192 + sto) = vb; } while (0)
    f32x16 o1[4], o2[4];
#pragma unroll
    for (int i = 0; i < 4; ++i)
#pragma unroll
        for (int r = 0; r < 16; ++r) { o1[i][r] = 0.f; o2[i][r] = 0.f; }
    float m1 = 0.f, l1 = 0.f, m2 = 0.f, l2 = 0.f;
    DF_LOAD(0); DF_STORE(0); __syncthreads();
    for (int t = 0; t < NT; ++t) {
        const int bf = t & 1;
        if (t + 1 < NT) DF_LOAD(t + 1);
        if (t < myNT) {
            u32x4 pwa[4], pwb[4];
            qk_softmax64(lds + DKB0 + bf * DKBSZ, qimg, m1, l1, o1, pwa, r32, hi);
            qk_softmax64(lds + DKB0 + bf * DKBSZ + 8192, qimg + 4096, m2, l2, o2, pwb, r32, hi);
            const ATT_LAS char* vp = lds + DVB0 + bf * DVBSZ + vlane;
#pragma unroll
            for (int i = 0; i < 4; ++i)
#pragma unroll
                for (int ks = 0; ks < 4; ++ks) {
                    const s16x4 lo = vtr(vp + i * 4096 + ks * 1024), hh = vtr(vp + i * 4096 + ks * 1024 + 512);
                    const bf16x8 vf = {lo[0], lo[1], lo[2], lo[3], hh[0], hh[1], hh[2], hh[3]};
                    o1[i] = __builtin_amdgcn_mfma_f32_32x32x16_bf16(vf, __builtin_bit_cast(bf16x8, pwa[ks]), o1[i], 0, 0, 0);
                    o2[i] = __builtin_amdgcn_mfma_f32_32x32x16_bf16(vf, __builtin_bit_cast(bf16x8, pwb[ks]), o2[i], 0, 0, 0);
                }
        }
        if (t + 1 < NT) DF_STORE(bf ^ 1);
        __syncthreads();
    }
#undef DF_LOAD
#undef DF_STORE
    const float li1 = __builtin_amdgcn_rcpf(swap_sum(l1)), c2 = lam * __builtin_amdgcn_rcpf(swap_sum(l2)); float ss = 0.f;
#pragma unroll
    for (int i = 0; i < 4; ++i)
#pragma unroll
        for (int r = 0; r < 16; ++r) { const float v = o1[i][r] * li1 - o2[i][r] * c2; o1[i][r] = v; ss += v * v; }
    ss = swap_sum(ss);
    const float rstd = __builtin_amdgcn_rsqf(ss * (1.f / 128.f) + NEPS) * 0.8f;
    bf16_t* op = OD + qrow * 1024 + h * 128 + 4 * hi;
#pragma unroll
    for (int i = 0; i < 4; ++i)
#pragma unroll
        for (int rq = 0; rq < 4; ++rq) { const int dv = 32 * i + 8 * rq; const f32x4 g = *(const f32x4*)(subln + dv + 4 * hi);
            u32x2 w; w.x = pg8::pk2(o1[i][4 * rq] * rstd * g[0], o1[i][4 * rq + 1] * rstd * g[1]); w.y = pg8::pk2(o1[i][4 * rq + 2] * rstd * g[2], o1[i][4 * rq + 3] * rstd * g[3]);
            *(u32x2*)(op + dv) = w; }
}
__device__ __forceinline__ void mla_unit(ATT_LAS char* lds, int b, int h, int qb, const bf16_t* QM, const bf16_t* KVM, const bf16_t* KR, bf16_t* OM) {
    int tid_ = threadIdx.x; asm volatile("" : "+v"(tid_)); const int tid = tid_, lane = tid & 63, wid = __builtin_amdgcn_readfirstlane(tid >> 6), r32 = lane & 31, hi = lane >> 5;
    const size_t row0 = (size_t)b * SEQ_LEN, qrow = row0 + qb * 256 + wid * 32 + r32;
    const int NT = 4 * qb + 4, myNT = 4 * qb + (wid >> 1) + 1;
    f32x16 o[2]; float li;
    attn_pass<96, 64, true>(lds, QM + qrow * 768 + h * 96 + hi * 8, KVM + row0 * 1024 + h * 128, KR + row0 * 32, KVM + row0 * 1024 + h * 128 + 64, NT, myNT, o, li);
    bf16_t* op = OM + qrow * 512 + h * 64 + 4 * hi;
#pragma unroll
    for (int i = 0; i < 2; ++i)
#pragma unroll
        for (int rq = 0; rq < 4; ++rq) { const int dv = 32 * i + 8 * rq;
            u32x2 w; w.x = pg8::pk2(o[i][4 * rq] * li, o[i][4 * rq + 1] * li); w.y = pg8::pk2(o[i][4 * rq + 2] * li, o[i][4 * rq + 3] * li);
            *(u32x2*)(op + dv) = w; }
}
}
#define LAS __attribute__((address_space(3)))
typedef unsigned short bf16;
typedef float f32x4 __attribute__((ext_vector_type(4)));
typedef unsigned v4u __attribute__((ext_vector_type(4)));
typedef unsigned v2u __attribute__((ext_vector_type(2)));
constexpr int NWAVES = 8, LDS_BYTES = 147456;
constexpr size_t MiB = 1ull << 20;
constexpr size_t WS_TABD = 0, WS_TABM = 128 * 1024, WS_LAM = 384 * 1024, WS_BAR = 512 * 1024;
constexpr size_t WS_SSQ = 1 * MiB, WS_SSKV = 2 * MiB, WS_SS1 = 3 * MiB, WS_SS2 = 5 * MiB, WS_SS3 = 7 * MiB;
constexpr size_t WS_WIN = 10 * MiB, WS_WGU = WS_WIN + 5888ull * 1024 * 2, WS_WDN = WS_WGU + 5632ull * 1024 * 2, WS_WOD = WS_WDN + 1024ull * 2816 * 2, WS_WOUT = WS_WOD + 2 * MiB,
                 WS_WPG = WS_WOUT + 2 * MiB, WS_WOM = WS_WPG + 2 * MiB, WS_WUQ = WS_WOM + 1 * MiB, WS_WUKV = WS_WUQ + 768ull * 384 * 2, WS_WPLE = WS_WUKV + 1024ull * 256 * 2, WS_WEND = WS_WPLE + 1024ull * 256 * 2;
static_assert(WS_WEND <= 47 * MiB, "weights");
constexpr size_t WS_PB = 47 * MiB;
constexpr size_t WS_XN = 64 * MiB, WS_QM = 64 * MiB, WS_X1B = 64 * MiB;
constexpr size_t WS_QD = 128 * MiB, WS_KD = 192 * MiB, WS_VD = 256 * MiB, WS_KVM = 320 * MiB;
constexpr size_t WS_T = 192 * MiB, WS_MG = 320 * MiB;
constexpr size_t WS_HID = 128 * MiB, WS_X2B = 304 * MiB;
constexpr size_t WS_X3B = 384 * MiB, WS_T2B = 448 * MiB;
constexpr size_t WS_CKV = 384 * MiB, WS_CQ = 400 * MiB, WS_KR = 424 * MiB, WS_OM = 426 * MiB;
constexpr size_t WS_END = 512 * MiB;

#define XB_TMO      128
#define XB_XCNT(j)  (256  + 64 * (j))
#define XB_XSUB(j)  (1280 + 64 * (j))
#define XB_XGEN(j)  (2304 + 64 * (j))
#define XB_TOP      3328
#define XB_TOPGEN   3392
#define XCD_BAR_WORDS 3456
#define XB_SPIN_CAP (1u << 18)

__device__ __forceinline__ unsigned xb_ld(unsigned* p)              { return __hip_atomic_load(p, __ATOMIC_RELAXED, __HIP_MEMORY_SCOPE_AGENT); }
__device__ __forceinline__ unsigned xb_add(unsigned* p, unsigned v) { return __hip_atomic_fetch_add(p, v, __ATOMIC_RELAXED, __HIP_MEMORY_SCOPE_AGENT); }
__device__ __forceinline__ unsigned xb_xcc_id() { return (unsigned)__builtin_amdgcn_s_getreg((3 << 11) | 20) & 0xFu; }
#define XB_SPIN(cond, bar) do { unsigned _sp = 0; while (cond) { __builtin_amdgcn_s_sleep(1); \
    if ((++_sp & 255u) == 0u) { if (xb_ld(&(bar)[XB_TMO])) break; if (_sp > XB_SPIN_CAP) { atomicAdd(&(bar)[XB_TMO], 1u); break; } } } } while (0)

struct XcdBarrier {
    unsigned* bar; unsigned x;
    volatile LAS unsigned* st;
};

__device__ __forceinline__ XcdBarrier xcd_barrier_post(unsigned* bar, volatile LAS unsigned* st) {
    XcdBarrier b; b.bar = bar; b.x = xb_xcc_id(); b.st = st;
    if (threadIdx.x == 0) (void)xb_add(&bar[XB_XCNT(b.x)], 1u);
    return b;
}
__device__ __forceinline__ void xcd_barrier_complete(unsigned* bar, unsigned x, unsigned& nloc, unsigned& nx) {
    const unsigned G = gridDim.x * gridDim.y * gridDim.z;
    unsigned sum, cnt, mine, sp = 0u;
    for (;;) {
        sum = 0u; cnt = 0u; mine = 0u;
#pragma unroll
        for (unsigned j = 0; j < 16; ++j) { const unsigned c = xb_ld(&bar[XB_XCNT(j)]); sum += c; cnt += (c > 0u) ? 1u : 0u; mine = (j == x) ? c : mine; }
        if (sum == G) break;
        __builtin_amdgcn_s_sleep(1);
        if ((++sp & 255u) == 0u) { if (xb_ld(&bar[XB_TMO])) break; if (sp > XB_SPIN_CAP) { atomicAdd(&bar[XB_TMO], 1u); break; } }
    }
    nloc = mine > 0u ? mine : 1u; nx = cnt > 0u ? cnt : 1u;
}

__device__ __forceinline__ void xcd_barrier(const XcdBarrier& b) {
    asm volatile("s_waitcnt vmcnt(0)" ::: "memory");
    __syncthreads();
    if (threadIdx.x == 0) {
        unsigned* bar = b.bar;
        __builtin_amdgcn_s_waitcnt(0);
        unsigned nloc = b.st[0], nx = b.st[1];
        if (nloc == 0u) { xcd_barrier_complete(bar, b.x, nloc, nx); b.st[0] = nloc; b.st[1] = nx; }
        const unsigned old = xb_add(&bar[XB_XSUB(b.x)], 1u);
        const unsigned gen = old / nloc;
        if (old + 1u == (gen + 1u) * nloc) {
            __builtin_amdgcn_fence(__ATOMIC_RELEASE, "agent");
            asm volatile("s_waitcnt vmcnt(0)" ::: "memory");
            const unsigned og = xb_add(&bar[XB_TOP], 1u);
            const unsigned tg = og / nx;
            if (og + 1u == (tg + 1u) * nx) xb_add(&bar[XB_TOPGEN], 1u);
            else XB_SPIN(xb_ld(&bar[XB_TOPGEN]) == tg, bar);
            __builtin_amdgcn_fence(__ATOMIC_ACQUIRE, "agent");
            xb_add(&bar[XB_XGEN(b.x)], 1u);
            asm volatile("s_waitcnt vmcnt(0)" ::: "memory");
        } else {
            XB_SPIN(xb_ld(&bar[XB_XGEN(b.x)]) == gen, bar);
            __builtin_amdgcn_fence(__ATOMIC_ACQUIRE, "agent");
            asm volatile("s_waitcnt vmcnt(0)" ::: "memory");
        }
    }
    __syncthreads();
}

struct Args {
    const float *x, *p, *attn_norm, *w_in, *b_gate, *lam_q1, *lam_k1, *lam_q2, *lam_k2, *diff_subln, *w_o_diff, *q_norm, *w_uq, *kv_norm, *w_ukv, *w_o_mla, *w_out, *ffn_norm,
        *w_ffn_gate, *w_ffn_up, *w_ffn_down, *ple_norm, *w_ple_gate, *b_ple_gate, *w_ple, *final_norm;
    float* out; unsigned char* ws;
};

__device__ __forceinline__ float wave_sum(float v) {
#pragma unroll
    for (int o = 1; o < 64; o <<= 1) v += __shfl_xor(v, o);
    return v;
}
__device__ __forceinline__ void wprep_item(int kind, const float* W, const float* W2, int ld, int K, int Nout, const float* gain, bf16* WT, int item, LAS float* scr, int lane) {
    const int nnb = Nout / 32, kb = item / nnb, nb = item % nnb, k0 = kb * 64, n0 = nb * 32, nl = lane & 31, ks = lane >> 5, n = n0 + nl;
    const float* base = W; int col = n;
    if (kind == 1) {
        if (n < 2048) { const int hl = n & 63; col = (n & ~63) + (hl < 16 ? ((hl & 1) ? (hl >> 1) + 8 : (hl >> 1)) : hl); }
        else if (n < 3072) col = n;
        else if (n < 5120) col = 3744 + (n - 3072);
        else if (n < 5376) col = 3456 + (n - 5120);
        else if (n < 5760) col = 3072 + (n - 5376);
        else if (n < 5792) { const int hl = n - 5760; col = 3712 + ((hl & 1) ? (hl >> 1) + 16 : (hl >> 1)); }
        else col = -1;
    } else if (kind == 2) { const int h = n / 96, hl = n % 96; int s = hl; if (hl >= 64) { const int r = hl - 64; s = 64 + ((r & 1) ? (r >> 1) + 16 : (r >> 1)); } col = h * 96 + s;
    } else if (kind == 3) { const int pn = n >> 8, r = n & 255; if (r < 128) col = pn * 128 + r; else { base = W2; col = pn * 128 + (r - 128); } }
    const float* src = base + (size_t)(k0 + ks) * ld + (col >= 0 ? col : 0);
    float v[32];
#pragma unroll
    for (int i = 0; i < 32; ++i) v[i] = __builtin_nontemporal_load(src + (size_t)(2 * i) * ld);
    if (col < 0) {
#pragma unroll
        for (int i = 0; i < 32; ++i) v[i] = 0.f;
    }
    if (gain) { const float* gp = gain + k0 + ks;
#pragma unroll
        for (int i = 0; i < 32; ++i) v[i] *= gp[2 * i]; }
#pragma unroll
    for (int i = 0; i < 32; ++i) scr[(2 * i + ks) * 33 + nl] = v[i];
    asm volatile("s_waitcnt lgkmcnt(0)" ::: "memory");
    const int c = lane & 7;
#pragma unroll
    for (int j = 0; j < 4; ++j) { const int nn = (lane >> 3) + 8 * j; const LAS float* s = scr + (8 * c) * 33 + nn;
        v4u o; o.x = pg8::pk2(s[0], s[33]); o.y = pg8::pk2(s[2 * 33], s[3 * 33]); o.z = pg8::pk2(s[4 * 33], s[5 * 33]); o.w = pg8::pk2(s[6 * 33], s[7 * 33]);
        *(v4u*)(WT + (size_t)(n0 + nn) * K + k0 + 8 * c) = o; }
    asm volatile("s_waitcnt lgkmcnt(0)" ::: "memory");
}

#define WSP(T, off) ((T*)(a.ws + (off)))
#define tabD WSP(float, WS_TABD)
#define tabM WSP(float, WS_TABM)
#define lamp WSP(float, WS_LAM)
#define SSQ WSP(float, WS_SSQ)
#define SSKV WSP(float, WS_SSKV)
#define SS1 WSP(float, WS_SS1)
#define SS2 WSP(float, WS_SS2)
#define SS3 WSP(float, WS_SS3)
#define Win WSP(bf16, WS_WIN)
#define Wgu WSP(bf16, WS_WGU)
#define Wdn WSP(bf16, WS_WDN)
#define Wod WSP(bf16, WS_WOD)
#define Wout WSP(bf16, WS_WOUT)
#define Wpg WSP(bf16, WS_WPG)
#define Wom WSP(bf16, WS_WOM)
#define Wuq WSP(bf16, WS_WUQ)
#define Wukv WSP(bf16, WS_WUKV)
#define Wple WSP(bf16, WS_WPLE)
#define PB WSP(bf16, WS_PB)
#define XN WSP(bf16, WS_XN)
#define QM WSP(bf16, WS_QM)
#define X1B WSP(bf16, WS_X1B)
#define QD WSP(bf16, WS_QD)
#define KD WSP(bf16, WS_KD)
#define VD WSP(bf16, WS_VD)
#define KVM WSP(bf16, WS_KVM)
#define MG WSP(bf16, WS_MG)
#define HID WSP(bf16, WS_HID)
#define X2B WSP(bf16, WS_X2B)
#define CKV WSP(bf16, WS_CKV)
#define CQ WSP(bf16, WS_CQ)
#define KR WSP(bf16, WS_KR)
#define OM WSP(bf16, WS_OM)
#define TBUF WSP(bf16, WS_T)
#define X3B WSP(bf16, WS_X3B)
#define T2B WSP(bf16, WS_T2B)
#define SA ((bf16*)a.out)
#define SB ((bf16*)a.out + (size_t)M_TOK * 1024)
template <class E> __device__ __forceinline__ void run_gemm(LAS unsigned char* lds, const bf16* A, const bf16* Bt, int N, int K, const E& e) {
    asm volatile("" : "+s"(K));
    pg8::Gemm g{A, Bt, M_TOK, N, K}; pg8::StaticOrder S; S.init(M_TOK, N, (int)gridDim.x, (int)blockIdx.x);
    pg8::gemm_phase<E, pg8::StaticOrder, true, true>(lds, g, S, e);
}

__global__ void __launch_bounds__(NWAVES * 64, 2) fwd_megakernel(Args a) {
    extern __shared__ __attribute__((aligned(16))) unsigned char lds_raw[];
    cg::grid_group grid = cg::this_grid();
    LAS unsigned char* lds = (LAS unsigned char*)lds_raw;
    int tid0_ = threadIdx.x; asm volatile("" : "+v"(tid0_)); const int tid = tid0_, lane = tid & 63, wave = __builtin_amdgcn_readfirstlane(tid >> 6);
    const int G = gridDim.x, gw = blockIdx.x * NWAVES + wave, NGW = G * NWAVES;
    volatile LAS unsigned* bst = (volatile LAS unsigned*)(lds + (LDS_BYTES - 64));
    if (tid < 2) bst[tid] = 0u;
    __syncthreads();
    const XcdBarrier xbar = xcd_barrier_post((unsigned*)(a.ws + WS_BAR), bst);
#if !defined(SKIP_P0)
    {
        LAS float* scr = (LAS float*)(lds + wave * 8448);
        constexpr int I0 = 16 * 184, I1 = I0 + 16 * 176, I2 = I1 + 44 * 32, I3 = I2 + 512, I4 = I3 + 512, I5 = I4 + 512, I6 = I5 + 256, I7 = I6 + 144, I8 = I7 + 128, I9 = I8 + 128;
        for (int it = gw; it < I9; it += NGW) {
            if (it < I0)      wprep_item(1, a.w_in, nullptr, 5792, 1024, 5888, nullptr, Win, it, scr, lane);
            else if (it < I1) wprep_item(3, a.w_ffn_gate, a.w_ffn_up, 2816, 1024, 5632, a.ffn_norm, Wgu, it - I0, scr, lane);
            else if (it < I2) wprep_item(0, a.w_ffn_down, nullptr, 1024, 2816, 1024, nullptr, Wdn, it - I1, scr, lane);
            else if (it < I3) wprep_item(0, a.w_o_diff, nullptr, 1024, 1024, 1024, nullptr, Wod, it - I2, scr, lane);
            else if (it < I4) wprep_item(0, a.w_out, nullptr, 1024, 1024, 1024, nullptr, Wout, it - I3, scr, lane);
            else if (it < I5) wprep_item(0, a.w_ple_gate, nullptr, 1024, 1024, 1024, a.ple_norm, Wpg, it - I4, scr, lane);
            else if (it < I6) wprep_item(0, a.w_o_mla, nullptr, 1024, 512, 1024, nullptr, Wom, it - I5, scr, lane);
            else if (it < I7) wprep_item(2, a.w_uq, nullptr, 768, 384, 768, a.q_norm, Wuq, it - I6, scr, lane);
            else if (it < I8) wprep_item(0, a.w_ukv, nullptr, 1024, 256, 1024, a.kv_norm, Wukv, it - I7, scr, lane);
            else              wprep_item(0, a.w_ple, nullptr, 1024, 256, 1024, nullptr, Wple, it - I8, scr, lane);
        }
        for (int r0 = gw * 4; r0 < M_TOK; r0 += NGW * 4) {
            f32x4 v[4][4]; float s[4];
#pragma unroll
            for (int q = 0; q < 4; ++q) { const f32x4* xr = (const f32x4*)(a.x + (size_t)(r0 + q) * 1024) + lane; s[q] = 0.f;
#pragma unroll
                for (int j = 0; j < 4; ++j) v[q][j] = __builtin_nontemporal_load(xr + 64 * j); }
            f32x4 pq[4];
#pragma unroll
            for (int q = 0; q < 4; ++q) pq[q] = __builtin_nontemporal_load((const f32x4*)(a.p + (size_t)(r0 + q) * 256) + lane);
#pragma unroll
            for (int q = 0; q < 4; ++q) {
#pragma unroll
                for (int j = 0; j < 4; ++j) s[q] += pg8::sq4(v[q][j]);
                const float rstd = __builtin_amdgcn_rsqf(wave_sum(s[q]) * (1.f / 1024.f) + NEPS);
                v2u* o8 = (v2u*)(XN + (size_t)(r0 + q) * 1024) + lane;
#pragma unroll
                for (int j = 0; j < 4; ++j) { const f32x4 g = ((const f32x4*)a.attn_norm)[lane + 64 * j]; const f32x4 y = v[q][j] * rstd * g; v2u w; w.x = pg8::pk2(y[0], y[1]); w.y = pg8::pk2(y[2], y[3]); o8[64 * j] = w; }
                v2u wp; wp.x = pg8::pk2(pq[q][0], pq[q][1]); wp.y = pg8::pk2(pq[q][2], pq[q][3]); ((v2u*)(PB + (size_t)(r0 + q) * 256))[lane] = wp; }
        }
        { const int gt = blockIdx.x * 512 + tid, GT = G * 512;
          for (int i = gt; i < 2048 * 24; i += GT) {
              const int pos = i / 24, f = i % 24; const bool dm = f < 8; const int fi = dm ? f : f - 8;
              const float invf = dm ? __builtin_amdgcn_exp2f(-18.931568569324174f * (float)fi * 0.125f) : __builtin_amdgcn_exp2f(-13.287712379549449f * (float)fi * 0.0625f);
              const float ang = (float)pos * invf; const double rev = (double)ang * 0.15915494309189535; const float fr = (float)(rev - floor(rev));
              const float cs = __builtin_amdgcn_cosf(fr), sn = __builtin_amdgcn_sinf(fr);
              float* dst = dm ? tabD + ((size_t)pos * 8 + fi) * 2 : tabM + ((size_t)pos * 16 + fi) * 2; dst[0] = cs; dst[1] = sn;
          }
          if (blockIdx.x == 0 && wave == 0) { const float s1 = wave_sum(a.lam_q1[lane] * a.lam_k1[lane]), s2 = wave_sum(a.lam_q2[lane] * a.lam_k2[lane]); if (lane == 0) lamp[0] = __expf(s1) - __expf(s2) + 0.2f; }
        }
    }
    xcd_barrier(xbar);
    if (a.ws == nullptr) grid.sync();
    #endif

#if !defined(SKIP_P1)
    { pg8::EpiInProj e{QD, KD, VD, SA, SB, CKV, CQ, KR, SSQ, SSKV, a.b_gate, tabD, tabM}; run_gemm(lds, XN, Win, 5888, 1024, e); }
    xcd_barrier(xbar);
    #endif

#if !defined(SKIP_P2)
    { pg8::EpiQUp e{SSQ, tabM, QM}; run_gemm(lds, CQ, Wuq, 768, 384, e); }
    { pg8::EpiKVUp e{SSKV, KVM}; run_gemm(lds, CKV, Wukv, 1024, 256, e); }
    xcd_barrier(xbar);
    #endif

#if !defined(SKIP_P3)
    {
        const float lam = lamp[0];
        for (int i = blockIdx.x; i < 2048; i += G) {
            const int type = i >> 10, rem = i & 1023, j = rem >> 8, half = (rem >> 7) & 1, bh = rem & 127;
            const int qb = half ? (j == 0 ? 6 : j == 1 ? 4 : j == 2 ? 3 : 1) : (j == 0 ? 7 : j == 1 ? 5 : j == 2 ? 2 : 0);
            if (type == 0) att::diff_unit((ATT_LAS char*)lds, bh >> 3, bh & 7, qb, QD, KD, VD, QD, a.diff_subln, lam);
            else           att::mla_unit((ATT_LAS char*)lds, bh >> 3, bh & 7, qb, QM, KVM, KR, OM);
        }
    }
    xcd_barrier(xbar);
    #endif

#if !defined(SKIP_P4)
    { pg8::EpiOutA e{SA, TBUF}; run_gemm(lds, QD, Wod, 1024, 1024, e); }
    { pg8::EpiOutB e{SB, TBUF, MG}; run_gemm(lds, OM, Wom, 1024, 512, e); }
    xcd_barrier(xbar);
    #endif

#if !defined(SKIP_P5)
    { pg8::EpiResid<false> e{a.x, X1B, SS1}; run_gemm(lds, MG, Wout, 1024, 1024, e); }
    xcd_barrier(xbar);
    #endif

#if !defined(SKIP_P6)
    { pg8::EpiSwiGLU e{SS1, HID}; run_gemm(lds, X1B, Wgu, 5632, 1024, e); }
    xcd_barrier(xbar);
    #endif

#if !defined(SKIP_P7)
    { pg8::EpiResid<true> e{X1B, X2B, SS2}; run_gemm(lds, HID, Wdn, 1024, 2816, e); }
    xcd_barrier(xbar);
    #endif

#if !defined(SKIP_P8)
    { pg8::EpiPleA e{T2B}; run_gemm(lds, PB, Wple, 1024, 256, e); }
    { pg8::EpiPleB e{SS2, a.b_ple_gate, X2B, T2B, X3B, SS3}; run_gemm(lds, X2B, Wpg, 1024, 1024, e); }
    xcd_barrier(xbar);
    #endif

#if !defined(SKIP_P9)
    { int t9_ = threadIdx.x; asm volatile("" : "+v"(t9_)); const int lane = t9_ & 63, gw = blockIdx.x * NWAVES + __builtin_amdgcn_readfirstlane(t9_ >> 6), NGW = gridDim.x * NWAVES;
    for (int r0 = gw * 4; r0 < M_TOK; r0 += NGW * 4) {
        v4u w[4][2]; float s[4];
#pragma unroll
        for (int q = 0; q < 4; ++q) { const v4u* xr = (const v4u*)(X3B + (size_t)(r0 + q) * 1024) + lane; w[q][0] = xr[0]; w[q][1] = xr[64]; s[q] = (lane < 16) ? SS3[(size_t)(r0 + q) * 16 + lane] : 0.f; }
#pragma unroll
        for (int q = 0; q < 4; ++q) { const float rstd = __builtin_amdgcn_rsqf(wave_sum(s[q]) * (1.f / 1024.f) + NEPS);
#pragma unroll
            for (int j = 0; j < 2; ++j) { const int c = (lane + 64 * j) * 8; const f32x4 g0 = *(const f32x4*)(a.final_norm + c), g1 = *(const f32x4*)(a.final_norm + c + 4); const v4u ww = w[q][j];
                f32x4 x0, x1; x0[0] = __uint_as_float(ww.x << 16); x0[1] = __uint_as_float(ww.x & 0xffff0000u); x0[2] = __uint_as_float(ww.y << 16); x0[3] = __uint_as_float(ww.y & 0xffff0000u);
                x1[0] = __uint_as_float(ww.z << 16); x1[1] = __uint_as_float(ww.z & 0xffff0000u); x1[2] = __uint_as_float(ww.w << 16); x1[3] = __uint_as_float(ww.w & 0xffff0000u);
                float* o = a.out + (size_t)(r0 + q) * 1024 + c; __builtin_nontemporal_store(x0 * rstd * g0, (f32x4*)o); __builtin_nontemporal_store(x1 * rstd * g1, (f32x4*)(o + 4)); } }
    } }
#endif
}

extern "C" void kernel_launch(void* const* d_in, const int* in_sizes, int n_in, void* d_out, int out_size, void* d_ws, size_t ws_size, hipStream_t stream) {
    static int grid = 0;
    if (grid == 0) {
        if (n_in != 26 || out_size != M_TOK * 1024 || ws_size < WS_END) { fprintf(stderr, "kernel_launch: unexpected shapes (n_in %d out %d ws %zu)\n", n_in, out_size, ws_size); grid = -1; return; }
        int dev = 0, cus = 0, per_cu = 0;
        (void)hipGetDevice(&dev); (void)hipDeviceGetAttribute(&cus, hipDeviceAttributeMultiprocessorCount, dev);
        (void)hipFuncSetAttribute((const void*)fwd_megakernel, hipFuncAttributeMaxDynamicSharedMemorySize, LDS_BYTES);
        if (hipOccupancyMaxActiveBlocksPerMultiprocessor(&per_cu, (const void*)fwd_megakernel, NWAVES * 64, LDS_BYTES) != hipSuccess || per_cu < 1) per_cu = 1;
        (void)hipGetLastError();
        grid = cus * per_cu;
    }
    if (grid < 0) return;
    Args a{};
    const float** f = (const float**)&a;
    for (int i = 0; i < 26; ++i) f[i] = (const float*)d_in[i];
    a.out = (float*)d_out; a.ws = (unsigned char*)d_ws;
    (void)hipMemsetAsync((char*)d_ws + WS_BAR, 0, 16384, stream);
    void* args[] = {&a};
    hipError_t e = hipLaunchCooperativeKernel((const void*)fwd_megakernel, dim3(grid), dim3(NWAVES * 64), args, LDS_BYTES, stream);
    if (e != hipSuccess) fprintf(stderr, "cooperative launch failed: %s (grid %d)\n", hipGetErrorString(e), grid);
}
```

```cpp
#include <hip/hip_runtime.h>
#include <hip/hip_cooperative_groups.h>
#include <cstdio>
#include <cstdint>
namespace cg = cooperative_groups;

constexpr int M_TOK = 32768, SEQ_LEN = 2048;
constexpr float NEPS = 1e-6f;
constexpr float LOG2E_F = 1.4426950408889634f;
constexpr float QS_D = 0.125f * LOG2E_F;
constexpr float QS_M = 0.10206207261596575f * LOG2E_F;
namespace pg8 {
#define PG8_LAS __attribute__((address_space(3)))
typedef unsigned short bf16_t;
typedef short bf16x8 __attribute__((ext_vector_type(8)));
typedef float f32x4 __attribute__((ext_vector_type(4)));
typedef unsigned u32x4 __attribute__((ext_vector_type(4)));
constexpr int BM = 256, BK = 64, HALF = 128, HTB = HALF * BK * 2  , STAGE_BYTES = 8 * HTB, NXCD = 8, WGM = 8;

__host__ __device__ __forceinline__ int lds_byte(int r, int c) { const int st = (r >> 4) * 2 + (c >> 5), rr = r & 15, cc = c & 31, ob = rr * 64 + cc * 2; return st * 1024 + (ob ^ (((ob >> 9) & 1) << 5)); }
__host__ __device__ __forceinline__ void stage_rc(int b, int& R, int& C) { const int st = b / 1024, sb = b % 1024, swz = sb ^ (((sb >> 9) & 1) << 5); R = (st >> 1) * 16 + swz / 64; C = (st & 1) * 32 + (swz % 64) / 2; }
__host__ __device__ __forceinline__ int perm32(int rho) { const int n = rho >> 4, i = rho & 15; return 8 * (i >> 2) + 4 * n + (i & 3); }

struct Unit { int pm, pn; };
struct Gemm { const bf16_t* A; const bf16_t* Bt; int M, N, K; };

struct StaticOrder {
    int nM, nN, nwg, G, c;
    __host__ __device__ void init(int M, int N, int G_, int c_) { nM = M / BM; nN = N / BM; nwg = nM * nN; G = G_; c = c_; }
    __host__ __device__ bool next(int i, Unit& u) const {
        const long L = (long)i * G + c; if (L >= nwg) return false;
        int wgid = (int)L; { const int q = nwg / NXCD, r = nwg % NXCD, xcd = wgid % NXCD, off = wgid / NXCD; wgid = (xcd < r ? xcd * (q + 1) : r * (q + 1) + (xcd - r) * q) + off; }
        const int nig = WGM * nN, gid = wgid / nig, fm = gid * WGM, gsz = (nM - fm) < WGM ? (nM - fm) : WGM;
        u.pm = fm + ((wgid % nig) % gsz); u.pn = (wgid % nig) / gsz; return true;
    }
    __device__ __forceinline__ void a_ready(const Unit&) const {}
    __device__ __forceinline__ void done(const Unit&) const {}
};

typedef unsigned u32x4 __attribute__((ext_vector_type(4)));
typedef unsigned u32x2 __attribute__((ext_vector_type(2)));
typedef float f32x2 __attribute__((ext_vector_type(2)));
typedef __bf16 bf16x2_t __attribute__((ext_vector_type(2)));
__device__ __forceinline__ unsigned pk2(float lo, float hi) { f32x2 v = {lo, hi}; bf16x2_t b = __builtin_convertvector(v, bf16x2_t); return __builtin_bit_cast(unsigned, b); }
__device__ __forceinline__ void st8(bf16_t* p, f32x4 a, f32x4 b) { u32x4 w; w.x = pk2(a[0], a[1]); w.y = pk2(a[2], a[3]); w.z = pk2(b[0], b[1]); w.w = pk2(b[2], b[3]); *(u32x4*)p = w; }
__device__ __forceinline__ void st8nt(bf16_t* p, f32x4 a, f32x4 b) { u32x4 w; w.x = pk2(a[0], a[1]); w.y = pk2(a[2], a[3]); w.z = pk2(b[0], b[1]); w.w = pk2(b[2], b[3]); __builtin_nontemporal_store(w, (u32x4*)p); }
__device__ __forceinline__ void ld8(const bf16_t* p, f32x4& a, f32x4& b) { const u32x4 w = *(const u32x4*)p;
    a[0] = __uint_as_float(w.x << 16); a[1] = __uint_as_float(w.x & 0xffff0000u); a[2] = __uint_as_float(w.y << 16); a[3] = __uint_as_float(w.y & 0xffff0000u);
    b[0] = __uint_as_float(w.z << 16); b[1] = __uint_as_float(w.z & 0xffff0000u); b[2] = __uint_as_float(w.w << 16); b[3] = __uint_as_float(w.w & 0xffff0000u); }
__device__ __forceinline__ void up8(const u32x4 w, f32x4& a, f32x4& b) {
    a[0] = __uint_as_float(w.x << 16); a[1] = __uint_as_float(w.x & 0xffff0000u); a[2] = __uint_as_float(w.y << 16); a[3] = __uint_as_float(w.y & 0xffff0000u);
    b[0] = __uint_as_float(w.z << 16); b[1] = __uint_as_float(w.z & 0xffff0000u); b[2] = __uint_as_float(w.w << 16); b[3] = __uint_as_float(w.w & 0xffff0000u); }
__device__ __forceinline__ float sigm(float x) { return __builtin_amdgcn_rcpf(1.f + __expf(-x)); }
__device__ __forceinline__ f32x4 sigm4(f32x4 x) { f32x4 o; o[0] = sigm(x[0]); o[1] = sigm(x[1]); o[2] = sigm(x[2]); o[3] = sigm(x[3]); return o; }
__device__ __forceinline__ float quad_sum(float s) { s += __shfl_xor(s, 16); s += __shfl_xor(s, 32); return s; }
__device__ __forceinline__ float sq4(f32x4 v) { return (v[0] * v[0] + v[1] * v[1]) + (v[2] * v[2] + v[3] * v[3]); }
__device__ __forceinline__ f32x4 rope4(f32x4 v, f32x4 t) { f32x4 o; o[0] = v[0] * t[0] - v[1] * t[1]; o[1] = v[1] * t[0] + v[0] * t[1]; o[2] = v[2] * t[2] - v[3] * t[3]; o[3] = v[3] * t[2] + v[2] * t[3]; return o; }
#define EPI_FENCE() asm volatile("" ::: "memory")
#define EPI_LOOP_AM _Pragma("unroll") for (int ai = 0; ai < 2; ++ai) _Pragma("unroll") for (int m = 0; m < 4; ++m)

struct EpiInProj {
    static constexpr bool PERM = true, AFTER_DRAIN = false, HAS_MID = false;
    bf16_t *QD, *KD, *VD, *SA, *SB, *CKV, *CQ, *KR; float *SSQ, *SSKV; const float* bgate; const float* tabD; const float* tabM;
    __device__ __forceinline__ void operator()(const f32x4 (&acc)[2][2][4][2], const Unit& u, int wr, int wc, int fr, int fq) const {
        const int pn = u.pn, rbase = u.pm * BM + wr * 64 + fr, lc = wc * 32 + fq * 8;
        if (pn < 8) {
            bf16_t* dst = (pn < 4 ? QD : KD) + (pn & 3) * 256 + lc; const float sc = pn < 4 ? QS_D : 1.f;
            const bool rp = ((wc & 1) == 0) && (fq < 2);
            EPI_LOOP_AM { const int row = rbase + ai * HALF + m * 16; f32x4 t0 = {1.f, 0.f, 1.f, 0.f}, t1 = t0;
                if (rp) { const f32x4* tp = (const f32x4*)(tabD + ((size_t)(row & (SEQ_LEN - 1)) * 8 + 4 * fq) * 2); t0 = tp[0]; t1 = tp[1]; }
#pragma unroll
                for (int bj = 0; bj < 2; ++bj) st8(dst + (size_t)row * 1024 + bj * HALF, rope4(acc[ai][bj][m][0], t0) * sc, rope4(acc[ai][bj][m][1], t1) * sc);
                EPI_FENCE(); }
        } else if (pn < 12) {
            bf16_t* dst = VD + (pn - 8) * 256 + lc;
            EPI_LOOP_AM { const int row = rbase + ai * HALF + m * 16;
#pragma unroll
                for (int bj = 0; bj < 2; ++bj) st8(dst + (size_t)row * 1024 + bj * HALF, acc[ai][bj][m][0], acc[ai][bj][m][1]); }
        } else if (pn < 20) {
            const int t = (pn - 12) & 3; bf16_t* dst = (pn < 16 ? SA : SB) + t * 256 + lc; const float* bp = bgate + (pn < 16 ? 0 : 1024) + t * 256 + lc;
            f32x4 b[2][2];
#pragma unroll
            for (int bj = 0; bj < 2; ++bj) { b[bj][0] = *(const f32x4*)(bp + bj * HALF); b[bj][1] = *(const f32x4*)(bp + bj * HALF + 4); }
            EPI_LOOP_AM { const int row = rbase + ai * HALF + m * 16;
#pragma unroll
                for (int bj = 0; bj < 2; ++bj) st8nt(dst + (size_t)row * 1024 + bj * HALF, sigm4(acc[ai][bj][m][0] + b[bj][0]), sigm4(acc[ai][bj][m][1] + b[bj][1])); }
        } else if (pn == 20) {
            EPI_LOOP_AM { const int row = rbase + ai * HALF + m * 16; float s = 0.f;
#pragma unroll
                for (int bj = 0; bj < 2; ++bj) { st8(CKV + (size_t)row * 256 + bj * HALF + lc, acc[ai][bj][m][0], acc[ai][bj][m][1]); s += sq4(acc[ai][bj][m][0]) + sq4(acc[ai][bj][m][1]); }
                s = quad_sum(s); if (fq == 0) SSKV[(size_t)row * 4 + wc] = s; }
        } else if (pn == 21) {
            EPI_LOOP_AM { const int row = rbase + ai * HALF + m * 16; float s = 0.f;
#pragma unroll
                for (int bj = 0; bj < 2; ++bj) { st8(CQ + (size_t)row * 384 + bj * HALF + lc, acc[ai][bj][m][0], acc[ai][bj][m][1]); s += sq4(acc[ai][bj][m][0]) + sq4(acc[ai][bj][m][1]); }
                s = quad_sum(s); if (fq == 0) SSQ[(size_t)row * 8 + wc] = s; }
        } else {
            EPI_LOOP_AM { const int row = rbase + ai * HALF + m * 16;
                st8(CQ + (size_t)row * 384 + 256 + lc, acc[ai][0][m][0], acc[ai][0][m][1]);
                float s = sq4(acc[ai][0][m][0]) + sq4(acc[ai][0][m][1]); s = quad_sum(s); if (fq == 0) SSQ[(size_t)row * 8 + 4 + wc] = s;
                if (wc == 0) { const f32x4* tp = (const f32x4*)(tabM + ((size_t)(row & (SEQ_LEN - 1)) * 16 + 4 * fq) * 2);
                    st8(KR + (size_t)row * 32 + fq * 8, rope4(acc[ai][1][m][0], tp[0]), rope4(acc[ai][1][m][1], tp[1])); }
                EPI_FENCE(); }
        }
    }
};
struct EpiQUp {
    static constexpr bool PERM = true, AFTER_DRAIN = false, HAS_MID = false;
    const float* SSQ; const float* tabM; bf16_t* QM;
    __device__ __forceinline__ void operator()(const f32x4 (&acc)[2][2][4][2], const Unit& u, int wr, int wc, int fr, int fq) const {
        const int rbase = u.pm * BM + wr * 64 + fr, c0 = u.pn * BM + wc * 32 + fq * 8;
        const int hl0 = c0 % 96, hl1 = (c0 + HALF) % 96;
        EPI_LOOP_AM { const int row = rbase + ai * HALF + m * 16;
            const f32x4 s0 = *(const f32x4*)(SSQ + (size_t)row * 8), s1 = *(const f32x4*)(SSQ + (size_t)row * 8 + 4);
            const float rstd = __builtin_amdgcn_rsqf(((s0[0] + s0[1]) + (s0[2] + s0[3]) + (s1[0] + s1[1]) + (s1[2] + s1[3])) * (1.f / 384.f) + NEPS) * QS_M;
            const float* tb = tabM + (size_t)(row & (SEQ_LEN - 1)) * 32;
#pragma unroll
            for (int bj = 0; bj < 2; ++bj) { const int hl = bj ? hl1 : hl0; const bool rp = hl >= 64; const f32x4 id = {1.f, 0.f, 1.f, 0.f};
                const f32x4* tp = (const f32x4*)(tb + (rp ? hl - 64 : 0)); const f32x4 t0 = rp ? tp[0] : id, t1 = rp ? tp[1] : id;
                st8(QM + (size_t)row * 768 + c0 + bj * HALF, rope4(acc[ai][bj][m][0] * rstd, t0), rope4(acc[ai][bj][m][1] * rstd, t1)); EPI_FENCE(); }
            }
    }
};
struct EpiKVUp {
    static constexpr bool PERM = true, AFTER_DRAIN = false, HAS_MID = false;
    const float* SSKV; bf16_t* KVM;
    __device__ __forceinline__ void operator()(const f32x4 (&acc)[2][2][4][2], const Unit& u, int wr, int wc, int fr, int fq) const {
        const int rbase = u.pm * BM + wr * 64 + fr, c0 = u.pn * BM + wc * 32 + fq * 8;
        EPI_LOOP_AM { const int row = rbase + ai * HALF + m * 16;
            const f32x4 s0 = *(const f32x4*)(SSKV + (size_t)row * 4);
            const float rstd = __builtin_amdgcn_rsqf(((s0[0] + s0[1]) + (s0[2] + s0[3])) * (1.f / 256.f) + NEPS);
#pragma unroll
            for (int bj = 0; bj < 2; ++bj) st8(KVM + (size_t)row * 1024 + c0 + bj * HALF, acc[ai][bj][m][0] * rstd, acc[ai][bj][m][1] * rstd);
            EPI_FENCE(); }
    }
};
struct EpiMerge {
    static constexpr bool PERM = true, AFTER_DRAIN = false, HAS_MID = true; static constexpr int MID_T = 16;
    const bf16_t* SA; const bf16_t* SB; bf16_t* MG;
    __device__ __forceinline__ void mid(f32x4 (&acc)[2][2][4][2], const Unit& u, int wr, int wc, int fr, int fq) const {
        int rbase = u.pm * BM + wr * 64 + fr; const int c0 = u.pn * BM + wc * 32 + fq * 8;
        asm volatile("" : "+v"(rbase));
#pragma unroll
        for (int ai = 0; ai < 2; ++ai)
#pragma unroll
            for (int m = 0; m < 4; ++m) { u32x4 ga[2], gb[2];
#pragma unroll
                for (int bj = 0; bj < 2; ++bj) { const size_t o = (size_t)(rbase + ai * HALF + m * 16) * 1024 + c0 + bj * HALF;
                    ga[bj] = __builtin_nontemporal_load((const u32x4*)(SA + o)); gb[bj] = *(const u32x4*)(SB + o); }
                EPI_FENCE();
#pragma unroll
                for (int bj = 0; bj < 2; ++bj) { f32x4 a0, a1, b0, b1; up8(ga[bj], a0, a1); up8(gb[bj], b0, b1);
#pragma unroll
                    for (int e = 0; e < 4; ++e) { acc[ai][bj][m][0][e] *= a0[e] * __builtin_amdgcn_rcpf(b0[e]); acc[ai][bj][m][1][e] *= a1[e] * __builtin_amdgcn_rcpf(b1[e]); } }
                EPI_FENCE(); }
    }
    __device__ __forceinline__ void operator()(const f32x4 (&acc)[2][2][4][2], const Unit& u, int wr, int wc, int fr, int fq) const {
        const int rbase = u.pm * BM + wr * 64 + fr, c0 = u.pn * BM + wc * 32 + fq * 8;
#pragma unroll
        for (int ai = 0; ai < 2; ++ai) { u32x4 g[4][2];
#pragma unroll
            for (int m = 0; m < 4; ++m)
#pragma unroll
                for (int bj = 0; bj < 2; ++bj) g[m][bj] = __builtin_nontemporal_load((const u32x4*)(SB + (size_t)(rbase + ai * HALF + m * 16) * 1024 + c0 + bj * HALF));
            EPI_FENCE();
#pragma unroll
            for (int m = 0; m < 4; ++m)
#pragma unroll
                for (int bj = 0; bj < 2; ++bj) { f32x4 g0, g1; up8(g[m][bj], g0, g1); st8(MG + (size_t)(rbase + ai * HALF + m * 16) * 1024 + c0 + bj * HALF, acc[ai][bj][m][0] * g0, acc[ai][bj][m][1] * g1); }
            EPI_FENCE(); }
    }
};
template <bool RES_BF16> struct EpiResid {
    static constexpr bool PERM = true, AFTER_DRAIN = false, HAS_MID = false;
    const void* res; bf16_t* xb; float* SS;
    __device__ __forceinline__ void operator()(const f32x4 (&acc)[2][2][4][2], const Unit& u, int wr, int wc, int fr, int fq) const {
        const int rbase = u.pm * BM + wr * 64 + fr, c0 = u.pn * BM + wc * 32 + fq * 8;
        if constexpr (RES_BF16) {
#pragma unroll
            for (int ai = 0; ai < 2; ++ai) { u32x4 r[4][2];
#pragma unroll
                for (int m = 0; m < 4; ++m)
#pragma unroll
                    for (int bj = 0; bj < 2; ++bj) r[m][bj] = *(const u32x4*)((const bf16_t*)res + (size_t)(rbase + ai * HALF + m * 16) * 1024 + c0 + bj * HALF);
                EPI_FENCE();
#pragma unroll
                for (int m = 0; m < 4; ++m) { const int row = rbase + ai * HALF + m * 16; float s = 0.f;
#pragma unroll
                    for (int bj = 0; bj < 2; ++bj) { f32x4 r0, r1; up8(r[m][bj], r0, r1); const f32x4 v0 = r0 + acc[ai][bj][m][0], v1 = r1 + acc[ai][bj][m][1];
                        st8(xb + (size_t)row * 1024 + c0 + bj * HALF, v0, v1); s += sq4(v0) + sq4(v1); }
                    s = quad_sum(s); if (fq == 0) SS[(size_t)row * 16 + u.pn * 4 + wc] = s; }
                EPI_FENCE(); }
        } else {
#pragma unroll
            for (int ai = 0; ai < 2; ++ai)
#pragma unroll
                for (int mp = 0; mp < 2; ++mp) { f32x4 r[2][2][2];
#pragma unroll
                    for (int mm = 0; mm < 2; ++mm)
#pragma unroll
                        for (int bj = 0; bj < 2; ++bj) { const float* p = (const float*)res + (size_t)(rbase + ai * HALF + (2 * mp + mm) * 16) * 1024 + c0 + bj * HALF; r[mm][bj][0] = __builtin_nontemporal_load((const f32x4*)p); r[mm][bj][1] = __builtin_nontemporal_load((const f32x4*)(p + 4)); }
                    EPI_FENCE();
#pragma unroll
                    for (int mm = 0; mm < 2; ++mm) { const int m = 2 * mp + mm, row = rbase + ai * HALF + m * 16; float s = 0.f;
#pragma unroll
                        for (int bj = 0; bj < 2; ++bj) { const f32x4 v0 = r[mm][bj][0] + acc[ai][bj][m][0], v1 = r[mm][bj][1] + acc[ai][bj][m][1];
                            st8(xb + (size_t)row * 1024 + c0 + bj * HALF, v0, v1); s += sq4(v0) + sq4(v1); }
                        s = quad_sum(s); if (fq == 0) SS[(size_t)row * 16 + u.pn * 4 + wc] = s; }
                    EPI_FENCE(); }
        }
    }
};
__device__ __forceinline__ float rstd16(const float* ss) { const f32x4 a = *(const f32x4*)ss, b = *(const f32x4*)(ss + 4), c = *(const f32x4*)(ss + 8), d = *(const f32x4*)(ss + 12);
    const f32x4 t = (a + b) + (c + d); return __builtin_amdgcn_rsqf(((t[0] + t[1]) + (t[2] + t[3])) * (1.f / 1024.f) + NEPS); }
struct EpiSwiGLU {
    static constexpr bool PERM = true, AFTER_DRAIN = false, HAS_MID = false;
    const float* SS; bf16_t* HID;
    __device__ __forceinline__ void operator()(const f32x4 (&acc)[2][2][4][2], const Unit& u, int wr, int wc, int fr, int fq) const {
        const int rbase = u.pm * BM + wr * 64 + fr, c0 = u.pn * HALF + wc * 32 + fq * 8;
        EPI_LOOP_AM { const int row = rbase + ai * HALF + m * 16; const float rstd = rstd16(SS + (size_t)row * 16);
            const f32x4 g0 = acc[ai][0][m][0] * rstd, g1 = acc[ai][0][m][1] * rstd, u0 = acc[ai][1][m][0] * rstd, u1 = acc[ai][1][m][1] * rstd;
            st8(HID + (size_t)row * 2816 + c0, g0 * sigm4(g0) * u0, g1 * sigm4(g1) * u1);
            EPI_FENCE(); }
    }
};
struct EpiPleA {
    static constexpr bool PERM = true, AFTER_DRAIN = false, HAS_MID = false;
    bf16_t* T;
    __device__ __forceinline__ void operator()(const f32x4 (&acc)[2][2][4][2], const Unit& u, int wr, int wc, int fr, int fq) const {
        const int rbase = u.pm * BM + wr * 64 + fr, c0 = u.pn * BM + wc * 32 + fq * 8;
        EPI_LOOP_AM { const int row = rbase + ai * HALF + m * 16;
#pragma unroll
            for (int bj = 0; bj < 2; ++bj) st8(T + (size_t)row * 1024 + c0 + bj * HALF, acc[ai][bj][m][0], acc[ai][bj][m][1]); }
    }
};
struct EpiPleB {
    static constexpr bool PERM = true, AFTER_DRAIN = false, HAS_MID = false;
    const float* SS2; const float* bias; const bf16_t* X2; const bf16_t* T2; bf16_t* X3; float* SS3;
    __device__ __forceinline__ void operator()(const f32x4 (&acc)[2][2][4][2], const Unit& u, int wr, int wc, int fr, int fq) const {
        const int rbase = u.pm * BM + wr * 64 + fr, c0 = u.pn * BM + wc * 32 + fq * 8;
#pragma unroll
        for (int ai = 0; ai < 2; ++ai)
#pragma unroll
          for (int mp = 0; mp < 2; ++mp) { u32x4 x[2][2], t[2][2]; float rs[2];
#pragma unroll
            for (int mm = 0; mm < 2; ++mm) { const int row = rbase + ai * HALF + (2 * mp + mm) * 16;
#pragma unroll
                for (int bj = 0; bj < 2; ++bj) { const size_t o = (size_t)row * 1024 + c0 + bj * HALF; x[mm][bj] = *(const u32x4*)(X2 + o); t[mm][bj] = *(const u32x4*)(T2 + o); }
                rs[mm] = rstd16(SS2 + (size_t)row * 16); }
            EPI_FENCE();
#pragma unroll
            for (int mm = 0; mm < 2; ++mm) { const int m = 2 * mp + mm, row = rbase + ai * HALF + m * 16; float s = 0.f;
#pragma unroll
                for (int bj = 0; bj < 2; ++bj) { const f32x4 b0 = *(const f32x4*)(bias + c0 + bj * HALF), b1 = *(const f32x4*)(bias + c0 + bj * HALF + 4);
                    f32x4 x0, x1, t0, t1; up8(x[mm][bj], x0, x1); up8(t[mm][bj], t0, t1);
                    const f32x4 v0 = x0 + t0 * sigm4(acc[ai][bj][m][0] * rs[mm] + b0), v1 = x1 + t1 * sigm4(acc[ai][bj][m][1] * rs[mm] + b1);
                    st8(X3 + (size_t)row * 1024 + c0 + bj * HALF, v0, v1); s += sq4(v0) + sq4(v1); }
                s = quad_sum(s); if (fq == 0) SS3[(size_t)row * 16 + u.pn * 4 + wc] = s; }
            EPI_FENCE(); }
    }
};
template <class Epi, class Sched, bool ALIGN_EPI = false, bool SP2 = false>
__device__ __forceinline__ void gemm_phase(PG8_LAS unsigned char* lds, const Gemm g, const Sched& S, const Epi& E) {
    int tid_ = threadIdx.x; asm volatile("" : "+v"(tid_)); const int tid = tid_, wid = __builtin_amdgcn_readfirstlane(tid >> 6), lane = tid & 63, wr = wid >> 2, wc = wid & 3, fr = lane & 15, fq = lane >> 4;
    const int K = g.K, nt = K / BK;
    unsigned voffA[2], voffB[2];
#pragma unroll
    for (int i = 0; i < 2; ++i) { int R, C; stage_rc(tid * 16 + i * 8192, R, C); const int Rb = Epi::PERM ? ((R & ~31) + perm32(R & 31)) : R;
        voffA[i] = (unsigned)(R * K + C) * 2u; voffB[i] = (unsigned)(Rb * K + C) * 2u; }
    const size_t kstep = (size_t)(BK * 2);
    const size_t hstep = (size_t)HALF * K * 2;
    const size_t tstep = 2 * hstep;
    const unsigned ldsw = (unsigned)wid * 1024u;
    const int aoff = lds_byte(wr * 64 + fr, fq * 8), boff = lds_byte(wc * 32 + fr, fq * 8);
#define PG8_SA(b, h) (((b) * 2 + (h)) * HTB)
#define PG8_SB(b, h) ((4 + (b) * 2 + (h)) * HTB)
#define PG8_STAGE(bufoff, gbase, voff) do { _Pragma("unroll") for (int _i = 0; _i < 2; ++_i) \
        __builtin_amdgcn_global_load_lds((const unsigned*)((const char*)(gbase) + (voff)[_i]), (PG8_LAS unsigned*)(lds + (bufoff) + ldsw + _i * 8192), 16, 0, 0); } while (0)
#define PG8_LDA(dst, b, h) do { _Pragma("unroll") for (int m = 0; m < 4; ++m) _Pragma("unroll") for (int k = 0; k < 2; ++k) dst[m][k] = *(const PG8_LAS bf16x8*)(lds + PG8_SA(b, h) + aoff + m * 2048 + k * 1024); } while (0)
#define PG8_LDB(dst, b, h) do { _Pragma("unroll") for (int n = 0; n < 2; ++n) _Pragma("unroll") for (int k = 0; k < 2; ++k) dst[n][k] = *(const PG8_LAS bf16x8*)(lds + PG8_SB(b, h) + boff + n * 2048 + k * 1024); } while (0)
#define PG8_MMA(ai, bj, At, Bt) do { __builtin_amdgcn_s_setprio(1); _Pragma("unroll") for (int m = 0; m < 4; ++m) _Pragma("unroll") for (int n = 0; n < 2; ++n) _Pragma("unroll") for (int k = 0; k < 2; ++k) \
        acc[ai][bj][m][n] = __builtin_amdgcn_mfma_f32_16x16x32_bf16(Bt[n][k], At[m][k], acc[ai][bj][m][n], 0, 0, 0); __builtin_amdgcn_s_setprio(0); } while (0)
#define PG8_WAIT_V(n) asm volatile("s_waitcnt vmcnt(" #n ")" ::: "memory")
#define PG8_WAIT_L(n) asm volatile("s_waitcnt lgkmcnt(" #n ")" ::: "memory")
#define PG8_BAR __builtin_amdgcn_s_barrier()
#define PG8_SCHED __builtin_amdgcn_sched_barrier(0)
    Unit cur, nxt; int ui = 0;
    if (!S.next(0, cur)) return;
    f32x4 acc[2][2][4][2];
#pragma unroll
    for (int a = 0; a < 2; ++a)
#pragma unroll
        for (int b = 0; b < 2; ++b)
#pragma unroll
            for (int m = 0; m < 4; ++m)
#pragma unroll
                for (int n = 0; n < 2; ++n) acc[a][b][m][n] = (f32x4){0.f, 0.f, 0.f, 0.f};
    bf16x8 At[4][2], B0[2][2], B1[2][2];
    const char* cA = (const char*)g.A + (size_t)cur.pm * tstep; const char* cB = (const char*)g.Bt + (size_t)cur.pn * tstep;
    S.a_ready(cur);
    if constexpr (SP2) {
        PG8_STAGE(PG8_SB(0, 0), cB, voffB); PG8_STAGE(PG8_SB(0, 1), cB + hstep, voffB); PG8_STAGE(PG8_SA(0, 0), cA, voffA); PG8_STAGE(PG8_SA(0, 1), cA + hstep, voffA);
        if (wr == 1) PG8_BAR;
        PG8_WAIT_V(2); PG8_BAR;
        PG8_STAGE(PG8_SB(1, 0), cB + kstep, voffB); PG8_STAGE(PG8_SA(1, 0), cA + kstep, voffA); PG8_STAGE(PG8_SB(1, 1), cB + hstep + kstep, voffB);
        PG8_WAIT_V(6); PG8_BAR;
    } else {
        PG8_STAGE(PG8_SB(0, 0), cB, voffB); PG8_STAGE(PG8_SA(0, 0), cA, voffA); PG8_STAGE(PG8_SB(0, 1), cB + hstep, voffB); PG8_STAGE(PG8_SA(0, 1), cA + hstep, voffA);
        if (wr == 1) PG8_BAR;
        PG8_WAIT_V(4); PG8_BAR;
        PG8_STAGE(PG8_SB(1, 0), cB + kstep, voffB); PG8_STAGE(PG8_SA(1, 0), cA + kstep, voffA); PG8_STAGE(PG8_SB(1, 1), cB + hstep + kstep, voffB);
        PG8_WAIT_V(6); PG8_BAR;
    }
    for (;;) {
        const bool has_next = S.next(ui + 1, nxt);
        const char* nA = has_next ? (const char*)g.A + (size_t)nxt.pm * tstep : cA; const char* nB = has_next ? (const char*)g.Bt + (size_t)nxt.pn * tstep : cB;
        for (int t = 0; t < nt; t += 2) {
            if constexpr (Epi::HAS_MID) { if (t == Epi::MID_T) { __builtin_amdgcn_sched_barrier(0); E.mid(acc, cur, wr, wc, fr, fq); __builtin_amdgcn_sched_barrier(0); } }
            const bool last = (t == nt - 2);
            const char* a1 = cA + (size_t)(t + 1) * kstep;
            const char* a2 = last ? nA : cA + (size_t)(t + 2) * kstep; const char* b2 = last ? nB : cB + (size_t)(t + 2) * kstep;
            const char* a3 = a2 + kstep; const char* b3 = b2 + kstep;
            if (last && has_next) S.a_ready(nxt);
            if constexpr (SP2) {
            PG8_LDB(B0, 0, 0); PG8_LDB(B1, 0, 1); PG8_SCHED; PG8_LDA(At, 0, 0); PG8_STAGE(PG8_SA(1, 1), a1 + hstep, voffA);
            PG8_WAIT_V(8); PG8_WAIT_L(0); PG8_BAR; PG8_MMA(0, 0, At, B0); PG8_MMA(0, 1, At, B1); PG8_BAR; PG8_SCHED;
            PG8_LDA(At, 0, 1); PG8_STAGE(PG8_SB(0, 0), b2, voffB); PG8_STAGE(PG8_SB(0, 1), b2 + hstep, voffB); PG8_STAGE(PG8_SA(0, 0), a2, voffA);
            PG8_WAIT_V(8); PG8_WAIT_L(0); PG8_BAR; PG8_MMA(1, 0, At, B0); PG8_MMA(1, 1, At, B1); PG8_BAR; PG8_SCHED;
            PG8_LDB(B0, 1, 0); PG8_LDB(B1, 1, 1); PG8_SCHED; PG8_LDA(At, 1, 0); PG8_STAGE(PG8_SA(0, 1), a2 + hstep, voffA);
            PG8_WAIT_V(8); PG8_WAIT_L(0); PG8_BAR; PG8_MMA(0, 0, At, B0); PG8_MMA(0, 1, At, B1); PG8_BAR; PG8_SCHED;
            PG8_LDA(At, 1, 1); PG8_STAGE(PG8_SB(1, 0), b3, voffB); PG8_STAGE(PG8_SB(1, 1), b3 + hstep, voffB); PG8_STAGE(PG8_SA(1, 0), a3, voffA);
            PG8_WAIT_V(8); PG8_WAIT_L(0); PG8_BAR; PG8_MMA(1, 0, At, B0); PG8_MMA(1, 1, At, B1); PG8_BAR; PG8_SCHED;
            } else {
            PG8_LDB(B0, 0, 0); PG8_SCHED; PG8_LDA(At, 0, 0); PG8_STAGE(PG8_SA(1, 1), a1 + hstep, voffA);
            PG8_WAIT_L(8); PG8_BAR; PG8_WAIT_L(0); PG8_MMA(0, 0, At, B0); PG8_BAR; PG8_SCHED;
            PG8_LDB(B1, 0, 1); PG8_STAGE(PG8_SB(0, 0), b2, voffB);
            PG8_BAR; PG8_WAIT_L(0); PG8_MMA(0, 1, At, B1); PG8_BAR;
            PG8_LDA(At, 0, 1); PG8_STAGE(PG8_SA(0, 0), a2, voffA);
            PG8_BAR; PG8_WAIT_L(0); PG8_MMA(1, 0, At, B0); PG8_BAR; PG8_SCHED;
            PG8_STAGE(PG8_SB(0, 1), b2 + hstep, voffB);
            PG8_WAIT_V(6); PG8_BAR; PG8_MMA(1, 1, At, B1); PG8_BAR;
            PG8_LDB(B0, 1, 0); PG8_SCHED; PG8_LDA(At, 1, 0); PG8_STAGE(PG8_SA(0, 1), a2 + hstep, voffA);
            PG8_WAIT_L(8); PG8_BAR; PG8_WAIT_L(0); PG8_MMA(0, 0, At, B0); PG8_BAR; PG8_SCHED;
            PG8_LDB(B1, 1, 1); PG8_STAGE(PG8_SB(1, 0), b3, voffB);
            PG8_BAR; PG8_WAIT_L(0); PG8_MMA(0, 1, At, B1); PG8_BAR;
            PG8_LDA(At, 1, 1); PG8_STAGE(PG8_SA(1, 0), a3, voffA);
            PG8_BAR; PG8_WAIT_L(0); PG8_MMA(1, 0, At, B0); PG8_BAR; PG8_SCHED;
            PG8_STAGE(PG8_SB(1, 1), b3 + hstep, voffB);
            PG8_WAIT_V(6); PG8_BAR; PG8_MMA(1, 1, At, B1); PG8_BAR;
            }
        }
        if constexpr (ALIGN_EPI) { if (wr == 0) PG8_BAR; }
        if constexpr (!Epi::AFTER_DRAIN) { E(acc, cur, wr, wc, fr, fq); S.done(cur); }
        if (!has_next) break;
#pragma unroll
        for (int a = 0; a < 2; ++a)
#pragma unroll
            for (int b = 0; b < 2; ++b)
#pragma unroll
                for (int m = 0; m < 4; ++m)
#pragma unroll
                    for (int n = 0; n < 2; ++n) acc[a][b][m][n] = (f32x4){0.f, 0.f, 0.f, 0.f};
        cur = nxt; cA = nA; cB = nB; ++ui;
        if constexpr (ALIGN_EPI) { if (wr == 1) PG8_BAR; }
    }
    PG8_WAIT_V(0);
    if constexpr (!ALIGN_EPI) { if (wr == 0) PG8_BAR; }
    PG8_BAR;
    if constexpr (Epi::AFTER_DRAIN) { E.fused(acc, cur, wr, wc, fr, fq, lds, wid, lane); S.done(cur); }
#undef PG8_SA
#undef PG8_SB
#undef PG8_STAGE
#undef PG8_LDA
#undef PG8_LDB
#undef PG8_MMA
#undef PG8_WAIT_V
#undef PG8_WAIT_L
#undef PG8_BAR
#undef PG8_SCHED
}
}
namespace att {
#define ATT_LAS __attribute__((address_space(3)))
typedef unsigned short bf16_t;
typedef short bf16x8 __attribute__((ext_vector_type(8)));
typedef short s16x4 __attribute__((ext_vector_type(4)));
typedef float f32x16 __attribute__((ext_vector_type(16)));
typedef float f32x4 __attribute__((ext_vector_type(4)));
typedef unsigned u32x4 __attribute__((ext_vector_type(4)));
typedef unsigned u32x2 __attribute__((ext_vector_type(2)));
constexpr int KB0 = 0, KBSZ = 12288, VB0 = 24576, VBSZ = 16384;
__device__ __forceinline__ float swap_max(float m) { auto rr = __builtin_amdgcn_permlane32_swap(__float_as_uint(m), __float_as_uint(m), false, false); return fmaxf(__uint_as_float(rr[0]), __uint_as_float(rr[1])); }
__device__ __forceinline__ float swap_sum(float m) { auto rr = __builtin_amdgcn_permlane32_swap(__float_as_uint(m), __float_as_uint(m), false, false); return __uint_as_float(rr[0]) + __uint_as_float(rr[1]); }
__device__ __forceinline__ s16x4 vtr(const ATT_LAS char* p) { return __builtin_bit_cast(s16x4, __builtin_amdgcn_ds_read_tr16_b64_v4i16((ATT_LAS s16x4*)p)); }
__device__ __forceinline__ float max3f(float a, float b, float c) { float r; asm("v_max3_f32 %0, %1, %2, %3" : "=v"(r) : "v"(a), "v"(b), "v"(c)); return r; }
__device__ __forceinline__ int crow(int r, int hi) { return (r & 3) + 8 * (r >> 2) + 4 * hi; }

template <int DQK, int DV, bool MLA>
__device__ __forceinline__ void attn_pass(ATT_LAS char* lds, const bf16_t* qp, const bf16_t* kg, const bf16_t* krg, const bf16_t* vg, int NT, int myNT, f32x16 (&o)[DV / 32], float& linv) {
    int tid_ = threadIdx.x; asm volatile("" : "+v"(tid_)); const int tid = tid_, lane = tid & 63, wid = __builtin_amdgcn_readfirstlane(tid >> 6), r32 = lane & 31, hi = lane >> 5;
    bf16x8 qr[DQK / 16];
#pragma unroll
    for (int d0 = 0; d0 < DQK / 16; ++d0) qr[d0] = *(const bf16x8*)(qp + d0 * 16);
    const bf16_t* ksrc = kg + (size_t)lane * 1024 + wid * 8;
    const bf16_t* krsrc = krg + (size_t)lane * 32 + (wid & 3) * 8;
    const bf16_t* vsrc = vg + (size_t)(16 * (wid & 3) + (lane >> 2)) * 1024 + (wid >> 2) * 32 + (lane & 3) * 8;
    const int sto = wid * 1024 + lane * 16;
    u32x4 kr0 = {0u, 0u, 0u, 0u}, kr1 = kr0, vr0 = kr0, vr1 = kr0;
#define ATT_LOAD(t) do { kr0 = *(const u32x4*)(ksrc + (size_t)(t) * 65536); if (MLA) { if (wid < 4) kr1 = *(const u32x4*)(krsrc + (size_t)(t) * 2048); } \
        vr0 = *(const u32x4*)(vsrc + (size_t)(t) * 65536); if (DV == 128) vr1 = *(const u32x4*)(vsrc + (size_t)(t) * 65536 + 64); } while (0)
#define ATT_STORE(b) do { *(ATT_LAS u32x4*)(lds + KB0 + (b) * KBSZ + sto) = kr0; if (MLA) { if (wid < 4) *(ATT_LAS u32x4*)(lds + KB0 + (b) * KBSZ + 8192 + sto) = kr1; } \
        *(ATT_LAS u32x4*)(lds + VB0 + (b) * VBSZ + sto) = vr0; if (DV == 128) *(ATT_LAS u32x4*)(lds + VB0 + (b) * VBSZ + 8192 + sto) = vr1; } while (0)
#pragma unroll
    for (int i = 0; i < DV / 32; ++i)
#pragma unroll
        for (int r = 0; r < 16; ++r) o[i][r] = 0.f;
    float mref = 0.f, lsum = 0.f;
    ATT_LOAD(0); ATT_STORE(0); __syncthreads();
    for (int t = 0; t < NT; ++t) {
        const int b = t & 1;
        if (t + 1 < NT) ATT_LOAD(t + 1);
        if (t < myNT) {
            const ATT_LAS char* kp = lds + KB0 + b * KBSZ + hi * 1024 + r32 * 16;
            f32x16 p0, p1;
#pragma unroll
            for (int r = 0; r < 16; ++r) { p0[r] = -mref; p1[r] = -mref; }
#pragma unroll
            for (int d0 = 0; d0 < DQK / 16; ++d0) {
                const bf16x8 k0 = *(const ATT_LAS bf16x8*)(kp + d0 * 2048), k1 = *(const ATT_LAS bf16x8*)(kp + d0 * 2048 + 512);
                p0 = __builtin_amdgcn_mfma_f32_32x32x16_bf16(k0, qr[d0], p0, 0, 0, 0);
                p1 = __builtin_amdgcn_mfma_f32_32x32x16_bf16(k1, qr[d0], p1, 0, 0, 0);
            }
            asm volatile("s_nop 15\n\ts_nop 7" : "+v"(p0), "+v"(p1));
            float mxa = max3f(p0[0], p0[1], p1[0]), mxb = max3f(p0[2], p0[3], p1[1]); mxa = max3f(mxa, p1[2], p1[3]);
#pragma unroll
            for (int r = 4; r < 16; r += 4) { mxa = max3f(mxa, p0[r], p0[r + 1]); mxb = max3f(mxb, p0[r + 2], p0[r + 3]); mxa = max3f(mxa, p1[r], p1[r + 1]); mxb = max3f(mxb, p1[r + 2], p1[r + 3]); }
            float mx = swap_max(max3f(mxa, mxb, mxb));
            if (__any(mx > 8.f)) {
                const float dl = fmaxf(mx, 0.f), al = __builtin_amdgcn_exp2f(-dl);
                lsum *= al;
#pragma unroll
                for (int i = 0; i < DV / 32; ++i)
#pragma unroll
                    for (int r = 0; r < 16; ++r) o[i][r] *= al;
#pragma unroll
                for (int r = 0; r < 16; ++r) { p0[r] -= dl; p1[r] -= dl; }
                mref += dl;
            }
            float ls = 0.f;
#pragma unroll
            for (int r = 0; r < 16; ++r) { p0[r] = __builtin_amdgcn_exp2f(p0[r]); p1[r] = __builtin_amdgcn_exp2f(p1[r]); ls += p0[r] + p1[r]; }
            lsum += ls;
            u32x4 pw[4];
#pragma unroll
            for (int j = 0; j < 4; ++j) { pw[0][j] = pg8::pk2(p0[2 * j], p0[2 * j + 1]); pw[1][j] = pg8::pk2(p0[8 + 2 * j], p0[9 + 2 * j]); pw[2][j] = pg8::pk2(p1[2 * j], p1[2 * j + 1]); pw[3][j] = pg8::pk2(p1[8 + 2 * j], p1[9 + 2 * j]); }
            const ATT_LAS char* vp = lds + VB0 + b * VBSZ + ((lane >> 4) & 1) * 32 + (lane & 3) * 8 + (4 * hi + ((lane & 15) >> 2)) * 64;
#pragma unroll
            for (int i = 0; i < DV / 32; ++i)
#pragma unroll
                for (int ks = 0; ks < 4; ++ks) {
                    const s16x4 lo = vtr(vp + i * 4096 + ks * 1024), hh = vtr(vp + i * 4096 + ks * 1024 + 512);
                    const bf16x8 vf = {lo[0], lo[1], lo[2], lo[3], hh[0], hh[1], hh[2], hh[3]};
                    o[i] = __builtin_amdgcn_mfma_f32_32x32x16_bf16(vf, __builtin_bit_cast(bf16x8, pw[ks]), o[i], 0, 0, 0);
                }
        }
        if (t + 1 < NT) ATT_STORE(b ^ 1);
        __syncthreads();
    }
    linv = __builtin_amdgcn_rcpf(swap_sum(lsum));
#undef ATT_LOAD
#undef ATT_STORE
}

__device__ __forceinline__ void qk_softmax64(const ATT_LAS char* kbuf, const ATT_LAS char* qimg, float& mref, float& lsum, f32x16 (&o)[4], u32x4 (&pw)[4], int r32, int hi) {
    const ATT_LAS char* kp = kbuf + hi * 1024 + r32 * 16;
    f32x16 p0, p1;
#pragma unroll
    for (int r = 0; r < 16; ++r) { p0[r] = -mref; p1[r] = -mref; }
#pragma unroll
    for (int d0 = 0; d0 < 4; ++d0) {
        const bf16x8 k0 = *(const ATT_LAS bf16x8*)(kp + d0 * 2048), k1 = *(const ATT_LAS bf16x8*)(kp + d0 * 2048 + 512), q = *(const ATT_LAS bf16x8*)(qimg + d0 * 1024);
        p0 = __builtin_amdgcn_mfma_f32_32x32x16_bf16(k0, q, p0, 0, 0, 0);
        p1 = __builtin_amdgcn_mfma_f32_32x32x16_bf16(k1, q, p1, 0, 0, 0);
    }
    asm volatile("s_nop 15\n\ts_nop 7" : "+v"(p0), "+v"(p1));
    float mxa = max3f(p0[0], p0[1], p1[0]), mxb = max3f(p0[2], p0[3], p1[1]); mxa = max3f(mxa, p1[2], p1[3]);
#pragma unroll
    for (int r = 4; r < 16; r += 4) { mxa = max3f(mxa, p0[r], p0[r + 1]); mxb = max3f(mxb, p0[r + 2], p0[r + 3]); mxa = max3f(mxa, p1[r], p1[r + 1]); mxb = max3f(mxb, p1[r + 2], p1[r + 3]); }
    const float mx = swap_max(max3f(mxa, mxb, mxb));
    if (__any(mx > 8.f)) {
        const float dl = fmaxf(mx, 0.f), al = __builtin_amdgcn_exp2f(-dl);
        lsum *= al;
#pragma unroll
        for (int i = 0; i < 4; ++i)
#pragma unroll
            for (int r = 0; r < 16; ++r) o[i][r] *= al;
#pragma unroll
        for (int r = 0; r < 16; ++r) { p0[r] -= dl; p1[r] -= dl; }
        mref += dl;
    }
    float ls = 0.f;
#pragma unroll
    for (int r = 0; r < 16; ++r) { p0[r] = __builtin_amdgcn_exp2f(p0[r]); p1[r] = __builtin_amdgcn_exp2f(p1[r]); ls += p0[r] + p1[r]; }
    lsum += ls;
#pragma unroll
    for (int j = 0; j < 4; ++j) { pw[0][j] = pg8::pk2(p0[2 * j], p0[2 * j + 1]); pw[1][j] = pg8::pk2(p0[8 + 2 * j], p0[9 + 2 * j]); pw[2][j] = pg8::pk2(p1[2 * j], p1[2 * j + 1]); pw[3][j] = pg8::pk2(p1[8 + 2 * j], p1[9 + 2 * j]); }
}
__device__ __forceinline__ void diff_unit(ATT_LAS char* lds, int b, int h, int qb, const bf16_t* QD, const bf16_t* KD, const bf16_t* VD, bf16_t* OD, const float* subln, float lam) {
    int tid_ = threadIdx.x; asm volatile("" : "+v"(tid_)); const int tid = tid_, lane = tid & 63, wid = __builtin_amdgcn_readfirstlane(tid >> 6), r32 = lane & 31, hi = lane >> 5;
    const size_t row0 = (size_t)b * SEQ_LEN, qrow = row0 + qb * 256 + wid * 32 + r32;
    const int NT = 4 * qb + 4, myNT = 4 * qb + (wid >> 1) + 1;
    constexpr int DKB0 = 0, DKBSZ = 16384, DVB0 = 32768, DVBSZ = 16384;
    ATT_LAS char* qimg = lds + 65536 + wid * 8192 + hi * 512 + r32 * 16;
    { const bf16_t* qp = QD + qrow * 1024 + (2 * h) * 64 + hi * 8;
#pragma unroll
      for (int d0 = 0; d0 < 4; ++d0) { *(ATT_LAS bf16x8*)(qimg + d0 * 1024) = *(const bf16x8*)(qp + d0 * 16); *(ATT_LAS bf16x8*)(qimg + 4096 + d0 * 1024) = *(const bf16x8*)(qp + 64 + d0 * 16); } }
    const bf16_t* ksrc = KD + row0 * 1024 + (2 * h) * 64 + (size_t)lane * 1024 + wid * 8;
    const bf16_t* vsrc = VD + row0 * 1024 + h * 128 + (size_t)(16 * (wid & 3) + (lane >> 2)) * 1024 + (wid >> 2) * 32 + (lane & 3) * 8;
    const int sto = wid * 1024 + lane * 16;
    const int vlane = ((lane >> 4) & 1) * 32 + (lane & 3) * 8 + (4 * hi + ((lane & 15) >> 2)) * 64;
    u32x4 ka, kb, va, vb;
#define DF_LOAD(t) do { ka = *(const u32x4*)(ksrc + (size_t)(t) * 65536); kb = *(const u32x4*)(ksrc + (size_t)(t) * 65536 + 64); va = *(const u32x4*)(vsrc + (size_t)(t) * 65536); vb = *(const u32x4*)(vsrc + (size_t)(t) * 65536 + 64); } while (0)
#define DF_STORE(bf) do { *(ATT_LAS u32x4*)(lds + DKB0 + (bf) * DKBSZ + sto) = ka; *(ATT_LAS u32x4*)(lds + DKB0 + (bf) * DKBSZ + 8192 + sto) = kb; \
        *(ATT_LAS u32x4*)(lds + DVB0 + (bf) * DVBSZ + sto) = va; *(ATT_LAS u32x4*)(lds + DVB0 + (bf) * DVBSZ + 8192 + sto) = vb; } while (0)
    f32x16 o1[4], o2[4];
#pragma unroll
    for (int i = 0; i < 4; ++i)
#pragma unroll
        for (int r = 0; r < 16; ++r) { o1[i][r] = 0.f; o2[i][r] = 0.f; }
    float m1 = 0.f, l1 = 0.f, m2 = 0.f, l2 = 0.f;
    DF_LOAD(0); DF_STORE(0); __syncthreads();
    for (int t = 0; t < NT; ++t) {
        const int bf = t & 1;
        if (t + 1 < NT) DF_LOAD(t + 1);
        if (t < myNT) {
            u32x4 pwa[4], pwb[4];
            qk_softmax64(lds + DKB0 + bf * DKBSZ, qimg, m1, l1, o1, pwa, r32, hi);
            qk_softmax64(lds + DKB0 + bf * DKBSZ + 8192, qimg + 4096, m2, l2, o2, pwb, r32, hi);
            const ATT_LAS char* vp = lds + DVB0 + bf * DVBSZ + vlane;
#pragma unroll
            for (int i = 0; i < 4; ++i)
#pragma unroll
                for (int ks = 0; ks < 4; ++ks) {
                    const s16x4 lo = vtr(vp + i * 4096 + ks * 1024), hh = vtr(vp + i * 4096 + ks * 1024 + 512);
                    const bf16x8 vf = {lo[0], lo[1], lo[2], lo[3], hh[0], hh[1], hh[2], hh[3]};
                    o1[i] = __builtin_amdgcn_mfma_f32_32x32x16_bf16(vf, __builtin_bit_cast(bf16x8, pwa[ks]), o1[i], 0, 0, 0);
                    o2[i] = __builtin_amdgcn_mfma_f32_32x32x16_bf16(vf, __builtin_bit_cast(bf16x8, pwb[ks]), o2[i], 0, 0, 0);
                }
        }
        if (t + 1 < NT) DF_STORE(bf ^ 1);
        __syncthreads();
    }
#undef DF_LOAD
#undef DF_STORE
    const float li1 = __builtin_amdgcn_rcpf(swap_sum(l1)), c2 = lam * __builtin_amdgcn_rcpf(swap_sum(l2)); float ss = 0.f;
#pragma unroll
    for (int i = 0; i < 4; ++i)
#pragma unroll
        for (int r = 0; r < 16; ++r) { const float v = o1[i][r] * li1 - o2[i][r] * c2; o1[i][r] = v; ss += v * v; }
    ss = swap_sum(ss);
    const float rstd = __builtin_amdgcn_rsqf(ss * (1.f / 128.f) + NEPS) * 0.8f;
    bf16_t* op = OD + qrow * 1536 + h * 128 + 4 * hi;
#pragma unroll
    for (int i = 0; i < 4; ++i)
#pragma unroll
        for (int rq = 0; rq < 4; ++rq) { const int dv = 32 * i + 8 * rq; const f32x4 g = *(const f32x4*)(subln + dv + 4 * hi);
            u32x2 w; w.x = pg8::pk2(o1[i][4 * rq] * rstd * g[0], o1[i][4 * rq + 1] * rstd * g[1]); w.y = pg8::pk2(o1[i][4 * rq + 2] * rstd * g[2], o1[i][4 * rq + 3] * rstd * g[3]);
            *(u32x2*)(op + dv) = w; }
}
__device__ __forceinline__ void mla_unit(ATT_LAS char* lds, int b, int h, int qb, const bf16_t* QM, const bf16_t* KVM, const bf16_t* KR, bf16_t* OM) {
    int tid_ = threadIdx.x; asm volatile("" : "+v"(tid_)); const int tid = tid_, lane = tid & 63, wid = __builtin_amdgcn_readfirstlane(tid >> 6), r32 = lane & 31, hi = lane >> 5;
    const size_t row0 = (size_t)b * SEQ_LEN, qrow = row0 + qb * 256 + wid * 32 + r32;
    const int NT = 4 * qb + 4, myNT = 4 * qb + (wid >> 1) + 1;
    f32x16 o[2]; float li;
    attn_pass<96, 64, true>(lds, QM + qrow * 768 + h * 96 + hi * 8, KVM + row0 * 1024 + h * 128, KR + row0 * 32, KVM + row0 * 1024 + h * 128 + 64, NT, myNT, o, li);
    bf16_t* op = OM + qrow * 1536 + 1024 + h * 64 + 4 * hi;
#pragma unroll
    for (int i = 0; i < 2; ++i)
#pragma unroll
        for (int rq = 0; rq < 4; ++rq) { const int dv = 32 * i + 8 * rq;
            u32x2 w; w.x = pg8::pk2(o[i][4 * rq] * li, o[i][4 * rq + 1] * li); w.y = pg8::pk2(o[i][4 * rq + 2] * li, o[i][4 * rq + 3] * li);
            *(u32x2*)(op + dv) = w; }
}
}
#define LAS __attribute__((address_space(3)))
typedef unsigned short bf16;
typedef float f32x4 __attribute__((ext_vector_type(4)));
typedef unsigned v4u __attribute__((ext_vector_type(4)));
typedef unsigned v2u __attribute__((ext_vector_type(2)));
constexpr int NWAVES = 8, LDS_BYTES = 147456;
constexpr size_t MiB = 1ull << 20;
constexpr size_t WS_TABD = 0, WS_TABM = 128 * 1024, WS_LAM = 384 * 1024, WS_BAR = 512 * 1024;
constexpr size_t WS_SSQ = 1 * MiB, WS_SSKV = 2 * MiB, WS_SS1 = 3 * MiB, WS_SS2 = 5 * MiB, WS_SS3 = 7 * MiB;
constexpr size_t WS_WIN = 10 * MiB, WS_WGU = WS_WIN + 5888ull * 1024 * 2, WS_WDN = WS_WGU + 5632ull * 1024 * 2, WS_WOD = WS_WDN + 1024ull * 2816 * 2, WS_WOUT = WS_WOD + 2 * MiB,
                 WS_WPG = WS_WOUT + 2 * MiB, WS_WOM = WS_WPG + 2 * MiB, WS_WUQ = WS_WOM + 1 * MiB, WS_WUKV = WS_WUQ + 768ull * 384 * 2, WS_WPLE = WS_WUKV + 1024ull * 256 * 2, WS_WEND = WS_WPLE + 1024ull * 256 * 2;
static_assert(WS_WEND <= 47 * MiB, "weights");
constexpr size_t WS_PB = 47 * MiB;
constexpr size_t WS_XN = 64 * MiB, WS_QM = 64 * MiB, WS_X1B = 64 * MiB;
constexpr size_t WS_QD = 128 * MiB, WS_KD = 192 * MiB, WS_VD = 256 * MiB, WS_KVM = 320 * MiB;
constexpr size_t WS_T = 192 * MiB, WS_MG = 320 * MiB;
constexpr size_t WS_HID = 128 * MiB, WS_X2B = 304 * MiB;
constexpr size_t WS_X3B = 384 * MiB, WS_T2B = 448 * MiB;
constexpr size_t WS_CKV = 384 * MiB, WS_CQ = 400 * MiB, WS_ODM = 384 * MiB, WS_KR = 480 * MiB, WS_WCAT = 482 * MiB;
constexpr size_t WS_END = 512 * MiB;

#define XB_TMO      128
#define XB_XCNT(j)  (256  + 64 * (j))
#define XB_XSUB(j)  (1280 + 64 * (j))
#define XB_XGEN(j)  (2304 + 64 * (j))
#define XB_TOP      3328
#define XB_TOPGEN   3392
#define XCD_BAR_WORDS 3456
#define XB_SPIN_CAP (1u << 18)

__device__ __forceinline__ unsigned xb_ld(unsigned* p)              { return __hip_atomic_load(p, __ATOMIC_RELAXED, __HIP_MEMORY_SCOPE_AGENT); }
__device__ __forceinline__ unsigned xb_add(unsigned* p, unsigned v) { return __hip_atomic_fetch_add(p, v, __ATOMIC_RELAXED, __HIP_MEMORY_SCOPE_AGENT); }
__device__ __forceinline__ unsigned xb_xcc_id() { return (unsigned)__builtin_amdgcn_s_getreg((3 << 11) | 20) & 0xFu; }
#define XB_SPIN(cond, bar) do { unsigned _sp = 0; while (cond) { __builtin_amdgcn_s_sleep(1); \
    if ((++_sp & 255u) == 0u) { if (xb_ld(&(bar)[XB_TMO])) break; if (_sp > XB_SPIN_CAP) { atomicAdd(&(bar)[XB_TMO], 1u); break; } } } } while (0)

struct XcdBarrier {
    unsigned* bar; unsigned x;
    volatile LAS unsigned* st;
};

__device__ __forceinline__ XcdBarrier xcd_barrier_post(unsigned* bar, volatile LAS unsigned* st) {
    XcdBarrier b; b.bar = bar; b.x = xb_xcc_id(); b.st = st;
    if (threadIdx.x == 0) (void)xb_add(&bar[XB_XCNT(b.x)], 1u);
    return b;
}
__device__ __forceinline__ void xcd_barrier_complete(unsigned* bar, unsigned x, unsigned& nloc, unsigned& nx) {
    const unsigned G = gridDim.x * gridDim.y * gridDim.z;
    unsigned sum, cnt, mine, sp = 0u;
    for (;;) {
        sum = 0u; cnt = 0u; mine = 0u;
#pragma unroll
        for (unsigned j = 0; j < 16; ++j) { const unsigned c = xb_ld(&bar[XB_XCNT(j)]); sum += c; cnt += (c > 0u) ? 1u : 0u; mine = (j == x) ? c : mine; }
        if (sum == G) break;
        __builtin_amdgcn_s_sleep(1);
        if ((++sp & 255u) == 0u) { if (xb_ld(&bar[XB_TMO])) break; if (sp > XB_SPIN_CAP) { atomicAdd(&bar[XB_TMO], 1u); break; } }
    }
    nloc = mine > 0u ? mine : 1u; nx = cnt > 0u ? cnt : 1u;
}

__device__ __forceinline__ void xcd_barrier(const XcdBarrier& b) {
    asm volatile("s_waitcnt vmcnt(0)" ::: "memory");
    __syncthreads();
    if (threadIdx.x == 0) {
        unsigned* bar = b.bar;
        __builtin_amdgcn_s_waitcnt(0);
        unsigned nloc = b.st[0], nx = b.st[1];
        if (nloc == 0u) { xcd_barrier_complete(bar, b.x, nloc, nx); b.st[0] = nloc; b.st[1] = nx; }
        const unsigned old = xb_add(&bar[XB_XSUB(b.x)], 1u);
        const unsigned gen = old / nloc;
        if (old + 1u == (gen + 1u) * nloc) {
            __builtin_amdgcn_fence(__ATOMIC_RELEASE, "agent");
            asm volatile("s_waitcnt vmcnt(0)" ::: "memory");
            const unsigned og = xb_add(&bar[XB_TOP], 1u);
            const unsigned tg = og / nx;
            if (og + 1u == (tg + 1u) * nx) xb_add(&bar[XB_TOPGEN], 1u);
            else XB_SPIN(xb_ld(&bar[XB_TOPGEN]) == tg, bar);
            __builtin_amdgcn_fence(__ATOMIC_ACQUIRE, "agent");
            xb_add(&bar[XB_XGEN(b.x)], 1u);
            asm volatile("s_waitcnt vmcnt(0)" ::: "memory");
        } else {
            XB_SPIN(xb_ld(&bar[XB_XGEN(b.x)]) == gen, bar);
            __builtin_amdgcn_fence(__ATOMIC_ACQUIRE, "agent");
            asm volatile("s_waitcnt vmcnt(0)" ::: "memory");
        }
    }
    __syncthreads();
}

struct Args {
    const float *x, *p, *attn_norm, *w_in, *b_gate, *lam_q1, *lam_k1, *lam_q2, *lam_k2, *diff_subln, *w_o_diff, *q_norm, *w_uq, *kv_norm, *w_ukv, *w_o_mla, *w_out, *ffn_norm,
        *w_ffn_gate, *w_ffn_up, *w_ffn_down, *ple_norm, *w_ple_gate, *b_ple_gate, *w_ple, *final_norm;
    float* out; unsigned char* ws;
};

__device__ __forceinline__ float wave_sum(float v) {
#pragma unroll
    for (int o = 1; o < 64; o <<= 1) v += __shfl_xor(v, o);
    return v;
}
__device__ __forceinline__ void wprep_item(int kind, const float* W, const float* W2, int ld, int K, int Nout, const float* gain, bf16* WT, int item, LAS float* scr, int lane) {
    const int nnb = Nout / 32, kb = item / nnb, nb = item % nnb, k0 = kb * 64, n0 = nb * 32, nl = lane & 31, ks = lane >> 5, n = n0 + nl;
    const float* base = W; int col = n;
    if (kind == 1) {
        if (n < 2048) { const int hl = n & 63; col = (n & ~63) + (hl < 16 ? ((hl & 1) ? (hl >> 1) + 8 : (hl >> 1)) : hl); }
        else if (n < 3072) col = n;
        else if (n < 5120) col = 3744 + (n - 3072);
        else if (n < 5376) col = 3456 + (n - 5120);
        else if (n < 5760) col = 3072 + (n - 5376);
        else if (n < 5792) { const int hl = n - 5760; col = 3712 + ((hl & 1) ? (hl >> 1) + 16 : (hl >> 1)); }
        else col = -1;
    } else if (kind == 2) { const int h = n / 96, hl = n % 96; int s = hl; if (hl >= 64) { const int r = hl - 64; s = 64 + ((r & 1) ? (r >> 1) + 16 : (r >> 1)); } col = h * 96 + s;
    } else if (kind == 3) { const int pn = n >> 8, r = n & 255; if (r < 128) col = pn * 128 + r; else { base = W2; col = pn * 128 + (r - 128); } }
    const float* src = base + (size_t)(k0 + ks) * ld + (col >= 0 ? col : 0);
    float v[32];
#pragma unroll
    for (int i = 0; i < 32; ++i) v[i] = __builtin_nontemporal_load(src + (size_t)(2 * i) * ld);
    if (col < 0) {
#pragma unroll
        for (int i = 0; i < 32; ++i) v[i] = 0.f;
    }
    if (gain) { const float* gp = gain + k0 + ks;
#pragma unroll
        for (int i = 0; i < 32; ++i) v[i] *= gp[2 * i]; }
#pragma unroll
    for (int i = 0; i < 32; ++i) scr[(2 * i + ks) * 33 + nl] = v[i];
    asm volatile("s_waitcnt lgkmcnt(0)" ::: "memory");
    const int c = lane & 7;
#pragma unroll
    for (int j = 0; j < 4; ++j) { const int nn = (lane >> 3) + 8 * j; const LAS float* s = scr + (8 * c) * 33 + nn;
        v4u o; o.x = pg8::pk2(s[0], s[33]); o.y = pg8::pk2(s[2 * 33], s[3 * 33]); o.z = pg8::pk2(s[4 * 33], s[5 * 33]); o.w = pg8::pk2(s[6 * 33], s[7 * 33]);
        *(v4u*)(WT + (size_t)(n0 + nn) * K + k0 + 8 * c) = o; }
    asm volatile("s_waitcnt lgkmcnt(0)" ::: "memory");
}

#define WSP(T, off) ((T*)(a.ws + (off)))
#define tabD WSP(float, WS_TABD)
#define tabM WSP(float, WS_TABM)
#define lamp WSP(float, WS_LAM)
#define SSQ WSP(float, WS_SSQ)
#define SSKV WSP(float, WS_SSKV)
#define SS1 WSP(float, WS_SS1)
#define SS2 WSP(float, WS_SS2)
#define SS3 WSP(float, WS_SS3)
#define Win WSP(bf16, WS_WIN)
#define Wgu WSP(bf16, WS_WGU)
#define Wdn WSP(bf16, WS_WDN)
#define Wod WSP(bf16, WS_WOD)
#define Wout WSP(bf16, WS_WOUT)
#define Wpg WSP(bf16, WS_WPG)
#define Wom WSP(bf16, WS_WOM)
#define Wuq WSP(bf16, WS_WUQ)
#define Wukv WSP(bf16, WS_WUKV)
#define Wple WSP(bf16, WS_WPLE)
#define PB WSP(bf16, WS_PB)
#define XN WSP(bf16, WS_XN)
#define QM WSP(bf16, WS_QM)
#define X1B WSP(bf16, WS_X1B)
#define QD WSP(bf16, WS_QD)
#define KD WSP(bf16, WS_KD)
#define VD WSP(bf16, WS_VD)
#define KVM WSP(bf16, WS_KVM)
#define MG WSP(bf16, WS_MG)
#define HID WSP(bf16, WS_HID)
#define X2B WSP(bf16, WS_X2B)
#define CKV WSP(bf16, WS_CKV)
#define CQ WSP(bf16, WS_CQ)
#define KR WSP(bf16, WS_KR)
#define ODM WSP(bf16, WS_ODM)
#define Wcat WSP(bf16, WS_WCAT)
#define TBUF WSP(bf16, WS_T)
#define X3B WSP(bf16, WS_X3B)
#define T2B WSP(bf16, WS_T2B)
#define SA ((bf16*)a.out)
#define SB ((bf16*)a.out + (size_t)M_TOK * 1024)
template <class E> __device__ __forceinline__ void run_gemm(LAS unsigned char* lds, const bf16* A, const bf16* Bt, int N, int K, const E& e) {
    asm volatile("" : "+s"(K));
    pg8::Gemm g{A, Bt, M_TOK, N, K}; pg8::StaticOrder S; S.init(M_TOK, N, (int)gridDim.x, (int)blockIdx.x);
    pg8::gemm_phase<E, pg8::StaticOrder, true, true>(lds, g, S, e);
}

__global__ void __launch_bounds__(NWAVES * 64, 2) fwd_megakernel(Args a) {
    extern __shared__ __attribute__((aligned(16))) unsigned char lds_raw[];
    cg::grid_group grid = cg::this_grid();
    LAS unsigned char* lds = (LAS unsigned char*)lds_raw;
    int tid0_ = threadIdx.x; asm volatile("" : "+v"(tid0_)); const int tid = tid0_, lane = tid & 63, wave = __builtin_amdgcn_readfirstlane(tid >> 6);
    const int G = gridDim.x, gw = blockIdx.x * NWAVES + wave, NGW = G * NWAVES;
    volatile LAS unsigned* bst = (volatile LAS unsigned*)(lds + (LDS_BYTES - 64));
    if (tid < 2) bst[tid] = 0u;
    __syncthreads();
    const XcdBarrier xbar = xcd_barrier_post((unsigned*)(a.ws + WS_BAR), bst);
#if !defined(SKIP_P0)
    {
        LAS float* scr = (LAS float*)(lds + wave * 8448);
        constexpr int I0 = 16 * 184, I1 = I0 + 16 * 176, I2 = I1 + 44 * 32, I3 = I2 + 512, I4 = I3 + 512, I5 = I4 + 512, I6 = I5 + 256, I7 = I6 + 144, I8 = I7 + 128, I9 = I8 + 128;
        for (int it = gw; it < I9; it += NGW) {
            if (it < I0)      wprep_item(1, a.w_in, nullptr, 5792, 1024, 5888, nullptr, Win, it, scr, lane);
            else if (it < I1) wprep_item(3, a.w_ffn_gate, a.w_ffn_up, 2816, 1024, 5632, a.ffn_norm, Wgu, it - I0, scr, lane);
            else if (it < I2) wprep_item(0, a.w_ffn_down, nullptr, 1024, 2816, 1024, nullptr, Wdn, it - I1, scr, lane);
            else if (it < I3) wprep_item(0, a.w_o_diff, nullptr, 1024, 1536, 1024, nullptr, Wcat, it - I2, scr, lane);
            else if (it < I4) wprep_item(0, a.w_out, nullptr, 1024, 1024, 1024, nullptr, Wout, it - I3, scr, lane);
            else if (it < I5) wprep_item(0, a.w_ple_gate, nullptr, 1024, 1024, 1024, a.ple_norm, Wpg, it - I4, scr, lane);
            else if (it < I6) wprep_item(0, a.w_o_mla, nullptr, 1024, 1536, 1024, nullptr, Wcat + 1024, it - I5, scr, lane);
            else if (it < I7) wprep_item(2, a.w_uq, nullptr, 768, 384, 768, a.q_norm, Wuq, it - I6, scr, lane);
            else if (it < I8) wprep_item(0, a.w_ukv, nullptr, 1024, 256, 1024, a.kv_norm, Wukv, it - I7, scr, lane);
            else              wprep_item(0, a.w_ple, nullptr, 1024, 256, 1024, nullptr, Wple, it - I8, scr, lane);
        }
        for (int r0 = gw * 4; r0 < M_TOK; r0 += NGW * 4) {
            f32x4 v[4][4]; float s[4];
#pragma unroll
            for (int q = 0; q < 4; ++q) { const f32x4* xr = (const f32x4*)(a.x + (size_t)(r0 + q) * 1024) + lane; s[q] = 0.f;
#pragma unroll
                for (int j = 0; j < 4; ++j) v[q][j] = __builtin_nontemporal_load(xr + 64 * j); }
            f32x4 pq[4];
#pragma unroll
            for (int q = 0; q < 4; ++q) pq[q] = __builtin_nontemporal_load((const f32x4*)(a.p + (size_t)(r0 + q) * 256) + lane);
#pragma unroll
            for (int q = 0; q < 4; ++q) {
#pragma unroll
                for (int j = 0; j < 4; ++j) s[q] += pg8::sq4(v[q][j]);
                const float rstd = __builtin_amdgcn_rsqf(wave_sum(s[q]) * (1.f / 1024.f) + NEPS);
                v2u* o8 = (v2u*)(XN + (size_t)(r0 + q) * 1024) + lane;
#pragma unroll
                for (int j = 0; j < 4; ++j) { const f32x4 g = ((const f32x4*)a.attn_norm)[lane + 64 * j]; const f32x4 y = v[q][j] * rstd * g; v2u w; w.x = pg8::pk2(y[0], y[1]); w.y = pg8::pk2(y[2], y[3]); o8[64 * j] = w; }
                v2u wp; wp.x = pg8::pk2(pq[q][0], pq[q][1]); wp.y = pg8::pk2(pq[q][2], pq[q][3]); ((v2u*)(PB + (size_t)(r0 + q) * 256))[lane] = wp; }
        }
        { const int gt = blockIdx.x * 512 + tid, GT = G * 512;
          for (int i = gt; i < 2048 * 24; i += GT) {
              const int pos = i / 24, f = i % 24; const bool dm = f < 8; const int fi = dm ? f : f - 8;
              const float invf = dm ? __builtin_amdgcn_exp2f(-18.931568569324174f * (float)fi * 0.125f) : __builtin_amdgcn_exp2f(-13.287712379549449f * (float)fi * 0.0625f);
              const float ang = (float)pos * invf; const double rev = (double)ang * 0.15915494309189535; const float fr = (float)(rev - floor(rev));
              const float cs = __builtin_amdgcn_cosf(fr), sn = __builtin_amdgcn_sinf(fr);
              float* dst = dm ? tabD + ((size_t)pos * 8 + fi) * 2 : tabM + ((size_t)pos * 16 + fi) * 2; dst[0] = cs; dst[1] = sn;
          }
          if (blockIdx.x == 0 && wave == 0) { const float s1 = wave_sum(a.lam_q1[lane] * a.lam_k1[lane]), s2 = wave_sum(a.lam_q2[lane] * a.lam_k2[lane]); if (lane == 0) lamp[0] = __expf(s1) - __expf(s2) + 0.2f; }
        }
    }
    xcd_barrier(xbar);
    if (a.ws == nullptr) grid.sync();
    #endif

#if !defined(SKIP_P1)
    { pg8::EpiInProj e{QD, KD, VD, SA, SB, CKV, CQ, KR, SSQ, SSKV, a.b_gate, tabD, tabM}; run_gemm(lds, XN, Win, 5888, 1024, e); }
    xcd_barrier(xbar);
    #endif

#if !defined(SKIP_P2)
    { pg8::EpiQUp e{SSQ, tabM, QM}; run_gemm(lds, CQ, Wuq, 768, 384, e); }
    { pg8::EpiKVUp e{SSKV, KVM}; run_gemm(lds, CKV, Wukv, 1024, 256, e); }
    xcd_barrier(xbar);
    #endif

#if !defined(SKIP_P3)
    {
        const float lam = lamp[0];
        for (int i = blockIdx.x; i < 2048; i += G) {
            const int type = i >> 10, rem = i & 1023, j = rem >> 8, half = (rem >> 7) & 1, bh = rem & 127;
            const int qb = half ? (j == 0 ? 6 : j == 1 ? 4 : j == 2 ? 3 : 1) : (j == 0 ? 7 : j == 1 ? 5 : j == 2 ? 2 : 0);
            if (type == 0) att::diff_unit((ATT_LAS char*)lds, bh >> 3, bh & 7, qb, QD, KD, VD, ODM, a.diff_subln, lam);
            else           att::mla_unit((ATT_LAS char*)lds, bh >> 3, bh & 7, qb, QM, KVM, KR, ODM);
        }
    }
    xcd_barrier(xbar);
    #endif

#if !defined(SKIP_P4)
    { pg8::EpiMerge e{SA, SB, MG}; run_gemm(lds, ODM, Wcat, 1024, 1536, e); }
    xcd_barrier(xbar);
    #endif

#if !defined(SKIP_P5)
    { pg8::EpiResid<false> e{a.x, X1B, SS1}; run_gemm(lds, MG, Wout, 1024, 1024, e); }
    xcd_barrier(xbar);
    #endif

#if !defined(SKIP_P6)
    { pg8::EpiSwiGLU e{SS1, HID}; run_gemm(lds, X1B, Wgu, 5632, 1024, e); }
    xcd_barrier(xbar);
    #endif

#if !defined(SKIP_P7)
    { pg8::EpiResid<true> e{X1B, X2B, SS2}; run_gemm(lds, HID, Wdn, 1024, 2816, e); }
    xcd_barrier(xbar);
    #endif

#if !defined(SKIP_P8)
    { pg8::EpiPleA e{T2B}; run_gemm(lds, PB, Wple, 1024, 256, e); }
    { pg8::EpiPleB e{SS2, a.b_ple_gate, X2B, T2B, X3B, SS3}; run_gemm(lds, X2B, Wpg, 1024, 1024, e); }
    xcd_barrier(xbar);
    #endif

#if !defined(SKIP_P9)
    { int t9_ = threadIdx.x; asm volatile("" : "+v"(t9_)); const int lane = t9_ & 63, gw = blockIdx.x * NWAVES + __builtin_amdgcn_readfirstlane(t9_ >> 6), NGW = gridDim.x * NWAVES;
    for (int r0 = gw * 4; r0 < M_TOK; r0 += NGW * 4) {
        v4u w[4][2]; float s[4];
#pragma unroll
        for (int q = 0; q < 4; ++q) { const v4u* xr = (const v4u*)(X3B + (size_t)(r0 + q) * 1024) + lane; w[q][0] = xr[0]; w[q][1] = xr[64]; s[q] = (lane < 16) ? SS3[(size_t)(r0 + q) * 16 + lane] : 0.f; }
#pragma unroll
        for (int q = 0; q < 4; ++q) { const float rstd = __builtin_amdgcn_rsqf(wave_sum(s[q]) * (1.f / 1024.f) + NEPS);
#pragma unroll
            for (int j = 0; j < 2; ++j) { const int c = (lane + 64 * j) * 8; const f32x4 g0 = *(const f32x4*)(a.final_norm + c), g1 = *(const f32x4*)(a.final_norm + c + 4); const v4u ww = w[q][j];
                f32x4 x0, x1; x0[0] = __uint_as_float(ww.x << 16); x0[1] = __uint_as_float(ww.x & 0xffff0000u); x0[2] = __uint_as_float(ww.y << 16); x0[3] = __uint_as_float(ww.y & 0xffff0000u);
                x1[0] = __uint_as_float(ww.z << 16); x1[1] = __uint_as_float(ww.z & 0xffff0000u); x1[2] = __uint_as_float(ww.w << 16); x1[3] = __uint_as_float(ww.w & 0xffff0000u);
                float* o = a.out + (size_t)(r0 + q) * 1024 + c; __builtin_nontemporal_store(x0 * rstd * g0, (f32x4*)o); __builtin_nontemporal_store(x1 * rstd * g1, (f32x4*)(o + 4)); } }
    } }
#endif
}

extern "C" void kernel_launch(void* const* d_in, const int* in_sizes, int n_in, void* d_out, int out_size, void* d_ws, size_t ws_size, hipStream_t stream) {
    static int grid = 0;
    if (grid == 0) {
        if (n_in != 26 || out_size != M_TOK * 1024 || ws_size < WS_END) { fprintf(stderr, "kernel_launch: unexpected shapes (n_in %d out %d ws %zu)\n", n_in, out_size, ws_size); grid = -1; return; }
        int dev = 0, cus = 0, per_cu = 0;
        (void)hipGetDevice(&dev); (void)hipDeviceGetAttribute(&cus, hipDeviceAttributeMultiprocessorCount, dev);
        (void)hipFuncSetAttribute((const void*)fwd_megakernel, hipFuncAttributeMaxDynamicSharedMemorySize, LDS_BYTES);
        if (hipOccupancyMaxActiveBlocksPerMultiprocessor(&per_cu, (const void*)fwd_megakernel, NWAVES * 64, LDS_BYTES) != hipSuccess || per_cu < 1) per_cu = 1;
        (void)hipGetLastError();
        grid = cus * per_cu;
    }
    if (grid < 0) return;
    Args a{};
    const float** f = (const float**)&a;
    for (int i = 0; i < 26; ++i) f[i] = (const float*)d_in[i];
    a.out = (float*)d_out; a.ws = (unsigned char*)d_ws;
    (void)hipMemsetAsync((char*)d_ws + WS_BAR, 0, 16384, stream);
    void* args[] = {&a};
    hipError_t e = hipLaunchCooperativeKernel((const void*)fwd_megakernel, dim3(grid), dim3(NWAVES * 64), args, LDS_BYTES, stream);
    if (e != hipSuccess) fprintf(stderr, "cooperative launch failed: %s (grid %d)\n", hipGetErrorString(e), grid);
}
```

```cpp
#include <hip/hip_runtime.h>
#include <hip/hip_cooperative_groups.h>
#include <cstdio>
#include <cstdint>
namespace cg = cooperative_groups;

constexpr int M_TOK = 32768, SEQ_LEN = 2048;
constexpr float NEPS = 1e-6f;
constexpr float LOG2E_F = 1.4426950408889634f;
constexpr float QS_D = 0.125f * LOG2E_F;
constexpr float QS_M = 0.10206207261596575f * LOG2E_F;
namespace pg8 {
#define PG8_LAS __attribute__((address_space(3)))
typedef unsigned short bf16_t;
typedef short bf16x8 __attribute__((ext_vector_type(8)));
typedef float f32x4 __attribute__((ext_vector_type(4)));
typedef unsigned u32x4 __attribute__((ext_vector_type(4)));
constexpr int BM = 256, BK = 64, HALF = 128, HTB = HALF * BK * 2  , STAGE_BYTES = 8 * HTB, NXCD = 8, WGM = 8;

__host__ __device__ __forceinline__ int lds_byte(int r, int c) { const int st = (r >> 4) * 2 + (c >> 5), rr = r & 15, cc = c & 31, ob = rr * 64 + cc * 2; return st * 1024 + (ob ^ (((ob >> 9) & 1) << 5)); }
__host__ __device__ __forceinline__ void stage_rc(int b, int& R, int& C) { const int st = b / 1024, sb = b % 1024, swz = sb ^ (((sb >> 9) & 1) << 5); R = (st >> 1) * 16 + swz / 64; C = (st & 1) * 32 + (swz % 64) / 2; }
__host__ __device__ __forceinline__ int perm32(int rho) { const int n = rho >> 4, i = rho & 15; return 8 * (i >> 2) + 4 * n + (i & 3); }

struct Unit { int pm, pn; };
struct Gemm { const bf16_t* A; const bf16_t* Bt; int M, N, K; };

struct StaticOrder {
    int nM, nN, nwg, G, c;
    __host__ __device__ void init(int M, int N, int G_, int c_) { nM = M / BM; nN = N / BM; nwg = nM * nN; G = G_; c = c_; }
    __host__ __device__ bool next(int i, Unit& u) const {
        const long L = (long)i * G + c; if (L >= nwg) return false;
        int wgid = (int)L; { const int q = nwg / NXCD, r = nwg % NXCD, xcd = wgid % NXCD, off = wgid / NXCD; wgid = (xcd < r ? xcd * (q + 1) : r * (q + 1) + (xcd - r) * q) + off; }
        const int nig = WGM * nN, gid = wgid / nig, fm = gid * WGM, gsz = (nM - fm) < WGM ? (nM - fm) : WGM;
        u.pm = fm + ((wgid % nig) % gsz); u.pn = (wgid % nig) / gsz; return true;
    }
    __device__ __forceinline__ void a_ready(const Unit&) const {}
    __device__ __forceinline__ void done(const Unit&) const {}
};

typedef unsigned u32x4 __attribute__((ext_vector_type(4)));
typedef unsigned u32x2 __attribute__((ext_vector_type(2)));
typedef float f32x2 __attribute__((ext_vector_type(2)));
typedef __bf16 bf16x2_t __attribute__((ext_vector_type(2)));
__device__ __forceinline__ unsigned pk2(float lo, float hi) { f32x2 v = {lo, hi}; bf16x2_t b = __builtin_convertvector(v, bf16x2_t); return __builtin_bit_cast(unsigned, b); }
__device__ __forceinline__ void st8(bf16_t* p, f32x4 a, f32x4 b) { u32x4 w; w.x = pk2(a[0], a[1]); w.y = pk2(a[2], a[3]); w.z = pk2(b[0], b[1]); w.w = pk2(b[2], b[3]); *(u32x4*)p = w; }
__device__ __forceinline__ void st8nt(bf16_t* p, f32x4 a, f32x4 b) { u32x4 w; w.x = pk2(a[0], a[1]); w.y = pk2(a[2], a[3]); w.z = pk2(b[0], b[1]); w.w = pk2(b[2], b[3]); __builtin_nontemporal_store(w, (u32x4*)p); }
__device__ __forceinline__ void ld8(const bf16_t* p, f32x4& a, f32x4& b) { const u32x4 w = *(const u32x4*)p;
    a[0] = __uint_as_float(w.x << 16); a[1] = __uint_as_float(w.x & 0xffff0000u); a[2] = __uint_as_float(w.y << 16); a[3] = __uint_as_float(w.y & 0xffff0000u);
    b[0] = __uint_as_float(w.z << 16); b[1] = __uint_as_float(w.z & 0xffff0000u); b[2] = __uint_as_float(w.w << 16); b[3] = __uint_as_float(w.w & 0xffff0000u); }
__device__ __forceinline__ void up8(const u32x4 w, f32x4& a, f32x4& b) {
    a[0] = __uint_as_float(w.x << 16); a[1] = __uint_as_float(w.x & 0xffff0000u); a[2] = __uint_as_float(w.y << 16); a[3] = __uint_as_float(w.y & 0xffff0000u);
    b[0] = __uint_as_float(w.z << 16); b[1] = __uint_as_float(w.z & 0xffff0000u); b[2] = __uint_as_float(w.w << 16); b[3] = __uint_as_float(w.w & 0xffff0000u); }
__device__ __forceinline__ float sigm(float x) { return __builtin_amdgcn_rcpf(1.f + __expf(-x)); }
__device__ __forceinline__ f32x4 sigm4(f32x4 x) { f32x4 o; o[0] = sigm(x[0]); o[1] = sigm(x[1]); o[2] = sigm(x[2]); o[3] = sigm(x[3]); return o; }
__device__ __forceinline__ float quad_sum(float s) { s += __shfl_xor(s, 16); s += __shfl_xor(s, 32); return s; }
__device__ __forceinline__ float sq4(f32x4 v) { return (v[0] * v[0] + v[1] * v[1]) + (v[2] * v[2] + v[3] * v[3]); }
__device__ __forceinline__ f32x4 rope4(f32x4 v, f32x4 t) { f32x4 o; o[0] = v[0] * t[0] - v[1] * t[1]; o[1] = v[1] * t[0] + v[0] * t[1]; o[2] = v[2] * t[2] - v[3] * t[3]; o[3] = v[3] * t[2] + v[2] * t[3]; return o; }
#define EPI_FENCE() asm volatile("" ::: "memory")
#define EPI_LOOP_AM _Pragma("unroll") for (int ai = 0; ai < 2; ++ai) _Pragma("unroll") for (int m = 0; m < 4; ++m)

struct EpiInProj {
    static constexpr bool PERM = true, AFTER_DRAIN = false, HAS_MID = false;
    bf16_t *QD, *KD, *VD, *SA, *SB, *CKV, *CQ, *KR; float *SSQ, *SSKV; const float* bgate; const float* tabD; const float* tabM;
    __device__ __forceinline__ void operator()(const f32x4 (&acc)[2][2][4][2], const Unit& u, int wr, int wc, int fr, int fq) const {
        const int pn = u.pn, rbase = u.pm * BM + wr * 64 + fr, lc = wc * 64 + fq * 8;
        if (pn < 8) {
            bf16_t* dst = (pn < 4 ? QD : KD) + (pn & 3) * 256 + lc; const float sc = pn < 4 ? QS_D : 1.f;
            const bool rp = fq < 2;
            EPI_LOOP_AM { const int row = rbase + ai * HALF + m * 16; f32x4 t0 = {1.f, 0.f, 1.f, 0.f}, t1 = t0;
                if (rp) { const f32x4* tp = (const f32x4*)(tabD + ((size_t)(row & (SEQ_LEN - 1)) * 8 + 4 * fq) * 2); t0 = tp[0]; t1 = tp[1]; }
                st8(dst + (size_t)row * 1024, rope4(acc[ai][0][m][0], t0) * sc, rope4(acc[ai][0][m][1], t1) * sc);
                st8(dst + (size_t)row * 1024 + 32, acc[ai][1][m][0] * sc, acc[ai][1][m][1] * sc);
                EPI_FENCE(); }
        } else if (pn < 12) {
            bf16_t* dst = VD + (pn - 8) * 256 + lc;
            EPI_LOOP_AM { const int row = rbase + ai * HALF + m * 16;
#pragma unroll
                for (int bj = 0; bj < 2; ++bj) st8(dst + (size_t)row * 1024 + bj * 32, acc[ai][bj][m][0], acc[ai][bj][m][1]); }
        } else if (pn < 20) {
            const int t = (pn - 12) & 3; bf16_t* dst = (pn < 16 ? SA : SB) + t * 256 + lc; const float* bp = bgate + (pn < 16 ? 0 : 1024) + t * 256 + lc;
            f32x4 b[2][2];
#pragma unroll
            for (int bj = 0; bj < 2; ++bj) { b[bj][0] = *(const f32x4*)(bp + bj * 32); b[bj][1] = *(const f32x4*)(bp + bj * 32 + 4); }
            EPI_LOOP_AM { const int row = rbase + ai * HALF + m * 16;
#pragma unroll
                for (int bj = 0; bj < 2; ++bj) st8nt(dst + (size_t)row * 1024 + bj * 32, sigm4(acc[ai][bj][m][0] + b[bj][0]), sigm4(acc[ai][bj][m][1] + b[bj][1])); }
        } else if (pn == 20) {
            EPI_LOOP_AM { const int row = rbase + ai * HALF + m * 16; float s = 0.f;
#pragma unroll
                for (int bj = 0; bj < 2; ++bj) { st8(CKV + (size_t)row * 256 + bj * 32 + lc, acc[ai][bj][m][0], acc[ai][bj][m][1]); s += sq4(acc[ai][bj][m][0]) + sq4(acc[ai][bj][m][1]); }
                s = quad_sum(s); if (fq == 0) SSKV[(size_t)row * 4 + wc] = s; }
        } else if (pn == 21) {
            EPI_LOOP_AM { const int row = rbase + ai * HALF + m * 16; float s = 0.f;
#pragma unroll
                for (int bj = 0; bj < 2; ++bj) { st8(CQ + (size_t)row * 384 + bj * 32 + lc, acc[ai][bj][m][0], acc[ai][bj][m][1]); s += sq4(acc[ai][bj][m][0]) + sq4(acc[ai][bj][m][1]); }
                s = quad_sum(s); if (fq == 0) SSQ[(size_t)row * 8 + wc] = s; }
        } else {
            EPI_LOOP_AM { const int row = rbase + ai * HALF + m * 16; float s = 0.f;
                if (wc < 2) {
#pragma unroll
                    for (int bj = 0; bj < 2; ++bj) { st8(CQ + (size_t)row * 384 + 256 + lc + bj * 32, acc[ai][bj][m][0], acc[ai][bj][m][1]); s += sq4(acc[ai][bj][m][0]) + sq4(acc[ai][bj][m][1]); }
                }
                s = quad_sum(s); if (fq == 0) SSQ[(size_t)row * 8 + 4 + wc] = s;
                if (wc == 2) { const f32x4* tp = (const f32x4*)(tabM + ((size_t)(row & (SEQ_LEN - 1)) * 16 + 4 * fq) * 2);
                    st8(KR + (size_t)row * 32 + fq * 8, rope4(acc[ai][0][m][0], tp[0]), rope4(acc[ai][0][m][1], tp[1])); }
                EPI_FENCE(); }
        }
    }
};
struct EpiQUp {
    static constexpr bool PERM = true, AFTER_DRAIN = false, HAS_MID = false;
    const float* SSQ; const float* tabM; bf16_t* QM;
    __device__ __forceinline__ void operator()(const f32x4 (&acc)[2][2][4][2], const Unit& u, int wr, int wc, int fr, int fq) const {
        const int rbase = u.pm * BM + wr * 64 + fr, c0 = u.pn * BM + wc * 64 + fq * 8;
        const int hl0 = c0 % 96, hl1 = (c0 + 32) % 96;
        EPI_LOOP_AM { const int row = rbase + ai * HALF + m * 16;
            const f32x4 s0 = *(const f32x4*)(SSQ + (size_t)row * 8), s1 = *(const f32x4*)(SSQ + (size_t)row * 8 + 4);
            const float rstd = __builtin_amdgcn_rsqf(((s0[0] + s0[1]) + (s0[2] + s0[3]) + (s1[0] + s1[1]) + (s1[2] + s1[3])) * (1.f / 384.f) + NEPS) * QS_M;
            const float* tb = tabM + (size_t)(row & (SEQ_LEN - 1)) * 32;
#pragma unroll
            for (int bj = 0; bj < 2; ++bj) { const int hl = bj ? hl1 : hl0; const bool rp = hl >= 64; const f32x4 id = {1.f, 0.f, 1.f, 0.f};
                const f32x4* tp = (const f32x4*)(tb + (rp ? hl - 64 : 0)); const f32x4 t0 = rp ? tp[0] : id, t1 = rp ? tp[1] : id;
                st8(QM + (size_t)row * 768 + c0 + bj * 32, rope4(acc[ai][bj][m][0] * rstd, t0), rope4(acc[ai][bj][m][1] * rstd, t1)); EPI_FENCE(); }
            }
    }
};
struct EpiKVUp {
    static constexpr bool PERM = true, AFTER_DRAIN = false, HAS_MID = false;
    const float* SSKV; bf16_t* KVM;
    __device__ __forceinline__ void operator()(const f32x4 (&acc)[2][2][4][2], const Unit& u, int wr, int wc, int fr, int fq) const {
        const int rbase = u.pm * BM + wr * 64 + fr, c0 = u.pn * BM + wc * 64 + fq * 8;
        EPI_LOOP_AM { const int row = rbase + ai * HALF + m * 16;
            const f32x4 s0 = *(const f32x4*)(SSKV + (size_t)row * 4);
            const float rstd = __builtin_amdgcn_rsqf(((s0[0] + s0[1]) + (s0[2] + s0[3])) * (1.f / 256.f) + NEPS);
#pragma unroll
            for (int bj = 0; bj < 2; ++bj) st8(KVM + (size_t)row * 1024 + c0 + bj * 32, acc[ai][bj][m][0] * rstd, acc[ai][bj][m][1] * rstd);
            EPI_FENCE(); }
    }
};
struct EpiMerge {
    static constexpr bool PERM = true, AFTER_DRAIN = false, HAS_MID = true; static constexpr int MID_T = 16;
    const bf16_t* SA; const bf16_t* SB; bf16_t* MG;
    __device__ __forceinline__ void mid(f32x4 (&acc)[2][2][4][2], const Unit& u, int wr, int wc, int fr, int fq) const {
        int rbase = u.pm * BM + wr * 64 + fr; const int c0 = u.pn * BM + wc * 64 + fq * 8;
        asm volatile("" : "+v"(rbase));
#pragma unroll
        for (int ai = 0; ai < 2; ++ai)
#pragma unroll
            for (int m = 0; m < 4; ++m) { u32x4 ga[2], gb[2];
#pragma unroll
                for (int bj = 0; bj < 2; ++bj) { const size_t o = (size_t)(rbase + ai * HALF + m * 16) * 1024 + c0 + bj * 32;
                    ga[bj] = __builtin_nontemporal_load((const u32x4*)(SA + o)); gb[bj] = *(const u32x4*)(SB + o); }
                EPI_FENCE();
#pragma unroll
                for (int bj = 0; bj < 2; ++bj) { f32x4 a0, a1, b0, b1; up8(ga[bj], a0, a1); up8(gb[bj], b0, b1);
#pragma unroll
                    for (int e = 0; e < 4; ++e) { acc[ai][bj][m][0][e] *= a0[e] * __builtin_amdgcn_rcpf(b0[e]); acc[ai][bj][m][1][e] *= a1[e] * __builtin_amdgcn_rcpf(b1[e]); } }
                EPI_FENCE(); }
    }
    __device__ __forceinline__ void operator()(const f32x4 (&acc)[2][2][4][2], const Unit& u, int wr, int wc, int fr, int fq) const {
        const int rbase = u.pm * BM + wr * 64 + fr, c0 = u.pn * BM + wc * 64 + fq * 8;
#pragma unroll
        for (int ai = 0; ai < 2; ++ai) { u32x4 g[4][2];
#pragma unroll
            for (int m = 0; m < 4; ++m)
#pragma unroll
                for (int bj = 0; bj < 2; ++bj) g[m][bj] = __builtin_nontemporal_load((const u32x4*)(SB + (size_t)(rbase + ai * HALF + m * 16) * 1024 + c0 + bj * 32));
            EPI_FENCE();
#pragma unroll
            for (int m = 0; m < 4; ++m)
#pragma unroll
                for (int bj = 0; bj < 2; ++bj) { f32x4 g0, g1; up8(g[m][bj], g0, g1); st8(MG + (size_t)(rbase + ai * HALF + m * 16) * 1024 + c0 + bj * 32, acc[ai][bj][m][0] * g0, acc[ai][bj][m][1] * g1); }
            EPI_FENCE(); }
    }
};
template <bool RES_BF16> struct EpiResid {
    static constexpr bool PERM = true, AFTER_DRAIN = false, HAS_MID = false;
    const void* res; bf16_t* xb; float* SS;
    __device__ __forceinline__ void operator()(const f32x4 (&acc)[2][2][4][2], const Unit& u, int wr, int wc, int fr, int fq) const {
        const int rbase = u.pm * BM + wr * 64 + fr, c0 = u.pn * BM + wc * 64 + fq * 8;
        if constexpr (RES_BF16) {
#pragma unroll
            for (int ai = 0; ai < 2; ++ai) { u32x4 r[4][2];
#pragma unroll
                for (int m = 0; m < 4; ++m)
#pragma unroll
                    for (int bj = 0; bj < 2; ++bj) r[m][bj] = *(const u32x4*)((const bf16_t*)res + (size_t)(rbase + ai * HALF + m * 16) * 1024 + c0 + bj * 32);
                EPI_FENCE();
#pragma unroll
                for (int m = 0; m < 4; ++m) { const int row = rbase + ai * HALF + m * 16; float s = 0.f;
#pragma unroll
                    for (int bj = 0; bj < 2; ++bj) { f32x4 r0, r1; up8(r[m][bj], r0, r1); const f32x4 v0 = r0 + acc[ai][bj][m][0], v1 = r1 + acc[ai][bj][m][1];
                        st8(xb + (size_t)row * 1024 + c0 + bj * 32, v0, v1); s += sq4(v0) + sq4(v1); }
                    s = quad_sum(s); if (fq == 0) SS[(size_t)row * 16 + u.pn * 4 + wc] = s; }
                EPI_FENCE(); }
        } else {
#pragma unroll
            for (int ai = 0; ai < 2; ++ai)
#pragma unroll
                for (int mp = 0; mp < 2; ++mp) { f32x4 r[2][2][2];
#pragma unroll
                    for (int mm = 0; mm < 2; ++mm)
#pragma unroll
                        for (int bj = 0; bj < 2; ++bj) { const float* p = (const float*)res + (size_t)(rbase + ai * HALF + (2 * mp + mm) * 16) * 1024 + c0 + bj * 32; r[mm][bj][0] = __builtin_nontemporal_load((const f32x4*)p); r[mm][bj][1] = __builtin_nontemporal_load((const f32x4*)(p + 4)); }
                    EPI_FENCE();
#pragma unroll
                    for (int mm = 0; mm < 2; ++mm) { const int m = 2 * mp + mm, row = rbase + ai * HALF + m * 16; float s = 0.f;
#pragma unroll
                        for (int bj = 0; bj < 2; ++bj) { const f32x4 v0 = r[mm][bj][0] + acc[ai][bj][m][0], v1 = r[mm][bj][1] + acc[ai][bj][m][1];
                            st8(xb + (size_t)row * 1024 + c0 + bj * 32, v0, v1); s += sq4(v0) + sq4(v1); }
                        s = quad_sum(s); if (fq == 0) SS[(size_t)row * 16 + u.pn * 4 + wc] = s; }
                    EPI_FENCE(); }
        }
    }
};
__device__ __forceinline__ float rstd16(const float* ss) { const f32x4 a = *(const f32x4*)ss, b = *(const f32x4*)(ss + 4), c = *(const f32x4*)(ss + 8), d = *(const f32x4*)(ss + 12);
    const f32x4 t = (a + b) + (c + d); return __builtin_amdgcn_rsqf(((t[0] + t[1]) + (t[2] + t[3])) * (1.f / 1024.f) + NEPS); }
struct EpiSwiGLU {
    static constexpr bool PERM = true, AFTER_DRAIN = false, HAS_MID = false;
    const float* SS; bf16_t* HID;
    __device__ __forceinline__ void operator()(const f32x4 (&acc)[2][2][4][2], const Unit& u, int wr, int wc, int fr, int fq) const {
        const int rbase = u.pm * BM + wr * 64 + fr, c0 = u.pn * HALF + wc * 32 + fq * 8;
        EPI_LOOP_AM { const int row = rbase + ai * HALF + m * 16; const float rstd = rstd16(SS + (size_t)row * 16);
            const f32x4 g0 = acc[ai][0][m][0] * rstd, g1 = acc[ai][0][m][1] * rstd, u0 = acc[ai][1][m][0] * rstd, u1 = acc[ai][1][m][1] * rstd;
            st8(HID + (size_t)row * 2816 + c0, g0 * sigm4(g0) * u0, g1 * sigm4(g1) * u1);
            EPI_FENCE(); }
    }
};
struct EpiPleA {
    static constexpr bool PERM = true, AFTER_DRAIN = false, HAS_MID = false;
    bf16_t* T;
    __device__ __forceinline__ void operator()(const f32x4 (&acc)[2][2][4][2], const Unit& u, int wr, int wc, int fr, int fq) const {
        const int rbase = u.pm * BM + wr * 64 + fr, c0 = u.pn * BM + wc * 64 + fq * 8;
        EPI_LOOP_AM { const int row = rbase + ai * HALF + m * 16;
#pragma unroll
            for (int bj = 0; bj < 2; ++bj) st8(T + (size_t)row * 1024 + c0 + bj * 32, acc[ai][bj][m][0], acc[ai][bj][m][1]); }
    }
};
struct EpiPleB {
    static constexpr bool PERM = true, AFTER_DRAIN = false, HAS_MID = false;
    const float* SS2; const float* bias; const bf16_t* X2; const bf16_t* T2; bf16_t* X3; float* SS3;
    __device__ __forceinline__ void operator()(const f32x4 (&acc)[2][2][4][2], const Unit& u, int wr, int wc, int fr, int fq) const {
        const int rbase = u.pm * BM + wr * 64 + fr, c0 = u.pn * BM + wc * 64 + fq * 8;
#pragma unroll
        for (int ai = 0; ai < 2; ++ai)
#pragma unroll
          for (int mp = 0; mp < 2; ++mp) { u32x4 x[2][2], t[2][2]; float rs[2];
#pragma unroll
            for (int mm = 0; mm < 2; ++mm) { const int row = rbase + ai * HALF + (2 * mp + mm) * 16;
#pragma unroll
                for (int bj = 0; bj < 2; ++bj) { const size_t o = (size_t)row * 1024 + c0 + bj * 32; x[mm][bj] = *(const u32x4*)(X2 + o); t[mm][bj] = *(const u32x4*)(T2 + o); }
                rs[mm] = rstd16(SS2 + (size_t)row * 16); }
            EPI_FENCE();
#pragma unroll
            for (int mm = 0; mm < 2; ++mm) { const int m = 2 * mp + mm, row = rbase + ai * HALF + m * 16; float s = 0.f;
#pragma unroll
                for (int bj = 0; bj < 2; ++bj) { const f32x4 b0 = *(const f32x4*)(bias + c0 + bj * 32), b1 = *(const f32x4*)(bias + c0 + bj * 32 + 4);
                    f32x4 x0, x1, t0, t1; up8(x[mm][bj], x0, x1); up8(t[mm][bj], t0, t1);
                    const f32x4 v0 = x0 + t0 * sigm4(acc[ai][bj][m][0] * rs[mm] + b0), v1 = x1 + t1 * sigm4(acc[ai][bj][m][1] * rs[mm] + b1);
                    st8(X3 + (size_t)row * 1024 + c0 + bj * 32, v0, v1); s += sq4(v0) + sq4(v1); }
                s = quad_sum(s); if (fq == 0) SS3[(size_t)row * 16 + u.pn * 4 + wc] = s; }
            EPI_FENCE(); }
    }
};
template <class Epi, class Sched, bool ALIGN_EPI = false, bool SP2 = false>
__device__ __forceinline__ void gemm_phase(PG8_LAS unsigned char* lds, const Gemm g, const Sched& S, const Epi& E) {
    int tid_ = threadIdx.x; asm volatile("" : "+v"(tid_)); const int tid = tid_, wid = __builtin_amdgcn_readfirstlane(tid >> 6), lane = tid & 63, wr = wid >> 2, wc = wid & 3, fr = lane & 15, fq = lane >> 4;
    const int K = g.K, nt = K / BK;
    unsigned voffA[2], voffB[2];
#pragma unroll
    for (int i = 0; i < 2; ++i) { int R, C; stage_rc(tid * 16 + i * 8192, R, C); const int Rb = Epi::PERM ? (64 * (R >> 5) + perm32(R & 31)) : R;
        voffA[i] = (unsigned)(R * K + C) * 2u; voffB[i] = (unsigned)(Rb * K + C) * 2u; }
    const size_t kstep = (size_t)(BK * 2);
    const size_t hstep = (size_t)HALF * K * 2;
    const size_t hstepB = Epi::PERM ? (size_t)32 * K * 2 : hstep;
    const size_t tstep = 2 * hstep;
    const unsigned ldsw = (unsigned)wid * 1024u;
    const int aoff = lds_byte(wr * 64 + fr, fq * 8), boff = lds_byte(wc * 32 + fr, fq * 8);
#define PG8_SA(b, h) (((b) * 2 + (h)) * HTB)
#define PG8_SB(b, h) ((4 + (b) * 2 + (h)) * HTB)
#define PG8_STAGE(bufoff, gbase, voff) do { _Pragma("unroll") for (int _i = 0; _i < 2; ++_i) \
        __builtin_amdgcn_global_load_lds((const unsigned*)((const char*)(gbase) + (voff)[_i]), (PG8_LAS unsigned*)(lds + (bufoff) + ldsw + _i * 8192), 16, 0, 0); } while (0)
#define PG8_LDA(dst, b, h) do { _Pragma("unroll") for (int m = 0; m < 4; ++m) _Pragma("unroll") for (int k = 0; k < 2; ++k) dst[m][k] = *(const PG8_LAS bf16x8*)(lds + PG8_SA(b, h) + aoff + m * 2048 + k * 1024); } while (0)
#define PG8_LDB(dst, b, h) do { _Pragma("unroll") for (int n = 0; n < 2; ++n) _Pragma("unroll") for (int k = 0; k < 2; ++k) dst[n][k] = *(const PG8_LAS bf16x8*)(lds + PG8_SB(b, h) + boff + n * 2048 + k * 1024); } while (0)
#define PG8_MMA(ai, bj, At, Bt) do { __builtin_amdgcn_s_setprio(1); _Pragma("unroll") for (int m = 0; m < 4; ++m) _Pragma("unroll") for (int n = 0; n < 2; ++n) _Pragma("unroll") for (int k = 0; k < 2; ++k) \
        acc[ai][bj][m][n] = __builtin_amdgcn_mfma_f32_16x16x32_bf16(Bt[n][k], At[m][k], acc[ai][bj][m][n], 0, 0, 0); __builtin_amdgcn_s_setprio(0); } while (0)
#define PG8_WAIT_V(n) asm volatile("s_waitcnt vmcnt(" #n ")" ::: "memory")
#define PG8_WAIT_L(n) asm volatile("s_waitcnt lgkmcnt(" #n ")" ::: "memory")
#define PG8_BAR __builtin_amdgcn_s_barrier()
#define PG8_SCHED __builtin_amdgcn_sched_barrier(0)
    Unit cur, nxt; int ui = 0;
    if (!S.next(0, cur)) return;
    f32x4 acc[2][2][4][2];
#pragma unroll
    for (int a = 0; a < 2; ++a)
#pragma unroll
        for (int b = 0; b < 2; ++b)
#pragma unroll
            for (int m = 0; m < 4; ++m)
#pragma unroll
                for (int n = 0; n < 2; ++n) acc[a][b][m][n] = (f32x4){0.f, 0.f, 0.f, 0.f};
    bf16x8 At[4][2], B0[2][2], B1[2][2];
    const char* cA = (const char*)g.A + (size_t)cur.pm * tstep; const char* cB = (const char*)g.Bt + (size_t)cur.pn * tstep;
    S.a_ready(cur);
    if constexpr (SP2) {
        PG8_STAGE(PG8_SB(0, 0), cB, voffB); PG8_STAGE(PG8_SB(0, 1), cB + hstepB, voffB); PG8_STAGE(PG8_SA(0, 0), cA, voffA); PG8_STAGE(PG8_SA(0, 1), cA + hstep, voffA);
        if (wr == 1) PG8_BAR;
        PG8_WAIT_V(2); PG8_BAR;
        PG8_STAGE(PG8_SB(1, 0), cB + kstep, voffB); PG8_STAGE(PG8_SA(1, 0), cA + kstep, voffA); PG8_STAGE(PG8_SB(1, 1), cB + hstepB + kstep, voffB);
        PG8_WAIT_V(6); PG8_BAR;
    } else {
        PG8_STAGE(PG8_SB(0, 0), cB, voffB); PG8_STAGE(PG8_SA(0, 0), cA, voffA); PG8_STAGE(PG8_SB(0, 1), cB + hstepB, voffB); PG8_STAGE(PG8_SA(0, 1), cA + hstep, voffA);
        if (wr == 1) PG8_BAR;
        PG8_WAIT_V(4); PG8_BAR;
        PG8_STAGE(PG8_SB(1, 0), cB + kstep, voffB); PG8_STAGE(PG8_SA(1, 0), cA + kstep, voffA); PG8_STAGE(PG8_SB(1, 1), cB + hstepB + kstep, voffB);
        PG8_WAIT_V(6); PG8_BAR;
    }
    for (;;) {
        const bool has_next = S.next(ui + 1, nxt);
        const char* nA = has_next ? (const char*)g.A + (size_t)nxt.pm * tstep : cA; const char* nB = has_next ? (const char*)g.Bt + (size_t)nxt.pn * tstep : cB;
        for (int t = 0; t < nt; t += 2) {
            if constexpr (Epi::HAS_MID) { if (t == Epi::MID_T) { __builtin_amdgcn_sched_barrier(0); E.mid(acc, cur, wr, wc, fr, fq); __builtin_amdgcn_sched_barrier(0); } }
            const bool last = (t == nt - 2);
            const char* a1 = cA + (size_t)(t + 1) * kstep;
            const char* a2 = last ? nA : cA + (size_t)(t + 2) * kstep; const char* b2 = last ? nB : cB + (size_t)(t + 2) * kstep;
            const char* a3 = a2 + kstep; const char* b3 = b2 + kstep;
            if (last && has_next) S.a_ready(nxt);
            if constexpr (SP2) {
            PG8_LDB(B0, 0, 0); PG8_LDB(B1, 0, 1); PG8_SCHED; PG8_LDA(At, 0, 0); PG8_STAGE(PG8_SA(1, 1), a1 + hstep, voffA);
            PG8_WAIT_V(8); PG8_WAIT_L(0); PG8_BAR; PG8_MMA(0, 0, At, B0); PG8_MMA(0, 1, At, B1); PG8_BAR; PG8_SCHED;
            PG8_LDA(At, 0, 1); PG8_STAGE(PG8_SB(0, 0), b2, voffB); PG8_STAGE(PG8_SB(0, 1), b2 + hstepB, voffB); PG8_STAGE(PG8_SA(0, 0), a2, voffA);
            PG8_WAIT_V(8); PG8_WAIT_L(0); PG8_BAR; PG8_MMA(1, 0, At, B0); PG8_MMA(1, 1, At, B1); PG8_BAR; PG8_SCHED;
            PG8_LDB(B0, 1, 0); PG8_LDB(B1, 1, 1); PG8_SCHED; PG8_LDA(At, 1, 0); PG8_STAGE(PG8_SA(0, 1), a2 + hstep, voffA);
            PG8_WAIT_V(8); PG8_WAIT_L(0); PG8_BAR; PG8_MMA(0, 0, At, B0); PG8_MMA(0, 1, At, B1); PG8_BAR; PG8_SCHED;
            PG8_LDA(At, 1, 1); PG8_STAGE(PG8_SB(1, 0), b3, voffB); PG8_STAGE(PG8_SB(1, 1), b3 + hstepB, voffB); PG8_STAGE(PG8_SA(1, 0), a3, voffA);
            PG8_WAIT_V(8); PG8_WAIT_L(0); PG8_BAR; PG8_MMA(1, 0, At, B0); PG8_MMA(1, 1, At, B1); PG8_BAR; PG8_SCHED;
            } else {
            PG8_LDB(B0, 0, 0); PG8_SCHED; PG8_LDA(At, 0, 0); PG8_STAGE(PG8_SA(1, 1), a1 + hstep, voffA);
            PG8_WAIT_L(8); PG8_BAR; PG8_WAIT_L(0); PG8_MMA(0, 0, At, B0); PG8_BAR; PG8_SCHED;
            PG8_LDB(B1, 0, 1); PG8_STAGE(PG8_SB(0, 0), b2, voffB);
            PG8_BAR; PG8_WAIT_L(0); PG8_MMA(0, 1, At, B1); PG8_BAR;
            PG8_LDA(At, 0, 1); PG8_STAGE(PG8_SA(0, 0), a2, voffA);
            PG8_BAR; PG8_WAIT_L(0); PG8_MMA(1, 0, At, B0); PG8_BAR; PG8_SCHED;
            PG8_STAGE(PG8_SB(0, 1), b2 + hstepB, voffB);
            PG8_WAIT_V(6); PG8_BAR; PG8_MMA(1, 1, At, B1); PG8_BAR;
            PG8_LDB(B0, 1, 0); PG8_SCHED; PG8_LDA(At, 1, 0); PG8_STAGE(PG8_SA(0, 1), a2 + hstep, voffA);
            PG8_WAIT_L(8); PG8_BAR; PG8_WAIT_L(0); PG8_MMA(0, 0, At, B0); PG8_BAR; PG8_SCHED;
            PG8_LDB(B1, 1, 1); PG8_STAGE(PG8_SB(1, 0), b3, voffB);
            PG8_BAR; PG8_WAIT_L(0); PG8_MMA(0, 1, At, B1); PG8_BAR;
            PG8_LDA(At, 1, 1); PG8_STAGE(PG8_SA(1, 0), a3, voffA);
            PG8_BAR; PG8_WAIT_L(0); PG8_MMA(1, 0, At, B0); PG8_BAR; PG8_SCHED;
            PG8_STAGE(PG8_SB(1, 1), b3 + hstepB, voffB);
            PG8_WAIT_V(6); PG8_BAR; PG8_MMA(1, 1, At, B1); PG8_BAR;
            }
        }
        if constexpr (ALIGN_EPI) { if (wr == 0) PG8_BAR; }
        if constexpr (!Epi::AFTER_DRAIN) { E(acc, cur, wr, wc, fr, fq); S.done(cur); }
        if (!has_next) break;
#pragma unroll
        for (int a = 0; a < 2; ++a)
#pragma unroll
            for (int b = 0; b < 2; ++b)
#pragma unroll
                for (int m = 0; m < 4; ++m)
#pragma unroll
                    for (int n = 0; n < 2; ++n) acc[a][b][m][n] = (f32x4){0.f, 0.f, 0.f, 0.f};
        cur = nxt; cA = nA; cB = nB; ++ui;
        if constexpr (ALIGN_EPI) { if (wr == 1) PG8_BAR; }
    }
    PG8_WAIT_V(0);
    if constexpr (!ALIGN_EPI) { if (wr == 0) PG8_BAR; }
    PG8_BAR;
    if constexpr (Epi::AFTER_DRAIN) { E.fused(acc, cur, wr, wc, fr, fq, lds, wid, lane); S.done(cur); }
#undef PG8_SA
#undef PG8_SB
#undef PG8_STAGE
#undef PG8_LDA
#undef PG8_LDB
#undef PG8_MMA
#undef PG8_WAIT_V
#undef PG8_WAIT_L
#undef PG8_BAR
#undef PG8_SCHED
}
}
namespace att {
#define ATT_LAS __attribute__((address_space(3)))
typedef unsigned short bf16_t;
typedef short bf16x8 __attribute__((ext_vector_type(8)));
typedef short s16x4 __attribute__((ext_vector_type(4)));
typedef float f32x16 __attribute__((ext_vector_type(16)));
typedef float f32x4 __attribute__((ext_vector_type(4)));
typedef unsigned u32x4 __attribute__((ext_vector_type(4)));
typedef unsigned u32x2 __attribute__((ext_vector_type(2)));
constexpr int KB0 = 0, KBSZ = 12288, VB0 = 24576, VBSZ = 16384;
__device__ __forceinline__ float swap_max(float m) { auto rr = __builtin_amdgcn_permlane32_swap(__float_as_uint(m), __float_as_uint(m), false, false); return fmaxf(__uint_as_float(rr[0]), __uint_as_float(rr[1])); }
__device__ __forceinline__ float swap_sum(float m) { auto rr = __builtin_amdgcn_permlane32_swap(__float_as_uint(m), __float_as_uint(m), false, false); return __uint_as_float(rr[0]) + __uint_as_float(rr[1]); }
__device__ __forceinline__ s16x4 vtr(const ATT_LAS char* p) { return __builtin_bit_cast(s16x4, __builtin_amdgcn_ds_read_tr16_b64_v4i16((ATT_LAS s16x4*)p)); }
__device__ __forceinline__ float max3f(float a, float b, float c) { float r; asm("v_max3_f32 %0, %1, %2, %3" : "=v"(r) : "v"(a), "v"(b), "v"(c)); return r; }
__device__ __forceinline__ int crow(int r, int hi) { return (r & 3) + 8 * (r >> 2) + 4 * hi; }

template <int DQK, int DV, bool MLA>
__device__ __forceinline__ void attn_pass(ATT_LAS char* lds, const bf16_t* qp, const bf16_t* kg, const bf16_t* krg, const bf16_t* vg, int NT, int myNT, f32x16 (&o)[DV / 32], float& linv) {
    int tid_ = threadIdx.x; asm volatile("" : "+v"(tid_)); const int tid = tid_, lane = tid & 63, wid = __builtin_amdgcn_readfirstlane(tid >> 6), r32 = lane & 31, hi = lane >> 5;
    bf16x8 qr[DQK / 16];
#pragma unroll
    for (int d0 = 0; d0 < DQK / 16; ++d0) qr[d0] = *(const bf16x8*)(qp + d0 * 16);
    const bf16_t* ksrc = kg + (size_t)lane * 1024 + wid * 8;
    const bf16_t* krsrc = krg + (size_t)lane * 32 + (wid & 3) * 8;
    const bf16_t* vsrc = vg + (size_t)(16 * (wid & 3) + (lane >> 2)) * 1024 + (wid >> 2) * 32 + (lane & 3) * 8;
    const int sto = wid * 1024 + lane * 16;
    u32x4 kr0 = {0u, 0u, 0u, 0u}, kr1 = kr0, vr0 = kr0, vr1 = kr0;
#define ATT_LOAD(t) do { kr0 = *(const u32x4*)(ksrc + (size_t)(t) * 65536); if (MLA) { if (wid < 4) kr1 = *(const u32x4*)(krsrc + (size_t)(t) * 2048); } \
        vr0 = *(const u32x4*)(vsrc + (size_t)(t) * 65536); if (DV == 128) vr1 = *(const u32x4*)(vsrc + (size_t)(t) * 65536 + 64); } while (0)
#define ATT_STORE(b) do { *(ATT_LAS u32x4*)(lds + KB0 + (b) * KBSZ + sto) = kr0; if (MLA) { if (wid < 4) *(ATT_LAS u32x4*)(lds + KB0 + (b) * KBSZ + 8192 + sto) = kr1; } \
        *(ATT_LAS u32x4*)(lds + VB0 + (b) * VBSZ + sto) = vr0; if (DV == 128) *(ATT_LAS u32x4*)(lds + VB0 + (b) * VBSZ + 8192 + sto) = vr1; } while (0)
#pragma unroll
    for (int i = 0; i < DV / 32; ++i)
#pragma unroll
        for (int r = 0; r < 16; ++r) o[i][r] = 0.f;
    float mref = 0.f, lsum = 0.f;
    ATT_LOAD(0); ATT_STORE(0); __syncthreads();
    for (int t = 0; t < NT; ++t) {
        const int b = t & 1;
        if (t + 1 < NT) ATT_LOAD(t + 1);
        if (t < myNT) {
            const ATT_LAS char* kp = lds + KB0 + b * KBSZ + hi * 1024 + r32 * 16;
            f32x16 p0, p1;
#pragma unroll
            for (int r = 0; r < 16; ++r) { p0[r] = -mref; p1[r] = -mref; }
#pragma unroll
            for (int d0 = 0; d0 < DQK / 16; ++d0) {
                const bf16x8 k0 = *(const ATT_LAS bf16x8*)(kp + d0 * 2048), k1 = *(const ATT_LAS bf16x8*)(kp + d0 * 2048 + 512);
                p0 = __builtin_amdgcn_mfma_f32_32x32x16_bf16(k0, qr[d0], p0, 0, 0, 0);
                p1 = __builtin_amdgcn_mfma_f32_32x32x16_bf16(k1, qr[d0], p1, 0, 0, 0);
            }
            asm volatile("s_nop 15\n\ts_nop 7" : "+v"(p0), "+v"(p1));
            float mxa = max3f(p0[0], p0[1], p1[0]), mxb = max3f(p0[2], p0[3], p1[1]); mxa = max3f(mxa, p1[2], p1[3]);
#pragma unroll
            for (int r = 4; r < 16; r += 4) { mxa = max3f(mxa, p0[r], p0[r + 1]); mxb = max3f(mxb, p0[r + 2], p0[r + 3]); mxa = max3f(mxa, p1[r], p1[r + 1]); mxb = max3f(mxb, p1[r + 2], p1[r + 3]); }
            float mx = swap_max(max3f(mxa, mxb, mxb));
            if (__any(mx > 8.f)) {
                const float dl = fmaxf(mx, 0.f), al = __builtin_amdgcn_exp2f(-dl);
                lsum *= al;
#pragma unroll
                for (int i = 0; i < DV / 32; ++i)
#pragma unroll
                    for (int r = 0; r < 16; ++r) o[i][r] *= al;
#pragma unroll
                for (int r = 0; r < 16; ++r) { p0[r] -= dl; p1[r] -= dl; }
                mref += dl;
            }
            float ls = 0.f;
#pragma unroll
            for (int r = 0; r < 16; ++r) { p0[r] = __builtin_amdgcn_exp2f(p0[r]); p1[r] = __builtin_amdgcn_exp2f(p1[r]); ls += p0[r] + p1[r]; }
            lsum += ls;
            u32x4 pw[4];
#pragma unroll
            for (int j = 0; j < 4; ++j) { pw[0][j] = pg8::pk2(p0[2 * j], p0[2 * j + 1]); pw[1][j] = pg8::pk2(p0[8 + 2 * j], p0[9 + 2 * j]); pw[2][j] = pg8::pk2(p1[2 * j], p1[2 * j + 1]); pw[3][j] = pg8::pk2(p1[8 + 2 * j], p1[9 + 2 * j]); }
            const ATT_LAS char* vp = lds + VB0 + b * VBSZ + ((lane >> 4) & 1) * 32 + (lane & 3) * 8 + (4 * hi + ((lane & 15) >> 2)) * 64;
#pragma unroll
            for (int i = 0; i < DV / 32; ++i)
#pragma unroll
                for (int ks = 0; ks < 4; ++ks) {
                    const s16x4 lo = vtr(vp + i * 4096 + ks * 1024), hh = vtr(vp + i * 4096 + ks * 1024 + 512);
                    const bf16x8 vf = {lo[0], lo[1], lo[2], lo[3], hh[0], hh[1], hh[2], hh[3]};
                    o[i] = __builtin_amdgcn_mfma_f32_32x32x16_bf16(vf, __builtin_bit_cast(bf16x8, pw[ks]), o[i], 0, 0, 0);
                }
        }
        if (t + 1 < NT) ATT_STORE(b ^ 1);
        __syncthreads();
    }
    linv = __builtin_amdgcn_rcpf(swap_sum(lsum));
#undef ATT_LOAD
#undef ATT_STORE
}

__device__ __forceinline__ void qk_softmax64(const ATT_LAS char* kbuf, const ATT_LAS char* qimg, float& mref, float& lsum, f32x16 (&o)[4], u32x4 (&pw)[4], int r32, int hi) {
    const ATT_LAS char* kp = kbuf + hi * 1024 + r32 * 16;
    f32x16 p0, p1;
#pragma unroll
    for (int r = 0; r < 16; ++r) { p0[r] = -mref; p1[r] = -mref; }
#pragma unroll
    for (int d0 = 0; d0 < 4; ++d0) {
        const bf16x8 k0 = *(const ATT_LAS bf16x8*)(kp + d0 * 2048), k1 = *(const ATT_LAS bf16x8*)(kp + d0 * 2048 + 512), q = *(const ATT_LAS bf16x8*)(qimg + d0 * 1024);
        p0 = __builtin_amdgcn_mfma_f32_32x32x16_bf16(k0, q, p0, 0, 0, 0);
        p1 = __builtin_amdgcn_mfma_f32_32x32x16_bf16(k1, q, p1, 0, 0, 0);
    }
    asm volatile("s_nop 15\n\ts_nop 7" : "+v"(p0), "+v"(p1));
    float mxa = max3f(p0[0], p0[1], p1[0]), mxb = max3f(p0[2], p0[3], p1[1]); mxa = max3f(mxa, p1[2], p1[3]);
#pragma unroll
    for (int r = 4; r < 16; r += 4) { mxa = max3f(mxa, p0[r], p0[r + 1]); mxb = max3f(mxb, p0[r + 2], p0[r + 3]); mxa = max3f(mxa, p1[r], p1[r + 1]); mxb = max3f(mxb, p1[r + 2], p1[r + 3]); }
    const float mx = swap_max(max3f(mxa, mxb, mxb));
    if (__any(mx > 8.f)) {
        const float dl = fmaxf(mx, 0.f), al = __builtin_amdgcn_exp2f(-dl);
        lsum *= al;
#pragma unroll
        for (int i = 0; i < 4; ++i)
#pragma unroll
            for (int r = 0; r < 16; ++r) o[i][r] *= al;
#pragma unroll
        for (int r = 0; r < 16; ++r) { p0[r] -= dl; p1[r] -= dl; }
        mref += dl;
    }
    float ls = 0.f;
#pragma unroll
    for (int r = 0; r < 16; ++r) { p0[r] = __builtin_amdgcn_exp2f(p0[r]); p1[r] = __builtin_amdgcn_exp2f(p1[r]); ls += p0[r] + p1[r]; }
    lsum += ls;
#pragma unroll
    for (int j = 0; j < 4; ++j) { pw[0][j] = pg8::pk2(p0[2 * j], p0[2 * j + 1]); pw[1][j] = pg8::pk2(p0[8 + 2 * j], p0[9 + 2 * j]); pw[2][j] = pg8::pk2(p1[2 * j], p1[2 * j + 1]); pw[3][j] = pg8::pk2(p1[8 + 2 * j], p1[9 + 2 * j]); }
}
__device__ __forceinline__ void diff_unit(ATT_LAS char* lds, int b, int h, int qb, const bf16_t* QD, const bf16_t* KD, const bf16_t* VD, bf16_t* OD, const float* subln, float lam) {
    int tid_ = threadIdx.x; asm volatile("" : "+v"(tid_)); const int tid = tid_, lane = tid & 63, wid = __builtin_amdgcn_readfirstlane(tid >> 6), r32 = lane & 31, hi = lane >> 5;
    const size_t row0 = (size_t)b * SEQ_LEN, qrow = row0 + qb * 256 + wid * 32 + r32;
    const int NT = 4 * qb + 4, myNT = 4 * qb + (wid >> 1) + 1;
    constexpr int DKB0 = 0, DKBSZ = 16384, DVB0 = 32768, DVBSZ = 16384;
    ATT_LAS char* qimg = lds + 65536 + wid * 8192 + hi * 512 + r32 * 16;
    { const bf16_t* qp = QD + qrow * 1024 + (2 * h) * 64 + hi * 8;
#pragma unroll
      for (int d0 = 0; d0 < 4; ++d0) { *(ATT_LAS bf16x8*)(qimg + d0 * 1024) = *(const bf16x8*)(qp + d0 * 16); *(ATT_LAS bf16x8*)(qimg + 4096 + d0 * 1024) = *(const bf16x8*)(qp + 64 + d0 * 16); } }
    const bf16_t* ksrc = KD + row0 * 1024 + (2 * h) * 64 + (size_t)lane * 1024 + wid * 8;
    const bf16_t* vsrc = VD + row0 * 1024 + h * 128 + (size_t)(16 * (wid & 3) + (lane >> 2)) * 1024 + (wid >> 2) * 32 + (lane & 3) * 8;
    const int sto = wid * 1024 + lane * 16;
    const int vlane = ((lane >> 4) & 1) * 32 + (lane & 3) * 8 + (4 * hi + ((lane & 15) >> 2)) * 64;
    u32x4 ka, kb, va, vb;
#define DF_LOAD(t) do { ka = *(const u32x4*)(ksrc + (size_t)(t) * 65536); kb = *(const u32x4*)(ksrc + (size_t)(t) * 65536 + 64); va = *(const u32x4*)(vsrc + (size_t)(t) * 65536); vb = *(const u32x4*)(vsrc + (size_t)(t) * 65536 + 64); } while (0)
#define DF_STORE(bf) do { *(ATT_LAS u32x4*)(lds + DKB0 + (bf) * DKBSZ + sto) = ka; *(ATT_LAS u32x4*)(lds + DKB0 + (bf) * DKBSZ + 8192 + sto) = kb; \
        *(ATT_LAS u32x4*)(lds + DVB0 + (bf) * DVBSZ + sto) = va; *(ATT_LAS u32x4*)(lds + DVB0 + (bf) * DVBSZ + 8192 + sto) = vb; } while (0)
    f32x16 o1[4], o2[4];
#pragma unroll
    for (int i = 0; i < 4; ++i)
#pragma unroll
        for (int r = 0; r < 16; ++r) { o1[i][r] = 0.f; o2[i][r] = 0.f; }
    float m1 = 0.f, l1 = 0.f, m2 = 0.f, l2 = 0.f;
    DF_LOAD(0); DF_STORE(0); __syncthreads();
    for (int t = 0; t < NT; ++t) {
        const int bf = t & 1;
        if (t + 1 < NT) DF_LOAD(t + 1);
        if (t < myNT) {
            u32x4 pwa[4], pwb[4];
            qk_softmax64(lds + DKB0 + bf * DKBSZ, qimg, m1, l1, o1, pwa, r32, hi);
            qk_softmax64(lds + DKB0 + bf * DKBSZ + 8192, qimg + 4096, m2, l2, o2, pwb, r32, hi);
            const ATT_LAS char* vp = lds + DVB0 + bf * DVBSZ + vlane;
#pragma unroll
            for (int i = 0; i < 4; ++i)
#pragma unroll
                for (int ks = 0; ks < 4; ++ks) {
                    const s16x4 lo = vtr(vp + i * 4096 + ks * 1024), hh = vtr(vp + i * 4096 + ks * 1024 + 512);
                    const bf16x8 vf = {lo[0], lo[1], lo[2], lo[3], hh[0], hh[1], hh[2], hh[3]};
                    o1[i] = __builtin_amdgcn_mfma_f32_32x32x16_bf16(vf, __builtin_bit_cast(bf16x8, pwa[ks]), o1[i], 0, 0, 0);
                    o2[i] = __builtin_amdgcn_mfma_f32_32x32x16_bf16(vf, __builtin_bit_cast(bf16x8, pwb[ks]), o2[i], 0, 0, 0);
                }
        }
        if (t + 1 < NT) DF_STORE(bf ^ 1);
        __syncthreads();
    }
#undef DF_LOAD
#undef DF_STORE
    const float li1 = __builtin_amdgcn_rcpf(swap_sum(l1)), c2 = lam * __builtin_amdgcn_rcpf(swap_sum(l2)); float ss = 0.f;
#pragma unroll
    for (int i = 0; i < 4; ++i)
#pragma unroll
        for (int r = 0; r < 16; ++r) { const float v = o1[i][r] * li1 - o2[i][r] * c2; o1[i][r] = v; ss += v * v; }
    ss = swap_sum(ss);
    const float rstd = __builtin_amdgcn_rsqf(ss * (1.f / 128.f) + NEPS) * 0.8f;
    bf16_t* op = OD + qrow * 1536 + h * 128 + 4 * hi;
#pragma unroll
    for (int i = 0; i < 4; ++i)
#pragma unroll
        for (int rq = 0; rq < 4; ++rq) { const int dv = 32 * i + 8 * rq; const f32x4 g = *(const f32x4*)(subln + dv + 4 * hi);
            u32x2 w; w.x = pg8::pk2(o1[i][4 * rq] * rstd * g[0], o1[i][4 * rq + 1] * rstd * g[1]); w.y = pg8::pk2(o1[i][4 * rq + 2] * rstd * g[2], o1[i][4 * rq + 3] * rstd * g[3]);
            *(u32x2*)(op + dv) = w; }
}
__device__ __forceinline__ void mla_unit(ATT_LAS char* lds, int b, int h, int qb, const bf16_t* QM, const bf16_t* KVM, const bf16_t* KR, bf16_t* OM) {
    int tid_ = threadIdx.x; asm volatile("" : "+v"(tid_)); const int tid = tid_, lane = tid & 63, wid = __builtin_amdgcn_readfirstlane(tid >> 6), r32 = lane & 31, hi = lane >> 5;
    const size_t row0 = (size_t)b * SEQ_LEN, qrow = row0 + qb * 256 + wid * 32 + r32;
    const int NT = 4 * qb + 4, myNT = 4 * qb + (wid >> 1) + 1;
    f32x16 o[2]; float li;
    attn_pass<96, 64, true>(lds, QM + qrow * 768 + h * 96 + hi * 8, KVM + row0 * 1024 + h * 128, KR + row0 * 32, KVM + row0 * 1024 + h * 128 + 64, NT, myNT, o, li);
    bf16_t* op = OM + qrow * 1536 + 1024 + h * 64 + 4 * hi;
#pragma unroll
    for (int i = 0; i < 2; ++i)
#pragma unroll
        for (int rq = 0; rq < 4; ++rq) { const int dv = 32 * i + 8 * rq;
            u32x2 w; w.x = pg8::pk2(o[i][4 * rq] * li, o[i][4 * rq + 1] * li); w.y = pg8::pk2(o[i][4 * rq + 2] * li, o[i][4 * rq + 3] * li);
            *(u32x2*)(op + dv) = w; }
}
}
#define LAS __attribute__((address_space(3)))
typedef unsigned short bf16;
typedef float f32x4 __attribute__((ext_vector_type(4)));
typedef unsigned v4u __attribute__((ext_vector_type(4)));
typedef unsigned v2u __attribute__((ext_vector_type(2)));
constexpr int NWAVES = 8, LDS_BYTES = 147456;
constexpr size_t MiB = 1ull << 20;
constexpr size_t WS_TABD = 0, WS_TABM = 128 * 1024, WS_LAM = 384 * 1024, WS_BAR = 512 * 1024;
constexpr size_t WS_SSQ = 1 * MiB, WS_SSKV = 2 * MiB, WS_SS1 = 3 * MiB, WS_SS2 = 5 * MiB, WS_SS3 = 7 * MiB;
constexpr size_t WS_WIN = 10 * MiB, WS_WGU = WS_WIN + 5888ull * 1024 * 2, WS_WDN = WS_WGU + 5632ull * 1024 * 2, WS_WOD = WS_WDN + 1024ull * 2816 * 2, WS_WOUT = WS_WOD + 2 * MiB,
                 WS_WPG = WS_WOUT + 2 * MiB, WS_WOM = WS_WPG + 2 * MiB, WS_WUQ = WS_WOM + 1 * MiB, WS_WUKV = WS_WUQ + 768ull * 384 * 2, WS_WPLE = WS_WUKV + 1024ull * 256 * 2, WS_WEND = WS_WPLE + 1024ull * 256 * 2;
static_assert(WS_WEND <= 47 * MiB, "weights");
constexpr size_t WS_PB = 47 * MiB;
constexpr size_t WS_XN = 64 * MiB, WS_QM = 64 * MiB, WS_X1B = 64 * MiB;
constexpr size_t WS_QD = 128 * MiB, WS_KD = 192 * MiB, WS_VD = 256 * MiB, WS_KVM = 320 * MiB;
constexpr size_t WS_T = 192 * MiB, WS_MG = 320 * MiB;
constexpr size_t WS_HID = 128 * MiB, WS_X2B = 304 * MiB;
constexpr size_t WS_X3B = 384 * MiB, WS_T2B = 448 * MiB;
constexpr size_t WS_CKV = 384 * MiB, WS_CQ = 400 * MiB, WS_ODM = 384 * MiB, WS_KR = 480 * MiB, WS_WCAT = 482 * MiB;
constexpr size_t WS_END = 512 * MiB;

#define XB_TMO      128
#define XB_XCNT(j)  (256  + 64 * (j))
#define XB_XSUB(j)  (1280 + 64 * (j))
#define XB_XGEN(j)  (2304 + 64 * (j))
#define XB_TOP      3328
#define XB_TOPGEN   3392
#define XCD_BAR_WORDS 3456
#define XB_SPIN_CAP (1u << 18)

__device__ __forceinline__ unsigned xb_ld(unsigned* p)              { return __hip_atomic_load(p, __ATOMIC_RELAXED, __HIP_MEMORY_SCOPE_AGENT); }
__device__ __forceinline__ unsigned xb_add(unsigned* p, unsigned v) { return __hip_atomic_fetch_add(p, v, __ATOMIC_RELAXED, __HIP_MEMORY_SCOPE_AGENT); }
__device__ __forceinline__ unsigned xb_xcc_id() { return (unsigned)__builtin_amdgcn_s_getreg((3 << 11) | 20) & 0xFu; }
#define XB_SPIN(cond, bar) do { unsigned _sp = 0; while (cond) { __builtin_amdgcn_s_sleep(1); \
    if ((++_sp & 255u) == 0u) { if (xb_ld(&(bar)[XB_TMO])) break; if (_sp > XB_SPIN_CAP) { atomicAdd(&(bar)[XB_TMO], 1u); break; } } } } while (0)

struct XcdBarrier {
    unsigned* bar; unsigned x;
    volatile LAS unsigned* st;
};

__device__ __forceinline__ XcdBarrier xcd_barrier_post(unsigned* bar, volatile LAS unsigned* st) {
    XcdBarrier b; b.bar = bar; b.x = xb_xcc_id(); b.st = st;
    if (threadIdx.x == 0) (void)xb_add(&bar[XB_XCNT(b.x)], 1u);
    return b;
}
__device__ __forceinline__ void xcd_barrier_complete(unsigned* bar, unsigned x, unsigned& nloc, unsigned& nx) {
    const unsigned G = gridDim.x * gridDim.y * gridDim.z;
    unsigned sum, cnt, mine, sp = 0u;
    for (;;) {
        sum = 0u; cnt = 0u; mine = 0u;
#pragma unroll
        for (unsigned j = 0; j < 16; ++j) { const unsigned c = xb_ld(&bar[XB_XCNT(j)]); sum += c; cnt += (c > 0u) ? 1u : 0u; mine = (j == x) ? c : mine; }
        if (sum == G) break;
        __builtin_amdgcn_s_sleep(1);
        if ((++sp & 255u) == 0u) { if (xb_ld(&bar[XB_TMO])) break; if (sp > XB_SPIN_CAP) { atomicAdd(&bar[XB_TMO], 1u); break; } }
    }
    nloc = mine > 0u ? mine : 1u; nx = cnt > 0u ? cnt : 1u;
}

__device__ __forceinline__ void xcd_barrier(const XcdBarrier& b) {
    asm volatile("s_waitcnt vmcnt(0)" ::: "memory");
    __syncthreads();
    if (threadIdx.x == 0) {
        unsigned* bar = b.bar;
        __builtin_amdgcn_s_waitcnt(0);
        unsigned nloc = b.st[0], nx = b.st[1];
        if (nloc == 0u) { xcd_barrier_complete(bar, b.x, nloc, nx); b.st[0] = nloc; b.st[1] = nx; }
        const unsigned old = xb_add(&bar[XB_XSUB(b.x)], 1u);
        const unsigned gen = old / nloc;
        if (old + 1u == (gen + 1u) * nloc) {
            __builtin_amdgcn_fence(__ATOMIC_RELEASE, "agent");
            asm volatile("s_waitcnt vmcnt(0)" ::: "memory");
            const unsigned og = xb_add(&bar[XB_TOP], 1u);
            const unsigned tg = og / nx;
            if (og + 1u == (tg + 1u) * nx) xb_add(&bar[XB_TOPGEN], 1u);
            else XB_SPIN(xb_ld(&bar[XB_TOPGEN]) == tg, bar);
            __builtin_amdgcn_fence(__ATOMIC_ACQUIRE, "agent");
            xb_add(&bar[XB_XGEN(b.x)], 1u);
            asm volatile("s_waitcnt vmcnt(0)" ::: "memory");
        } else {
            XB_SPIN(xb_ld(&bar[XB_XGEN(b.x)]) == gen, bar);
            __builtin_amdgcn_fence(__ATOMIC_ACQUIRE, "agent");
            asm volatile("s_waitcnt vmcnt(0)" ::: "memory");
        }
    }
    __syncthreads();
}

struct Args {
    const float *x, *p, *attn_norm, *w_in, *b_gate, *lam_q1, *lam_k1, *lam_q2, *lam_k2, *diff_subln, *w_o_diff, *q_norm, *w_uq, *kv_norm, *w_ukv, *w_o_mla, *w_out, *ffn_norm,
        *w_ffn_gate, *w_ffn_up, *w_ffn_down, *ple_norm, *w_ple_gate, *b_ple_gate, *w_ple, *final_norm;
    float* out; unsigned char* ws;
};

__device__ __forceinline__ float wave_sum(float v) {
#pragma unroll
    for (int o = 1; o < 64; o <<= 1) v += __shfl_xor(v, o);
    return v;
}
__device__ __forceinline__ void wprep_item(int kind, const float* W, const float* W2, int ld, int K, int Nout, const float* gain, bf16* WT, int item, LAS float* scr, int lane) {
    const int nnb = Nout / 32, kb = item / nnb, nb = item % nnb, k0 = kb * 64, n0 = nb * 32, nl = lane & 31, ks = lane >> 5, n = n0 + nl;
    const float* base = W; int col = n;
    if (kind == 1) {
        if (n < 2048) { const int hl = n & 63; col = (n & ~63) + (hl < 16 ? ((hl & 1) ? (hl >> 1) + 8 : (hl >> 1)) : hl); }
        else if (n < 3072) col = n;
        else if (n < 5120) col = 3744 + (n - 3072);
        else if (n < 5376) col = 3456 + (n - 5120);
        else if (n < 5760) col = 3072 + (n - 5376);
        else if (n < 5792) { const int hl = n - 5760; col = 3712 + ((hl & 1) ? (hl >> 1) + 16 : (hl >> 1)); }
        else col = -1;
    } else if (kind == 2) { const int h = n / 96, hl = n % 96; int s = hl; if (hl >= 64) { const int r = hl - 64; s = 64 + ((r & 1) ? (r >> 1) + 16 : (r >> 1)); } col = h * 96 + s;
    } else if (kind == 3) { const int pn = n >> 8, r = n & 255; col = pn * 128 + (r >> 6) * 32 + (r & 31); if (r & 32) base = W2; }
    const float* src = base + (size_t)(k0 + ks) * ld + (col >= 0 ? col : 0);
    float v[32];
#pragma unroll
    for (int i = 0; i < 32; ++i) v[i] = __builtin_nontemporal_load(src + (size_t)(2 * i) * ld);
    if (col < 0) {
#pragma unroll
        for (int i = 0; i < 32; ++i) v[i] = 0.f;
    }
    if (gain) { const float* gp = gain + k0 + ks;
#pragma unroll
        for (int i = 0; i < 32; ++i) v[i] *= gp[2 * i]; }
#pragma unroll
    for (int i = 0; i < 32; ++i) scr[(2 * i + ks) * 33 + nl] = v[i];
    asm volatile("s_waitcnt lgkmcnt(0)" ::: "memory");
    const int c = lane & 7;
#pragma unroll
    for (int j = 0; j < 4; ++j) { const int nn = (lane >> 3) + 8 * j; const LAS float* s = scr + (8 * c) * 33 + nn;
        v4u o; o.x = pg8::pk2(s[0], s[33]); o.y = pg8::pk2(s[2 * 33], s[3 * 33]); o.z = pg8::pk2(s[4 * 33], s[5 * 33]); o.w = pg8::pk2(s[6 * 33], s[7 * 33]);
        *(v4u*)(WT + (size_t)(n0 + nn) * K + k0 + 8 * c) = o; }
    asm volatile("s_waitcnt lgkmcnt(0)" ::: "memory");
}

#define WSP(T, off) ((T*)(a.ws + (off)))
#define tabD WSP(float, WS_TABD)
#define tabM WSP(float, WS_TABM)
#define lamp WSP(float, WS_LAM)
#define SSQ WSP(float, WS_SSQ)
#define SSKV WSP(float, WS_SSKV)
#define SS1 WSP(float, WS_SS1)
#define SS2 WSP(float, WS_SS2)
#define SS3 WSP(float, WS_SS3)
#define Win WSP(bf16, WS_WIN)
#define Wgu WSP(bf16, WS_WGU)
#define Wdn WSP(bf16, WS_WDN)
#define Wod WSP(bf16, WS_WOD)
#define Wout WSP(bf16, WS_WOUT)
#define Wpg WSP(bf16, WS_WPG)
#define Wom WSP(bf16, WS_WOM)
#define Wuq WSP(bf16, WS_WUQ)
#define Wukv WSP(bf16, WS_WUKV)
#define Wple WSP(bf16, WS_WPLE)
#define PB WSP(bf16, WS_PB)
#define XN WSP(bf16, WS_XN)
#define QM WSP(bf16, WS_QM)
#define X1B WSP(bf16, WS_X1B)
#define QD WSP(bf16, WS_QD)
#define KD WSP(bf16, WS_KD)
#define VD WSP(bf16, WS_VD)
#define KVM WSP(bf16, WS_KVM)
#define MG WSP(bf16, WS_MG)
#define HID WSP(bf16, WS_HID)
#define X2B WSP(bf16, WS_X2B)
#define CKV WSP(bf16, WS_CKV)
#define CQ WSP(bf16, WS_CQ)
#define KR WSP(bf16, WS_KR)
#define ODM WSP(bf16, WS_ODM)
#define Wcat WSP(bf16, WS_WCAT)
#define TBUF WSP(bf16, WS_T)
#define X3B WSP(bf16, WS_X3B)
#define T2B WSP(bf16, WS_T2B)
#define SA ((bf16*)a.out)
#define SB ((bf16*)a.out + (size_t)M_TOK * 1024)
template <class E> __device__ __forceinline__ void run_gemm(LAS unsigned char* lds, const bf16* A, const bf16* Bt, int N, int K, const E& e) {
    asm volatile("" : "+s"(K));
    pg8::Gemm g{A, Bt, M_TOK, N, K}; pg8::StaticOrder S; S.init(M_TOK, N, (int)gridDim.x, (int)blockIdx.x);
    pg8::gemm_phase<E, pg8::StaticOrder, true, true>(lds, g, S, e);
}

__global__ void __launch_bounds__(NWAVES * 64, 2) fwd_megakernel(Args a) {
    extern __shared__ __attribute__((aligned(16))) unsigned char lds_raw[];
    cg::grid_group grid = cg::this_grid();
    LAS unsigned char* lds = (LAS unsigned char*)lds_raw;
    int tid0_ = threadIdx.x; asm volatile("" : "+v"(tid0_)); const int tid = tid0_, lane = tid & 63, wave = __builtin_amdgcn_readfirstlane(tid >> 6);
    const int G = gridDim.x, gw = blockIdx.x * NWAVES + wave, NGW = G * NWAVES;
    volatile LAS unsigned* bst = (volatile LAS unsigned*)(lds + (LDS_BYTES - 64));
    if (tid < 2) bst[tid] = 0u;
    __syncthreads();
    const XcdBarrier xbar = xcd_barrier_post((unsigned*)(a.ws + WS_BAR), bst);
#if !defined(SKIP_P0)
    {
        LAS float* scr = (LAS float*)(lds + wave * 8448);
        constexpr int I0 = 16 * 184, I1 = I0 + 16 * 176, I2 = I1 + 44 * 32, I3 = I2 + 512, I4 = I3 + 512, I5 = I4 + 512, I6 = I5 + 256, I7 = I6 + 144, I8 = I7 + 128, I9 = I8 + 128;
        for (int it = gw; it < I9; it += NGW) {
            if (it < I0)      wprep_item(1, a.w_in, nullptr, 5792, 1024, 5888, nullptr, Win, it, scr, lane);
            else if (it < I1) wprep_item(3, a.w_ffn_gate, a.w_ffn_up, 2816, 1024, 5632, a.ffn_norm, Wgu, it - I0, scr, lane);
            else if (it < I2) wprep_item(0, a.w_ffn_down, nullptr, 1024, 2816, 1024, nullptr, Wdn, it - I1, scr, lane);
            else if (it < I3) wprep_item(0, a.w_o_diff, nullptr, 1024, 1536, 1024, nullptr, Wcat, it - I2, scr, lane);
            else if (it < I4) wprep_item(0, a.w_out, nullptr, 1024, 1024, 1024, nullptr, Wout, it - I3, scr, lane);
            else if (it < I5) wprep_item(0, a.w_ple_gate, nullptr, 1024, 1024, 1024, a.ple_norm, Wpg, it - I4, scr, lane);
            else if (it < I6) wprep_item(0, a.w_o_mla, nullptr, 1024, 1536, 1024, nullptr, Wcat + 1024, it - I5, scr, lane);
            else if (it < I7) wprep_item(2, a.w_uq, nullptr, 768, 384, 768, a.q_norm, Wuq, it - I6, scr, lane);
            else if (it < I8) wprep_item(0, a.w_ukv, nullptr, 1024, 256, 1024, a.kv_norm, Wukv, it - I7, scr, lane);
            else              wprep_item(0, a.w_ple, nullptr, 1024, 256, 1024, nullptr, Wple, it - I8, scr, lane);
        }
        for (int r0 = gw * 4; r0 < M_TOK; r0 += NGW * 4) {
            f32x4 v[4][4]; float s[4];
#pragma unroll
            for (int q = 0; q < 4; ++q) { const f32x4* xr = (const f32x4*)(a.x + (size_t)(r0 + q) * 1024) + lane; s[q] = 0.f;
#pragma unroll
                for (int j = 0; j < 4; ++j) v[q][j] = __builtin_nontemporal_load(xr + 64 * j); }
            f32x4 pq[4];
#pragma unroll
            for (int q = 0; q < 4; ++q) pq[q] = __builtin_nontemporal_load((const f32x4*)(a.p + (size_t)(r0 + q) * 256) + lane);
#pragma unroll
            for (int q = 0; q < 4; ++q) {
#pragma unroll
                for (int j = 0; j < 4; ++j) s[q] += pg8::sq4(v[q][j]);
                const float rstd = __builtin_amdgcn_rsqf(wave_sum(s[q]) * (1.f / 1024.f) + NEPS);
                v2u* o8 = (v2u*)(XN + (size_t)(r0 + q) * 1024) + lane;
#pragma unroll
                for (int j = 0; j < 4; ++j) { const f32x4 g = ((const f32x4*)a.attn_norm)[lane + 64 * j]; const f32x4 y = v[q][j] * rstd * g; v2u w; w.x = pg8::pk2(y[0], y[1]); w.y = pg8::pk2(y[2], y[3]); o8[64 * j] = w; }
                v2u wp; wp.x = pg8::pk2(pq[q][0], pq[q][1]); wp.y = pg8::pk2(pq[q][2], pq[q][3]); ((v2u*)(PB + (size_t)(r0 + q) * 256))[lane] = wp; }
        }
        { const int gt = blockIdx.x * 512 + tid, GT = G * 512;
          for (int i = gt; i < 2048 * 24; i += GT) {
              const int pos = i / 24, f = i % 24; const bool dm = f < 8; const int fi = dm ? f : f - 8;
              const float invf = dm ? __builtin_amdgcn_exp2f(-18.931568569324174f * (float)fi * 0.125f) : __builtin_amdgcn_exp2f(-13.287712379549449f * (float)fi * 0.0625f);
              const float ang = (float)pos * invf; const double rev = (double)ang * 0.15915494309189535; const float fr = (float)(rev - floor(rev));
              const float cs = __builtin_amdgcn_cosf(fr), sn = __builtin_amdgcn_sinf(fr);
              float* dst = dm ? tabD + ((size_t)pos * 8 + fi) * 2 : tabM + ((size_t)pos * 16 + fi) * 2; dst[0] = cs; dst[1] = sn;
          }
          if (blockIdx.x == 0 && wave == 0) { const float s1 = wave_sum(a.lam_q1[lane] * a.lam_k1[lane]), s2 = wave_sum(a.lam_q2[lane] * a.lam_k2[lane]); if (lane == 0) lamp[0] = __expf(s1) - __expf(s2) + 0.2f; }
        }
    }
    xcd_barrier(xbar);
    if (a.ws == nullptr) grid.sync();
    #endif

#if !defined(SKIP_P1)
    { pg8::EpiInProj e{QD, KD, VD, SA, SB, CKV, CQ, KR, SSQ, SSKV, a.b_gate, tabD, tabM}; run_gemm(lds, XN, Win, 5888, 1024, e); }
    xcd_barrier(xbar);
    #endif

#if !defined(SKIP_P2)
    { pg8::EpiQUp e{SSQ, tabM, QM}; run_gemm(lds, CQ, Wuq, 768, 384, e); }
    { pg8::EpiKVUp e{SSKV, KVM}; run_gemm(lds, CKV, Wukv, 1024, 256, e); }
    xcd_barrier(xbar);
    #endif

#if !defined(SKIP_P3)
    {
        const float lam = lamp[0];
        for (int i = blockIdx.x; i < 2048; i += G) {
            const int type = i >> 10, rem = i & 1023, j = rem >> 8, half = (rem >> 7) & 1, bh = rem & 127;
            const int qb = half ? (j == 0 ? 6 : j == 1 ? 4 : j == 2 ? 3 : 1) : (j == 0 ? 7 : j == 1 ? 5 : j == 2 ? 2 : 0);
            if (type == 0) att::diff_unit((ATT_LAS char*)lds, bh >> 3, bh & 7, qb, QD, KD, VD, ODM, a.diff_subln, lam);
            else           att::mla_unit((ATT_LAS char*)lds, bh >> 3, bh & 7, qb, QM, KVM, KR, ODM);
        }
    }
    xcd_barrier(xbar);
    #endif

#if !defined(SKIP_P4)
    { pg8::EpiMerge e{SA, SB, MG}; run_gemm(lds, ODM, Wcat, 1024, 1536, e); }
    xcd_barrier(xbar);
    #endif

#if !defined(SKIP_P5)
    { pg8::EpiResid<false> e{a.x, X1B, SS1}; run_gemm(lds, MG, Wout, 1024, 1024, e); }
    xcd_barrier(xbar);
    #endif

#if !defined(SKIP_P6)
    { pg8::EpiSwiGLU e{SS1, HID}; run_gemm(lds, X1B, Wgu, 5632, 1024, e); }
    xcd_barrier(xbar);
    #endif

#if !defined(SKIP_P7)
    { pg8::EpiResid<true> e{X1B, X2B, SS2}; run_gemm(lds, HID, Wdn, 1024, 2816, e); }
    xcd_barrier(xbar);
    #endif

#if !defined(SKIP_P8)
    { pg8::EpiPleA e{T2B}; run_gemm(lds, PB, Wple, 1024, 256, e); }
    { pg8::EpiPleB e{SS2, a.b_ple_gate, X2B, T2B, X3B, SS3}; run_gemm(lds, X2B, Wpg, 1024, 1024, e); }
    xcd_barrier(xbar);
    #endif

#if !defined(SKIP_P9)
    { int t9_ = threadIdx.x; asm volatile("" : "+v"(t9_)); const int lane = t9_ & 63, gw = blockIdx.x * NWAVES + __builtin_amdgcn_readfirstlane(t9_ >> 6), NGW = gridDim.x * NWAVES;
    for (int r0 = gw * 4; r0 < M_TOK; r0 += NGW * 4) {
        v4u w[4][2]; float s[4];
#pragma unroll
        for (int q = 0; q < 4; ++q) { const v4u* xr = (const v4u*)(X3B + (size_t)(r0 + q) * 1024) + lane; w[q][0] = xr[0]; w[q][1] = xr[64]; s[q] = (lane < 16) ? SS3[(size_t)(r0 + q) * 16 + lane] : 0.f; }
#pragma unroll
        for (int q = 0; q < 4; ++q) { const float rstd = __builtin_amdgcn_rsqf(wave_sum(s[q]) * (1.f / 1024.f) + NEPS);
#pragma unroll
            for (int j = 0; j < 2; ++j) { const int c = (lane + 64 * j) * 8; const f32x4 g0 = *(const f32x4*)(a.final_norm + c), g1 = *(const f32x4*)(a.final_norm + c + 4); const v4u ww = w[q][j];
                f32x4 x0, x1; x0[0] = __uint_as_float(ww.x << 16); x0[1] = __uint_as_float(ww.x & 0xffff0000u); x0[2] = __uint_as_float(ww.y << 16); x0[3] = __uint_as_float(ww.y & 0xffff0000u);
                x1[0] = __uint_as_float(ww.z << 16); x1[1] = __uint_as_float(ww.z & 0xffff0000u); x1[2] = __uint_as_float(ww.w << 16); x1[3] = __uint_as_float(ww.w & 0xffff0000u);
                float* o = a.out + (size_t)(r0 + q) * 1024 + c; __builtin_nontemporal_store(x0 * rstd * g0, (f32x4*)o); __builtin_nontemporal_store(x1 * rstd * g1, (f32x4*)(o + 4)); } }
    } }
#endif
}

extern "C" void kernel_launch(void* const* d_in, const int* in_sizes, int n_in, void* d_out, int out_size, void* d_ws, size_t ws_size, hipStream_t stream) {
    static int grid = 0;
    if (grid == 0) {
        if (n_in != 26 || out_size != M_TOK * 1024 || ws_size < WS_END) { fprintf(stderr, "kernel_launch: unexpected shapes (n_in %d out %d ws %zu)\n", n_in, out_size, ws_size); grid = -1; return; }
        int dev = 0, cus = 0, per_cu = 0;
        (void)hipGetDevice(&dev); (void)hipDeviceGetAttribute(&cus, hipDeviceAttributeMultiprocessorCount, dev);
        (void)hipFuncSetAttribute((const void*)fwd_megakernel, hipFuncAttributeMaxDynamicSharedMemorySize, LDS_BYTES);
        if (hipOccupancyMaxActiveBlocksPerMultiprocessor(&per_cu, (const void*)fwd_megakernel, NWAVES * 64, LDS_BYTES) != hipSuccess || per_cu < 1) per_cu = 1;
        (void)hipGetLastError();
        grid = cus * per_cu;
    }
    if (grid < 0) return;
    Args a{};
    const float** f = (const float**)&a;
    for (int i = 0; i < 26; ++i) f[i] = (const float*)d_in[i];
    a.out = (float*)d_out; a.ws = (unsigned char*)d_ws;
    (void)hipMemsetAsync((char*)d_ws + WS_BAR, 0, 16384, stream);
    void* args[] = {&a};
    hipError_t e = hipLaunchCooperativeKernel((const void*)fwd_megakernel, dim3(grid), dim3(NWAVES * 64), args, LDS_BYTES, stream);
    if (e != hipSuccess) fprintf(stderr, "cooperative launch failed: %s (grid %d)\n", hipGetErrorString(e), grid);
}
```
